# Optimizing an MI355X kernel written in HIP

```python
import math
import jax, jax.numpy as jnp
from jax import lax
import numpy as np

D_MODEL = 1024
BATCH = 8
SEQ = 8192
DEPTH = 1

MIX_WIDTH = D_MODEL
GM_WIDTH = MIX_WIDTH // 2
GM_HEADS = 4
GM_HEAD_DIM = GM_WIDTH // GM_HEADS
CHUNK = 128
SSM_WIDTH = MIX_WIDTH - GM_WIDTH
SSM_GROUP = 16
SSM_GROUPS = SSM_WIDTH // SSM_GROUP
SSM_STATE = 64
IN_WIDTH = 2 * GM_WIDTH + SSM_WIDTH
PEER_HEADS = 8
PEER_NKEYS = 128
PEER_EXPERTS = PEER_NKEYS * PEER_NKEYS
PEER_TOPK = 16
PEER_DKEY = 128
PEER_BLOCK = 128
N_MOD = 6
EPS = 1e-6

kernel_name = "hybrid_gmlp_s5_peer_adaln_block"


def _rmsnorm(x, g):
    xf = x.astype(jnp.float32)
    y = xf * lax.rsqrt(jnp.mean(xf * xf, axis=-1, keepdims=True) + EPS)
    return (y * g.astype(jnp.float32)).astype(x.dtype)


def _layernorm(x, g, b):
    xf = x.astype(jnp.float32)
    mu = jnp.mean(xf, axis=-1, keepdims=True)
    var = jnp.mean(jnp.square(xf - mu), axis=-1, keepdims=True)
    y = (xf - mu) * lax.rsqrt(var + EPS)
    return (y * g.astype(jnp.float32) + b.astype(jnp.float32)).astype(x.dtype)


def _sgu(zu, zv, ln_g, ln_b, w_s, b_s):
    u = jax.nn.gelu(zu)
    v = _layernorm(jax.nn.gelu(zv), ln_g, ln_b)
    bsz, seq, _ = v.shape
    vc = v.reshape(bsz, seq // CHUNK, CHUNK, GM_HEADS, GM_HEAD_DIM)
    mask = jnp.tril(jnp.ones((CHUNK, CHUNK), dtype=w_s.dtype))
    mixed = jnp.einsum('hij,bnjhd->bnihd', w_s * mask, vc)
    mixed = mixed + jnp.transpose(b_s)[:, :, None]
    return u * mixed.reshape(bsz, seq, GM_WIDTH)


def _ssm_combine(e1, e2):
    a1, b1 = e1
    a2, b2 = e2
    return a1 * a2, a2 * b1 + b2


def _s5(u, a_re, a_im, log_dt, b_re, b_im, c_re, c_im, d_skip, w_glu, b_glu):
    f32 = jnp.float32
    bsz, seq, _ = u.shape
    lam = lax.complex(jnp.minimum(a_re.astype(f32), -1e-4), a_im.astype(f32))
    delta = jnp.exp(log_dt.astype(f32))[:, None]
    a_bar = jnp.exp(lam * delta)
    b_mat = lax.complex(b_re.astype(f32), b_im.astype(f32))
    b_bar = ((a_bar - 1.0) / lam)[:, :, None] * b_mat
    c_mat = lax.complex(c_re.astype(f32), c_im.astype(f32))
    ug = u.astype(f32).reshape(bsz, seq, SSM_GROUPS, SSM_GROUP)

    def one_sequence(us):
        bu = jnp.einsum('gph,sgh->sgp', b_bar, us.astype(jnp.complex64))
        a = jnp.broadcast_to(a_bar, bu.shape)
        _, states = lax.associative_scan(_ssm_combine, (a, bu), axis=0)
        return jnp.einsum('ghp,sgp->sgh', c_mat, states).real

    y = lax.map(one_sequence, ug) + d_skip.astype(f32) * ug
    y = jax.nn.gelu(y.reshape(bsz, seq, SSM_WIDTH))
    y = y * jax.nn.sigmoid(y @ w_glu.astype(f32) + b_glu.astype(f32))
    return y.astype(u.dtype)


def _peer(h, w_q, keys, u_tab, v_tab):
    f32 = jnp.float32
    bsz, seq, dm = h.shape
    hb = h.reshape(-1, PEER_BLOCK, dm)

    def block(t):
        tb = t.shape[0]
        q = (t @ w_q).reshape(tb, PEER_HEADS, 2, PEER_DKEY // 2)
        s = jnp.einsum('thcd,hckd->thck', q.astype(f32), keys.astype(f32))
        top_s, top_i = lax.top_k(s, PEER_TOPK)
        cand_s = (top_s[:, :, 0, :, None] + top_s[:, :, 1, None, :]).reshape(tb, PEER_HEADS, -1)
        cand_i = (top_i[:, :, 0, :, None] * PEER_NKEYS + top_i[:, :, 1, None, :]).reshape(tb, PEER_HEADS, -1)
        best_s, pos = lax.top_k(cand_s, PEER_TOPK)
        idx = jnp.take_along_axis(cand_i, pos, axis=-1)
        g = jax.nn.softmax(best_s, axis=-1)
        act = jax.nn.gelu(jnp.einsum('thkd,td->thk', u_tab[idx], t).astype(f32))
        w = (g * act).astype(t.dtype)
        return jnp.einsum('thk,thkd->td', w, v_tab[idx])

    return lax.map(block, hb).reshape(bsz, seq, dm)


def setup_inputs(seed: int = 0) -> dict:
    key = jax.random.key(seed)
    ks = jax.random.split(key, 32)
    f32 = jnp.float32

    def nrm(k, shape, scale):
        return jax.random.normal(k, shape, f32) * scale

    L = DEPTH
    n_idx = jnp.arange(SSM_STATE, dtype=f32)
    a_im = jnp.broadcast_to(math.pi * n_idx, (L, SSM_GROUPS, SSM_STATE)) + nrm(ks[11], (L, SSM_GROUPS, SSM_STATE), 0.01)
    a_re = -0.5 + nrm(ks[10], (L, SSM_GROUPS, SSM_STATE), 0.01)
    log_dt = jax.random.uniform(ks[12], (L, SSM_GROUPS), f32, math.log(1e-3), math.log(1e-1))
    return {
        "x": nrm(ks[0], (BATCH, SEQ, D_MODEL), 1.0),
        "c": nrm(ks[1], (BATCH, D_MODEL), 1.0),
        "w_ada": nrm(ks[2], (L, D_MODEL, N_MOD * D_MODEL), 0.5 * D_MODEL ** -0.5),
        "b_ada": nrm(ks[3], (L, N_MOD * D_MODEL), 0.02),
        "g_mix": 1.0 + nrm(ks[4], (L, D_MODEL), 0.02),
        "w_in": nrm(ks[5], (L, D_MODEL, IN_WIDTH), D_MODEL ** -0.5),
        "sgu_ln_g": 1.0 + nrm(ks[6], (L, GM_WIDTH), 0.02),
        "sgu_ln_b": nrm(ks[7], (L, GM_WIDTH), 0.02),
        "w_s": nrm(ks[8], (L, GM_HEADS, CHUNK, CHUNK), CHUNK ** -0.5),
        "b_s": 1.0 + nrm(ks[9], (L, GM_HEADS, CHUNK), 0.02),
        "ssm_a_re": a_re,
        "ssm_a_im": a_im,
        "ssm_log_dt": log_dt,
        "ssm_b_re": nrm(ks[13], (L, SSM_GROUPS, SSM_STATE, SSM_GROUP), (2 * SSM_GROUP) ** -0.5),
        "ssm_b_im": nrm(ks[14], (L, SSM_GROUPS, SSM_STATE, SSM_GROUP), (2 * SSM_GROUP) ** -0.5),
        "ssm_c_re": nrm(ks[15], (L, SSM_GROUPS, SSM_GROUP, SSM_STATE), 2.0 * SSM_STATE ** -0.5),
        "ssm_c_im": nrm(ks[16], (L, SSM_GROUPS, SSM_GROUP, SSM_STATE), 2.0 * SSM_STATE ** -0.5),
        "ssm_d": nrm(ks[17], (L, SSM_GROUPS, SSM_GROUP), 0.5),
        "w_glu": nrm(ks[18], (L, SSM_WIDTH, SSM_WIDTH), SSM_WIDTH ** -0.5),
        "b_glu": nrm(ks[19], (L, SSM_WIDTH), 0.02),
        "w_out": nrm(ks[20], (L, MIX_WIDTH, D_MODEL), MIX_WIDTH ** -0.5),
        "g_ffn": 1.0 + nrm(ks[21], (L, D_MODEL), 0.02),
        "w_q": nrm(ks[22], (L, D_MODEL, PEER_HEADS * PEER_DKEY), D_MODEL ** -0.5),
        "peer_keys": nrm(ks[23], (L, PEER_HEADS, 2, PEER_NKEYS, PEER_DKEY // 2), (PEER_DKEY // 2) ** -0.5),
        "peer_u": nrm(ks[24], (L, PEER_EXPERTS, D_MODEL), D_MODEL ** -0.5),
        "peer_v": nrm(ks[25], (L, PEER_EXPERTS, D_MODEL), PEER_HEADS ** -0.5),
        "g_final": 1.0 + nrm(ks[26], (D_MODEL,), 0.02),
    }


def reference(x, c, w_ada, b_ada, g_mix, w_in, sgu_ln_g, sgu_ln_b, w_s, b_s,
              ssm_a_re, ssm_a_im, ssm_log_dt, ssm_b_re, ssm_b_im, ssm_c_re, ssm_c_im,
              ssm_d, w_glu, b_glu, w_out, g_ffn, w_q, peer_keys, peer_u, peer_v, g_final):
    cond = jax.nn.silu(c)
    for l in range(DEPTH):
        mod = cond @ w_ada[l] + b_ada[l]
        sh1, sc1, gt1, sh2, sc2, gt2 = jnp.split(mod[:, None, :], N_MOD, axis=-1)

        h = _rmsnorm(x, g_mix[l]) * (1.0 + sc1) + sh1
        z = h @ w_in[l]
        zu = z[..., :GM_WIDTH]
        zv = z[..., GM_WIDTH:2 * GM_WIDTH]
        zs = z[..., 2 * GM_WIDTH:]
        y_gm = _sgu(zu, zv, sgu_ln_g[l], sgu_ln_b[l], w_s[l], b_s[l])
        y_ssm = _s5(zs, ssm_a_re[l], ssm_a_im[l], ssm_log_dt[l], ssm_b_re[l], ssm_b_im[l],
                    ssm_c_re[l], ssm_c_im[l], ssm_d[l], w_glu[l], b_glu[l])
        y = jnp.concatenate([y_gm, y_ssm], axis=-1) @ w_out[l]
        x = x + gt1 * y

        h2 = _rmsnorm(x, g_ffn[l]) * (1.0 + sc2) + sh2
        x = x + gt2 * _peer(h2, w_q[l], peer_keys[l], peer_u[l], peer_v[l])
    return _rmsnorm(x, g_final)
```

```cpp
#include <hip/hip_runtime.h>
#include <hip/hip_cooperative_groups.h>
#include <cstdio>
#include <cstdint>
namespace cg = cooperative_groups;

#ifndef N_LAUNCHES
#define N_LAUNCHES 1
#endif

#define GAS __attribute__((address_space(1)))
#define LAS __attribute__((address_space(3)))
namespace pg8 {
#define PG8_LAS __attribute__((address_space(3)))
typedef unsigned short bf16_t;
typedef short bf16x8 __attribute__((ext_vector_type(8)));
typedef float f32x4 __attribute__((ext_vector_type(4)));
typedef unsigned u32x4 __attribute__((ext_vector_type(4)));
constexpr int BM = 256, BK = 64, HALF = 128, HTB = HALF * BK * 2  , STAGE_BYTES = 8 * HTB, NXCD = 8, WGM = 8;

__host__ __device__ __forceinline__ int lds_byte(int r, int c) { const int st = (r >> 4) * 2 + (c >> 5), rr = r & 15, cc = c & 31, ob = rr * 64 + cc * 2; return st * 1024 + (ob ^ (((ob >> 9) & 1) << 5)); }
__host__ __device__ __forceinline__ void stage_rc(int b, int& R, int& C) { const int st = b / 1024, sb = b % 1024, swz = sb ^ (((sb >> 9) & 1) << 5); R = (st >> 1) * 16 + swz / 64; C = (st & 1) * 32 + (swz % 64) / 2; }
__host__ __device__ __forceinline__ int perm32(int rho) { const int n = rho >> 4, i = rho & 15; return 8 * (i >> 2) + 4 * n + (i & 3); }

struct Unit { int pm, pn; };
struct Gemm { const bf16_t* A; const bf16_t* Bt; int M, N, K; };

struct StaticOrder {
    int nM, nN, nwg, G, c;
    __host__ __device__ void init(int M, int N, int G_, int c_) { nM = M / BM; nN = N / BM; nwg = nM * nN; G = G_; c = c_; }
    __host__ __device__ bool next(int i, Unit& u) const {
        const long L = (long)i * G + c; if (L >= nwg) return false;
        int wgid = (int)L; { const int q = nwg / NXCD, r = nwg % NXCD, xcd = wgid % NXCD, off = wgid / NXCD; wgid = (xcd < r ? xcd * (q + 1) : r * (q + 1) + (xcd - r) * q) + off; }
        const int nig = WGM * nN, gid = wgid / nig, fm = gid * WGM, gsz = (nM - fm) < WGM ? (nM - fm) : WGM;
        u.pm = fm + ((wgid % nig) % gsz); u.pn = (wgid % nig) / gsz; return true;
    }
    __device__ __forceinline__ void a_ready(const Unit&) const {}
    __device__ __forceinline__ void done(const Unit&) const {}
};

typedef float f32x2 __attribute__((ext_vector_type(2)));
__device__ __forceinline__ unsigned cvt_pk_bf16(float lo, float hi) { unsigned r; asm volatile("v_cvt_pk_bf16_f32 %0, %1, %2" : "=v"(r) : "v"(lo), "v"(hi)); return r; }
__device__ __forceinline__ float bf_lo(unsigned u) { return __builtin_bit_cast(float, u << 16); }
__device__ __forceinline__ float bf_hi(unsigned u) { return __builtin_bit_cast(float, u & 0xffff0000u); }
__device__ __forceinline__ float gelu_t(float x) { const float t = x * (1.0f + 0.044715f * x * x) * (-2.3022082f); return x * __builtin_amdgcn_rcpf(1.0f + __builtin_amdgcn_exp2f(t)); }
__device__ __forceinline__ float sigmoid_f(float x) { return __builtin_amdgcn_rcpf(1.0f + __builtin_amdgcn_exp2f(x * -1.4426950409f)); }

struct EpiIn { static constexpr bool PERM = true, AFTER_DRAIN = false; bf16_t* ZG; bf16_t* ZS;
    __device__ __forceinline__ void operator()(const f32x4 (&acc)[2][2][4][2], const Unit& u, int wr, int wc, int fr, int fq) const {
        const int row0 = u.pm * BM + wr * 64 + fr, colt = u.pn * BM;
#pragma unroll
        for (int ai = 0; ai < 2; ++ai)
#pragma unroll
            for (int m = 0; m < 4; ++m) { const int row = row0 + ai * HALF + m * 16;
#pragma unroll
                for (int bj = 0; bj < 2; ++bj) { const int col = colt + bj * HALF + wc * 32 + 8 * fq; f32x4 v0 = acc[ai][bj][m][0], v1 = acc[ai][bj][m][1]; u32x4 w;
                    if (colt < 1024) {
                        w.x = cvt_pk_bf16(gelu_t(v0[0]), gelu_t(v0[1])); w.y = cvt_pk_bf16(gelu_t(v0[2]), gelu_t(v0[3])); w.z = cvt_pk_bf16(gelu_t(v1[0]), gelu_t(v1[1])); w.w = cvt_pk_bf16(gelu_t(v1[2]), gelu_t(v1[3]));
                        *(u32x4*)(ZG + (size_t)row * 1024 + col) = w;
                    } else {
                        w.x = cvt_pk_bf16(v0[0], v0[1]); w.y = cvt_pk_bf16(v0[2], v0[3]); w.z = cvt_pk_bf16(v1[0], v1[1]); w.w = cvt_pk_bf16(v1[2], v1[3]);
                        const int cs = col - 1024, g = cs >> 4, ch = cs & 15, b = row >> 13, s = row & 8191;
                        *(u32x4*)(ZS + ((((size_t)(b * 32 + g)) * 8192 + s) << 4) + ch) = w;
                    } } }
    }
};
struct EpiGlu { static constexpr bool PERM = true, AFTER_DRAIN = false; const bf16_t* YS; const float* bglu; bf16_t* Y;
    __device__ __forceinline__ void operator()(const f32x4 (&acc)[2][2][4][2], const Unit& u, int wr, int wc, int fr, int fq) const {
        const int row0 = u.pm * BM + wr * 64 + fr, colt = u.pn * BM;
#pragma unroll
        for (int bj = 0; bj < 2; ++bj) { const int col = colt + bj * HALF + wc * 32 + 8 * fq; const f32x4 b0 = *(const f32x4*)(bglu + col), b1 = *(const f32x4*)(bglu + col + 4);
#pragma unroll
            for (int ai = 0; ai < 2; ++ai)
#pragma unroll
                for (int m = 0; m < 4; ++m) { const int row = row0 + ai * HALF + m * 16; const f32x4 v0 = acc[ai][bj][m][0] + b0, v1 = acc[ai][bj][m][1] + b1;
                    const u32x4 ys = *(const u32x4*)(YS + (size_t)row * 512 + col); u32x4 w;
                    w.x = cvt_pk_bf16(bf_lo(ys.x) * sigmoid_f(v0[0]), bf_hi(ys.x) * sigmoid_f(v0[1])); w.y = cvt_pk_bf16(bf_lo(ys.y) * sigmoid_f(v0[2]), bf_hi(ys.y) * sigmoid_f(v0[3]));
                    w.z = cvt_pk_bf16(bf_lo(ys.z) * sigmoid_f(v1[0]), bf_hi(ys.z) * sigmoid_f(v1[1])); w.w = cvt_pk_bf16(bf_lo(ys.w) * sigmoid_f(v1[2]), bf_hi(ys.w) * sigmoid_f(v1[3]));
                    *(u32x4*)(Y + (size_t)row * 1024 + 512 + col) = w; } }
    }
};
struct EpiOut { static constexpr bool PERM = true, AFTER_DRAIN = false; const float* x; const float* mod; bf16_t* X1;
    __device__ __forceinline__ void operator()(const f32x4 (&acc)[2][2][4][2], const Unit& u, int wr, int wc, int fr, int fq) const {
        const int row0 = u.pm * BM + wr * 64 + fr, colt = u.pn * BM; const float* gt = mod + (size_t)((u.pm * BM) >> 13) * 6144 + 2048;
#pragma unroll
        for (int bj = 0; bj < 2; ++bj) { const int col = colt + bj * HALF + wc * 32 + 8 * fq; const f32x4 g0 = *(const f32x4*)(gt + col), g1 = *(const f32x4*)(gt + col + 4);
            f32x4 xv[8][2];
#pragma unroll
            for (int ai = 0; ai < 2; ++ai)
#pragma unroll
                for (int m = 0; m < 4; ++m) { const size_t o = (size_t)(row0 + ai * HALF + m * 16) * 1024 + col;
                    xv[ai * 4 + m][0] = __builtin_nontemporal_load((const f32x4*)(x + o)); xv[ai * 4 + m][1] = __builtin_nontemporal_load((const f32x4*)(x + o + 4)); }
            __builtin_amdgcn_sched_barrier(0);
#pragma unroll
            for (int ai = 0; ai < 2; ++ai)
#pragma unroll
                for (int m = 0; m < 4; ++m) { const size_t o = (size_t)(row0 + ai * HALF + m * 16) * 1024 + col;
                    const f32x4 v0 = xv[ai * 4 + m][0] + g0 * acc[ai][bj][m][0], v1 = xv[ai * 4 + m][1] + g1 * acc[ai][bj][m][1]; u32x4 w;
                    w.x = cvt_pk_bf16(v0[0], v0[1]); w.y = cvt_pk_bf16(v0[2], v0[3]); w.z = cvt_pk_bf16(v1[0], v1[1]); w.w = cvt_pk_bf16(v1[2], v1[3]);
                    *(u32x4*)(X1 + o) = w; }
            __builtin_amdgcn_sched_barrier(0); }
    }
};
struct EpiPlain { static constexpr bool PERM = true, AFTER_DRAIN = false; bf16_t* O; int ldc;
    __device__ __forceinline__ void operator()(const f32x4 (&acc)[2][2][4][2], const Unit& u, int wr, int wc, int fr, int fq) const {
        const int row0 = u.pm * BM + wr * 64 + fr, colt = u.pn * BM;
#pragma unroll
        for (int ai = 0; ai < 2; ++ai)
#pragma unroll
            for (int m = 0; m < 4; ++m) { const int row = row0 + ai * HALF + m * 16;
#pragma unroll
                for (int bj = 0; bj < 2; ++bj) { const int col = colt + bj * HALF + wc * 32 + 8 * fq; const f32x4 v0 = acc[ai][bj][m][0], v1 = acc[ai][bj][m][1]; u32x4 w;
                    w.x = cvt_pk_bf16(v0[0], v0[1]); w.y = cvt_pk_bf16(v0[2], v0[3]); w.z = cvt_pk_bf16(v1[0], v1[1]); w.w = cvt_pk_bf16(v1[2], v1[3]);
                    *(u32x4*)(O + (size_t)row * ldc + col) = w; } }
    }
};
template <class Epi, class Sched, bool ALIGN_EPI = false, bool SP2 = false>
__device__ __forceinline__ void gemm_phase(PG8_LAS unsigned char* lds, const Gemm g, const Sched& S, const Epi& E) {
    const int tid = threadIdx.x, wid = __builtin_amdgcn_readfirstlane(tid >> 6), lane = tid & 63, wr = wid >> 2, wc = wid & 3, fr = lane & 15, fq = lane >> 4;
    const int K = g.K, nt = K / BK;
    unsigned voffA[2], voffB[2];
#pragma unroll
    for (int i = 0; i < 2; ++i) { int R, C; stage_rc(tid * 16 + i * 8192, R, C); const int Rb = Epi::PERM ? ((R & ~31) + perm32(R & 31)) : R;
        voffA[i] = (unsigned)(R * K + C) * 2u; voffB[i] = (unsigned)(Rb * K + C) * 2u; }
    const size_t kstep = (size_t)(BK * 2);
    const size_t hstep = (size_t)HALF * K * 2;
    const size_t tstep = 2 * hstep;
    const unsigned ldsw = (unsigned)wid * 1024u;
    const int aoff = lds_byte(wr * 64 + fr, fq * 8), boff = lds_byte(wc * 32 + fr, fq * 8);
#define PG8_SA(b, h) (((b) * 2 + (h)) * HTB)
#define PG8_SB(b, h) ((4 + (b) * 2 + (h)) * HTB)
#define PG8_STAGE(bufoff, gbase, voff) do { _Pragma("unroll") for (int _i = 0; _i < 2; ++_i) \
        __builtin_amdgcn_global_load_lds((const unsigned*)((const char*)(gbase) + (voff)[_i]), (PG8_LAS unsigned*)(lds + (bufoff) + ldsw + _i * 8192), 16, 0, 0); } while (0)
#define PG8_LDA(dst, b, h) do { _Pragma("unroll") for (int m = 0; m < 4; ++m) _Pragma("unroll") for (int k = 0; k < 2; ++k) dst[m][k] = *(const PG8_LAS bf16x8*)(lds + PG8_SA(b, h) + aoff + m * 2048 + k * 1024); } while (0)
#define PG8_LDB(dst, b, h) do { _Pragma("unroll") for (int n = 0; n < 2; ++n) _Pragma("unroll") for (int k = 0; k < 2; ++k) dst[n][k] = *(const PG8_LAS bf16x8*)(lds + PG8_SB(b, h) + boff + n * 2048 + k * 1024); } while (0)
#define PG8_MMA(ai, bj, At, Bt) do { __builtin_amdgcn_s_setprio(1); _Pragma("unroll") for (int m = 0; m < 4; ++m) _Pragma("unroll") for (int n = 0; n < 2; ++n) _Pragma("unroll") for (int k = 0; k < 2; ++k) \
        acc[ai][bj][m][n] = __builtin_amdgcn_mfma_f32_16x16x32_bf16(Bt[n][k], At[m][k], acc[ai][bj][m][n], 0, 0, 0); __builtin_amdgcn_s_setprio(0); } while (0)
#define PG8_WAIT_V(n) asm volatile("s_waitcnt vmcnt(" #n ")" ::: "memory")
#define PG8_WAIT_L(n) asm volatile("s_waitcnt lgkmcnt(" #n ")" ::: "memory")
#define PG8_BAR __builtin_amdgcn_s_barrier()
#define PG8_SCHED __builtin_amdgcn_sched_barrier(0)
    Unit cur, nxt; int ui = 0;
    if (!S.next(0, cur)) return;
    f32x4 acc[2][2][4][2];
#pragma unroll
    for (int a = 0; a < 2; ++a)
#pragma unroll
        for (int b = 0; b < 2; ++b)
#pragma unroll
            for (int m = 0; m < 4; ++m)
#pragma unroll
                for (int n = 0; n < 2; ++n) acc[a][b][m][n] = (f32x4){0.f, 0.f, 0.f, 0.f};
    bf16x8 At[4][2], B0[2][2], B1[2][2];
    const char* cA = (const char*)g.A + (size_t)cur.pm * tstep; const char* cB = (const char*)g.Bt + (size_t)cur.pn * tstep;
    S.a_ready(cur);
    if constexpr (SP2) {
        PG8_STAGE(PG8_SB(0, 0), cB, voffB); PG8_STAGE(PG8_SB(0, 1), cB + hstep, voffB); PG8_STAGE(PG8_SA(0, 0), cA, voffA); PG8_STAGE(PG8_SA(0, 1), cA + hstep, voffA);
        if (wr == 1) PG8_BAR;
        PG8_WAIT_V(2); PG8_BAR;
        PG8_STAGE(PG8_SB(1, 0), cB + kstep, voffB); PG8_STAGE(PG8_SA(1, 0), cA + kstep, voffA); PG8_STAGE(PG8_SB(1, 1), cB + hstep + kstep, voffB);
        PG8_WAIT_V(6); PG8_BAR;
    } else {
        PG8_STAGE(PG8_SB(0, 0), cB, voffB); PG8_STAGE(PG8_SA(0, 0), cA, voffA); PG8_STAGE(PG8_SB(0, 1), cB + hstep, voffB); PG8_STAGE(PG8_SA(0, 1), cA + hstep, voffA);
        if (wr == 1) PG8_BAR;
        PG8_WAIT_V(4); PG8_BAR;
        PG8_STAGE(PG8_SB(1, 0), cB + kstep, voffB); PG8_STAGE(PG8_SA(1, 0), cA + kstep, voffA); PG8_STAGE(PG8_SB(1, 1), cB + hstep + kstep, voffB);
        PG8_WAIT_V(6); PG8_BAR;
    }
    for (;;) {
        const bool has_next = S.next(ui + 1, nxt);
        const char* nA = has_next ? (const char*)g.A + (size_t)nxt.pm * tstep : cA; const char* nB = has_next ? (const char*)g.Bt + (size_t)nxt.pn * tstep : cB;
        for (int t = 0; t < nt; t += 2) {
            const bool last = (t == nt - 2);
            const char* a1 = cA + (size_t)(t + 1) * kstep;
            const char* a2 = last ? nA : cA + (size_t)(t + 2) * kstep; const char* b2 = last ? nB : cB + (size_t)(t + 2) * kstep;
            const char* a3 = a2 + kstep; const char* b3 = b2 + kstep;
            if (last && has_next) S.a_ready(nxt);
            if constexpr (SP2) {
            PG8_LDB(B0, 0, 0); PG8_LDB(B1, 0, 1); PG8_SCHED; PG8_LDA(At, 0, 0); PG8_STAGE(PG8_SA(1, 1), a1 + hstep, voffA);
            PG8_WAIT_V(8); PG8_WAIT_L(0); PG8_BAR; PG8_MMA(0, 0, At, B0); PG8_MMA(0, 1, At, B1); PG8_BAR; PG8_SCHED;
            PG8_LDA(At, 0, 1); PG8_STAGE(PG8_SB(0, 0), b2, voffB); PG8_STAGE(PG8_SB(0, 1), b2 + hstep, voffB); PG8_STAGE(PG8_SA(0, 0), a2, voffA);
            PG8_WAIT_V(8); PG8_WAIT_L(0); PG8_BAR; PG8_MMA(1, 0, At, B0); PG8_MMA(1, 1, At, B1); PG8_BAR; PG8_SCHED;
            PG8_LDB(B0, 1, 0); PG8_LDB(B1, 1, 1); PG8_SCHED; PG8_LDA(At, 1, 0); PG8_STAGE(PG8_SA(0, 1), a2 + hstep, voffA);
            PG8_WAIT_V(8); PG8_WAIT_L(0); PG8_BAR; PG8_MMA(0, 0, At, B0); PG8_MMA(0, 1, At, B1); PG8_BAR; PG8_SCHED;
            PG8_LDA(At, 1, 1); PG8_STAGE(PG8_SB(1, 0), b3, voffB); PG8_STAGE(PG8_SB(1, 1), b3 + hstep, voffB); PG8_STAGE(PG8_SA(1, 0), a3, voffA);
            PG8_WAIT_V(8); PG8_WAIT_L(0); PG8_BAR; PG8_MMA(1, 0, At, B0); PG8_MMA(1, 1, At, B1); PG8_BAR; PG8_SCHED;
            } else {
            PG8_LDB(B0, 0, 0); PG8_SCHED; PG8_LDA(At, 0, 0); PG8_STAGE(PG8_SA(1, 1), a1 + hstep, voffA);
            PG8_WAIT_L(8); PG8_BAR; PG8_WAIT_L(0); PG8_MMA(0, 0, At, B0); PG8_BAR; PG8_SCHED;
            PG8_LDB(B1, 0, 1); PG8_STAGE(PG8_SB(0, 0), b2, voffB);
            PG8_BAR; PG8_WAIT_L(0); PG8_MMA(0, 1, At, B1); PG8_BAR;
            PG8_LDA(At, 0, 1); PG8_STAGE(PG8_SA(0, 0), a2, voffA);
            PG8_BAR; PG8_WAIT_L(0); PG8_MMA(1, 0, At, B0); PG8_BAR; PG8_SCHED;
            PG8_STAGE(PG8_SB(0, 1), b2 + hstep, voffB);
            PG8_WAIT_V(6); PG8_BAR; PG8_MMA(1, 1, At, B1); PG8_BAR;
            PG8_LDB(B0, 1, 0); PG8_SCHED; PG8_LDA(At, 1, 0); PG8_STAGE(PG8_SA(0, 1), a2 + hstep, voffA);
            PG8_WAIT_L(8); PG8_BAR; PG8_WAIT_L(0); PG8_MMA(0, 0, At, B0); PG8_BAR; PG8_SCHED;
            PG8_LDB(B1, 1, 1); PG8_STAGE(PG8_SB(1, 0), b3, voffB);
            PG8_BAR; PG8_WAIT_L(0); PG8_MMA(0, 1, At, B1); PG8_BAR;
            PG8_LDA(At, 1, 1); PG8_STAGE(PG8_SA(1, 0), a3, voffA);
            PG8_BAR; PG8_WAIT_L(0); PG8_MMA(1, 0, At, B0); PG8_BAR; PG8_SCHED;
            PG8_STAGE(PG8_SB(1, 1), b3 + hstep, voffB);
            PG8_WAIT_V(6); PG8_BAR; PG8_MMA(1, 1, At, B1); PG8_BAR;
            }
        }
        if constexpr (ALIGN_EPI) { if (wr == 0) PG8_BAR; }
        if constexpr (!Epi::AFTER_DRAIN) { E(acc, cur, wr, wc, fr, fq); S.done(cur); }
        if (!has_next) break;
#pragma unroll
        for (int a = 0; a < 2; ++a)
#pragma unroll
            for (int b = 0; b < 2; ++b)
#pragma unroll
                for (int m = 0; m < 4; ++m)
#pragma unroll
                    for (int n = 0; n < 2; ++n) acc[a][b][m][n] = (f32x4){0.f, 0.f, 0.f, 0.f};
        cur = nxt; cA = nA; cB = nB; ++ui;
        if constexpr (ALIGN_EPI) { if (wr == 1) PG8_BAR; }
    }
    PG8_WAIT_V(0);
    if constexpr (!ALIGN_EPI) { if (wr == 0) PG8_BAR; }
    PG8_BAR;
    if constexpr (Epi::AFTER_DRAIN) { E.fused(acc, cur, wr, wc, fr, fq, lds, wid, lane); S.done(cur); }
#undef PG8_SA
#undef PG8_SB
#undef PG8_STAGE
#undef PG8_LDA
#undef PG8_LDB
#undef PG8_MMA
#undef PG8_WAIT_V
#undef PG8_WAIT_L
#undef PG8_BAR
#undef PG8_SCHED
}
}
typedef unsigned short bf16;
typedef unsigned v4u __attribute__((ext_vector_type(4)));
typedef unsigned v2u __attribute__((ext_vector_type(2)));
typedef float f32x4 __attribute__((ext_vector_type(4)));
typedef float f2_t __attribute__((ext_vector_type(2)));
typedef float f32x16 __attribute__((ext_vector_type(16)));
typedef short bf16x8 __attribute__((ext_vector_type(8)));
typedef short s16x4 __attribute__((ext_vector_type(4)));
typedef __bf16 bf2_t __attribute__((ext_vector_type(2)));

constexpr int NWAVES = 8;
constexpr int DM = 1024, NB = 8, SEQ = 8192, M = NB * SEQ, INW = 1536, NMODC = 6144;
constexpr int LDS_BYTES = 160 * 1024, LDS_MISC_OFF = LDS_BYTES - 64;
constexpr size_t MiB = 1u << 20;
constexpr size_t WS_MOD = 0;
constexpr size_t WS_BAR = 208 * 1024;
constexpr size_t WS_SU = 256 * 1024;
constexpr size_t WS_SV = 384 * 1024;
constexpr size_t WS_WIN = 1 * MiB;
constexpr size_t WS_WGLU = 4 * MiB;
constexpr size_t WS_WOUT = 5 * MiB;
constexpr size_t WS_WQ = 7 * MiB;
constexpr size_t WS_KEYS = 9 * MiB;
constexpr size_t WS_WM = 9 * MiB + 512 * 1024;
constexpr size_t WS_UB = 16 * MiB;
constexpr size_t WS_VB = 48 * MiB;
constexpr size_t WS_H = 80 * MiB;
constexpr size_t WS_ZG = 208 * MiB;
constexpr size_t WS_ZS = 336 * MiB;
constexpr size_t WS_Y = 400 * MiB;
constexpr size_t WS_YS = 528 * MiB;
constexpr size_t WS_E = 592 * MiB;
constexpr size_t WS_G = 624 * MiB;
constexpr size_t WS_W = 656 * MiB;
constexpr size_t WS_SS = 688 * MiB;
constexpr size_t WS_PA = 336 * MiB;
constexpr size_t WS_X1B = 690 * MiB;
constexpr size_t WS_H2Q = 818 * MiB;
constexpr size_t WS_SH = 882 * MiB;
constexpr size_t WS_END = 883 * MiB;
constexpr float EPS = 1e-6f;

#define LDS_WAIT() asm volatile("s_waitcnt lgkmcnt(0)" ::: "memory")
__device__ __forceinline__ unsigned f2bf(float f) { unsigned u = __builtin_bit_cast(unsigned, f); return (u + 0x7fffu + ((u >> 16) & 1u)) >> 16; }
__device__ __forceinline__ unsigned pk2(float lo, float hi) { return f2bf(lo) | (f2bf(hi) << 16); }
__device__ __forceinline__ float bflo(unsigned u) { return __builtin_bit_cast(float, u << 16); }
__device__ __forceinline__ float bfhi(unsigned u) { return __builtin_bit_cast(float, u & 0xffff0000u); }
__device__ __forceinline__ float wave_sum(float v) {
#pragma unroll
    for (int o = 1; o < 64; o <<= 1) v += __shfl_xor(v, o);
    return v;
}
using pg8::gelu_t;
using pg8::sigmoid_f;

struct Args { const float* in[27]; float* out; unsigned char* ws; int ph_lo, ph_hi; };
enum { I_X = 0, I_C, I_WADA, I_BADA, I_GMIX, I_WIN, I_LNG, I_LNB, I_WS, I_BS, I_ARE, I_AIM, I_LOGDT, I_BRE, I_BIM, I_CRE, I_CIM, I_D, I_WGLU, I_BGLU, I_WOUT, I_GFFN, I_WQ, I_KEYS, I_PU, I_PV, I_GFIN };

__device__ __forceinline__ void p0_transpose_item(const float* W, int K, int N, bf16* WT, LAS float* scr, int item, int lane) {
    const int nblk = N / 32, kb = item / nblk, nb = item % nblk, k0 = 64 * kb, n0 = 32 * nb;
#pragma unroll 8
    for (int i = 0; i < 32; ++i) { const int kk = 2 * i + (lane >> 5); scr[kk * 33 + (lane & 31)] = W[(size_t)(k0 + kk) * N + n0 + (lane & 31)]; }
    LDS_WAIT(); asm volatile("" ::: "memory");
    const int c = lane & 7;
#pragma unroll
    for (int j = 0; j < 4; ++j) { const int n = (lane >> 3) + 8 * j; const LAS float* s = scr + (8 * c) * 33 + n;
        v4u o; o.x = pk2(s[0 * 33], s[1 * 33]); o.y = pk2(s[2 * 33], s[3 * 33]); o.z = pk2(s[4 * 33], s[5 * 33]); o.w = pk2(s[6 * 33], s[7 * 33]);
        *(v4u*)(WT + (size_t)(n0 + n) * K + k0 + 8 * c) = o; }
    LDS_WAIT(); asm volatile("" ::: "memory");
}
__device__ __forceinline__ void cvt_stream(const float* src, bf16* dst, size_t n8, size_t gtid, size_t gthreads) {
    for (size_t i = gtid; i < n8; i += gthreads) { const f32x4 a = *(const f32x4*)(src + i * 8), b = *(const f32x4*)(src + i * 8 + 4);
        v4u o; o.x = pk2(a.x, a.y); o.y = pk2(a.z, a.w); o.z = pk2(b.x, b.y); o.w = pk2(b.z, b.w); *(v4u*)(dst + i * 8) = o; }
}
__device__ __forceinline__ float wave_max(float v) {
#pragma unroll
    for (int o = 1; o < 64; o <<= 1) v = fmaxf(v, __shfl_xor(v, o));
    return v;
}
__device__ __forceinline__ void cvt_rows_fp8(const float* src, unsigned char* dst, float* inv, int gw, int NGW, int lane) {
    for (int row = gw; row < 16384; row += NGW) { const f32x4* p = (const f32x4*)(src + (size_t)row * 1024) + lane;
        f32x4 v[4]; float m = 0.f;
#pragma unroll
        for (int j = 0; j < 4; ++j) { v[j] = __builtin_nontemporal_load(p + 64 * j); m = fmaxf(fmaxf(m, fmaxf(fabsf(v[j].x), fabsf(v[j].y))), fmaxf(fabsf(v[j].z), fabsf(v[j].w))); }
        m = wave_max(m); const float sc = m > 0.f ? 240.0f / m : 1.0f;
#pragma unroll
        for (int j = 0; j < 4; ++j) { int pk = 0; pk = __builtin_amdgcn_cvt_pk_fp8_f32(v[j].x * sc, v[j].y * sc, pk, false); pk = __builtin_amdgcn_cvt_pk_fp8_f32(v[j].z * sc, v[j].w * sc, pk, true);
            const int c = 4 * lane + 256 * j; *(unsigned*)(dst + ((size_t)(c >> 7) * 16384 + row) * 128 + (c & 127)) = (unsigned)pk; }
        if (lane == 0) inv[row] = m > 0.f ? m * (1.0f / 240.0f) : 1.0f; }
}
__device__ __forceinline__ unsigned pack_i8x4(float a, float b, float c, float d) {
    const int ia = (int)rintf(a), ib = (int)rintf(b), ic = (int)rintf(c), id = (int)rintf(d);
    return (unsigned)(ia & 0xff) | ((unsigned)(ib & 0xff) << 8) | ((unsigned)(ic & 0xff) << 16) | ((unsigned)(id & 0xff) << 24);
}
__device__ __forceinline__ void cvt_rows_i8(const float* src, unsigned char* dst, float* inv, int gw, int NGW, int lane) {
    for (int row = gw; row < 16384; row += NGW) { const f32x4* p = (const f32x4*)(src + (size_t)row * 1024) + lane;
        f32x4 v[4]; float m = 0.f;
#pragma unroll
        for (int j = 0; j < 4; ++j) { v[j] = __builtin_nontemporal_load(p + 64 * j); m = fmaxf(fmaxf(m, fmaxf(fabsf(v[j].x), fabsf(v[j].y))), fmaxf(fabsf(v[j].z), fabsf(v[j].w))); }
        m = wave_max(m); const float sc = m > 0.f ? 127.0f / m : 1.0f;
#pragma unroll
        for (int j = 0; j < 4; ++j) { const int c = 4 * lane + 256 * j; *(unsigned*)(dst + ((size_t)(c >> 7) * 16384 + row) * 128 + (c & 127)) = pack_i8x4(v[j].x * sc, v[j].y * sc, v[j].z * sc, v[j].w * sc); }
        if (lane == 0) inv[row] = m > 0.f ? m * (1.0f / 127.0f) : 1.0f; }
}
__device__ __forceinline__ unsigned pack_i4x8(const float (&v)[8], float inv) {
    unsigned d = 0;
#pragma unroll
    for (int i = 0; i < 8; ++i) { int q = (int)rintf(v[i] * inv); q = q < -8 ? -8 : (q > 7 ? 7 : q); d |= (unsigned)(q & 15) << (4 * i); }
    return d;
}
__device__ __forceinline__ void cvt_rows_i4(const float* src, unsigned char* dst, float* invs, int gw, int NGW, int lane) {
    for (int row = gw; row < 16384; row += NGW) { const float* p = src + (size_t)row * 1024;
        float v[2][8]; float ss = 0.f;
#pragma unroll
        for (int q = 0; q < 2; ++q) { const f32x4 x0 = __builtin_nontemporal_load((const f32x4*)(p + 512 * q + 8 * lane)), x1 = __builtin_nontemporal_load((const f32x4*)(p + 512 * q + 8 * lane + 4));
            v[q][0] = x0.x; v[q][1] = x0.y; v[q][2] = x0.z; v[q][3] = x0.w; v[q][4] = x1.x; v[q][5] = x1.y; v[q][6] = x1.z; v[q][7] = x1.w;
#pragma unroll
            for (int i = 0; i < 8; ++i) ss += v[q][i] * v[q][i]; }
        const float rms = sqrtf(wave_sum(ss) * (1.0f / 1024.0f)); const float step = rms > 0.f ? rms * (2.5f / 7.5f) : 1.0f, inv = 1.0f / step;
#pragma unroll
        for (int q = 0; q < 2; ++q) { const int c = 512 * q + 8 * lane; *(unsigned*)(dst + ((size_t)(c >> 7) * 16384 + row) * 64 + ((c & 127) >> 1)) = pack_i4x8(v[q], inv); }
        if (lane == 0) invs[row] = step; }
}
template <int LOG2W> __device__ __forceinline__ void cvt_rows_fp4(const float* src, unsigned char* dst, float* invs, int gw, int NGW, int lane) {
    for (int base = gw; base < 16384; base += 4 * NGW) {
        float v[4][2][8]; float ss[4];
#pragma unroll
        for (int rr = 0; rr < 4; ++rr) { const int row = min(base + rr * NGW, 16383); const float* p = src + (size_t)row * 1024;
#pragma unroll
            for (int q = 0; q < 2; ++q) { const f32x4 x0 = __builtin_nontemporal_load((const f32x4*)(p + 512 * q + 8 * lane)), x1 = __builtin_nontemporal_load((const f32x4*)(p + 512 * q + 8 * lane + 4));
                v[rr][q][0] = x0.x; v[rr][q][1] = x0.y; v[rr][q][2] = x0.z; v[rr][q][3] = x0.w; v[rr][q][4] = x1.x; v[rr][q][5] = x1.y; v[rr][q][6] = x1.z; v[rr][q][7] = x1.w; } }
#pragma unroll
        for (int rr = 0; rr < 4; ++rr) { float s = 0.f;
#pragma unroll
            for (int q = 0; q < 2; ++q)
#pragma unroll
                for (int i = 0; i < 8; ++i) s += v[rr][q][i] * v[rr][q][i];
            ss[rr] = wave_sum(s); }
#pragma unroll
        for (int rr = 0; rr < 4; ++rr) { const int row = base + rr * NGW; if (row < 16384) {
            const float rms = sqrtf(ss[rr] * (1.0f / 1024.0f)); const float sc = rms > 0.f ? rms * 0.5f : 1.0f, inv = 1.0f / sc;
#pragma unroll
            for (int q = 0; q < 2; ++q) { float t[8];
#pragma unroll
                for (int i = 0; i < 8; ++i) t[i] = fminf(fmaxf(v[rr][q][i] * inv, -6.0f), 6.0f);
                unsigned d = 0;
                d = __builtin_amdgcn_cvt_scalef32_pk_fp4_f32(d, t[0], t[1], 1.0f, 0); d = __builtin_amdgcn_cvt_scalef32_pk_fp4_f32(d, t[2], t[3], 1.0f, 1);
                d = __builtin_amdgcn_cvt_scalef32_pk_fp4_f32(d, t[4], t[5], 1.0f, 2); d = __builtin_amdgcn_cvt_scalef32_pk_fp4_f32(d, t[6], t[7], 1.0f, 3);
                const int c = 512 * q + 8 * lane; constexpr int W = 1 << LOG2W; *(unsigned*)(dst + ((size_t)(c >> LOG2W) * 16384 + row) * (W / 2) + ((c & (W - 1)) >> 1)) = d; }
            if (lane == 0) invs[row] = sc; } }
    }
}
__device__ __forceinline__ void p0_mod_item(const float* c, const float* w_ada, const float* b_ada, float* mod, LAS float* scr, int item, int tid) {
    LAS float* cond = scr;
    LAS float* red = scr + 8 * 1024;
    for (int i = tid; i < 8 * 1024; i += 512) { const float v = c[i]; cond[i] = v * sigmoid_f(v); }
    __syncthreads();
    const int kq = tid >> 3, cq = tid & 7, j0 = item * 24 + cq * 3;
    float acc[8][3];
#pragma unroll
    for (int b = 0; b < 8; ++b) { acc[b][0] = 0.f; acc[b][1] = 0.f; acc[b][2] = 0.f; }
    for (int i = 0; i < 16; ++i) { const int k = kq + 64 * i; const float* wp = w_ada + (size_t)k * NMODC + j0; const float w0 = wp[0], w1 = wp[1], w2 = wp[2];
#pragma unroll
        for (int b = 0; b < 8; ++b) { const float s = cond[b * 1024 + k]; acc[b][0] += s * w0; acc[b][1] += s * w1; acc[b][2] += s * w2; } }
#pragma unroll
    for (int b = 0; b < 8; ++b)
#pragma unroll
        for (int e = 0; e < 3; ++e) red[kq * 192 + b * 24 + cq * 3 + e] = acc[b][e];
    __syncthreads();
    if (tid < 192) { float s = 0.f; for (int q = 0; q < 64; ++q) s += red[q * 192 + tid]; const int b = tid / 24, j = item * 24 + tid % 24; mod[b * NMODC + j] = s + b_ada[j]; }
    __syncthreads();
}
__device__ __forceinline__ void phase_prologue(const Args& a, LAS unsigned char* lds, int tid, int wave, int lane) {
    unsigned char* ws = a.ws; const int G = gridDim.x, bx = blockIdx.x;
    for (int it = bx; it < 256; it += G) p0_mod_item(a.in[I_C], a.in[I_WADA], a.in[I_BADA], (float*)(ws + WS_MOD), (LAS float*)lds, it, tid);
    LAS float* scr = (LAS float*)(lds + wave * 16384);
    const int gw = bx * NWAVES + wave, NGW = G * NWAVES;
    constexpr int I_IN = 16 * 48, I_GLU = 8 * 16, I_OUT = 16 * 32, I_Q = 16 * 32, NITEMS = I_IN + I_GLU + I_OUT + I_Q;
    for (int it = gw; it < NITEMS; it += NGW) { int r = it;
        if (r < I_IN) { p0_transpose_item(a.in[I_WIN], 1024, 1536, (bf16*)(ws + WS_WIN), scr, r, lane); continue; } r -= I_IN;
        if (r < I_GLU) { p0_transpose_item(a.in[I_WGLU], 512, 512, (bf16*)(ws + WS_WGLU), scr, r, lane); continue; } r -= I_GLU;
        if (r < I_OUT) { p0_transpose_item(a.in[I_WOUT], 1024, 1024, (bf16*)(ws + WS_WOUT), scr, r, lane); continue; } r -= I_OUT;
        p0_transpose_item(a.in[I_WQ], 1024, 1024, (bf16*)(ws + WS_WQ), scr, r, lane); }
    const size_t gtid = (size_t)bx * 512 + tid, gth = (size_t)G * 512;
    cvt_stream(a.in[I_KEYS], (bf16*)(ws + WS_KEYS), 8 * 2 * 128 * 64 / 8, gtid, gth);
    { const float* w = a.in[I_WS]; bf16* wm = (bf16*)(ws + WS_WM);
      for (size_t i = gtid; i < 4 * 128 * 128 / 8; i += gth) { const int e0 = (int)i * 8, ii = (e0 >> 7) & 127, j0 = e0 & 127; const f32x4 p = *(const f32x4*)(w + e0), q = *(const f32x4*)(w + e0 + 4);
          float v[8] = {p.x, p.y, p.z, p.w, q.x, q.y, q.z, q.w};
#pragma unroll
          for (int e = 0; e < 8; ++e) v[e] = (j0 + e <= ii) ? v[e] : 0.f;
          v4u o; o.x = pk2(v[0], v[1]); o.y = pk2(v[2], v[3]); o.z = pk2(v[4], v[5]); o.w = pk2(v[6], v[7]); *(v4u*)(wm + e0) = o; } }
    cvt_rows_fp4<8>(a.in[I_PU], ws + WS_UB, (float*)(ws + WS_SU), gw, NGW, lane); cvt_rows_fp4<8>(a.in[I_PV], ws + WS_VB, (float*)(ws + WS_SV), gw, NGW, lane);
}

__device__ __forceinline__ void phase_norm_mod(const float* x, const float* gw, const float* mod, int sh_off, int sc_off, bf16* H, int wave, int lane) {
    const int G = gridDim.x;
    for (int it = blockIdx.x; it < 256; it += G) { const int b = it >> 5; const float* mb = mod + (size_t)b * NMODC;
        f32x4 A[4], S[4];
#pragma unroll
        for (int j = 0; j < 4; ++j) { const int c0 = 4 * lane + 256 * j; const f32x4 g = *(const f32x4*)(gw + c0), sc = *(const f32x4*)(mb + sc_off + c0); A[j] = g * (sc + 1.0f); S[j] = *(const f32x4*)(mb + sh_off + c0); }
        for (int r = 0; r < 32; ++r) { const size_t row = (size_t)it * 256 + wave * 32 + r; const f32x4* xr = (const f32x4*)(x + row * 1024) + lane;
            f32x4 v[4]; float s = 0.f;
#pragma unroll
            for (int j = 0; j < 4; ++j) { v[j] = __builtin_nontemporal_load(xr + 64 * j); s += (v[j].x * v[j].x + v[j].y * v[j].y) + (v[j].z * v[j].z + v[j].w * v[j].w); }
            const float rstd = 1.0f / sqrtf(wave_sum(s) * (1.0f / 1024.0f) + EPS);
            unsigned long long* o8 = (unsigned long long*)(H + row * 1024) + lane;
#pragma unroll
            for (int j = 0; j < 4; ++j) { const f32x4 h = v[j] * rstd * A[j] + S[j]; o8[64 * j] = (unsigned long long)pk2(h.x, h.y) | ((unsigned long long)pk2(h.z, h.w) << 32); } } }
}
__device__ __forceinline__ void phase_norm_mod_bf(const bf16* x, const float* gw, const float* mod, int sh_off, int sc_off, bf16* H, unsigned char* HQ, float* SH, int wave, int lane) {
    const int G = gridDim.x;
    for (int it = blockIdx.x; it < 256; it += G) { const int b = it >> 5; const float* mb = mod + (size_t)b * NMODC;
        float A[16], S[16];
#pragma unroll
        for (int q = 0; q < 2; ++q)
#pragma unroll
            for (int j = 0; j < 8; ++j) { const int c = 512 * q + 8 * lane + j; A[8 * q + j] = gw[c] * (mb[sc_off + c] + 1.0f); S[8 * q + j] = mb[sh_off + c]; }
        for (int r = 0; r < 32; ++r) { const size_t row = (size_t)it * 256 + wave * 32 + r;
            const v4u r0 = *(const v4u*)(x + row * 1024 + 8 * lane), r1 = *(const v4u*)(x + row * 1024 + 512 + 8 * lane);
            float v[16] = {bflo(r0.x), bfhi(r0.x), bflo(r0.y), bfhi(r0.y), bflo(r0.z), bfhi(r0.z), bflo(r0.w), bfhi(r0.w), bflo(r1.x), bfhi(r1.x), bflo(r1.y), bfhi(r1.y), bflo(r1.z), bfhi(r1.z), bflo(r1.w), bfhi(r1.w)};
            float s = 0.f;
#pragma unroll
            for (int j = 0; j < 16; ++j) s += v[j] * v[j];
            const float rstd = 1.0f / sqrtf(wave_sum(s) * (1.0f / 1024.0f) + EPS);
#pragma unroll
            for (int j = 0; j < 16; ++j) v[j] = v[j] * rstd * A[j] + S[j];
            v4u o0, o1; o0.x = pk2(v[0], v[1]); o0.y = pk2(v[2], v[3]); o0.z = pk2(v[4], v[5]); o0.w = pk2(v[6], v[7]); o1.x = pk2(v[8], v[9]); o1.y = pk2(v[10], v[11]); o1.z = pk2(v[12], v[13]); o1.w = pk2(v[14], v[15]);
            *(v4u*)(H + row * 1024 + 8 * lane) = o0; *(v4u*)(H + row * 1024 + 512 + 8 * lane) = o1;
            float mx = 0.f;
#pragma unroll
            for (int j = 0; j < 16; ++j) mx = fmaxf(mx, fabsf(v[j]));
            mx = wave_max(mx); const float qs = mx > 0.f ? 200.0f / mx : 1.0f;
#pragma unroll
            for (int q = 0; q < 2; ++q) { int p0 = 0, p1 = 0;
                p0 = __builtin_amdgcn_cvt_pk_fp8_f32(v[8 * q] * qs, v[8 * q + 1] * qs, p0, false); p0 = __builtin_amdgcn_cvt_pk_fp8_f32(v[8 * q + 2] * qs, v[8 * q + 3] * qs, p0, true);
                p1 = __builtin_amdgcn_cvt_pk_fp8_f32(v[8 * q + 4] * qs, v[8 * q + 5] * qs, p1, false); p1 = __builtin_amdgcn_cvt_pk_fp8_f32(v[8 * q + 6] * qs, v[8 * q + 7] * qs, p1, true);
                *(v2u*)(HQ + row * 1024 + 512 * q + 8 * lane) = (v2u){(unsigned)p0, (unsigned)p1}; }
            if (lane == 0) SH[row] = mx > 0.f ? mx * (1.0f / 200.0f) : 1.0f; } }
}
__device__ __forceinline__ void sincos_f(float th, float& s, float& c) {
    const float q = rintf(th * 0.63661977236758f);
    float y = fmaf(q, -1.5707962513f, th); y = fmaf(q, -7.5497894159e-8f, y); y = fmaf(q, -5.3903029534e-15f, y);
    const float y2 = y * y;
    const float sp = y + y * y2 * (-1.6666667163e-1f + y2 * (8.3333337680e-3f + y2 * (-1.9841270114e-4f + y2 * 2.7557314297e-6f)));
    const float cp = 1.0f + y2 * (-0.5f + y2 * (4.1666667908e-2f + y2 * (-1.3888889225e-3f + y2 * (2.4801587642e-5f + y2 * -2.7557314297e-7f))));
    const int qi = (int)q & 3;
    s = (qi == 0) ? sp : (qi == 1) ? cp : (qi == 2) ? -sp : -cp;
    c = (qi == 0) ? cp : (qi == 1) ? -sp : (qi == 2) ? -cp : sp;
}
__device__ __forceinline__ void s5_disc(const float* are, const float* aim, float dt, int gp, float& abr, float& abi, float& cr, float& ci) {
    const float ar = fminf(are[gp], -1e-4f), ai = aim[gp];
    const float mag = expf(ar * dt); float sn, cs; sincos_f(ai * dt, sn, cs);
    abr = mag * cs; abi = mag * sn;
    const float nr = abr - 1.0f, ni = abi, den = 1.0f / (ar * ar + ai * ai);
    cr = (nr * ar + ni * ai) * den; ci = (ni * ar - nr * ai) * den;
}
constexpr int S5_X_LD = 136;
constexpr int S5_X_OFF = 0, S5_E_OFF = 128 * S5_X_LD * 2;
#define LDS_BARRIER() do { asm volatile("s_waitcnt lgkmcnt(0)" ::: "memory"); __builtin_amdgcn_s_barrier(); asm volatile("" ::: "memory"); } while (0)
#define CMAC_R(ar, ai, br, bi, cr) fmaf((ar), (br), fmaf(-(ai), (bi), (cr)))
#define CMAC_I(ar, ai, br, bi, ci) fmaf((ar), (bi), fmaf((ai), (br), (ci)))
#define CMUL_R(ar, ai, br, bi) ((ar) * (br) - (ai) * (bi))
#define CMUL_I(ar, ai, br, bi) ((ar) * (bi) + (ai) * (br))
__device__ __forceinline__ void s5_item(const Args& a, LAS unsigned char* lds, int item, int wave, int lane) {
    const int b = item >> 5, g = item & 31;
    const float dt = expf(a.in[I_LOGDT][g]);
    LAS bf16* X = (LAS bf16*)(lds + S5_X_OFF); LAS float* E = (LAS float*)(lds + S5_E_OFF);
    const int mt = wave >> 1, sh = wave & 1, l32 = lane & 31, hf = lane >> 5, p = 32 * sh + l32;
    float a1r, a1i, cr, ci; s5_disc(a.in[I_ARE], a.in[I_AIM], dt, g * 64 + p, a1r, a1i, cr, ci);
    const float a2r = CMUL_R(a1r, a1i, a1r, a1i), a2i = CMUL_I(a1r, a1i, a1r, a1i), a3r = CMUL_R(a2r, a2i, a1r, a1i), a3i = CMUL_I(a2r, a2i, a1r, a1i);
    const float a4r = CMUL_R(a2r, a2i, a2r, a2i), a4i = CMUL_I(a2r, a2i, a2r, a2i), a8r = CMUL_R(a4r, a4i, a4r, a4i), a8i = CMUL_I(a4r, a4i, a4r, a4i);
    const float a12r = CMUL_R(a8r, a8i, a4r, a4i), a12i = CMUL_I(a8r, a8i, a4r, a4i), a16r = CMUL_R(a8r, a8i, a8r, a8i), a16i = CMUL_I(a8r, a8i, a8r, a8i);
    const float a20r = CMUL_R(a16r, a16i, a4r, a4i), a20i = CMUL_I(a16r, a16i, a4r, a4i), a24r = CMUL_R(a16r, a16i, a8r, a8i), a24i = CMUL_I(a16r, a16i, a8r, a8i);
    const float a28r = CMUL_R(a24r, a24i, a4r, a4i), a28i = CMUL_I(a24r, a24i, a4r, a4i), a32r = CMUL_R(a16r, a16i, a16r, a16i), a32i = CMUL_I(a16r, a16i, a16r, a16i);
    const float pwr[4] = {a1r, a2r, a3r, a4r}, pwi[4] = {a1i, a2i, a3i, a4i};
    const float qkr[4] = {hf ? a4r : 1.0f, hf ? a12r : a8r, hf ? a20r : a16r, hf ? a28r : a24r}, qki[4] = {hf ? a4i : 0.0f, hf ? a12i : a8i, hf ? a20i : a16i, hf ? a28i : a24i};
    bf16x8 bfr_re, bfr_im;
    { const float* br = a.in[I_BRE] + (size_t)(g * 64 + p) * 16 + 8 * hf; const float* bi = a.in[I_BIM] + (size_t)(g * 64 + p) * 16 + 8 * hf;
      float vr[8], vi[8];
#pragma unroll
      for (int j = 0; j < 8; ++j) { vr[j] = cr * br[j] - ci * bi[j]; vi[j] = cr * bi[j] + ci * br[j]; }
      v4u o; o.x = pk2(vr[0], vr[1]); o.y = pk2(vr[2], vr[3]); o.z = pk2(vr[4], vr[5]); o.w = pk2(vr[6], vr[7]); bfr_re = __builtin_bit_cast(bf16x8, o);
      o.x = pk2(vi[0], vi[1]); o.y = pk2(vi[2], vi[3]); o.z = pk2(vi[4], vi[5]); o.w = pk2(vi[6], vi[7]); bfr_im = __builtin_bit_cast(bf16x8, o); }
    const int l16 = lane & 15, q4 = lane >> 4;
    bf16x8 cm[4];
#pragma unroll
    for (int ks = 0; ks < 4; ++ks) { const int s0 = 16 * ks + 4 * q4; const float* cre = a.in[I_CRE] + (size_t)(g * 16 + l16) * 64 + s0; const float* cim = a.in[I_CIM] + (size_t)(g * 16 + l16) * 64 + s0;
        v4u o; o.x = pk2(cre[0], -cim[0]); o.y = pk2(cre[1], -cim[1]); o.z = pk2(cre[2], -cim[2]); o.w = pk2(cre[3], -cim[3]); cm[ks] = __builtin_bit_cast(bf16x8, o); }
    float dsk[4];
#pragma unroll
    for (int r = 0; r < 4; ++r) dsk[r] = a.in[I_D][g * 16 + 4 * q4 + r];
    const bf16* ZS = (const bf16*)(a.ws + WS_ZS) + ((size_t)(b * 32 + g) * 8192) * 16;
    bf16* YS = (bf16*)(a.ws + WS_YS) + (size_t)b * 8192 * 512 + g * 16;
    float xinr = 0.f, xini = 0.f;
    bf16x8 ua_n = *(const bf16x8*)(ZS + (mt * 32 + l32) * 16 + hf * 8);
    v2u uu_n = *(const v2u*)(ZS + (16 * wave + l16) * 16 + 4 * q4);
    for (int ch = 0; ch < 64; ++ch) {
        const bf16x8 ua = ua_n; const v2u uu = uu_n;
        { const int cn = ch < 63 ? ch + 1 : 63; const bf16* zn = ZS + (size_t)cn * 128 * 16;
          ua_n = *(const bf16x8*)(zn + (mt * 32 + l32) * 16 + hf * 8); uu_n = *(const v2u*)(zn + (16 * wave + l16) * 16 + 4 * q4); }
        const f32x16 z16 = {0.f, 0.f, 0.f, 0.f, 0.f, 0.f, 0.f, 0.f, 0.f, 0.f, 0.f, 0.f, 0.f, 0.f, 0.f, 0.f};
        const f32x16 bre = __builtin_amdgcn_mfma_f32_32x32x16_bf16(ua, bfr_re, z16, 0, 0, 0), bim = __builtin_amdgcn_mfma_f32_32x32x16_bf16(ua, bfr_im, z16, 0, 0, 0);
        float xr[16], xi[16];
#pragma unroll
        for (int j = 0; j < 4; ++j) { xr[4 * j] = bre[4 * j]; xi[4 * j] = bim[4 * j];
#pragma unroll
            for (int i = 1; i < 4; ++i) { xr[4 * j + i] = CMAC_R(a1r, a1i, xr[4 * j + i - 1], xi[4 * j + i - 1], bre[4 * j + i]); xi[4 * j + i] = CMAC_I(a1r, a1i, xr[4 * j + i - 1], xi[4 * j + i - 1], bim[4 * j + i]); } }
        float clr[4], cli[4], ber, bei;
        { float pgr[4], pgi[4];
#pragma unroll
          for (int j = 0; j < 4; ++j) { pgr[j] = __shfl_xor(xr[4 * j + 3], 32); pgi[j] = __shfl_xor(xi[4 * j + 3], 32); }
          float cr_ = 0.f, ci_ = 0.f;
#pragma unroll
          for (int k = 0; k < 8; ++k) { const int j = k >> 1; const bool mine = (hf == (k & 1));
              if ((k & 1) == 0) { clr[j] = cr_; cli[j] = ci_; } else { clr[j] = mine ? cr_ : clr[j]; cli[j] = mine ? ci_ : cli[j]; }
              const float gr = mine ? xr[4 * j + 3] : pgr[j], gi = mine ? xi[4 * j + 3] : pgi[j];
              const float nr = CMAC_R(a4r, a4i, cr_, ci_, gr), ni = CMAC_I(a4r, a4i, cr_, ci_, gi); cr_ = nr; ci_ = ni; }
          ber = cr_; bei = ci_; }
        if (hf == 0) { E[(mt * 64 + p) * 2] = ber; E[(mt * 64 + p) * 2 + 1] = bei; }
        LDS_BARRIER();
        float mbr = 0.f, mbi = 0.f;
        { float cr_ = xinr, ci_ = xini;
#pragma unroll
          for (int m = 0; m < 4; ++m) { if (m == mt) { mbr = cr_; mbi = ci_; } const float er = E[(m * 64 + p) * 2], ei = E[(m * 64 + p) * 2 + 1];
              const float nr = CMAC_R(a32r, a32i, cr_, ci_, er), ni = CMAC_I(a32r, a32i, cr_, ci_, ei); cr_ = nr; ci_ = ni; }
          xinr = cr_; xini = ci_; }
#pragma unroll
        for (int j = 0; j < 4; ++j) { const float ckr = CMAC_R(qkr[j], qki[j], mbr, mbi, clr[j]), cki = CMAC_I(qkr[j], qki[j], mbr, mbi, cli[j]);
#pragma unroll
            for (int i = 0; i < 4; ++i) { const float fr = CMAC_R(pwr[i], pwi[i], ckr, cki, xr[4 * j + i]), fi = CMAC_I(pwr[i], pwi[i], ckr, cki, xi[4 * j + i]);
                *(LAS unsigned*)(X + (32 * mt + 8 * j + 4 * hf + i) * S5_X_LD + 2 * p) = pg8::cvt_pk_bf16(fr, fi); } }
        LDS_BARRIER();
        { f32x4 o = {0.f, 0.f, 0.f, 0.f};
#pragma unroll
          for (int ks = 0; ks < 4; ++ks) { const bf16x8 xa = *(const LAS bf16x8*)(X + (16 * wave + l16) * S5_X_LD + 32 * ks + 8 * q4); o = __builtin_amdgcn_mfma_f32_16x16x32_bf16(cm[ks], xa, o, 0, 0, 0); }
          const int t = 16 * wave + l16;
          const float y0 = gelu_t(o[0] + dsk[0] * bflo(uu.x)), y1 = gelu_t(o[1] + dsk[1] * bfhi(uu.x)), y2 = gelu_t(o[2] + dsk[2] * bflo(uu.y)), y3 = gelu_t(o[3] + dsk[3] * bfhi(uu.y));
          v2u w; w.x = pg8::cvt_pk_bf16(y0, y1); w.y = pg8::cvt_pk_bf16(y2, y3); *(v2u*)(YS + (size_t)(ch * 128 + t) * 512 + 4 * q4) = w; }
    }
    __syncthreads();
}

constexpr int SGU_RS = 1056;
typedef short v4i16_t __attribute__((ext_vector_type(4)));
__device__ __forceinline__ s16x4 ds_tr16(const LAS unsigned char* p) { return __builtin_bit_cast(s16x4, __builtin_amdgcn_ds_read_tr16_b64_v4i16((LAS v4i16_t*)p)); }
__device__ __forceinline__ void sgu_item(const Args& a, LAS unsigned char* lds, int item, int wave, int lane) {
    const bf16* ZG = (const bf16*)(a.ws + WS_ZG); bf16* Y = (bf16*)(a.ws + WS_Y); const bf16* WM = (const bf16*)(a.ws + WS_WM);
    const int r0 = item * 128;
    { float lg[8], lb[8];
#pragma unroll
      for (int j = 0; j < 8; ++j) { lg[j] = a.in[I_LNG][8 * lane + j]; lb[j] = a.in[I_LNB][8 * lane + j]; }
      v4u raw[16];
#pragma unroll
      for (int tt = 0; tt < 16; ++tt) raw[tt] = __builtin_nontemporal_load((const v4u*)(ZG + (size_t)(r0 + 16 * wave + tt) * 1024 + 512 + 8 * lane));
      float s1[16], s2[16];
#pragma unroll
      for (int tt = 0; tt < 16; ++tt) { const float f[8] = {bflo(raw[tt].x), bfhi(raw[tt].x), bflo(raw[tt].y), bfhi(raw[tt].y), bflo(raw[tt].z), bfhi(raw[tt].z), bflo(raw[tt].w), bfhi(raw[tt].w)};
          float a1 = 0.f, a2 = 0.f;
#pragma unroll
          for (int j = 0; j < 8; ++j) { a1 += f[j]; a2 += f[j] * f[j]; }
          s1[tt] = a1; s2[tt] = a2; }
#pragma unroll
      for (int o = 1; o < 64; o <<= 1) {
#pragma unroll
          for (int tt = 0; tt < 16; ++tt) { s1[tt] += __shfl_xor(s1[tt], o); s2[tt] += __shfl_xor(s2[tt], o); } }
#pragma unroll
      for (int tt = 0; tt < 16; ++tt) { const int t = 16 * wave + tt;
          float f[8] = {bflo(raw[tt].x), bfhi(raw[tt].x), bflo(raw[tt].y), bfhi(raw[tt].y), bflo(raw[tt].z), bfhi(raw[tt].z), bflo(raw[tt].w), bfhi(raw[tt].w)};
          const float mu = s1[tt] * (1.0f / 512.0f), var = fmaxf(s2[tt] * (1.0f / 512.0f) - mu * mu, 0.f), rstd = 1.0f / sqrtf(var + EPS);
#pragma unroll
          for (int j = 0; j < 8; ++j) f[j] = (f[j] - mu) * rstd * lg[j] + lb[j];
          v4u o; o.x = pk2(f[0], f[1]); o.y = pk2(f[2], f[3]); o.z = pk2(f[4], f[5]); o.w = pk2(f[6], f[7]);
          *(LAS v4u*)(lds + t * SGU_RS + 16 * lane) = o; } }
    __syncthreads();
    const int l16 = lane & 15, q4 = lane >> 4, qq = l16 >> 2, pp = l16 & 3, nks = (wave >> 1) + 1, irow = 16 * wave + l16;
    for (int h = 0; h < 4; ++h) {
        f32x4 acc[8];
#pragma unroll
        for (int nt = 0; nt < 8; ++nt) acc[nt] = (f32x4){0.f, 0.f, 0.f, 0.f};
        bf16x8 wf[4]; v2u uu[8];
#pragma unroll
        for (int ks = 0; ks < 4; ++ks) { const int kc = ks < nks ? ks : nks - 1; wf[ks] = *(const bf16x8*)(WM + ((size_t)(h * 128 + irow)) * 128 + 32 * kc + 8 * q4); }
#pragma unroll
        for (int nt = 0; nt < 8; ++nt) uu[nt] = __builtin_nontemporal_load((const v2u*)(ZG + (size_t)(r0 + irow) * 1024 + h * 128 + 16 * nt + 4 * q4));
        const float bs = a.in[I_BS][h * 128 + irow];
#pragma unroll
        for (int ks = 0; ks < 4; ++ks) { if (ks < nks) {
            const LAS unsigned char* vb = lds + (32 * ks + 8 * q4 + qq) * SGU_RS + (h * 128 + 4 * pp) * 2;
#pragma unroll
            for (int nt = 0; nt < 8; ++nt) { const s16x4 lo = ds_tr16(vb + nt * 32), hi = ds_tr16(vb + nt * 32 + 4 * SGU_RS);
                const bf16x8 vf = {lo[0], lo[1], lo[2], lo[3], hi[0], hi[1], hi[2], hi[3]};
                acc[nt] = __builtin_amdgcn_mfma_f32_16x16x32_bf16(vf, wf[ks], acc[nt], 0, 0, 0); } } }
#pragma unroll
        for (int nt = 0; nt < 8; ++nt) { const size_t o = (size_t)(r0 + irow) * 1024 + h * 128 + 16 * nt + 4 * q4;
            v2u w; w.x = pk2(bflo(uu[nt].x) * (acc[nt][0] + bs), bfhi(uu[nt].x) * (acc[nt][1] + bs)); w.y = pk2(bflo(uu[nt].y) * (acc[nt][2] + bs), bfhi(uu[nt].y) * (acc[nt][3] + bs)); *(v2u*)(Y + o) = w; }
    }
    __syncthreads();
}
__device__ __forceinline__ int f2i(float f) { return __builtin_bit_cast(int, f); }
__device__ __forceinline__ float i2f(int i) { return __builtin_bit_cast(float, i); }
__device__ __forceinline__ float kmax(float a, float b) { float r; asm("v_max_f32 %0, %1, %2" : "=v"(r) : "v"(a), "v"(b)); return r; }
__device__ __forceinline__ float kmin(float a, float b) { float r; asm("v_min_f32 %0, %1, %2" : "=v"(r) : "v"(a), "v"(b)); return r; }
__device__ __forceinline__ float mkkey(float s, int keep, int payload) { return i2f((f2i(s) & keep) | payload); }
__device__ __forceinline__ void sort16(float (&v)[16]) {
#define CE16(i, j) { const float x_ = v[i], y_ = v[j]; v[i] = kmax(x_, y_); v[j] = kmin(x_, y_); }
    CE16(0,1) CE16(2,3) CE16(0,2) CE16(1,3) CE16(1,2) CE16(4,5) CE16(6,7) CE16(4,6) CE16(5,7) CE16(5,6) CE16(0,4) CE16(2,6) CE16(2,4) CE16(1,5) CE16(3,7) CE16(3,5) CE16(1,2) CE16(3,4) CE16(5,6) CE16(8,9) CE16(10,11) CE16(8,10) CE16(9,11) CE16(9,10) CE16(12,13) CE16(14,15) CE16(12,14) CE16(13,15) CE16(13,14) CE16(8,12) CE16(10,14) CE16(10,12) CE16(9,13) CE16(11,15) CE16(11,13) CE16(9,10) CE16(11,12) CE16(13,14) CE16(0,8) CE16(4,12) CE16(4,8) CE16(2,10) CE16(6,14) CE16(6,10) CE16(2,4) CE16(6,8) CE16(10,12) CE16(1,9) CE16(5,13) CE16(5,9) CE16(3,11) CE16(7,15) CE16(7,11) CE16(3,5) CE16(7,9) CE16(11,13) CE16(1,2) CE16(3,4) CE16(5,6) CE16(7,8) CE16(9,10) CE16(11,12) CE16(13,14)
#undef CE16
}
__device__ __forceinline__ void merge16(float (&a)[16], const float (&b)[16]) {
#pragma unroll
    for (int i = 0; i < 16; ++i) a[i] = kmax(a[i], b[15 - i]);
#pragma unroll
    for (int j = 8; j > 0; j >>= 1)
#pragma unroll
        for (int i = 0; i < 16; ++i) { const int l = i ^ j; if (l > i) { const float x = a[i], y = a[l]; a[i] = kmax(x, y); a[l] = kmin(x, y); } }
}
constexpr int NCAND = 50;
constexpr int cand_a(int n) { int c = 0; for (int a = 0; a < 16; ++a) for (int b = 0; b < 16; ++b) if ((a + 1) * (b + 1) <= 16) { if (c == n) return a; ++c; } return 0; }
constexpr int cand_b(int n) { int c = 0; for (int a = 0; a < 16; ++a) for (int b = 0; b < 16; ++b) if ((a + 1) * (b + 1) <= 16) { if (c == n) return b; ++c; } return 0; }
template <int N> struct CandAB { static constexpr int a = cand_a(N), b = cand_b(N); };
template <int S> __device__ __forceinline__ float cand_key2(const float (&f1)[16], const float (&f2)[16], bool hf) {
    if constexpr (S < 25) { constexpr int a0 = CandAB<S>::a, b0 = CandAB<S>::b, a1 = CandAB<25 + S>::a, b1 = CandAB<25 + S>::b;
        const float s = (hf ? f1[a1] : f1[a0]) + (hf ? f2[b1] : f2[b0]); return mkkey(s, ~0xff, hf ? ((a1 << 4) | b1) : ((a0 << 4) | b0)); }
    else return i2f((int)0xff800000);
}
template <int G> __device__ __forceinline__ void cand_fill2(float (&v)[16], const float (&f1)[16], const float (&f2)[16], bool hf) {
    v[0] = cand_key2<G * 16 + 0>(f1, f2, hf); v[1] = cand_key2<G * 16 + 1>(f1, f2, hf); v[2] = cand_key2<G * 16 + 2>(f1, f2, hf); v[3] = cand_key2<G * 16 + 3>(f1, f2, hf);
    v[4] = cand_key2<G * 16 + 4>(f1, f2, hf); v[5] = cand_key2<G * 16 + 5>(f1, f2, hf); v[6] = cand_key2<G * 16 + 6>(f1, f2, hf); v[7] = cand_key2<G * 16 + 7>(f1, f2, hf);
    v[8] = cand_key2<G * 16 + 8>(f1, f2, hf); v[9] = cand_key2<G * 16 + 9>(f1, f2, hf); v[10] = cand_key2<G * 16 + 10>(f1, f2, hf); v[11] = cand_key2<G * 16 + 11>(f1, f2, hf);
    v[12] = cand_key2<G * 16 + 12>(f1, f2, hf); v[13] = cand_key2<G * 16 + 13>(f1, f2, hf); v[14] = cand_key2<G * 16 + 14>(f1, f2, hf); v[15] = cand_key2<G * 16 + 15>(f1, f2, hf);
}

__device__ __forceinline__ void peer_topk32(const bf16* Q, const bf16* KEYS, unsigned short* EO, float* GO, LAS unsigned char* wl  , int tok0, int lane) {
    const int l32 = lane & 31, hf = lane >> 5; const size_t tok = (size_t)tok0 + l32;
    for (int h = 0; h < 8; ++h) {
        float L0[16], L1[16];
#pragma unroll
        for (int c = 0; c < 2; ++c) {
            bf16x8 bq[4];
#pragma unroll
            for (int ks = 0; ks < 4; ++ks) bq[ks] = __builtin_nontemporal_load((const bf16x8*)(Q + tok * 1024 + h * 128 + c * 64 + ks * 16 + hf * 8));
            float T[16], S[16];
            { f32x16 acc = (f32x16){0.f, 0.f, 0.f, 0.f, 0.f, 0.f, 0.f, 0.f, 0.f, 0.f, 0.f, 0.f, 0.f, 0.f, 0.f, 0.f};
              const bf16* kp = KEYS + ((size_t)((h * 2 + c) * 128 + l32)) * 64 + hf * 8;
#pragma unroll
              for (int ks = 0; ks < 4; ++ks) { const bf16x8 ak = *(const bf16x8*)(kp + ks * 16); acc = __builtin_amdgcn_mfma_f32_32x32x16_bf16(ak, bq[ks], acc, 0, 0, 0); }
#pragma unroll
              for (int r = 0; r < 16; ++r) T[r] = mkkey(acc[r], ~0x7f, 8 * (r >> 2) + 4 * hf + (r & 3));
              sort16(T); }
            for (int mt = 1; mt < 4; ++mt) {
                f32x16 acc = (f32x16){0.f, 0.f, 0.f, 0.f, 0.f, 0.f, 0.f, 0.f, 0.f, 0.f, 0.f, 0.f, 0.f, 0.f, 0.f, 0.f};
                const bf16* kp = KEYS + ((size_t)((h * 2 + c) * 128 + mt * 32 + l32)) * 64 + hf * 8;
#pragma unroll
                for (int ks = 0; ks < 4; ++ks) { const bf16x8 ak = *(const bf16x8*)(kp + ks * 16); acc = __builtin_amdgcn_mfma_f32_32x32x16_bf16(ak, bq[ks], acc, 0, 0, 0); }
#pragma unroll
                for (int r = 0; r < 16; ++r) S[r] = mkkey(acc[r], ~0x7f, mt * 32 + 8 * (r >> 2) + 4 * hf + (r & 3));
                sort16(S); merge16(T, S); }
#pragma unroll
            for (int r = 0; r < 16; ++r) S[r] = __shfl_xor(T[r], 32);
            merge16(T, S);
            if (c == 0) {
#pragma unroll
                for (int r = 0; r < 16; ++r) L0[r] = T[r];
            } else {
#pragma unroll
                for (int r = 0; r < 16; ++r) L1[r] = T[r];
            }
        }
        float f1[16], f2[16];
#pragma unroll
        for (int r = 0; r < 16; ++r) { const int k0 = f2i(L0[r]), k1 = f2i(L1[r]); f1[r] = i2f(k0 & ~0x7f); f2[r] = i2f(k1 & ~0x7f); wl[lane * 36 + r] = (unsigned char)(k0 & 0x7f); wl[lane * 36 + 16 + r] = (unsigned char)(k1 & 0x7f); }
        float K[16], S2[16];
        cand_fill2<0>(K, f1, f2, hf != 0); sort16(K);
        cand_fill2<1>(S2, f1, f2, hf != 0); sort16(S2); merge16(K, S2);
#pragma unroll
        for (int r = 0; r < 16; ++r) S2[r] = __shfl_xor(K[r], 32);
        merge16(K, S2);
        float pe[16], ssum = 0.f; const float mx = i2f(f2i(K[0]) & ~0xff);
#pragma unroll
        for (int r = 0; r < 16; ++r) { pe[r] = __expf(i2f(f2i(K[r]) & ~0xff) - mx); ssum += pe[r]; }
        const float inv = 1.0f / ssum;
        int ev[16]; float gv[16];
#pragma unroll
        for (int j = 0; j < 16; ++j) { const int ab = f2i(K[j]) & 0xff; const int i1 = wl[lane * 36 + (ab >> 4)], i2 = wl[lane * 36 + 16 + (ab & 15)]; ev[j] = i1 * 128 + i2; gv[j] = pe[j] * inv; }
        if (hf == 0) { unsigned short* ed = EO + (tok * 8 + h) * 16; float* gd = GO + (tok * 8 + h) * 16;
            *(v4u*)(ed) = (v4u){(unsigned)ev[0] | ((unsigned)ev[1] << 16), (unsigned)ev[2] | ((unsigned)ev[3] << 16), (unsigned)ev[4] | ((unsigned)ev[5] << 16), (unsigned)ev[6] | ((unsigned)ev[7] << 16)};
            *(v4u*)(ed + 8) = (v4u){(unsigned)ev[8] | ((unsigned)ev[9] << 16), (unsigned)ev[10] | ((unsigned)ev[11] << 16), (unsigned)ev[12] | ((unsigned)ev[13] << 16), (unsigned)ev[14] | ((unsigned)ev[15] << 16)};
#pragma unroll
            for (int j = 0; j < 4; ++j) *(f32x4*)(gd + 4 * j) = (f32x4){gv[4 * j], gv[4 * j + 1], gv[4 * j + 2], gv[4 * j + 3]}; }
    }
}

typedef float f32x2_t __attribute__((ext_vector_type(2)));
typedef _Float16 h2_t __attribute__((ext_vector_type(2)));
__device__ __forceinline__ h2_t as_h2(unsigned u) { return __builtin_bit_cast(h2_t, u); }
template <bool HI> __device__ __forceinline__ h2_t cvt_h2_fp8(unsigned d) { const auto t = __builtin_amdgcn_cvt_scalef32_pk_f16_fp8((int)d, 1.0f, HI); return __builtin_bit_cast(h2_t, t); }
typedef int v4i __attribute__((ext_vector_type(4)));
__device__ __forceinline__ void cvt8x2(v4u r, f32x2_t (&f)[8]) {
    const unsigned w0 = r.x, w1 = r.y, w2 = r.z, w3 = r.w;
    f[0] = __builtin_amdgcn_cvt_pk_f32_fp8((int)w0, false); f[1] = __builtin_amdgcn_cvt_pk_f32_fp8((int)w0, true);
    f[2] = __builtin_amdgcn_cvt_pk_f32_fp8((int)w1, false); f[3] = __builtin_amdgcn_cvt_pk_f32_fp8((int)w1, true);
    f[4] = __builtin_amdgcn_cvt_pk_f32_fp8((int)w2, false); f[5] = __builtin_amdgcn_cvt_pk_f32_fp8((int)w2, true);
    f[6] = __builtin_amdgcn_cvt_pk_f32_fp8((int)w3, false); f[7] = __builtin_amdgcn_cvt_pk_f32_fp8((int)w3, true);
}
__device__ __forceinline__ void load_elist(const unsigned short* E, size_t tok, int h, int (&e)[16]) {
    const v4u* ep = (const v4u*)(E + tok * 128 + h * 16);
#pragma unroll
    for (int i = 0; i < 2; ++i) { const v4u v = ep[i]; const unsigned w[4] = {v.x, v.y, v.z, v.w};
#pragma unroll
        for (int c = 0; c < 4; ++c) { e[8 * i + 2 * c] = (int)(w[c] & 0xffffu); e[8 * i + 2 * c + 1] = (int)(w[c] >> 16); } }
}
__device__ __forceinline__ void issue_rows(v4u (&r)[16], const unsigned char* tb, unsigned poff, const int (&e)[16]) {
#pragma unroll
    for (int k = 0; k < 16; ++k) r[k] = *(const v4u*)(tb + ((unsigned)e[k] * 128u + poff));
}
template <int B2, int B1, int B0> __device__ __forceinline__ void treduce16(const float (&v)[16], int lane, float& o0, float& o1) {
    float q8[8], q4[4];
    { const bool hi = (lane & B2) != 0;
#pragma unroll
      for (int i = 0; i < 8; ++i) { const float keep = hi ? v[i + 8] : v[i], send = hi ? v[i] : v[i + 8]; q8[i] = keep + __shfl_xor(send, B2); } }
    { const bool hi = (lane & B1) != 0;
#pragma unroll
      for (int i = 0; i < 4; ++i) { const float keep = hi ? q8[i + 4] : q8[i], send = hi ? q8[i] : q8[i + 4]; q4[i] = keep + __shfl_xor(send, B1); } }
    { const bool hi = (lane & B0) != 0;
      { const float keep = hi ? q4[2] : q4[0], send = hi ? q4[0] : q4[2]; o0 = keep + __shfl_xor(send, B0); }
      { const float keep = hi ? q4[3] : q4[1], send = hi ? q4[1] : q4[3]; o1 = keep + __shfl_xor(send, B0); } }
}
__device__ __forceinline__ void treduce16i_p(const int (&v)[16], int lane, int& o0, int& o1) {
    int q8[8], q4[4];
    { const bool hi = (lane & 4) != 0;
#pragma unroll
      for (int i = 0; i < 8; ++i) { const int keep = hi ? v[i + 8] : v[i], send = hi ? v[i] : v[i + 8]; q8[i] = keep + __builtin_amdgcn_update_dpp(0, send, 0x141, 0xF, 0xF, false); } }
    { const bool hi = (lane & 2) != 0;
#pragma unroll
      for (int i = 0; i < 4; ++i) { const int keep = hi ? q8[i + 4] : q8[i], send = hi ? q8[i] : q8[i + 4]; q4[i] = keep + __builtin_amdgcn_update_dpp(0, send, 0x4E, 0xF, 0xF, false); } }
    { const bool hi = (lane & 1) != 0;
      { const int keep = hi ? q4[2] : q4[0], send = hi ? q4[0] : q4[2]; o0 = keep + __builtin_amdgcn_update_dpp(0, send, 0xB1, 0xF, 0xF, false); }
      { const int keep = hi ? q4[3] : q4[1], send = hi ? q4[1] : q4[3]; o1 = keep + __builtin_amdgcn_update_dpp(0, send, 0xB1, 0xF, 0xF, false); } }
}
__device__ __forceinline__ void treduce16f_h(const float (&v)[16], int lane, float& o0, float& o1) {
    float q8[8], q4[4];
    { const bool hi = (lane & 8) != 0;
#pragma unroll
      for (int i = 0; i < 8; ++i) { const float keep = hi ? v[i + 8] : v[i], send = hi ? v[i] : v[i + 8];
          q8[i] = keep + __builtin_bit_cast(float, __builtin_amdgcn_update_dpp(0, __builtin_bit_cast(int, send), 0x128, 0xF, 0xF, false)); } }
    { const bool hi = (lane & 16) != 0;
#pragma unroll
      for (int i = 0; i < 4; ++i) { const float keep = hi ? q8[i + 4] : q8[i], send = hi ? q8[i] : q8[i + 4];
          q4[i] = keep + __builtin_bit_cast(float, __builtin_amdgcn_ds_swizzle(__builtin_bit_cast(int, send), 0x401F)); } }
    { const bool hi = (lane & 32) != 0;
      { const float keep = hi ? q4[2] : q4[0], send = hi ? q4[0] : q4[2]; o0 = keep + __shfl_xor(send, 32); }
      { const float keep = hi ? q4[3] : q4[1], send = hi ? q4[1] : q4[3]; o1 = keep + __shfl_xor(send, 32); } }
}
__device__ __forceinline__ void upass_compute(const v4u (&r)[16], v4u hq, short* pa, int lane, v4u (&rn)[16], const unsigned char* tb, unsigned poff, const int (&en)[16]) {
    int part[16];
#pragma unroll
    for (int k = 0; k < 16; ++k) { rn[k] = *(const v4u*)(tb + ((unsigned)en[k] * 128u + poff));
        int s = __builtin_amdgcn_sdot4((int)r[k].x, (int)hq.x, 0, false); s = __builtin_amdgcn_sdot4((int)r[k].y, (int)hq.y, s, false); s = __builtin_amdgcn_sdot4((int)r[k].z, (int)hq.z, s, false); part[k] = __builtin_amdgcn_sdot4((int)r[k].w, (int)hq.w, s, false);
        __builtin_amdgcn_sched_barrier(0); }
    int o0, o1; treduce16i_p(part, lane, o0, o1);
    *(unsigned*)(pa + (lane >> 3) * 16 + 2 * (lane & 7)) = (unsigned)(((o0 + 32) >> 6) & 0xffff) | ((unsigned)((o1 + 32) >> 6) << 16);
}
__device__ __forceinline__ void vpass_compute(const v4u (&r)[16], const v4u (&wp)[2], bf16* xo  , const float* gt  , int lane, v4u (&rn)[16], const unsigned char* tb, unsigned poff, const int (&en)[16]) {
    h2_t o2[8];
#pragma unroll
    for (int i = 0; i < 8; ++i) o2[i] = (h2_t){(_Float16)0.f, (_Float16)0.f};
    const unsigned wq[8] = {wp[0].x, wp[0].y, wp[0].z, wp[0].w, wp[1].x, wp[1].y, wp[1].z, wp[1].w};
#pragma unroll
    for (int k = 0; k < 16; ++k) { rn[k] = *(const v4u*)(tb + ((unsigned)en[k] * 128u + poff));
        const unsigned d0 = r[k].x, d1 = r[k].y, d2 = r[k].z, d3 = r[k].w; const h2_t wpair = as_h2(wq[k >> 1]); const _Float16 wh = (k & 1) ? wpair.y : wpair.x; const h2_t ww = {wh, wh};
        o2[0] = __builtin_elementwise_fma(cvt_h2_fp8<false>(d0), ww, o2[0]); o2[1] = __builtin_elementwise_fma(cvt_h2_fp8<true>(d0), ww, o2[1]);
        o2[2] = __builtin_elementwise_fma(cvt_h2_fp8<false>(d1), ww, o2[2]); o2[3] = __builtin_elementwise_fma(cvt_h2_fp8<true>(d1), ww, o2[3]);
        o2[4] = __builtin_elementwise_fma(cvt_h2_fp8<false>(d2), ww, o2[4]); o2[5] = __builtin_elementwise_fma(cvt_h2_fp8<true>(d2), ww, o2[5]);
        o2[6] = __builtin_elementwise_fma(cvt_h2_fp8<false>(d3), ww, o2[6]); o2[7] = __builtin_elementwise_fma(cvt_h2_fp8<true>(d3), ww, o2[7]);
        __builtin_amdgcn_sched_barrier(0); }
    float v[16];
#pragma unroll
    for (int i = 0; i < 8; ++i) { v[2 * i] = (float)o2[i].x * (1.0f / 64.0f); v[2 * i + 1] = (float)o2[i].y * (1.0f / 64.0f); }
    float o0, o1; treduce16f_h(v, lane, o0, o1);
    const int c = 16 * (lane & 7) + 2 * (((lane >> 1) & 4) | ((lane >> 3) & 2) | ((lane >> 5) & 1));
    const unsigned xb = *(const unsigned*)(xo + c); const f32x2_t g = *(const f32x2_t*)(gt + c);
    const float a0 = bflo(xb) + g.x * o0, a1 = bfhi(xb) + g.y * o1;
    const unsigned ob = pk2(a0, a1);
    *(unsigned*)(xo + c) = ob;
}
template <bool UP> __device__ __forceinline__ void peer_pass(const Args& a, int wave, int lane_in) {
    int lane = lane_in; asm volatile("" : "+v"(lane));
    const int G = gridDim.x, bx = blockIdx.x;
    const bool sliced = (G % 8) == 0;
    const int nj = sliced ? 1 : 8, j0 = sliced ? (bx & 7) : 0;
    const int first = sliced ? ((bx >> 3) * NWAVES + wave) : (bx * NWAVES + wave), stride = sliced ? (G >> 3) * NWAVES : G * NWAVES;
    const int h = lane >> 3, p = lane & 7;
    const unsigned short* E = (const unsigned short*)(a.ws + WS_E); const unsigned char* HQ = a.ws + WS_H2Q; const _Float16* W = (const _Float16*)(a.ws + WS_W);
    short* PA = (short*)(a.ws + WS_PA); const float* MOD = (const float*)(a.ws + WS_MOD);
    const unsigned char* T8 = a.ws + (UP ? WS_UB : WS_VB);
    const int ntok = (M - first + stride - 1) / stride;
    for (int jj = 0; jj < nj; ++jj) { const int j = j0 + jj;
        const unsigned char* tb = T8 + (size_t)j * (16384 * 128);
        v4u RA[16], RB[16]; int en[16], en2[16];
        v4u hA0, hB0; v4u wA[2], wB[2];
        { const size_t t0 = (size_t)first; int e0[16]; load_elist(E, t0, h, e0); issue_rows(RA, tb, 16u * p, e0);
          if (UP) { hA0 = *(const v4u*)(HQ + t0 * 1024 + 128 * j + 16 * p); }
          else { wA[0] = *(const v4u*)(W + t0 * 128 + h * 16); wA[1] = *(const v4u*)(W + t0 * 128 + h * 16 + 8); }
          const size_t t1 = (size_t)first + (size_t)(ntok > 1 ? 1 : 0) * stride; load_elist(E, t1, h, en); }
        for (int u = 0; u < ntok; u += 2) {
            { const int u1 = (u + 1 < ntok) ? u + 1 : ntok - 1, u2 = (u + 2 < ntok) ? u + 2 : ntok - 1; const size_t t1 = (size_t)first + (size_t)u1 * stride, t2 = (size_t)first + (size_t)u2 * stride;
              load_elist(E, t2, h, en2);
              if (UP) { hB0 = *(const v4u*)(HQ + t1 * 1024 + 128 * j + 16 * p); }
              else { wB[0] = *(const v4u*)(W + t1 * 128 + h * 16); wB[1] = *(const v4u*)(W + t1 * 128 + h * 16 + 8); }
              const size_t t = (size_t)first + (size_t)u * stride;
              if (UP) upass_compute(RA, hA0, PA + ((size_t)j * M + t) * 128, lane, RB, tb, 16u * p, en);
              else vpass_compute(RA, wA, (bf16*)(a.ws + WS_X1B) + t * 1024 + 128 * j, MOD + (t >> 13) * NMODC + 5120 + 128 * j, lane, RB, tb, 16u * p, en); }
            if (u + 1 >= ntok) break;
            { const int u1 = (u + 2 < ntok) ? u + 2 : ntok - 1, u2 = (u + 3 < ntok) ? u + 3 : ntok - 1; const size_t t1 = (size_t)first + (size_t)u1 * stride, t2 = (size_t)first + (size_t)u2 * stride;
              load_elist(E, t2, h, en);
              if (UP) { hA0 = *(const v4u*)(HQ + t1 * 1024 + 128 * j + 16 * p); }
              else { wA[0] = *(const v4u*)(W + t1 * 128 + h * 16); wA[1] = *(const v4u*)(W + t1 * 128 + h * 16 + 8); }
              const size_t t = (size_t)first + (size_t)(u + 1) * stride;
              if (UP) upass_compute(RB, hB0, PA + ((size_t)j * M + t) * 128, lane, RA, tb, 16u * p, en2);
              else vpass_compute(RB, wB, (bf16*)(a.ws + WS_X1B) + t * 1024 + 128 * j, MOD + (t >> 13) * NMODC + 5120 + 128 * j, lane, RA, tb, 16u * p, en2); }
        }
    }
}
__device__ __forceinline__ void upass4(const Args& a, int wave, int lane_in) {
    int lane = lane_in; asm volatile("" : "+v"(lane));
    const int G = gridDim.x, bx = blockIdx.x;
    const bool sliced = (G % 8) == 0;
    const int nj = sliced ? 1 : 8, j0 = sliced ? (bx & 7) : 0;
    const int first = sliced ? ((bx >> 3) * NWAVES + wave) : (bx * NWAVES + wave), stride = sliced ? (G >> 3) * NWAVES : G * NWAVES;
    const int r = lane >> 2, p = lane & 3;
    const unsigned short* E = (const unsigned short*)(a.ws + WS_E); const unsigned char* HQh = a.ws + WS_H2Q; const unsigned char* HQl = a.ws + WS_H2Q + (size_t)32 * MiB; short* PA = (short*)(a.ws + WS_PA);
    const int ntok = (M - first + stride - 1) / stride;
    const int eoff = (r >> 1) * 16 + 8 * (r & 1);
    for (int jj = 0; jj < nj; ++jj) { const int j = j0 + jj;
        const unsigned char* tb = a.ws + WS_UB + (size_t)j * (16384 * 64);
        const unsigned poff = 16u * p;
        v4u R0[8], R1[8], R2[8], R3[8], hh0, hl0, hh1, hl1, hh2, hl2, hh3, hl3, eA, eB;
#define U4_ROWS(R, ev) do { const unsigned w_[4] = {ev.x, ev.y, ev.z, ev.w}; _Pragma("unroll") for (int c_ = 0; c_ < 4; ++c_) { R[2 * c_] = *(const v4u*)(tb + ((w_[c_] & 0xffffu) * 64u + poff)); R[2 * c_ + 1] = *(const v4u*)(tb + ((w_[c_] >> 16) * 64u + poff)); } } while (0)
#define U4_COMPUTE(R, hh, hl, t) do { int part[8]; _Pragma("unroll") for (int i_ = 0; i_ < 8; ++i_) { \
            int sh_ = __builtin_amdgcn_sdot8((int)R[i_].x, (int)hh.x, 0, false); sh_ = __builtin_amdgcn_sdot8((int)R[i_].y, (int)hh.y, sh_, false); sh_ = __builtin_amdgcn_sdot8((int)R[i_].z, (int)hh.z, sh_, false); sh_ = __builtin_amdgcn_sdot8((int)R[i_].w, (int)hh.w, sh_, false); \
            int sl_ = __builtin_amdgcn_sdot8((int)R[i_].x, (int)hl.x, 0, false); sl_ = __builtin_amdgcn_sdot8((int)R[i_].y, (int)hl.y, sl_, false); sl_ = __builtin_amdgcn_sdot8((int)R[i_].z, (int)hl.z, sl_, false); sl_ = __builtin_amdgcn_sdot8((int)R[i_].w, (int)hl.w, sl_, false); \
            part[i_] = 16 * sh_ + sl_; } \
        int q4_[4]; { const bool hi_ = (lane & 2) != 0; _Pragma("unroll") for (int i_ = 0; i_ < 4; ++i_) { const int keep_ = hi_ ? part[i_ + 4] : part[i_], send_ = hi_ ? part[i_] : part[i_ + 4]; q4_[i_] = keep_ + __builtin_amdgcn_update_dpp(0, send_, 0x4E, 0xF, 0xF, false); } } \
        int o0_, o1_; { const bool hi_ = (lane & 1) != 0; { const int keep_ = hi_ ? q4_[2] : q4_[0], send_ = hi_ ? q4_[0] : q4_[2]; o0_ = keep_ + __builtin_amdgcn_update_dpp(0, send_, 0xB1, 0xF, 0xF, false); } \
            { const int keep_ = hi_ ? q4_[3] : q4_[1], send_ = hi_ ? q4_[1] : q4_[3]; o1_ = keep_ + __builtin_amdgcn_update_dpp(0, send_, 0xB1, 0xF, 0xF, false); } } \
        *(unsigned*)(PA + ((size_t)j * M + (t)) * 128 + eoff + 2 * p) = (unsigned)(((o0_ + 2) >> 2) & 0xffff) | ((unsigned)((o1_ + 2) >> 2) << 16); } while (0)
#define U4_TOK(u_) ((size_t)first + (size_t)((u_) < ntok ? (u_) : ntok - 1) * stride)
#define U4_E(ev, u_) do { ev = *(const v4u*)(E + U4_TOK(u_) * 128 + eoff); } while (0)
#define U4_H(hh, hl, u_) do { const size_t t_ = U4_TOK(u_); hh = *(const v4u*)(HQh + t_ * 512 + 64 * j + poff); hl = *(const v4u*)(HQl + t_ * 512 + 64 * j + poff); } while (0)
        { v4u e0, e1, e2; U4_E(e0, 0); U4_E(e1, 1); U4_E(e2, 2); U4_E(eA, 3);
          U4_H(hh0, hl0, 0); U4_ROWS(R0, e0); U4_H(hh1, hl1, 1); U4_ROWS(R1, e1); U4_H(hh2, hl2, 2); U4_ROWS(R2, e2); }
        for (int u = 0; u < ntok; u += 4) {
            U4_E(eB, u + 4); U4_H(hh3, hl3, u + 3); U4_ROWS(R3, eA); U4_COMPUTE(R0, hh0, hl0, U4_TOK(u));
            if (u + 1 >= ntok) break;
            U4_E(eA, u + 5); U4_H(hh0, hl0, u + 4); U4_ROWS(R0, eB); U4_COMPUTE(R1, hh1, hl1, U4_TOK(u + 1));
            if (u + 2 >= ntok) break;
            U4_E(eB, u + 6); U4_H(hh1, hl1, u + 5); U4_ROWS(R1, eA); U4_COMPUTE(R2, hh2, hl2, U4_TOK(u + 2));
            if (u + 3 >= ntok) break;
            U4_E(eA, u + 7); U4_H(hh2, hl2, u + 6); U4_ROWS(R2, eB); U4_COMPUTE(R3, hh3, hl3, U4_TOK(u + 3));
        }
#undef U4_TOK
#undef U4_E
#undef U4_H
#undef U4_ROWS
#undef U4_COMPUTE
    }
}
typedef long i64_t;
typedef int v2i_t __attribute__((ext_vector_type(2)));
__device__ __forceinline__ i64_t ds_tr8(const LAS unsigned char* p) { const v2i_t r = __builtin_amdgcn_ds_read_tr8_b64_v2i32((LAS v2i_t*)p); return (i64_t)(unsigned)r.x | ((i64_t)(unsigned)r.y << 32); }
__device__ __forceinline__ void vpass_mfma(const Args& a, LAS unsigned char* lds, int wave, int lane_in) {
    int lane = lane_in; asm volatile("" : "+v"(lane));
    const int G = gridDim.x, bx = blockIdx.x;
    const bool sliced = (G % 8) == 0;
    const int nj = sliced ? 1 : 8, j0 = sliced ? (bx & 7) : 0;
    const int first = sliced ? ((bx >> 3) * NWAVES + wave) : (bx * NWAVES + wave), stride = sliced ? (G >> 3) * NWAVES : G * NWAVES;
    const int r = lane >> 2, p4 = lane & 3, n16 = lane & 15, qp = lane >> 4;
    const unsigned short* E = (const unsigned short*)(a.ws + WS_E); const unsigned char* W8 = a.ws + WS_W; const float* MOD = (const float*)(a.ws + WS_MOD);
    LAS unsigned char* slot = lds + wave * 16384;
    const int ntok = (M - first + stride - 1) / stride;
    const int eoff = (r >> 1) * 16 + 8 * (r & 1);
    const int wbase = (8 * r) * 128, hk = (r >> 2) & 1;
    const int rkey = (n16 >> 1) ^ (qp & 1), rbase = (32 * qp + (n16 >> 1)) * 128 + 8 * (n16 & 1);
    const bool even = (n16 & 1) == 0; const int ccol = 32 * qp + (even ? n16 : 15 + n16);
    for (int jj = 0; jj < nj; ++jj) { const int j = j0 + jj;
        const unsigned char* tb = a.ws + WS_VB + (size_t)j * (16384 * 128);
        const unsigned poff = 32u * p4;
        v4u RA[16], RB[16], wA, wB, en, en2;
#define VM_ROWS(R, ev) do { const unsigned w_[4] = {ev.x, ev.y, ev.z, ev.w}; _Pragma("unroll") for (int c_ = 0; c_ < 4; ++c_) { \
            const unsigned char* r0_ = tb + ((w_[c_] & 0xffffu) * 128u + poff); const unsigned char* r1_ = tb + ((w_[c_] >> 16) * 128u + poff); \
            R[4 * c_] = *(const v4u*)r0_; R[4 * c_ + 1] = *(const v4u*)(r0_ + 16); R[4 * c_ + 2] = *(const v4u*)r1_; R[4 * c_ + 3] = *(const v4u*)(r1_ + 16); } } while (0)
#define VM_W(wv, t) do { wv = *(const v4u*)(W8 + (size_t)(t) * 128 + 32 * qp + 16 * (n16 & 1)); } while (0)
#define VM_COMPUTE(R, wv, t) do { \
        _Pragma("unroll") for (int i_ = 0; i_ < 8; ++i_) { const int k_ = (i_ & 7) ^ hk; *(LAS v4u*)(slot + wbase + i_ * 128 + 16 * ((2 * p4) ^ k_)) = R[2 * i_]; *(LAS v4u*)(slot + wbase + i_ * 128 + 16 * ((2 * p4 + 1) ^ k_)) = R[2 * i_ + 1]; } \
        unsigned wq_[8]; { const unsigned o0_ = (unsigned)__builtin_amdgcn_update_dpp(0, (int)wv.x, 0xB1, 0xF, 0xF, false), o1_ = (unsigned)__builtin_amdgcn_update_dpp(0, (int)wv.y, 0xB1, 0xF, 0xF, false), \
              o2_ = (unsigned)__builtin_amdgcn_update_dpp(0, (int)wv.z, 0xB1, 0xF, 0xF, false), o3_ = (unsigned)__builtin_amdgcn_update_dpp(0, (int)wv.w, 0xB1, 0xF, 0xF, false); \
          wq_[0] = even ? wv.x : o0_; wq_[1] = even ? wv.y : o1_; wq_[2] = even ? wv.z : o2_; wq_[3] = even ? wv.w : o3_; wq_[4] = even ? o0_ : wv.x; wq_[5] = even ? o1_ : wv.y; wq_[6] = even ? o2_ : wv.z; wq_[7] = even ? o3_ : wv.w; } \
        f32x4 acc_[8]; _Pragma("unroll") for (int nt_ = 0; nt_ < 8; ++nt_) acc_[nt_] = (f32x4){0.f, 0.f, 0.f, 0.f}; \
        _Pragma("unroll") for (int ks_ = 0; ks_ < 4; ++ks_) { const i64_t aw_ = (i64_t)wq_[2 * ks_] | ((i64_t)wq_[2 * ks_ + 1] << 32); \
            _Pragma("unroll") for (int nt_ = 0; nt_ < 8; ++nt_) { const i64_t bv_ = ds_tr8(slot + rbase + ks_ * 1024 + 16 * (nt_ ^ rkey)); acc_[nt_] = __builtin_amdgcn_mfma_f32_16x16x32_fp8_fp8(aw_, bv_, acc_[nt_], 0, 0, 0); } } \
        const float e01_ = (qp & 1) ? acc_[2][0] : acc_[0][0], e23_ = (qp & 1) ? acc_[6][0] : acc_[4][0], o01_ = (qp & 1) ? acc_[3][0] : acc_[1][0], o23_ = (qp & 1) ? acc_[7][0] : acc_[5][0]; \
        const float se_ = (qp & 2) ? e23_ : e01_, so_ = (qp & 2) ? o23_ : o01_; \
        const float mine_ = even ? se_ : so_, send_ = even ? so_ : se_; \
        const float recv_ = __builtin_bit_cast(float, __builtin_amdgcn_update_dpp(0, __builtin_bit_cast(int, send_), 0xB1, 0xF, 0xF, false)); \
        const float lo_ = even ? mine_ : recv_, hi_ = even ? recv_ : mine_; \
        bf16* xo_ = (bf16*)(a.ws + WS_X1B) + (size_t)(t) * 1024 + 128 * j + ccol; const float* gt_ = MOD + ((size_t)(t) >> 13) * NMODC + 5120 + 128 * j + ccol; \
        const unsigned xb_ = *(const unsigned*)xo_; const f32x2_t g_ = *(const f32x2_t*)gt_; \
        *(unsigned*)xo_ = pk2(bflo(xb_) + g_.x * lo_ * (1.0f / 4096.0f), bfhi(xb_) + g_.y * hi_ * (1.0f / 4096.0f)); } while (0)
#define VM_TOK(u_) ((size_t)first + (size_t)((u_) < ntok ? (u_) : ntok - 1) * stride)
        { v4u e0 = *(const v4u*)(E + VM_TOK(0) * 128 + eoff); VM_ROWS(RA, e0); VM_W(wA, VM_TOK(0)); en = *(const v4u*)(E + VM_TOK(1) * 128 + eoff); }
        for (int u = 0; u < ntok; u += 2) {
            { en2 = *(const v4u*)(E + VM_TOK(u + 2) * 128 + eoff); VM_W(wB, VM_TOK(u + 1)); VM_ROWS(RB, en); VM_COMPUTE(RA, wA, VM_TOK(u)); }
            if (u + 1 >= ntok) break;
            { en = *(const v4u*)(E + VM_TOK(u + 3) * 128 + eoff); VM_W(wA, VM_TOK(u + 2)); VM_ROWS(RA, en2); VM_COMPUTE(RB, wB, VM_TOK(u + 1)); }
        }
#undef VM_ROWS
#undef VM_COMPUTE
#undef VM_W
#undef VM_TOK
    }
}
typedef int v8i_t __attribute__((ext_vector_type(8)));
__device__ __forceinline__ v2i_t ds_tr4(const LAS unsigned char* p) { return __builtin_amdgcn_ds_read_tr4_b64_v2i32((LAS v2i_t*)p); }
__device__ __forceinline__ void vpass_mfma4(const Args& a, LAS unsigned char* lds, int wave, int lane_in) {
    int lane = lane_in; asm volatile("" : "+v"(lane));
    const int G = gridDim.x, bx = blockIdx.x;
    const bool sliced = (G % 8) == 0;
    const int nj = sliced ? 1 : 8, j0 = sliced ? (bx & 7) : 0;
    const int first = sliced ? ((bx >> 3) * NWAVES + wave) : (bx * NWAVES + wave), stride = sliced ? (G >> 3) * NWAVES : G * NWAVES;
    const int r = lane >> 2, p4 = lane & 3, n16 = lane & 15, qp = lane >> 4;
    const unsigned short* E = (const unsigned short*)(a.ws + WS_E); const unsigned char* W8 = a.ws + WS_W; const float* MOD = (const float*)(a.ws + WS_MOD);
    LAS unsigned char* slot = lds + wave * 8192;
    const int ntok = (M - first + stride - 1) / stride;
    const int eoff = 8 * r;
    const int wbase = (8 * r) * 64;
    const int rkey = (n16 >> 2) & 3, rbase = (32 * qp + n16) * 64;
    const bool even = (n16 & 1) == 0; const int ccol = 32 * qp + (even ? n16 : 15 + n16);
    for (int jj = 0; jj < nj; ++jj) { const int j = j0 + jj;
        const unsigned char* tb = a.ws + WS_VB + (size_t)j * (16384 * 64);
        const unsigned poff = 16u * p4;
        v4u R0[8], R1[8], R2[8], R3[8], w0, w1, w2, w3, eA, eB;
#define V4_ROWS(R, ev) do { const unsigned w_[4] = {ev.x, ev.y, ev.z, ev.w}; _Pragma("unroll") for (int c_ = 0; c_ < 4; ++c_) { R[2 * c_] = *(const v4u*)(tb + ((w_[c_] & 0xffffu) * 64u + poff)); R[2 * c_ + 1] = *(const v4u*)(tb + ((w_[c_] >> 16) * 64u + poff)); } } while (0)
#define V4_TOK(u_) ((size_t)first + (size_t)((u_) < ntok ? (u_) : ntok - 1) * stride)
#define V4_E(ev, u_) do { ev = *(const v4u*)(E + V4_TOK(u_) * 128 + eoff); } while (0)
#define V4_W(wv, u_) do { wv = *(const v4u*)(W8 + V4_TOK(u_) * 128 + 16 * qp + 64 * (n16 & 1)); } while (0)
#define V4_COMPUTE(R, wv, t) do { \
        _Pragma("unroll") for (int i_ = 0; i_ < 8; ++i_) *(LAS v4u*)(slot + wbase + i_ * 64 + 16 * (p4 ^ ((2 * r + (i_ >> 2)) & 3))) = R[i_]; \
        v8i_t aw_; { const int o0_ = __builtin_amdgcn_update_dpp(0, (int)wv.x, 0xB1, 0xF, 0xF, false), o1_ = __builtin_amdgcn_update_dpp(0, (int)wv.y, 0xB1, 0xF, 0xF, false), \
              o2_ = __builtin_amdgcn_update_dpp(0, (int)wv.z, 0xB1, 0xF, 0xF, false), o3_ = __builtin_amdgcn_update_dpp(0, (int)wv.w, 0xB1, 0xF, 0xF, false); \
          aw_[0] = even ? (int)wv.x : o0_; aw_[1] = even ? (int)wv.y : o1_; aw_[2] = even ? (int)wv.z : o2_; aw_[3] = even ? (int)wv.w : o3_; \
          aw_[4] = even ? o0_ : (int)wv.x; aw_[5] = even ? o1_ : (int)wv.y; aw_[6] = even ? o2_ : (int)wv.z; aw_[7] = even ? o3_ : (int)wv.w; } \
        f32x4 acc_[8]; \
        _Pragma("unroll") for (int nt_ = 0; nt_ < 8; ++nt_) { const LAS unsigned char* rp_ = slot + rbase + 16 * ((nt_ >> 1) ^ rkey) + 8 * (nt_ & 1); \
            const v2i_t b0_ = ds_tr4(rp_), b1_ = ds_tr4(rp_ + 16 * 64); const v8i_t bv_ = {b0_.x, b0_.y, b1_.x, b1_.y, 0, 0, 0, 0}; \
            acc_[nt_] = __builtin_amdgcn_mfma_scale_f32_16x16x128_f8f6f4(aw_, bv_, (f32x4){0.f, 0.f, 0.f, 0.f}, 0, 4, 0, 0, 0, 0); } \
        const float e01_ = (qp & 1) ? acc_[2][0] : acc_[0][0], e23_ = (qp & 1) ? acc_[6][0] : acc_[4][0], o01_ = (qp & 1) ? acc_[3][0] : acc_[1][0], o23_ = (qp & 1) ? acc_[7][0] : acc_[5][0]; \
        const float se_ = (qp & 2) ? e23_ : e01_, so_ = (qp & 2) ? o23_ : o01_; \
        const float mine_ = even ? se_ : so_, send_ = even ? so_ : se_; \
        const float recv_ = __builtin_bit_cast(float, __builtin_amdgcn_update_dpp(0, __builtin_bit_cast(int, send_), 0xB1, 0xF, 0xF, false)); \
        const float lo_ = even ? mine_ : recv_, hi_ = even ? recv_ : mine_; \
        bf16* xo_ = (bf16*)(a.ws + WS_X1B) + (size_t)(t) * 1024 + 128 * j + ccol; const float* gt_ = MOD + ((size_t)(t) >> 13) * NMODC + 5120 + 128 * j + ccol; \
        const unsigned xb_ = *(const unsigned*)xo_; const f32x2_t g_ = *(const f32x2_t*)gt_; \
        *(unsigned*)xo_ = pk2(bflo(xb_) + g_.x * lo_ * (1.0f / 256.0f), bfhi(xb_) + g_.y * hi_ * (1.0f / 256.0f)); } while (0)
        { v4u e0, e1, e2; V4_E(e0, 0); V4_E(e1, 1); V4_E(e2, 2); V4_E(eA, 3);
          V4_W(w0, 0); V4_ROWS(R0, e0); V4_W(w1, 1); V4_ROWS(R1, e1); V4_W(w2, 2); V4_ROWS(R2, e2); }
        for (int u = 0; u < ntok; u += 4) {
            V4_E(eB, u + 4); V4_W(w3, u + 3); V4_ROWS(R3, eA); V4_COMPUTE(R0, w0, V4_TOK(u));
            if (u + 1 >= ntok) break;
            V4_E(eA, u + 5); V4_W(w0, u + 4); V4_ROWS(R0, eB); V4_COMPUTE(R1, w1, V4_TOK(u + 1));
            if (u + 2 >= ntok) break;
            V4_E(eB, u + 6); V4_W(w1, u + 5); V4_ROWS(R1, eA); V4_COMPUTE(R2, w2, V4_TOK(u + 2));
            if (u + 3 >= ntok) break;
            V4_E(eA, u + 7); V4_W(w2, u + 6); V4_ROWS(R2, eB); V4_COMPUTE(R3, w3, V4_TOK(u + 3));
        }
#undef V4_ROWS
#undef V4_TOK
#undef V4_E
#undef V4_W
#undef V4_COMPUTE
    }
}
__device__ __forceinline__ void vpass_wide(const Args& a, LAS unsigned char* lds, int wave, int lane_in, size_t xdst_off = WS_X1B) {
    int lane = lane_in; asm volatile("" : "+v"(lane));
    const int G = gridDim.x, bx = blockIdx.x;
    const bool sliced = (G % 8) == 0;
    const int nj = sliced ? 1 : 4, j0 = sliced ? ((bx & 7) >> 1) : 0;
    const int tmul = sliced ? 2 : 1, tadd = sliced ? (bx & 1) : 0;
    const int first = sliced ? ((bx >> 3) * NWAVES + wave) : (bx * NWAVES + wave), stride = sliced ? (G >> 3) * NWAVES : G * NWAVES;
    const int ntok = ((sliced ? M / 2 : M) - first + stride - 1) / stride;
    const int r = lane >> 2, p4 = lane & 3, n16 = lane & 15, qp = lane >> 4;
    const unsigned short* E = (const unsigned short*)(a.ws + WS_E); const unsigned char* W8 = a.ws + WS_W; const float* MOD = (const float*)(a.ws + WS_MOD);
    LAS unsigned char* slot = lds + wave * 16384;
    const int eoff = 8 * r;
    const int wbase = (8 * r) * 128;
    const int rkey = (n16 >> 1) & 7, rbase = (32 * qp + n16) * 128;
    const bool even = (n16 & 1) == 0;
    const int ccol0 = 16 * (4 * qp + (even ? 0 : 1)) + (even ? n16 : n16 - 1), ccol1 = ccol0 + 32;
    for (int jj = 0; jj < nj; ++jj) { const int j = j0 + jj;
        const unsigned char* tb = a.ws + WS_VB + (size_t)j * (16384 * 128);
        const unsigned poff = 32u * p4;
        v4u RA[16], RB[16], wA, wB, en, en2; unsigned xA0, xA1, xB0, xB1; f32x2_t gA0, gA1, gB0, gB1;
#define VW_TOK(u_) ((size_t)tmul * ((size_t)first + (size_t)((u_) < ntok ? (u_) : ntok - 1) * stride) + tadd)
#define VW_ROWS(R, ev) do { const unsigned w_[4] = {ev.x, ev.y, ev.z, ev.w}; _Pragma("unroll") for (int c_ = 0; c_ < 4; ++c_) { \
            const unsigned char* r0_ = tb + ((w_[c_] & 0xffffu) * 128u + poff); const unsigned char* r1_ = tb + ((w_[c_] >> 16) * 128u + poff); \
            R[4 * c_] = *(const v4u*)r0_; R[4 * c_ + 1] = *(const v4u*)(r0_ + 16); R[4 * c_ + 2] = *(const v4u*)r1_; R[4 * c_ + 3] = *(const v4u*)(r1_ + 16); } } while (0)
#define VW_W(wv, u_) do { wv = *(const v4u*)(W8 + VW_TOK(u_) * 128 + 16 * qp + 64 * (n16 & 1)); } while (0)
#define VW_X(x0v, x1v, g0v, g1v, u_) do { const size_t t_ = VW_TOK(u_); const bf16* xi_ = (const bf16*)(a.ws + WS_X1B) + t_ * 1024 + 256 * j; const float* gt_ = MOD + (t_ >> 13) * NMODC + 5120 + 256 * j; \
        x0v = *(const unsigned*)(xi_ + ccol0); x1v = *(const unsigned*)(xi_ + ccol1); g0v = *(const f32x2_t*)(gt_ + ccol0); g1v = *(const f32x2_t*)(gt_ + ccol1); } while (0)
#define VW_COMPUTE(R, wv, xa_, xb_, ga_, gb_, t) do { \
        _Pragma("unroll") for (int i_ = 0; i_ < 8; ++i_) { const int k_ = (4 * r + (i_ >> 1)) & 7; *(LAS v4u*)(slot + wbase + i_ * 128 + 16 * ((2 * p4) ^ k_)) = R[2 * i_]; *(LAS v4u*)(slot + wbase + i_ * 128 + 16 * ((2 * p4 + 1) ^ k_)) = R[2 * i_ + 1]; } \
        v8i_t aw_; { const int o0_ = __builtin_amdgcn_update_dpp(0, (int)wv.x, 0xB1, 0xF, 0xF, false), o1_ = __builtin_amdgcn_update_dpp(0, (int)wv.y, 0xB1, 0xF, 0xF, false), \
              o2_ = __builtin_amdgcn_update_dpp(0, (int)wv.z, 0xB1, 0xF, 0xF, false), o3_ = __builtin_amdgcn_update_dpp(0, (int)wv.w, 0xB1, 0xF, 0xF, false); \
          aw_[0] = even ? (int)wv.x : o0_; aw_[1] = even ? (int)wv.y : o1_; aw_[2] = even ? (int)wv.z : o2_; aw_[3] = even ? (int)wv.w : o3_; \
          aw_[4] = even ? o0_ : (int)wv.x; aw_[5] = even ? o1_ : (int)wv.y; aw_[6] = even ? o2_ : (int)wv.z; aw_[7] = even ? o3_ : (int)wv.w; } \
        float tv_[16]; \
        _Pragma("unroll") for (int nt_ = 0; nt_ < 16; ++nt_) { const LAS unsigned char* rp_ = slot + rbase + 16 * ((nt_ >> 1) ^ rkey) + 8 * (nt_ & 1); \
            const v2i_t b0_ = ds_tr4(rp_), b1_ = ds_tr4(rp_ + 16 * 128); const v8i_t bv_ = {b0_.x, b0_.y, b1_.x, b1_.y, 0, 0, 0, 0}; \
            const f32x4 c_ = __builtin_amdgcn_mfma_scale_f32_16x16x128_f8f6f4(aw_, bv_, (f32x4){0.f, 0.f, 0.f, 0.f}, 0, 4, 0, 0, 0, 0); tv_[nt_] = c_[0]; } \
          \
        float t0_ = (qp & 1) ? tv_[4] : tv_[0], t1_ = (qp & 1) ? tv_[5] : tv_[1], t2_ = (qp & 1) ? tv_[6] : tv_[2], t3_ = (qp & 1) ? tv_[7] : tv_[3]; \
        { const float u0_ = (qp & 1) ? tv_[12] : tv_[8], u1_ = (qp & 1) ? tv_[13] : tv_[9], u2_ = (qp & 1) ? tv_[14] : tv_[10], u3_ = (qp & 1) ? tv_[15] : tv_[11]; \
          t0_ = (qp & 2) ? u0_ : t0_; t1_ = (qp & 2) ? u1_ : t1_; t2_ = (qp & 2) ? u2_ : t2_; t3_ = (qp & 2) ? u3_ : t3_; } \
          \
        const float mA_ = even ? t0_ : t1_, mB_ = even ? t2_ : t3_, sA_ = even ? t1_ : t0_, sB_ = even ? t3_ : t2_; \
        const float rA_ = __builtin_bit_cast(float, __builtin_amdgcn_update_dpp(0, __builtin_bit_cast(int, sA_), 0xB1, 0xF, 0xF, false)); \
        const float rB_ = __builtin_bit_cast(float, __builtin_amdgcn_update_dpp(0, __builtin_bit_cast(int, sB_), 0xB1, 0xF, 0xF, false)); \
        const float loA_ = even ? mA_ : rA_, hiA_ = even ? rA_ : mA_, loB_ = even ? mB_ : rB_, hiB_ = even ? rB_ : mB_; \
        bf16* xo_ = (bf16*)(a.ws + xdst_off) + (size_t)(t) * 1024 + 256 * j; \
        *(unsigned*)(xo_ + ccol0) = pk2(bflo(xa_) + ga_.x * loA_ * (1.0f / 256.0f), bfhi(xa_) + ga_.y * hiA_ * (1.0f / 256.0f)); \
        *(unsigned*)(xo_ + ccol1) = pk2(bflo(xb_) + gb_.x * loB_ * (1.0f / 256.0f), bfhi(xb_) + gb_.y * hiB_ * (1.0f / 256.0f)); } while (0)
        { v4u e0 = *(const v4u*)(E + VW_TOK(0) * 128 + eoff); VW_W(wA, 0); VW_X(xA0, xA1, gA0, gA1, 0); VW_ROWS(RA, e0); en = *(const v4u*)(E + VW_TOK(1) * 128 + eoff); }
        for (int u = 0; u < ntok; u += 2) {
            { en2 = *(const v4u*)(E + VW_TOK(u + 2) * 128 + eoff); VW_W(wB, u + 1); VW_X(xB0, xB1, gB0, gB1, u + 1); VW_ROWS(RB, en); VW_COMPUTE(RA, wA, xA0, xA1, gA0, gA1, VW_TOK(u)); }
            if (u + 1 >= ntok) break;
            { en = *(const v4u*)(E + VW_TOK(u + 3) * 128 + eoff); VW_W(wA, u + 2); VW_X(xA0, xA1, gA0, gA1, u + 2); VW_ROWS(RA, en2); VW_COMPUTE(RB, wB, xB0, xB1, gB0, gB1, VW_TOK(u + 1)); }
        }
#undef VW_TOK
#undef VW_ROWS
#undef VW_W
#undef VW_X
#undef VW_COMPUTE
    }
}
__device__ __forceinline__ void upass_wide(const Args& a, LAS unsigned char* lds, int wave, int lane_in) {
    int lane = lane_in; asm volatile("" : "+v"(lane));
    const int G = gridDim.x, bx = blockIdx.x;
    const bool sliced = (G % 8) == 0;
    const int nj = sliced ? 1 : 4, j0 = sliced ? ((bx & 7) >> 1) : 0;
    const int tmul = sliced ? 2 : 1, tadd = sliced ? (bx & 1) : 0;
    const int first = sliced ? ((bx >> 3) * NWAVES + wave) : (bx * NWAVES + wave), stride = sliced ? (G >> 3) * NWAVES : G * NWAVES;
    const int ntok = ((sliced ? M / 2 : M) - first + stride - 1) / stride;
    const int r = lane >> 2, p4 = lane & 3, n16 = lane & 15, qp = lane >> 4;
    const unsigned short* E = (const unsigned short*)(a.ws + WS_E); const unsigned char* H8 = a.ws + WS_H2Q; bf16* PA = (bf16*)(a.ws + WS_PA);
    LAS unsigned char* slot = lds + wave * 16384;
    const int eoff = 8 * r, wbase = (8 * r) * 128;
    const int akey = (n16 >> 1) & 7, abase = n16 * 128;
    const bool even = (n16 & 1) == 0;
    for (int jj = 0; jj < nj; ++jj) { const int j = j0 + jj;
        const unsigned char* tb = a.ws + WS_UB + (size_t)j * (16384 * 128);
        const unsigned poff = 32u * p4;
        v4u RA[16], RB[16], haA, hbA, haB, hbB, en, en2;
#define UW_TOK(u_) ((size_t)tmul * ((size_t)first + (size_t)((u_) < ntok ? (u_) : ntok - 1) * stride) + tadd)
#define UW_ROWS(R, ev) do { const unsigned w_[4] = {ev.x, ev.y, ev.z, ev.w}; _Pragma("unroll") for (int c_ = 0; c_ < 4; ++c_) { \
            const unsigned char* r0_ = tb + ((w_[c_] & 0xffffu) * 128u + poff); const unsigned char* r1_ = tb + ((w_[c_] >> 16) * 128u + poff); \
            R[4 * c_] = *(const v4u*)r0_; R[4 * c_ + 1] = *(const v4u*)(r0_ + 16); R[4 * c_ + 2] = *(const v4u*)r1_; R[4 * c_ + 3] = *(const v4u*)(r1_ + 16); } } while (0)
#define UW_H(ha, hb, u_) do { const unsigned char* hp_ = H8 + UW_TOK(u_) * 1024 + 256 * j + 16 * qp + 128 * (n16 & 1); ha = *(const v4u*)hp_; hb = *(const v4u*)(hp_ + 64); } while (0)
#define UW_COMPUTE(R, ha, hb, t) do { \
        _Pragma("unroll") for (int i_ = 0; i_ < 8; ++i_) { const int k_ = (4 * r + (i_ >> 1)) & 7; *(LAS v4u*)(slot + wbase + i_ * 128 + 16 * ((2 * p4) ^ k_)) = R[2 * i_]; *(LAS v4u*)(slot + wbase + i_ * 128 + 16 * ((2 * p4 + 1) ^ k_)) = R[2 * i_ + 1]; } \
        v8i_t bh0_, bh1_; { const int mine_[8] = {(int)ha.x, (int)ha.y, (int)ha.z, (int)ha.w, (int)hb.x, (int)hb.y, (int)hb.z, (int)hb.w}; \
          _Pragma("unroll") for (int d_ = 0; d_ < 8; ++d_) { const int o_ = __builtin_amdgcn_update_dpp(0, mine_[d_], 0xB1, 0xF, 0xF, false); bh0_[d_] = even ? mine_[d_] : o_; bh1_[d_] = even ? o_ : mine_[d_]; } } \
        f32x4 acc_[8]; \
        _Pragma("unroll") for (int mb_ = 0; mb_ < 8; ++mb_) { \
            const v4u a0_ = *(const LAS v4u*)(slot + mb_ * 2048 + abase + 16 * (qp ^ akey)), a1_ = *(const LAS v4u*)(slot + mb_ * 2048 + abase + 16 * ((4 + qp) ^ akey)); \
            const v8i_t av0_ = {(int)a0_.x, (int)a0_.y, (int)a0_.z, (int)a0_.w, 0, 0, 0, 0}, av1_ = {(int)a1_.x, (int)a1_.y, (int)a1_.z, (int)a1_.w, 0, 0, 0, 0}; \
            f32x4 c_ = __builtin_amdgcn_mfma_scale_f32_16x16x128_f8f6f4(av0_, bh0_, (f32x4){0.f, 0.f, 0.f, 0.f}, 4, 0, 0, 0, 0, 0); \
            acc_[mb_] = __builtin_amdgcn_mfma_scale_f32_16x16x128_f8f6f4(av1_, bh1_, c_, 4, 0, 0, 0, 0, 0); } \
        const f32x4 s01_ = (n16 & 1) ? acc_[1] : acc_[0], s23_ = (n16 & 1) ? acc_[3] : acc_[2], s45_ = (n16 & 1) ? acc_[5] : acc_[4], s67_ = (n16 & 1) ? acc_[7] : acc_[6]; \
        const f32x4 s03_ = (n16 & 2) ? s23_ : s01_, s47_ = (n16 & 2) ? s67_ : s45_; const f32x4 sel_ = (n16 & 4) ? s47_ : s03_; \
        if (n16 < 8) *(v2u*)(PA + ((size_t)j * M + (t)) * 128 + n16 * 16 + 4 * qp) = (v2u){pg8::cvt_pk_bf16(sel_[0], sel_[1]), pg8::cvt_pk_bf16(sel_[2], sel_[3])}; } while (0)
        { v4u e0 = *(const v4u*)(E + UW_TOK(0) * 128 + eoff); UW_ROWS(RA, e0); UW_H(haA, hbA, 0); en = *(const v4u*)(E + UW_TOK(1) * 128 + eoff); }
        for (int u = 0; u < ntok; u += 2) {
            { en2 = *(const v4u*)(E + UW_TOK(u + 2) * 128 + eoff); UW_H(haB, hbB, u + 1); UW_ROWS(RB, en); UW_COMPUTE(RA, haA, hbA, UW_TOK(u)); }
            if (u + 1 >= ntok) break;
            { en = *(const v4u*)(E + UW_TOK(u + 3) * 128 + eoff); UW_H(haA, hbA, u + 2); UW_ROWS(RA, en2); UW_COMPUTE(RB, haB, hbB, UW_TOK(u + 1)); }
        }
#undef UW_TOK
#undef UW_ROWS
#undef UW_H
#undef UW_COMPUTE
    }
}
__device__ __forceinline__ void peer_reduce(const Args& a, LAS unsigned char* lds, int tid) {
    const unsigned short* E = (const unsigned short*)(a.ws + WS_E); const float* Gt = (const float*)(a.ws + WS_G); unsigned char* W = a.ws + WS_W; const bf16* PA = (const bf16*)(a.ws + WS_PA);
    const float* SU = (const float*)(a.ws + WS_SU); const float* SV = (const float*)(a.ws + WS_SV); const float* SH = (const float*)(a.ws + WS_SH);
    __syncthreads();
    for (int i = tid; i < 16384 / 4; i += 512) { const f32x4 u4 = *(const f32x4*)(SU + 4 * i), v4 = *(const f32x4*)(SV + 4 * i);
        *(LAS f32x4*)(lds + 32 * i) = (f32x4){u4.x, v4.x, u4.y, v4.y}; *(LAS f32x4*)(lds + 32 * i + 16) = (f32x4){u4.z, v4.z, u4.w, v4.w}; }
    __syncthreads();
    const size_t n4 = (size_t)M * 128 / 4, gth = (size_t)gridDim.x * 512;
    for (size_t i = (size_t)blockIdx.x * 512 + tid; i < n4; i += gth) {
        f32x4 s = {0.f, 0.f, 0.f, 0.f};
#pragma unroll
        for (int j = 0; j < 4; ++j) { const v2u pq = __builtin_nontemporal_load((const v2u*)(PA + (size_t)j * M * 128 + i * 4)); s += (f32x4){bflo(pq.x), bfhi(pq.x), bflo(pq.y), bfhi(pq.y)}; }
        const float sh = SH[i >> 5];
        const v2u ep = *(const v2u*)(E + i * 4); const f32x4 g = *(const f32x4*)(Gt + i * 4); f32x4 w;
        const f2_t t0 = *(const LAS f2_t*)(lds + 8 * (ep.x & 0xffffu)), t1 = *(const LAS f2_t*)(lds + 8 * (ep.x >> 16)), t2 = *(const LAS f2_t*)(lds + 8 * (ep.y & 0xffffu)), t3 = *(const LAS f2_t*)(lds + 8 * (ep.y >> 16));
        w.x = g.x * gelu_t(s.x * sh * t0.x) * t0.y; w.y = g.y * gelu_t(s.y * sh * t1.x) * t1.y; w.z = g.z * gelu_t(s.z * sh * t2.x) * t2.y; w.w = g.w * gelu_t(s.w * sh * t3.x) * t3.y;
        { const f32x4 ws_ = w * 256.0f; int pk = 0;
          pk = __builtin_amdgcn_cvt_pk_fp8_f32(fminf(fmaxf(ws_.x, -440.f), 440.f), fminf(fmaxf(ws_.y, -440.f), 440.f), pk, false);
          pk = __builtin_amdgcn_cvt_pk_fp8_f32(fminf(fmaxf(ws_.z, -440.f), 440.f), fminf(fmaxf(ws_.w, -440.f), 440.f), pk, true);
          *(unsigned*)(W + i * 4) = (unsigned)pk; } }
}
__device__ __forceinline__ void final_norm(const Args& a, int wave, int lane) {
    const float* gf = a.in[I_GFIN]; const bf16* X2 = (const bf16*)(a.ws + WS_X1B);
    f32x4 g[4];
#pragma unroll
    for (int q = 0; q < 2; ++q) { g[2 * q] = *(const f32x4*)(gf + 512 * q + 8 * lane); g[2 * q + 1] = *(const f32x4*)(gf + 512 * q + 8 * lane + 4); }
    for (size_t row = (size_t)blockIdx.x * NWAVES + wave; row < (size_t)M; row += (size_t)gridDim.x * NWAVES) {
        f32x4 x[4]; float ss = 0.f;
#pragma unroll
        for (int q = 0; q < 2; ++q) { const v4u r = __builtin_nontemporal_load((const v4u*)(X2 + row * 1024 + 512 * q + 8 * lane)); x[2 * q] = (f32x4){bflo(r.x), bfhi(r.x), bflo(r.y), bfhi(r.y)}; x[2 * q + 1] = (f32x4){bflo(r.z), bfhi(r.z), bflo(r.w), bfhi(r.w)}; }
#pragma unroll
        for (int i = 0; i < 4; ++i) ss += (x[i].x * x[i].x + x[i].y * x[i].y) + (x[i].z * x[i].z + x[i].w * x[i].w);
        const float rstd = 1.0f / sqrtf(wave_sum(ss) * (1.0f / 1024.0f) + EPS);
#pragma unroll
        for (int q = 0; q < 2; ++q) { float* o = a.out + row * 1024 + 512 * q + 8 * lane; __builtin_nontemporal_store(x[2 * q] * rstd * g[2 * q], (f32x4*)(o)); __builtin_nontemporal_store(x[2 * q + 1] * rstd * g[2 * q + 1], (f32x4*)(o + 4)); } }
}
__device__ __forceinline__ void phase_topk(const Args& a, LAS unsigned char* lds, int wave, int lane) {
    const bf16* Q = (const bf16*)(a.ws + WS_ZG); const bf16* KEYS = (const bf16*)(a.ws + WS_KEYS);
    const int G = gridDim.x, gw = blockIdx.x * NWAVES + wave, NGW = G * NWAVES;
    for (int grp = gw; grp < M / 32; grp += NGW) peer_topk32(Q, KEYS, (unsigned short*)(a.ws + WS_E), (float*)(a.ws + WS_G), lds + wave * 4096, grp * 32, lane);
}
#define XB_TMO      128
#define XB_XCNT(j)  (256  + 64 * (j))
#define XB_XSUB(j)  (1280 + 64 * (j))
#define XB_XGEN(j)  (2304 + 64 * (j))
#define XB_TOP      3328
#define XB_TOPGEN   3392
#define XCD_BAR_WORDS 3456
#define XB_SPIN_CAP (1u << 18)

__device__ __forceinline__ unsigned xb_ld(unsigned* p)              { return __hip_atomic_load(p, __ATOMIC_RELAXED, __HIP_MEMORY_SCOPE_AGENT); }
__device__ __forceinline__ unsigned xb_add(unsigned* p, unsigned v) { return __hip_atomic_fetch_add(p, v, __ATOMIC_RELAXED, __HIP_MEMORY_SCOPE_AGENT); }
__device__ __forceinline__ unsigned xb_xcc_id() { return (unsigned)__builtin_amdgcn_s_getreg((3 << 11) | 20) & 0xFu; }
#define XB_SPIN(cond, bar) do { unsigned _sp = 0; while (cond) { __builtin_amdgcn_s_sleep(1); \
    if ((++_sp & 255u) == 0u) { if (xb_ld(&(bar)[XB_TMO])) break; if (_sp > XB_SPIN_CAP) { atomicAdd(&(bar)[XB_TMO], 1u); break; } } } } while (0)

struct XcdBarrier {
    unsigned* bar; unsigned x;
    volatile LAS unsigned* st;
};

__device__ __forceinline__ XcdBarrier xcd_barrier_post(unsigned* bar, volatile LAS unsigned* st) {
    XcdBarrier b; b.bar = bar; b.x = xb_xcc_id(); b.st = st;
    if (threadIdx.x == 0) (void)xb_add(&bar[XB_XCNT(b.x)], 1u);
    return b;
}
__device__ __forceinline__ void xcd_barrier_complete(unsigned* bar, unsigned x, unsigned& nloc, unsigned& nx) {
    const unsigned G = gridDim.x * gridDim.y * gridDim.z;
    unsigned sum, cnt, mine, sp = 0u;
    for (;;) {
        sum = 0u; cnt = 0u; mine = 0u;
#pragma unroll
        for (unsigned j = 0; j < 16; ++j) { const unsigned c = xb_ld(&bar[XB_XCNT(j)]); sum += c; cnt += (c > 0u) ? 1u : 0u; mine = (j == x) ? c : mine; }
        if (sum == G) break;
        __builtin_amdgcn_s_sleep(1);
        if ((++sp & 255u) == 0u) { if (xb_ld(&bar[XB_TMO])) break; if (sp > XB_SPIN_CAP) { atomicAdd(&bar[XB_TMO], 1u); break; } }
    }
    nloc = mine > 0u ? mine : 1u; nx = cnt > 0u ? cnt : 1u;
}

__device__ __forceinline__ void xcd_barrier(const XcdBarrier& b) {
    asm volatile("s_waitcnt vmcnt(0)" ::: "memory");
    __syncthreads();
    if (threadIdx.x == 0) {
        unsigned* bar = b.bar;
        __builtin_amdgcn_s_waitcnt(0);
        unsigned nloc = b.st[0], nx = b.st[1];
        if (nloc == 0u) { xcd_barrier_complete(bar, b.x, nloc, nx); b.st[0] = nloc; b.st[1] = nx; }
        const unsigned old = xb_add(&bar[XB_XSUB(b.x)], 1u);
        const unsigned gen = old / nloc;
        if (old + 1u == (gen + 1u) * nloc) {
            __builtin_amdgcn_fence(__ATOMIC_RELEASE, "agent");
            asm volatile("s_waitcnt vmcnt(0)" ::: "memory");
            const unsigned og = xb_add(&bar[XB_TOP], 1u);
            const unsigned tg = og / nx;
            if (og + 1u == (tg + 1u) * nx) xb_add(&bar[XB_TOPGEN], 1u);
            else XB_SPIN(xb_ld(&bar[XB_TOPGEN]) == tg, bar);
            __builtin_amdgcn_fence(__ATOMIC_ACQUIRE, "agent");
            xb_add(&bar[XB_XGEN(b.x)], 1u);
            asm volatile("s_waitcnt vmcnt(0)" ::: "memory");
        } else {
            XB_SPIN(xb_ld(&bar[XB_XGEN(b.x)]) == gen, bar);
            __builtin_amdgcn_fence(__ATOMIC_ACQUIRE, "agent");
            asm volatile("s_waitcnt vmcnt(0)" ::: "memory");
        }
    }
    __syncthreads();
}
constexpr int N_PHASES = 13;
__global__ void __launch_bounds__(NWAVES * 64, 2) hybrid_fwd(Args a) {
    extern __shared__ __attribute__((aligned(16))) unsigned char lds_raw[];
    LAS unsigned char* lds = (LAS unsigned char*)lds_raw;
    const int tid = threadIdx.x, lane = tid & 63, wave = __builtin_amdgcn_readfirstlane(tid >> 6);
    const int G = gridDim.x, bx = blockIdx.x;
    unsigned char* ws = a.ws;
    const float* MOD = (const float*)(ws + WS_MOD);
    const int lo = a.ph_lo, hi = a.ph_hi;
    if (tid < 16) ((LAS unsigned*)(lds + LDS_MISC_OFF))[tid] = 0u;
    __syncthreads();
    XcdBarrier xbar = xcd_barrier_post((unsigned*)(ws + WS_BAR), (volatile LAS unsigned*)(lds + LDS_MISC_OFF));
#ifndef REP_MASK
#define REP_MASK 0
#endif
#define IN(k) (lo <= (k) && (k) < hi)
#ifndef REPN
#define REPN 1
#endif
#define REPS(k) (1 + REPN * ((REP_MASK >> (k)) & 1))
#define SEAM(k) do { if (IN(k) && IN((k) + 1)) xcd_barrier(xbar); } while (0)
    if (hi > N_PHASES) cg::this_grid().sync();

    if (IN(0)) for (int rep_ = 0; rep_ < REPS(0); ++rep_) { phase_prologue(a, lds, tid, wave, lane); } SEAM(0);
    if (IN(1)) for (int rep_ = 0; rep_ < REPS(1); ++rep_) { phase_norm_mod(a.in[I_X], a.in[I_GMIX], MOD, 0, 1024, (bf16*)(ws + WS_H), wave, lane); } SEAM(1);
    if (IN(2)) for (int rep_ = 0; rep_ < REPS(2); ++rep_) { pg8::Gemm g{(const pg8::bf16_t*)(ws + WS_H), (const pg8::bf16_t*)(ws + WS_WIN), M, INW, DM}; pg8::StaticOrder S; S.init(M, INW, G, bx);
        pg8::EpiIn E{(pg8::bf16_t*)(ws + WS_ZG), (pg8::bf16_t*)(ws + WS_ZS)};
        pg8::gemm_phase<pg8::EpiIn, pg8::StaticOrder, true, true>(lds, g, S, E); } SEAM(2);
    if (IN(3)) for (int rep_ = 0; rep_ < REPS(3); ++rep_) { for (int it = bx; it < 256; it += G) s5_item(a, lds, it, wave, lane);
        for (int it = bx; it < 512; it += G) sgu_item(a, lds, it, wave, lane); } SEAM(3);
    if (IN(4)) for (int rep_ = 0; rep_ < REPS(4); ++rep_) { pg8::Gemm g{(const pg8::bf16_t*)(ws + WS_YS), (const pg8::bf16_t*)(ws + WS_WGLU), M, 512, 512}; pg8::StaticOrder S; S.init(M, 512, G, bx);
        pg8::EpiGlu E{(const pg8::bf16_t*)(ws + WS_YS), a.in[I_BGLU], (pg8::bf16_t*)(ws + WS_Y)};
        pg8::gemm_phase<pg8::EpiGlu, pg8::StaticOrder, true, true>(lds, g, S, E); } SEAM(4);
    if (IN(5)) for (int rep_ = 0; rep_ < REPS(5); ++rep_) { pg8::Gemm g{(const pg8::bf16_t*)(ws + WS_Y), (const pg8::bf16_t*)(ws + WS_WOUT), M, DM, DM}; pg8::StaticOrder S; S.init(M, DM, G, bx);
        pg8::EpiOut E{a.in[I_X], MOD, (pg8::bf16_t*)(ws + WS_X1B)};
        pg8::gemm_phase<pg8::EpiOut, pg8::StaticOrder, true, true>(lds, g, S, E); } SEAM(5);
    if (IN(6)) for (int rep_ = 0; rep_ < REPS(6); ++rep_) { phase_norm_mod_bf((const bf16*)(ws + WS_X1B), a.in[I_GFFN], MOD, 3072, 4096, (bf16*)(ws + WS_H), ws + WS_H2Q, (float*)(ws + WS_SH), wave, lane); } SEAM(6);
    if (IN(7)) for (int rep_ = 0; rep_ < REPS(7); ++rep_) { pg8::Gemm g{(const pg8::bf16_t*)(ws + WS_H), (const pg8::bf16_t*)(ws + WS_WQ), M, DM, DM}; pg8::StaticOrder S; S.init(M, DM, G, bx);
        pg8::EpiPlain E{(pg8::bf16_t*)(ws + WS_ZG), 1024};
        pg8::gemm_phase<pg8::EpiPlain, pg8::StaticOrder, true, true>(lds, g, S, E); } SEAM(7);
    if (IN(8)) for (int rep_ = 0; rep_ < REPS(8); ++rep_) { phase_topk(a, lds, wave, lane); } SEAM(8);
    if (IN(9)) for (int rep_ = 0; rep_ < REPS(9); ++rep_) { upass_wide(a, lds, wave, lane); } SEAM(9);
    if (IN(10)) for (int rep_ = 0; rep_ < REPS(10); ++rep_) { peer_reduce(a, lds, tid); } SEAM(10);
    if (IN(11)) for (int rep_ = 0; rep_ < REPS(11); ++rep_) { vpass_wide(a, lds, wave, lane); } SEAM(11);
    if (IN(12)) for (int rep_ = 0; rep_ < REPS(12); ++rep_) { final_norm(a, wave, lane); }
#undef IN
#undef SEAM
}

extern "C" void kernel_launch(void* const* d_in, const int* in_sizes, int n_in, void* d_out, int out_size, void* d_ws, size_t ws_size, hipStream_t stream) {
    static int grid = 0;
    if (grid == 0) {
        if (n_in != 27 || in_sizes[0] != M * DM || out_size != M * DM || ws_size < WS_END) { fprintf(stderr, "kernel_launch: unexpected problem (n_in %d, in0 %d, out %d, ws %zu); nothing launched\n", n_in, n_in > 0 ? in_sizes[0] : -1, out_size, ws_size); grid = -1; return; }
        int dev = 0, cus = 0, per_cu = 0;
        if (hipGetDevice(&dev) != hipSuccess || hipDeviceGetAttribute(&cus, hipDeviceAttributeMultiprocessorCount, dev) != hipSuccess) { grid = -1; return; }
        if (hipFuncSetAttribute((const void*)hybrid_fwd, hipFuncAttributeMaxDynamicSharedMemorySize, LDS_BYTES) != hipSuccess) { fprintf(stderr, "kernel_launch: hipFuncSetAttribute failed\n"); grid = -1; return; }
        if (hipOccupancyMaxActiveBlocksPerMultiprocessor(&per_cu, (const void*)hybrid_fwd, NWAVES * 64, LDS_BYTES) != hipSuccess || per_cu < 1) { fprintf(stderr, "kernel_launch: occupancy query failed (%d)\n", per_cu); (void)hipGetLastError(); per_cu = 1; }
        grid = cus * 1;
        if (per_cu < 1) grid = -1;
    }
    if (grid < 0) return;
    if (hipMemsetAsync((char*)d_ws + WS_BAR, 0, 16384, stream) != hipSuccess) { fprintf(stderr, "kernel_launch: hipMemsetAsync failed\n"); return; }
    Args a{};
    for (int i = 0; i < 27; ++i) a.in[i] = (const float*)d_in[i];
    a.out = (float*)d_out; a.ws = (unsigned char*)d_ws;
#if N_LAUNCHES == 1
    a.ph_lo = 0; a.ph_hi = N_PHASES;
    void* args[] = {&a};
    hipError_t e = hipLaunchCooperativeKernel((const void*)hybrid_fwd, dim3(grid), dim3(NWAVES * 64), args, LDS_BYTES, stream);
    if (e != hipSuccess) fprintf(stderr, "kernel_launch: cooperative launch failed: %s (grid %d)\n", hipGetErrorString(e), grid);
#else
    for (int p = 0; p < N_PHASES; ++p) { a.ph_lo = p; a.ph_hi = p + 1;
        hipLaunchKernelGGL(hybrid_fwd, dim3(grid), dim3(NWAVES * 64), LDS_BYTES, stream, a);
        const hipError_t le = hipPeekAtLastError(); if (le != hipSuccess) { fprintf(stderr, "kernel_launch: launch %d failed: %s\n", p, hipGetErrorName(le)); break; } }
#endif
}
```

```cpp
#include <hip/hip_runtime.h>
#include <hip/hip_cooperative_groups.h>
#include <cstdio>
#include <cstdint>
namespace cg = cooperative_groups;

#ifndef N_LAUNCHES
#define N_LAUNCHES 1
#endif

#define GAS __attribute__((address_space(1)))
#define LAS __attribute__((address_space(3)))
namespace pg8 {
#define PG8_LAS __attribute__((address_space(3)))
typedef unsigned short bf16_t;
typedef short bf16x8 __attribute__((ext_vector_type(8)));
typedef float f32x4 __attribute__((ext_vector_type(4)));
typedef unsigned u32x4 __attribute__((ext_vector_type(4)));
constexpr int BM = 256, BK = 64, HALF = 128, HTB = HALF * BK * 2  , STAGE_BYTES = 8 * HTB, NXCD = 8, WGM = 8;

__host__ __device__ __forceinline__ int lds_byte(int r, int c) { const int st = (r >> 4) * 2 + (c >> 5), rr = r & 15, cc = c & 31, ob = rr * 64 + cc * 2; return st * 1024 + (ob ^ (((ob >> 9) & 1) << 5)); }
__host__ __device__ __forceinline__ void stage_rc(int b, int& R, int& C) { const int st = b / 1024, sb = b % 1024, swz = sb ^ (((sb >> 9) & 1) << 5); R = (st >> 1) * 16 + swz / 64; C = (st & 1) * 32 + (swz % 64) / 2; }
__host__ __device__ __forceinline__ int perm32(int rho) { const int n = rho >> 4, i = rho & 15; return 8 * (i >> 2) + 4 * n + (i & 3); }

struct Unit { int pm, pn; };
struct Gemm { const bf16_t* A; const bf16_t* Bt; int M, N, K; };

struct StaticOrder {
    int nM, nN, nwg, G, c;
    __host__ __device__ void init(int M, int N, int G_, int c_) { nM = M / BM; nN = N / BM; nwg = nM * nN; G = G_; c = c_; }
    __host__ __device__ bool next(int i, Unit& u) const {
        const long L = (long)i * G + c; if (L >= nwg) return false;
        int wgid = (int)L; { const int q = nwg / NXCD, r = nwg % NXCD, xcd = wgid % NXCD, off = wgid / NXCD; wgid = (xcd < r ? xcd * (q + 1) : r * (q + 1) + (xcd - r) * q) + off; }
        const int nig = WGM * nN, gid = wgid / nig, fm = gid * WGM, gsz = (nM - fm) < WGM ? (nM - fm) : WGM;
        u.pm = fm + ((wgid % nig) % gsz); u.pn = (wgid % nig) / gsz; return true;
    }
    __device__ __forceinline__ void a_ready(const Unit&) const {}
    __device__ __forceinline__ void done(const Unit&) const {}
};

typedef float f32x2 __attribute__((ext_vector_type(2)));
__device__ __forceinline__ unsigned cvt_pk_bf16(float lo, float hi) { unsigned r; asm volatile("v_cvt_pk_bf16_f32 %0, %1, %2" : "=v"(r) : "v"(lo), "v"(hi)); return r; }
__device__ __forceinline__ float bf_lo(unsigned u) { return __builtin_bit_cast(float, u << 16); }
__device__ __forceinline__ float bf_hi(unsigned u) { return __builtin_bit_cast(float, u & 0xffff0000u); }
__device__ __forceinline__ float gelu_t(float x) { const float t = x * (1.0f + 0.044715f * x * x) * (-2.3022082f); return x * __builtin_amdgcn_rcpf(1.0f + __builtin_amdgcn_exp2f(t)); }
__device__ __forceinline__ float sigmoid_f(float x) { return __builtin_amdgcn_rcpf(1.0f + __builtin_amdgcn_exp2f(x * -1.4426950409f)); }

struct EpiIn { static constexpr bool PERM = true, AFTER_DRAIN = false; bf16_t* ZG; bf16_t* ZS;
    __device__ __forceinline__ void operator()(const f32x4 (&acc)[2][2][4][2], const Unit& u, int wr, int wc, int fr, int fq) const {
        const int row0 = u.pm * BM + wr * 64 + fr, colt = u.pn * BM;
#pragma unroll
        for (int ai = 0; ai < 2; ++ai)
#pragma unroll
            for (int m = 0; m < 4; ++m) { const int row = row0 + ai * HALF + m * 16;
#pragma unroll
                for (int bj = 0; bj < 2; ++bj) { const int col = colt + bj * HALF + wc * 32 + 8 * fq; f32x4 v0 = acc[ai][bj][m][0], v1 = acc[ai][bj][m][1]; u32x4 w;
                    if (colt < 1024) {
                        w.x = cvt_pk_bf16(gelu_t(v0[0]), gelu_t(v0[1])); w.y = cvt_pk_bf16(gelu_t(v0[2]), gelu_t(v0[3])); w.z = cvt_pk_bf16(gelu_t(v1[0]), gelu_t(v1[1])); w.w = cvt_pk_bf16(gelu_t(v1[2]), gelu_t(v1[3]));
                        *(u32x4*)(ZG + (size_t)row * 1024 + col) = w;
                    } else {
                        w.x = cvt_pk_bf16(v0[0], v0[1]); w.y = cvt_pk_bf16(v0[2], v0[3]); w.z = cvt_pk_bf16(v1[0], v1[1]); w.w = cvt_pk_bf16(v1[2], v1[3]);
                        const int cs = col - 1024, g = cs >> 4, ch = cs & 15, b = row >> 13, s = row & 8191;
                        *(u32x4*)(ZS + ((((size_t)(b * 32 + g)) * 8192 + s) << 4) + ch) = w;
                    } } }
    }
};
struct EpiGlu { static constexpr bool PERM = true, AFTER_DRAIN = false; const bf16_t* YS; const float* bglu; bf16_t* Y;
    __device__ __forceinline__ void operator()(const f32x4 (&acc)[2][2][4][2], const Unit& u, int wr, int wc, int fr, int fq) const {
        const int row0 = u.pm * BM + wr * 64 + fr, colt = u.pn * BM;
#pragma unroll
        for (int bj = 0; bj < 2; ++bj) { const int col = colt + bj * HALF + wc * 32 + 8 * fq; const f32x4 b0 = *(const f32x4*)(bglu + col), b1 = *(const f32x4*)(bglu + col + 4);
#pragma unroll
            for (int ai = 0; ai < 2; ++ai)
#pragma unroll
                for (int m = 0; m < 4; ++m) { const int row = row0 + ai * HALF + m * 16; const f32x4 v0 = acc[ai][bj][m][0] + b0, v1 = acc[ai][bj][m][1] + b1;
                    const u32x4 ys = *(const u32x4*)(YS + (size_t)row * 512 + col); u32x4 w;
                    w.x = cvt_pk_bf16(bf_lo(ys.x) * sigmoid_f(v0[0]), bf_hi(ys.x) * sigmoid_f(v0[1])); w.y = cvt_pk_bf16(bf_lo(ys.y) * sigmoid_f(v0[2]), bf_hi(ys.y) * sigmoid_f(v0[3]));
                    w.z = cvt_pk_bf16(bf_lo(ys.z) * sigmoid_f(v1[0]), bf_hi(ys.z) * sigmoid_f(v1[1])); w.w = cvt_pk_bf16(bf_lo(ys.w) * sigmoid_f(v1[2]), bf_hi(ys.w) * sigmoid_f(v1[3]));
                    *(u32x4*)(Y + (size_t)row * 1024 + 512 + col) = w; } }
    }
};
struct EpiOut { static constexpr bool PERM = true, AFTER_DRAIN = false; const float* x; const float* mod; bf16_t* X1;
    __device__ __forceinline__ void operator()(const f32x4 (&acc)[2][2][4][2], const Unit& u, int wr, int wc, int fr, int fq) const {
        const int row0 = u.pm * BM + wr * 64 + fr, colt = u.pn * BM; const float* gt = mod + (size_t)((u.pm * BM) >> 13) * 6144 + 2048;
#pragma unroll
        for (int bj = 0; bj < 2; ++bj) { const int col = colt + bj * HALF + wc * 32 + 8 * fq; const f32x4 g0 = *(const f32x4*)(gt + col), g1 = *(const f32x4*)(gt + col + 4);
            f32x4 xv[8][2];
#pragma unroll
            for (int ai = 0; ai < 2; ++ai)
#pragma unroll
                for (int m = 0; m < 4; ++m) { const size_t o = (size_t)(row0 + ai * HALF + m * 16) * 1024 + col;
                    xv[ai * 4 + m][0] = __builtin_nontemporal_load((const f32x4*)(x + o)); xv[ai * 4 + m][1] = __builtin_nontemporal_load((const f32x4*)(x + o + 4)); }
            __builtin_amdgcn_sched_barrier(0);
#pragma unroll
            for (int ai = 0; ai < 2; ++ai)
#pragma unroll
                for (int m = 0; m < 4; ++m) { const size_t o = (size_t)(row0 + ai * HALF + m * 16) * 1024 + col;
                    const f32x4 v0 = xv[ai * 4 + m][0] + g0 * acc[ai][bj][m][0], v1 = xv[ai * 4 + m][1] + g1 * acc[ai][bj][m][1]; u32x4 w;
                    w.x = cvt_pk_bf16(v0[0], v0[1]); w.y = cvt_pk_bf16(v0[2], v0[3]); w.z = cvt_pk_bf16(v1[0], v1[1]); w.w = cvt_pk_bf16(v1[2], v1[3]);
                    *(u32x4*)(X1 + o) = w; }
            __builtin_amdgcn_sched_barrier(0); }
    }
};
struct EpiPlain { static constexpr bool PERM = true, AFTER_DRAIN = false; bf16_t* O; int ldc;
    __device__ __forceinline__ void operator()(const f32x4 (&acc)[2][2][4][2], const Unit& u, int wr, int wc, int fr, int fq) const {
        const int row0 = u.pm * BM + wr * 64 + fr, colt = u.pn * BM;
#pragma unroll
        for (int ai = 0; ai < 2; ++ai)
#pragma unroll
            for (int m = 0; m < 4; ++m) { const int row = row0 + ai * HALF + m * 16;
#pragma unroll
                for (int bj = 0; bj < 2; ++bj) { const int col = colt + bj * HALF + wc * 32 + 8 * fq; const f32x4 v0 = acc[ai][bj][m][0], v1 = acc[ai][bj][m][1]; u32x4 w;
                    w.x = cvt_pk_bf16(v0[0], v0[1]); w.y = cvt_pk_bf16(v0[2], v0[3]); w.z = cvt_pk_bf16(v1[0], v1[1]); w.w = cvt_pk_bf16(v1[2], v1[3]);
                    *(u32x4*)(O + (size_t)row * ldc + col) = w; } }
    }
};
template <class Epi, class Sched, bool ALIGN_EPI = false, bool SP2 = false>
__device__ __forceinline__ void gemm_phase(PG8_LAS unsigned char* lds, const Gemm g, const Sched& S, const Epi& E) {
    const int tid = threadIdx.x, wid = __builtin_amdgcn_readfirstlane(tid >> 6), lane = tid & 63, wr = wid >> 2, wc = wid & 3, fr = lane & 15, fq = lane >> 4;
    const int K = g.K, nt = K / BK;
    unsigned voffA[2], voffB[2];
#pragma unroll
    for (int i = 0; i < 2; ++i) { int R, C; stage_rc(tid * 16 + i * 8192, R, C); const int Rb = Epi::PERM ? ((R & ~31) + perm32(R & 31)) : R;
        voffA[i] = (unsigned)(R * K + C) * 2u; voffB[i] = (unsigned)(Rb * K + C) * 2u; }
    const size_t kstep = (size_t)(BK * 2);
    const size_t hstep = (size_t)HALF * K * 2;
    const size_t tstep = 2 * hstep;
    const unsigned ldsw = (unsigned)wid * 1024u;
    const int aoff = lds_byte(wr * 64 + fr, fq * 8), boff = lds_byte(wc * 32 + fr, fq * 8);
#define PG8_SA(b, h) (((b) * 2 + (h)) * HTB)
#define PG8_SB(b, h) ((4 + (b) * 2 + (h)) * HTB)
#define PG8_STAGE(bufoff, gbase, voff) do { _Pragma("unroll") for (int _i = 0; _i < 2; ++_i) \
        __builtin_amdgcn_global_load_lds((const unsigned*)((const char*)(gbase) + (voff)[_i]), (PG8_LAS unsigned*)(lds + (bufoff) + ldsw + _i * 8192), 16, 0, 0); } while (0)
#define PG8_LDA(dst, b, h) do { _Pragma("unroll") for (int m = 0; m < 4; ++m) _Pragma("unroll") for (int k = 0; k < 2; ++k) dst[m][k] = *(const PG8_LAS bf16x8*)(lds + PG8_SA(b, h) + aoff + m * 2048 + k * 1024); } while (0)
#define PG8_LDB(dst, b, h) do { _Pragma("unroll") for (int n = 0; n < 2; ++n) _Pragma("unroll") for (int k = 0; k < 2; ++k) dst[n][k] = *(const PG8_LAS bf16x8*)(lds + PG8_SB(b, h) + boff + n * 2048 + k * 1024); } while (0)
#define PG8_MMA(ai, bj, At, Bt) do { __builtin_amdgcn_s_setprio(1); _Pragma("unroll") for (int m = 0; m < 4; ++m) _Pragma("unroll") for (int n = 0; n < 2; ++n) _Pragma("unroll") for (int k = 0; k < 2; ++k) \
        acc[ai][bj][m][n] = __builtin_amdgcn_mfma_f32_16x16x32_bf16(Bt[n][k], At[m][k], acc[ai][bj][m][n], 0, 0, 0); __builtin_amdgcn_s_setprio(0); } while (0)
#define PG8_WAIT_V(n) asm volatile("s_waitcnt vmcnt(" #n ")" ::: "memory")
#define PG8_WAIT_L(n) asm volatile("s_waitcnt lgkmcnt(" #n ")" ::: "memory")
#define PG8_BAR __builtin_amdgcn_s_barrier()
#define PG8_SCHED __builtin_amdgcn_sched_barrier(0)
    Unit cur, nxt; int ui = 0;
    if (!S.next(0, cur)) return;
    f32x4 acc[2][2][4][2];
#pragma unroll
    for (int a = 0; a < 2; ++a)
#pragma unroll
        for (int b = 0; b < 2; ++b)
#pragma unroll
            for (int m = 0; m < 4; ++m)
#pragma unroll
                for (int n = 0; n < 2; ++n) acc[a][b][m][n] = (f32x4){0.f, 0.f, 0.f, 0.f};
    bf16x8 At[4][2], B0[2][2], B1[2][2];
    const char* cA = (const char*)g.A + (size_t)cur.pm * tstep; const char* cB = (const char*)g.Bt + (size_t)cur.pn * tstep;
    S.a_ready(cur);
    if constexpr (SP2) {
        PG8_STAGE(PG8_SB(0, 0), cB, voffB); PG8_STAGE(PG8_SB(0, 1), cB + hstep, voffB); PG8_STAGE(PG8_SA(0, 0), cA, voffA); PG8_STAGE(PG8_SA(0, 1), cA + hstep, voffA);
        if (wr == 1) PG8_BAR;
        PG8_WAIT_V(2); PG8_BAR;
        PG8_STAGE(PG8_SB(1, 0), cB + kstep, voffB); PG8_STAGE(PG8_SA(1, 0), cA + kstep, voffA); PG8_STAGE(PG8_SB(1, 1), cB + hstep + kstep, voffB);
        PG8_WAIT_V(6); PG8_BAR;
    } else {
        PG8_STAGE(PG8_SB(0, 0), cB, voffB); PG8_STAGE(PG8_SA(0, 0), cA, voffA); PG8_STAGE(PG8_SB(0, 1), cB + hstep, voffB); PG8_STAGE(PG8_SA(0, 1), cA + hstep, voffA);
        if (wr == 1) PG8_BAR;
        PG8_WAIT_V(4); PG8_BAR;
        PG8_STAGE(PG8_SB(1, 0), cB + kstep, voffB); PG8_STAGE(PG8_SA(1, 0), cA + kstep, voffA); PG8_STAGE(PG8_SB(1, 1), cB + hstep + kstep, voffB);
        PG8_WAIT_V(6); PG8_BAR;
    }
    for (;;) {
        const bool has_next = S.next(ui + 1, nxt);
        const char* nA = has_next ? (const char*)g.A + (size_t)nxt.pm * tstep : cA; const char* nB = has_next ? (const char*)g.Bt + (size_t)nxt.pn * tstep : cB;
        for (int t = 0; t < nt; t += 2) {
            const bool last = (t == nt - 2);
            const char* a1 = cA + (size_t)(t + 1) * kstep;
            const char* a2 = last ? nA : cA + (size_t)(t + 2) * kstep; const char* b2 = last ? nB : cB + (size_t)(t + 2) * kstep;
            const char* a3 = a2 + kstep; const char* b3 = b2 + kstep;
            if (last && has_next) S.a_ready(nxt);
            if constexpr (SP2) {
            PG8_LDB(B0, 0, 0); PG8_LDB(B1, 0, 1); PG8_SCHED; PG8_LDA(At, 0, 0); PG8_STAGE(PG8_SA(1, 1), a1 + hstep, voffA);
            PG8_WAIT_V(8); PG8_WAIT_L(0); PG8_BAR; PG8_MMA(0, 0, At, B0); PG8_MMA(0, 1, At, B1); PG8_BAR; PG8_SCHED;
            PG8_LDA(At, 0, 1); PG8_STAGE(PG8_SB(0, 0), b2, voffB); PG8_STAGE(PG8_SB(0, 1), b2 + hstep, voffB); PG8_STAGE(PG8_SA(0, 0), a2, voffA);
            PG8_WAIT_V(8); PG8_WAIT_L(0); PG8_BAR; PG8_MMA(1, 0, At, B0); PG8_MMA(1, 1, At, B1); PG8_BAR; PG8_SCHED;
            PG8_LDB(B0, 1, 0); PG8_LDB(B1, 1, 1); PG8_SCHED; PG8_LDA(At, 1, 0); PG8_STAGE(PG8_SA(0, 1), a2 + hstep, voffA);
            PG8_WAIT_V(8); PG8_WAIT_L(0); PG8_BAR; PG8_MMA(0, 0, At, B0); PG8_MMA(0, 1, At, B1); PG8_BAR; PG8_SCHED;
            PG8_LDA(At, 1, 1); PG8_STAGE(PG8_SB(1, 0), b3, voffB); PG8_STAGE(PG8_SB(1, 1), b3 + hstep, voffB); PG8_STAGE(PG8_SA(1, 0), a3, voffA);
            PG8_WAIT_V(8); PG8_WAIT_L(0); PG8_BAR; PG8_MMA(1, 0, At, B0); PG8_MMA(1, 1, At, B1); PG8_BAR; PG8_SCHED;
            } else {
            PG8_LDB(B0, 0, 0); PG8_SCHED; PG8_LDA(At, 0, 0); PG8_STAGE(PG8_SA(1, 1), a1 + hstep, voffA);
            PG8_WAIT_L(8); PG8_BAR; PG8_WAIT_L(0); PG8_MMA(0, 0, At, B0); PG8_BAR; PG8_SCHED;
            PG8_LDB(B1, 0, 1); PG8_STAGE(PG8_SB(0, 0), b2, voffB);
            PG8_BAR; PG8_WAIT_L(0); PG8_MMA(0, 1, At, B1); PG8_BAR;
            PG8_LDA(At, 0, 1); PG8_STAGE(PG8_SA(0, 0), a2, voffA);
            PG8_BAR; PG8_WAIT_L(0); PG8_MMA(1, 0, At, B0); PG8_BAR; PG8_SCHED;
            PG8_STAGE(PG8_SB(0, 1), b2 + hstep, voffB);
            PG8_WAIT_V(6); PG8_BAR; PG8_MMA(1, 1, At, B1); PG8_BAR;
            PG8_LDB(B0, 1, 0); PG8_SCHED; PG8_LDA(At, 1, 0); PG8_STAGE(PG8_SA(0, 1), a2 + hstep, voffA);
            PG8_WAIT_L(8); PG8_BAR; PG8_WAIT_L(0); PG8_MMA(0, 0, At, B0); PG8_BAR; PG8_SCHED;
            PG8_LDB(B1, 1, 1); PG8_STAGE(PG8_SB(1, 0), b3, voffB);
            PG8_BAR; PG8_WAIT_L(0); PG8_MMA(0, 1, At, B1); PG8_BAR;
            PG8_LDA(At, 1, 1); PG8_STAGE(PG8_SA(1, 0), a3, voffA);
            PG8_BAR; PG8_WAIT_L(0); PG8_MMA(1, 0, At, B0); PG8_BAR; PG8_SCHED;
            PG8_STAGE(PG8_SB(1, 1), b3 + hstep, voffB);
            PG8_WAIT_V(6); PG8_BAR; PG8_MMA(1, 1, At, B1); PG8_BAR;
            }
        }
        if constexpr (ALIGN_EPI) { if (wr == 0) PG8_BAR; }
        if constexpr (!Epi::AFTER_DRAIN) { E(acc, cur, wr, wc, fr, fq); S.done(cur); }
        if (!has_next) break;
#pragma unroll
        for (int a = 0; a < 2; ++a)
#pragma unroll
            for (int b = 0; b < 2; ++b)
#pragma unroll
                for (int m = 0; m < 4; ++m)
#pragma unroll
                    for (int n = 0; n < 2; ++n) acc[a][b][m][n] = (f32x4){0.f, 0.f, 0.f, 0.f};
        cur = nxt; cA = nA; cB = nB; ++ui;
        if constexpr (ALIGN_EPI) { if (wr == 1) PG8_BAR; }
    }
    PG8_WAIT_V(0);
    if constexpr (!ALIGN_EPI) { if (wr == 0) PG8_BAR; }
    PG8_BAR;
    if constexpr (Epi::AFTER_DRAIN) { E.fused(acc, cur, wr, wc, fr, fq, lds, wid, lane); S.done(cur); }
#undef PG8_SA
#undef PG8_SB
#undef PG8_STAGE
#undef PG8_LDA
#undef PG8_LDB
#undef PG8_MMA
#undef PG8_WAIT_V
#undef PG8_WAIT_L
#undef PG8_BAR
#undef PG8_SCHED
}
}
typedef unsigned short bf16;
typedef unsigned v4u __attribute__((ext_vector_type(4)));
typedef unsigned v2u __attribute__((ext_vector_type(2)));
typedef float f32x4 __attribute__((ext_vector_type(4)));
typedef float f2_t __attribute__((ext_vector_type(2)));
typedef float f32x16 __attribute__((ext_vector_type(16)));
typedef short bf16x8 __attribute__((ext_vector_type(8)));
typedef short s16x4 __attribute__((ext_vector_type(4)));
typedef __bf16 bf2_t __attribute__((ext_vector_type(2)));

constexpr int NWAVES = 8;
constexpr int DM = 1024, NB = 8, SEQ = 8192, M = NB * SEQ, INW = 1536, NMODC = 6144;
constexpr int LDS_BYTES = 160 * 1024, LDS_MISC_OFF = LDS_BYTES - 64;
constexpr size_t MiB = 1u << 20;
constexpr size_t WS_MOD = 0;
constexpr size_t WS_BAR = 208 * 1024;
constexpr size_t WS_SU = 256 * 1024;
constexpr size_t WS_SV = 384 * 1024;
constexpr size_t WS_WIN = 1 * MiB;
constexpr size_t WS_WGLU = 4 * MiB;
constexpr size_t WS_WOUT = 5 * MiB;
constexpr size_t WS_WQ = 7 * MiB;
constexpr size_t WS_KEYS = 9 * MiB;
constexpr size_t WS_WM = 9 * MiB + 512 * 1024;
constexpr size_t WS_UB = 16 * MiB;
constexpr size_t WS_VB = 48 * MiB;
constexpr size_t WS_H = 80 * MiB;
constexpr size_t WS_ZG = 208 * MiB;
constexpr size_t WS_ZS = 336 * MiB;
constexpr size_t WS_Y = 400 * MiB;
constexpr size_t WS_YS = 528 * MiB;
constexpr size_t WS_E = 592 * MiB;
constexpr size_t WS_G = 624 * MiB;
constexpr size_t WS_W = 656 * MiB;
constexpr size_t WS_SS = 688 * MiB;
constexpr size_t WS_PA = 336 * MiB;
constexpr size_t WS_X1B = 690 * MiB;
constexpr size_t WS_H2Q = 818 * MiB;
constexpr size_t WS_SH = 882 * MiB;
constexpr size_t WS_END = 883 * MiB;
constexpr float EPS = 1e-6f;

#define LDS_WAIT() asm volatile("s_waitcnt lgkmcnt(0)" ::: "memory")
__device__ __forceinline__ unsigned f2bf(float f) { unsigned u = __builtin_bit_cast(unsigned, f); return (u + 0x7fffu + ((u >> 16) & 1u)) >> 16; }
__device__ __forceinline__ unsigned pk2(float lo, float hi) { return f2bf(lo) | (f2bf(hi) << 16); }
__device__ __forceinline__ float bflo(unsigned u) { return __builtin_bit_cast(float, u << 16); }
__device__ __forceinline__ float bfhi(unsigned u) { return __builtin_bit_cast(float, u & 0xffff0000u); }
__device__ __forceinline__ float wave_sum(float v) {
#pragma unroll
    for (int o = 1; o < 64; o <<= 1) v += __shfl_xor(v, o);
    return v;
}
using pg8::gelu_t;
using pg8::sigmoid_f;

struct Args { const float* in[27]; float* out; unsigned char* ws; int ph_lo, ph_hi; };
enum { I_X = 0, I_C, I_WADA, I_BADA, I_GMIX, I_WIN, I_LNG, I_LNB, I_WS, I_BS, I_ARE, I_AIM, I_LOGDT, I_BRE, I_BIM, I_CRE, I_CIM, I_D, I_WGLU, I_BGLU, I_WOUT, I_GFFN, I_WQ, I_KEYS, I_PU, I_PV, I_GFIN };

__device__ __forceinline__ void p0_transpose_item(const float* W, int K, int N, bf16* WT, LAS float* scr, int item, int lane) {
    const int nblk = N / 32, kb = item / nblk, nb = item % nblk, k0 = 64 * kb, n0 = 32 * nb;
#pragma unroll 8
    for (int i = 0; i < 32; ++i) { const int kk = 2 * i + (lane >> 5); scr[kk * 33 + (lane & 31)] = W[(size_t)(k0 + kk) * N + n0 + (lane & 31)]; }
    LDS_WAIT(); asm volatile("" ::: "memory");
    const int c = lane & 7;
#pragma unroll
    for (int j = 0; j < 4; ++j) { const int n = (lane >> 3) + 8 * j; const LAS float* s = scr + (8 * c) * 33 + n;
        v4u o; o.x = pk2(s[0 * 33], s[1 * 33]); o.y = pk2(s[2 * 33], s[3 * 33]); o.z = pk2(s[4 * 33], s[5 * 33]); o.w = pk2(s[6 * 33], s[7 * 33]);
        *(v4u*)(WT + (size_t)(n0 + n) * K + k0 + 8 * c) = o; }
    LDS_WAIT(); asm volatile("" ::: "memory");
}
__device__ __forceinline__ void cvt_stream(const float* src, bf16* dst, size_t n8, size_t gtid, size_t gthreads) {
    for (size_t i = gtid; i < n8; i += gthreads) { const f32x4 a = *(const f32x4*)(src + i * 8), b = *(const f32x4*)(src + i * 8 + 4);
        v4u o; o.x = pk2(a.x, a.y); o.y = pk2(a.z, a.w); o.z = pk2(b.x, b.y); o.w = pk2(b.z, b.w); *(v4u*)(dst + i * 8) = o; }
}
__device__ __forceinline__ float wave_max(float v) {
#pragma unroll
    for (int o = 1; o < 64; o <<= 1) v = fmaxf(v, __shfl_xor(v, o));
    return v;
}
__device__ __forceinline__ void cvt_rows_fp8(const float* src, unsigned char* dst, float* inv, int gw, int NGW, int lane) {
    for (int row = gw; row < 16384; row += NGW) { const f32x4* p = (const f32x4*)(src + (size_t)row * 1024) + lane;
        f32x4 v[4]; float m = 0.f;
#pragma unroll
        for (int j = 0; j < 4; ++j) { v[j] = __builtin_nontemporal_load(p + 64 * j); m = fmaxf(fmaxf(m, fmaxf(fabsf(v[j].x), fabsf(v[j].y))), fmaxf(fabsf(v[j].z), fabsf(v[j].w))); }
        m = wave_max(m); const float sc = m > 0.f ? 240.0f / m : 1.0f;
#pragma unroll
        for (int j = 0; j < 4; ++j) { int pk = 0; pk = __builtin_amdgcn_cvt_pk_fp8_f32(v[j].x * sc, v[j].y * sc, pk, false); pk = __builtin_amdgcn_cvt_pk_fp8_f32(v[j].z * sc, v[j].w * sc, pk, true);
            const int c = 4 * lane + 256 * j; *(unsigned*)(dst + ((size_t)(c >> 7) * 16384 + row) * 128 + (c & 127)) = (unsigned)pk; }
        if (lane == 0) inv[row] = m > 0.f ? m * (1.0f / 240.0f) : 1.0f; }
}
__device__ __forceinline__ unsigned pack_i8x4(float a, float b, float c, float d) {
    const int ia = (int)rintf(a), ib = (int)rintf(b), ic = (int)rintf(c), id = (int)rintf(d);
    return (unsigned)(ia & 0xff) | ((unsigned)(ib & 0xff) << 8) | ((unsigned)(ic & 0xff) << 16) | ((unsigned)(id & 0xff) << 24);
}
__device__ __forceinline__ void cvt_rows_i8(const float* src, unsigned char* dst, float* inv, int gw, int NGW, int lane) {
    for (int row = gw; row < 16384; row += NGW) { const f32x4* p = (const f32x4*)(src + (size_t)row * 1024) + lane;
        f32x4 v[4]; float m = 0.f;
#pragma unroll
        for (int j = 0; j < 4; ++j) { v[j] = __builtin_nontemporal_load(p + 64 * j); m = fmaxf(fmaxf(m, fmaxf(fabsf(v[j].x), fabsf(v[j].y))), fmaxf(fabsf(v[j].z), fabsf(v[j].w))); }
        m = wave_max(m); const float sc = m > 0.f ? 127.0f / m : 1.0f;
#pragma unroll
        for (int j = 0; j < 4; ++j) { const int c = 4 * lane + 256 * j; *(unsigned*)(dst + ((size_t)(c >> 7) * 16384 + row) * 128 + (c & 127)) = pack_i8x4(v[j].x * sc, v[j].y * sc, v[j].z * sc, v[j].w * sc); }
        if (lane == 0) inv[row] = m > 0.f ? m * (1.0f / 127.0f) : 1.0f; }
}
__device__ __forceinline__ unsigned pack_i4x8(const float (&v)[8], float inv) {
    unsigned d = 0;
#pragma unroll
    for (int i = 0; i < 8; ++i) { int q = (int)rintf(v[i] * inv); q = q < -8 ? -8 : (q > 7 ? 7 : q); d |= (unsigned)(q & 15) << (4 * i); }
    return d;
}
__device__ __forceinline__ void cvt_rows_i4(const float* src, unsigned char* dst, float* invs, int gw, int NGW, int lane) {
    for (int row = gw; row < 16384; row += NGW) { const float* p = src + (size_t)row * 1024;
        float v[2][8]; float ss = 0.f;
#pragma unroll
        for (int q = 0; q < 2; ++q) { const f32x4 x0 = __builtin_nontemporal_load((const f32x4*)(p + 512 * q + 8 * lane)), x1 = __builtin_nontemporal_load((const f32x4*)(p + 512 * q + 8 * lane + 4));
            v[q][0] = x0.x; v[q][1] = x0.y; v[q][2] = x0.z; v[q][3] = x0.w; v[q][4] = x1.x; v[q][5] = x1.y; v[q][6] = x1.z; v[q][7] = x1.w;
#pragma unroll
            for (int i = 0; i < 8; ++i) ss += v[q][i] * v[q][i]; }
        const float rms = sqrtf(wave_sum(ss) * (1.0f / 1024.0f)); const float step = rms > 0.f ? rms * (2.5f / 7.5f) : 1.0f, inv = 1.0f / step;
#pragma unroll
        for (int q = 0; q < 2; ++q) { const int c = 512 * q + 8 * lane; *(unsigned*)(dst + ((size_t)(c >> 7) * 16384 + row) * 64 + ((c & 127) >> 1)) = pack_i4x8(v[q], inv); }
        if (lane == 0) invs[row] = step; }
}
template <int LOG2W> __device__ __forceinline__ void cvt_rows_fp4(const float* src, unsigned char* dst, float* invs, int gw, int NGW, int lane) {
    for (int base = gw; base < 16384; base += 4 * NGW) {
        float v[4][2][8]; float ss[4];
#pragma unroll
        for (int rr = 0; rr < 4; ++rr) { const int row = min(base + rr * NGW, 16383); const float* p = src + (size_t)row * 1024;
#pragma unroll
            for (int q = 0; q < 2; ++q) { const f32x4 x0 = __builtin_nontemporal_load((const f32x4*)(p + 512 * q + 8 * lane)), x1 = __builtin_nontemporal_load((const f32x4*)(p + 512 * q + 8 * lane + 4));
                v[rr][q][0] = x0.x; v[rr][q][1] = x0.y; v[rr][q][2] = x0.z; v[rr][q][3] = x0.w; v[rr][q][4] = x1.x; v[rr][q][5] = x1.y; v[rr][q][6] = x1.z; v[rr][q][7] = x1.w; } }
#pragma unroll
        for (int rr = 0; rr < 4; ++rr) { float s = 0.f;
#pragma unroll
            for (int q = 0; q < 2; ++q)
#pragma unroll
                for (int i = 0; i < 8; ++i) s += v[rr][q][i] * v[rr][q][i];
            ss[rr] = wave_sum(s); }
#pragma unroll
        for (int rr = 0; rr < 4; ++rr) { const int row = base + rr * NGW; if (row < 16384) {
            const float rms = sqrtf(ss[rr] * (1.0f / 1024.0f)); const float sc = rms > 0.f ? rms * 0.5f : 1.0f, inv = 1.0f / sc;
#pragma unroll
            for (int q = 0; q < 2; ++q) { float t[8];
#pragma unroll
                for (int i = 0; i < 8; ++i) t[i] = fminf(fmaxf(v[rr][q][i] * inv, -6.0f), 6.0f);
                unsigned d = 0;
                d = __builtin_amdgcn_cvt_scalef32_pk_fp4_f32(d, t[0], t[1], 1.0f, 0); d = __builtin_amdgcn_cvt_scalef32_pk_fp4_f32(d, t[2], t[3], 1.0f, 1);
                d = __builtin_amdgcn_cvt_scalef32_pk_fp4_f32(d, t[4], t[5], 1.0f, 2); d = __builtin_amdgcn_cvt_scalef32_pk_fp4_f32(d, t[6], t[7], 1.0f, 3);
                const int c = 512 * q + 8 * lane; constexpr int W = 1 << LOG2W; *(unsigned*)(dst + ((size_t)(c >> LOG2W) * 16384 + row) * (W / 2) + ((c & (W - 1)) >> 1)) = d; }
            if (lane == 0) invs[row] = sc; } }
    }
}
__device__ __forceinline__ void p0_mod_item(const float* c, const float* w_ada, const float* b_ada, float* mod, LAS float* scr, int item, int tid) {
    LAS float* cond = scr;
    LAS float* red = scr + 8 * 1024;
    for (int i = tid; i < 8 * 1024; i += 512) { const float v = c[i]; cond[i] = v * sigmoid_f(v); }
    __syncthreads();
    const int kq = tid >> 3, cq = tid & 7, j0 = item * 24 + cq * 3;
    float acc[8][3];
#pragma unroll
    for (int b = 0; b < 8; ++b) { acc[b][0] = 0.f; acc[b][1] = 0.f; acc[b][2] = 0.f; }
    for (int i = 0; i < 16; ++i) { const int k = kq + 64 * i; const float* wp = w_ada + (size_t)k * NMODC + j0; const float w0 = wp[0], w1 = wp[1], w2 = wp[2];
#pragma unroll
        for (int b = 0; b < 8; ++b) { const float s = cond[b * 1024 + k]; acc[b][0] += s * w0; acc[b][1] += s * w1; acc[b][2] += s * w2; } }
#pragma unroll
    for (int b = 0; b < 8; ++b)
#pragma unroll
        for (int e = 0; e < 3; ++e) red[kq * 192 + b * 24 + cq * 3 + e] = acc[b][e];
    __syncthreads();
    if (tid < 192) { float s = 0.f; for (int q = 0; q < 64; ++q) s += red[q * 192 + tid]; const int b = tid / 24, j = item * 24 + tid % 24; mod[b * NMODC + j] = s + b_ada[j]; }
    __syncthreads();
}
__device__ __forceinline__ void phase_prologue(const Args& a, LAS unsigned char* lds, int tid, int wave, int lane) {
    unsigned char* ws = a.ws; const int G = gridDim.x, bx = blockIdx.x;
    for (int it = bx; it < 256; it += G) p0_mod_item(a.in[I_C], a.in[I_WADA], a.in[I_BADA], (float*)(ws + WS_MOD), (LAS float*)lds, it, tid);
    LAS float* scr = (LAS float*)(lds + wave * 16384);
    const int gw = bx * NWAVES + wave, NGW = G * NWAVES;
    constexpr int I_IN = 16 * 48, I_GLU = 8 * 16, I_OUT = 16 * 32, I_Q = 16 * 32, NITEMS = I_IN + I_GLU + I_OUT + I_Q;
    for (int it = gw; it < NITEMS; it += NGW) { int r = it;
        if (r < I_IN) { p0_transpose_item(a.in[I_WIN], 1024, 1536, (bf16*)(ws + WS_WIN), scr, r, lane); continue; } r -= I_IN;
        if (r < I_GLU) { p0_transpose_item(a.in[I_WGLU], 512, 512, (bf16*)(ws + WS_WGLU), scr, r, lane); continue; } r -= I_GLU;
        if (r < I_OUT) { p0_transpose_item(a.in[I_WOUT], 1024, 1024, (bf16*)(ws + WS_WOUT), scr, r, lane); continue; } r -= I_OUT;
        p0_transpose_item(a.in[I_WQ], 1024, 1024, (bf16*)(ws + WS_WQ), scr, r, lane); }
    const size_t gtid = (size_t)bx * 512 + tid, gth = (size_t)G * 512;
    cvt_stream(a.in[I_KEYS], (bf16*)(ws + WS_KEYS), 8 * 2 * 128 * 64 / 8, gtid, gth);
    { const float* w = a.in[I_WS]; bf16* wm = (bf16*)(ws + WS_WM);
      for (size_t i = gtid; i < 4 * 128 * 128 / 8; i += gth) { const int e0 = (int)i * 8, ii = (e0 >> 7) & 127, j0 = e0 & 127; const f32x4 p = *(const f32x4*)(w + e0), q = *(const f32x4*)(w + e0 + 4);
          float v[8] = {p.x, p.y, p.z, p.w, q.x, q.y, q.z, q.w};
#pragma unroll
          for (int e = 0; e < 8; ++e) v[e] = (j0 + e <= ii) ? v[e] : 0.f;
          v4u o; o.x = pk2(v[0], v[1]); o.y = pk2(v[2], v[3]); o.z = pk2(v[4], v[5]); o.w = pk2(v[6], v[7]); *(v4u*)(wm + e0) = o; } }
    cvt_rows_fp4<8>(a.in[I_PU], ws + WS_UB, (float*)(ws + WS_SU), gw, NGW, lane); cvt_rows_fp4<8>(a.in[I_PV], ws + WS_VB, (float*)(ws + WS_SV), gw, NGW, lane);
}

__device__ __forceinline__ void phase_norm_mod(const float* x, const float* gw, const float* mod, int sh_off, int sc_off, bf16* H, int wave, int lane) {
    const int G = gridDim.x;
    for (int it = blockIdx.x; it < 256; it += G) { const int b = it >> 5; const float* mb = mod + (size_t)b * NMODC;
        f32x4 A[4], S[4];
#pragma unroll
        for (int j = 0; j < 4; ++j) { const int c0 = 4 * lane + 256 * j; const f32x4 g = *(const f32x4*)(gw + c0), sc = *(const f32x4*)(mb + sc_off + c0); A[j] = g * (sc + 1.0f); S[j] = *(const f32x4*)(mb + sh_off + c0); }
        for (int r = 0; r < 32; ++r) { const size_t row = (size_t)it * 256 + wave * 32 + r; const f32x4* xr = (const f32x4*)(x + row * 1024) + lane;
            f32x4 v[4]; float s = 0.f;
#pragma unroll
            for (int j = 0; j < 4; ++j) { v[j] = __builtin_nontemporal_load(xr + 64 * j); s += (v[j].x * v[j].x + v[j].y * v[j].y) + (v[j].z * v[j].z + v[j].w * v[j].w); }
            const float rstd = 1.0f / sqrtf(wave_sum(s) * (1.0f / 1024.0f) + EPS);
            unsigned long long* o8 = (unsigned long long*)(H + row * 1024) + lane;
#pragma unroll
            for (int j = 0; j < 4; ++j) { const f32x4 h = v[j] * rstd * A[j] + S[j]; o8[64 * j] = (unsigned long long)pk2(h.x, h.y) | ((unsigned long long)pk2(h.z, h.w) << 32); } } }
}
__device__ __forceinline__ void phase_norm_mod_bf(const bf16* x, const float* gw, const float* mod, int sh_off, int sc_off, bf16* H, unsigned char* HQ, float* SH, int wave, int lane) {
    const int G = gridDim.x;
    for (int it = blockIdx.x; it < 256; it += G) { const int b = it >> 5; const float* mb = mod + (size_t)b * NMODC;
        float A[16], S[16];
#pragma unroll
        for (int q = 0; q < 2; ++q)
#pragma unroll
            for (int j = 0; j < 8; ++j) { const int c = 512 * q + 8 * lane + j; A[8 * q + j] = gw[c] * (mb[sc_off + c] + 1.0f); S[8 * q + j] = mb[sh_off + c]; }
        for (int r = 0; r < 32; ++r) { const size_t row = (size_t)it * 256 + wave * 32 + r;
            const v4u r0 = *(const v4u*)(x + row * 1024 + 8 * lane), r1 = *(const v4u*)(x + row * 1024 + 512 + 8 * lane);
            float v[16] = {bflo(r0.x), bfhi(r0.x), bflo(r0.y), bfhi(r0.y), bflo(r0.z), bfhi(r0.z), bflo(r0.w), bfhi(r0.w), bflo(r1.x), bfhi(r1.x), bflo(r1.y), bfhi(r1.y), bflo(r1.z), bfhi(r1.z), bflo(r1.w), bfhi(r1.w)};
            float s = 0.f;
#pragma unroll
            for (int j = 0; j < 16; ++j) s += v[j] * v[j];
            const float rstd = 1.0f / sqrtf(wave_sum(s) * (1.0f / 1024.0f) + EPS);
#pragma unroll
            for (int j = 0; j < 16; ++j) v[j] = v[j] * rstd * A[j] + S[j];
            v4u o0, o1; o0.x = pk2(v[0], v[1]); o0.y = pk2(v[2], v[3]); o0.z = pk2(v[4], v[5]); o0.w = pk2(v[6], v[7]); o1.x = pk2(v[8], v[9]); o1.y = pk2(v[10], v[11]); o1.z = pk2(v[12], v[13]); o1.w = pk2(v[14], v[15]);
            *(v4u*)(H + row * 1024 + 8 * lane) = o0; *(v4u*)(H + row * 1024 + 512 + 8 * lane) = o1;
            float mx = 0.f;
#pragma unroll
            for (int j = 0; j < 16; ++j) mx = fmaxf(mx, fabsf(v[j]));
            mx = wave_max(mx); const float qs = mx > 0.f ? 200.0f / mx : 1.0f;
#pragma unroll
            for (int q = 0; q < 2; ++q) { int p0 = 0, p1 = 0;
                p0 = __builtin_amdgcn_cvt_pk_fp8_f32(v[8 * q] * qs, v[8 * q + 1] * qs, p0, false); p0 = __builtin_amdgcn_cvt_pk_fp8_f32(v[8 * q + 2] * qs, v[8 * q + 3] * qs, p0, true);
                p1 = __builtin_amdgcn_cvt_pk_fp8_f32(v[8 * q + 4] * qs, v[8 * q + 5] * qs, p1, false); p1 = __builtin_amdgcn_cvt_pk_fp8_f32(v[8 * q + 6] * qs, v[8 * q + 7] * qs, p1, true);
                *(v2u*)(HQ + row * 1024 + 512 * q + 8 * lane) = (v2u){(unsigned)p0, (unsigned)p1}; }
            if (lane == 0) SH[row] = mx > 0.f ? mx * (1.0f / 200.0f) : 1.0f; } }
}
__device__ __forceinline__ void sincos_f(float th, float& s, float& c) {
    const float q = rintf(th * 0.63661977236758f);
    float y = fmaf(q, -1.5707962513f, th); y = fmaf(q, -7.5497894159e-8f, y); y = fmaf(q, -5.3903029534e-15f, y);
    const float y2 = y * y;
    const float sp = y + y * y2 * (-1.6666667163e-1f + y2 * (8.3333337680e-3f + y2 * (-1.9841270114e-4f + y2 * 2.7557314297e-6f)));
    const float cp = 1.0f + y2 * (-0.5f + y2 * (4.1666667908e-2f + y2 * (-1.3888889225e-3f + y2 * (2.4801587642e-5f + y2 * -2.7557314297e-7f))));
    const int qi = (int)q & 3;
    s = (qi == 0) ? sp : (qi == 1) ? cp : (qi == 2) ? -sp : -cp;
    c = (qi == 0) ? cp : (qi == 1) ? -sp : (qi == 2) ? -cp : sp;
}
__device__ __forceinline__ void s5_disc(const float* are, const float* aim, float dt, int gp, float& abr, float& abi, float& cr, float& ci) {
    const float ar = fminf(are[gp], -1e-4f), ai = aim[gp];
    const float mag = expf(ar * dt); float sn, cs; sincos_f(ai * dt, sn, cs);
    abr = mag * cs; abi = mag * sn;
    const float nr = abr - 1.0f, ni = abi, den = 1.0f / (ar * ar + ai * ai);
    cr = (nr * ar + ni * ai) * den; ci = (ni * ar - nr * ai) * den;
}
constexpr int S5_X_LD = 136;
constexpr int S5_X_OFF = 0, S5_E_OFF = 128 * S5_X_LD * 2;
#define LDS_BARRIER() do { asm volatile("s_waitcnt lgkmcnt(0)" ::: "memory"); __builtin_amdgcn_s_barrier(); asm volatile("" ::: "memory"); } while (0)
#define CMAC_R(ar, ai, br, bi, cr) fmaf((ar), (br), fmaf(-(ai), (bi), (cr)))
#define CMAC_I(ar, ai, br, bi, ci) fmaf((ar), (bi), fmaf((ai), (br), (ci)))
#define CMUL_R(ar, ai, br, bi) ((ar) * (br) - (ai) * (bi))
#define CMUL_I(ar, ai, br, bi) ((ar) * (bi) + (ai) * (br))
__device__ __forceinline__ void s5_item(const Args& a, LAS unsigned char* lds, int item, int wave, int lane) {
    const int b = item >> 5, g = item & 31;
    const float dt = expf(a.in[I_LOGDT][g]);
    LAS bf16* X = (LAS bf16*)(lds + S5_X_OFF); LAS float* E = (LAS float*)(lds + S5_E_OFF);
    const int mt = wave >> 1, sh = wave & 1, l32 = lane & 31, hf = lane >> 5, p = 32 * sh + l32;
    float a1r, a1i, cr, ci; s5_disc(a.in[I_ARE], a.in[I_AIM], dt, g * 64 + p, a1r, a1i, cr, ci);
    const float a2r = CMUL_R(a1r, a1i, a1r, a1i), a2i = CMUL_I(a1r, a1i, a1r, a1i), a3r = CMUL_R(a2r, a2i, a1r, a1i), a3i = CMUL_I(a2r, a2i, a1r, a1i);
    const float a4r = CMUL_R(a2r, a2i, a2r, a2i), a4i = CMUL_I(a2r, a2i, a2r, a2i), a8r = CMUL_R(a4r, a4i, a4r, a4i), a8i = CMUL_I(a4r, a4i, a4r, a4i);
    const float a12r = CMUL_R(a8r, a8i, a4r, a4i), a12i = CMUL_I(a8r, a8i, a4r, a4i), a16r = CMUL_R(a8r, a8i, a8r, a8i), a16i = CMUL_I(a8r, a8i, a8r, a8i);
    const float a20r = CMUL_R(a16r, a16i, a4r, a4i), a20i = CMUL_I(a16r, a16i, a4r, a4i), a24r = CMUL_R(a16r, a16i, a8r, a8i), a24i = CMUL_I(a16r, a16i, a8r, a8i);
    const float a28r = CMUL_R(a24r, a24i, a4r, a4i), a28i = CMUL_I(a24r, a24i, a4r, a4i), a32r = CMUL_R(a16r, a16i, a16r, a16i), a32i = CMUL_I(a16r, a16i, a16r, a16i);
    const float pwr[4] = {a1r, a2r, a3r, a4r}, pwi[4] = {a1i, a2i, a3i, a4i};
    const float qkr[4] = {hf ? a4r : 1.0f, hf ? a12r : a8r, hf ? a20r : a16r, hf ? a28r : a24r}, qki[4] = {hf ? a4i : 0.0f, hf ? a12i : a8i, hf ? a20i : a16i, hf ? a28i : a24i};
    bf16x8 bfr_re, bfr_im;
    { const float* br = a.in[I_BRE] + (size_t)(g * 64 + p) * 16 + 8 * hf; const float* bi = a.in[I_BIM] + (size_t)(g * 64 + p) * 16 + 8 * hf;
      float vr[8], vi[8];
#pragma unroll
      for (int j = 0; j < 8; ++j) { vr[j] = cr * br[j] - ci * bi[j]; vi[j] = cr * bi[j] + ci * br[j]; }
      v4u o; o.x = pk2(vr[0], vr[1]); o.y = pk2(vr[2], vr[3]); o.z = pk2(vr[4], vr[5]); o.w = pk2(vr[6], vr[7]); bfr_re = __builtin_bit_cast(bf16x8, o);
      o.x = pk2(vi[0], vi[1]); o.y = pk2(vi[2], vi[3]); o.z = pk2(vi[4], vi[5]); o.w = pk2(vi[6], vi[7]); bfr_im = __builtin_bit_cast(bf16x8, o); }
    const int l16 = lane & 15, q4 = lane >> 4;
    bf16x8 cm[4];
#pragma unroll
    for (int ks = 0; ks < 4; ++ks) { const int s0 = 16 * ks + 4 * q4; const float* cre = a.in[I_CRE] + (size_t)(g * 16 + l16) * 64 + s0; const float* cim = a.in[I_CIM] + (size_t)(g * 16 + l16) * 64 + s0;
        v4u o; o.x = pk2(cre[0], -cim[0]); o.y = pk2(cre[1], -cim[1]); o.z = pk2(cre[2], -cim[2]); o.w = pk2(cre[3], -cim[3]); cm[ks] = __builtin_bit_cast(bf16x8, o); }
    float dsk[4];
#pragma unroll
    for (int r = 0; r < 4; ++r) dsk[r] = a.in[I_D][g * 16 + 4 * q4 + r];
    const bf16* ZS = (const bf16*)(a.ws + WS_ZS) + ((size_t)(b * 32 + g) * 8192) * 16;
    bf16* YS = (bf16*)(a.ws + WS_YS) + (size_t)b * 8192 * 512 + g * 16;
    float xinr = 0.f, xini = 0.f;
    bf16x8 ua_n = *(const bf16x8*)(ZS + (mt * 32 + l32) * 16 + hf * 8);
    v2u uu_n = *(const v2u*)(ZS + (16 * wave + l16) * 16 + 4 * q4);
    for (int ch = 0; ch < 64; ++ch) {
        const bf16x8 ua = ua_n; const v2u uu = uu_n;
        { const int cn = ch < 63 ? ch + 1 : 63; const bf16* zn = ZS + (size_t)cn * 128 * 16;
          ua_n = *(const bf16x8*)(zn + (mt * 32 + l32) * 16 + hf * 8); uu_n = *(const v2u*)(zn + (16 * wave + l16) * 16 + 4 * q4); }
        const f32x16 z16 = {0.f, 0.f, 0.f, 0.f, 0.f, 0.f, 0.f, 0.f, 0.f, 0.f, 0.f, 0.f, 0.f, 0.f, 0.f, 0.f};
        const f32x16 bre = __builtin_amdgcn_mfma_f32_32x32x16_bf16(ua, bfr_re, z16, 0, 0, 0), bim = __builtin_amdgcn_mfma_f32_32x32x16_bf16(ua, bfr_im, z16, 0, 0, 0);
        float xr[16], xi[16];
#pragma unroll
        for (int j = 0; j < 4; ++j) { xr[4 * j] = bre[4 * j]; xi[4 * j] = bim[4 * j];
#pragma unroll
            for (int i = 1; i < 4; ++i) { xr[4 * j + i] = CMAC_R(a1r, a1i, xr[4 * j + i - 1], xi[4 * j + i - 1], bre[4 * j + i]); xi[4 * j + i] = CMAC_I(a1r, a1i, xr[4 * j + i - 1], xi[4 * j + i - 1], bim[4 * j + i]); } }
        float clr[4], cli[4], ber, bei;
        { float pgr[4], pgi[4];
#pragma unroll
          for (int j = 0; j < 4; ++j) { pgr[j] = __shfl_xor(xr[4 * j + 3], 32); pgi[j] = __shfl_xor(xi[4 * j + 3], 32); }
          float cr_ = 0.f, ci_ = 0.f;
#pragma unroll
          for (int k = 0; k < 8; ++k) { const int j = k >> 1; const bool mine = (hf == (k & 1));
              if ((k & 1) == 0) { clr[j] = cr_; cli[j] = ci_; } else { clr[j] = mine ? cr_ : clr[j]; cli[j] = mine ? ci_ : cli[j]; }
              const float gr = mine ? xr[4 * j + 3] : pgr[j], gi = mine ? xi[4 * j + 3] : pgi[j];
              const float nr = CMAC_R(a4r, a4i, cr_, ci_, gr), ni = CMAC_I(a4r, a4i, cr_, ci_, gi); cr_ = nr; ci_ = ni; }
          ber = cr_; bei = ci_; }
        if (hf == 0) { E[(mt * 64 + p) * 2] = ber; E[(mt * 64 + p) * 2 + 1] = bei; }
        LDS_BARRIER();
        float mbr = 0.f, mbi = 0.f;
        { float cr_ = xinr, ci_ = xini;
#pragma unroll
          for (int m = 0; m < 4; ++m) { if (m == mt) { mbr = cr_; mbi = ci_; } const float er = E[(m * 64 + p) * 2], ei = E[(m * 64 + p) * 2 + 1];
              const float nr = CMAC_R(a32r, a32i, cr_, ci_, er), ni = CMAC_I(a32r, a32i, cr_, ci_, ei); cr_ = nr; ci_ = ni; }
          xinr = cr_; xini = ci_; }
#pragma unroll
        for (int j = 0; j < 4; ++j) { const float ckr = CMAC_R(qkr[j], qki[j], mbr, mbi, clr[j]), cki = CMAC_I(qkr[j], qki[j], mbr, mbi, cli[j]);
#pragma unroll
            for (int i = 0; i < 4; ++i) { const float fr = CMAC_R(pwr[i], pwi[i], ckr, cki, xr[4 * j + i]), fi = CMAC_I(pwr[i], pwi[i], ckr, cki, xi[4 * j + i]);
                *(LAS unsigned*)(X + (32 * mt + 8 * j + 4 * hf + i) * S5_X_LD + 2 * p) = pg8::cvt_pk_bf16(fr, fi); } }
        LDS_BARRIER();
        { f32x4 o = {0.f, 0.f, 0.f, 0.f};
#pragma unroll
          for (int ks = 0; ks < 4; ++ks) { const bf16x8 xa = *(const LAS bf16x8*)(X + (16 * wave + l16) * S5_X_LD + 32 * ks + 8 * q4); o = __builtin_amdgcn_mfma_f32_16x16x32_bf16(cm[ks], xa, o, 0, 0, 0); }
          const int t = 16 * wave + l16;
          const float y0 = gelu_t(o[0] + dsk[0] * bflo(uu.x)), y1 = gelu_t(o[1] + dsk[1] * bfhi(uu.x)), y2 = gelu_t(o[2] + dsk[2] * bflo(uu.y)), y3 = gelu_t(o[3] + dsk[3] * bfhi(uu.y));
          v2u w; w.x = pg8::cvt_pk_bf16(y0, y1); w.y = pg8::cvt_pk_bf16(y2, y3); *(v2u*)(YS + (size_t)(ch * 128 + t) * 512 + 4 * q4) = w; }
    }
    __syncthreads();
}

constexpr int SGU_RS = 1056;
typedef short v4i16_t __attribute__((ext_vector_type(4)));
__device__ __forceinline__ s16x4 ds_tr16(const LAS unsigned char* p) { return __builtin_bit_cast(s16x4, __builtin_amdgcn_ds_read_tr16_b64_v4i16((LAS v4i16_t*)p)); }
__device__ __forceinline__ void sgu_item(const Args& a, LAS unsigned char* lds, int item, int wave, int lane) {
    const bf16* ZG = (const bf16*)(a.ws + WS_ZG); bf16* Y = (bf16*)(a.ws + WS_Y); const bf16* WM = (const bf16*)(a.ws + WS_WM);
    const int r0 = item * 128;
    { float lg[8], lb[8];
#pragma unroll
      for (int j = 0; j < 8; ++j) { lg[j] = a.in[I_LNG][8 * lane + j]; lb[j] = a.in[I_LNB][8 * lane + j]; }
      v4u raw[16];
#pragma unroll
      for (int tt = 0; tt < 16; ++tt) raw[tt] = __builtin_nontemporal_load((const v4u*)(ZG + (size_t)(r0 + 16 * wave + tt) * 1024 + 512 + 8 * lane));
      float s1[16], s2[16];
#pragma unroll
      for (int tt = 0; tt < 16; ++tt) { const float f[8] = {bflo(raw[tt].x), bfhi(raw[tt].x), bflo(raw[tt].y), bfhi(raw[tt].y), bflo(raw[tt].z), bfhi(raw[tt].z), bflo(raw[tt].w), bfhi(raw[tt].w)};
          float a1 = 0.f, a2 = 0.f;
#pragma unroll
          for (int j = 0; j < 8; ++j) { a1 += f[j]; a2 += f[j] * f[j]; }
          s1[tt] = a1; s2[tt] = a2; }
#pragma unroll
      for (int o = 1; o < 64; o <<= 1) {
#pragma unroll
          for (int tt = 0; tt < 16; ++tt) { s1[tt] += __shfl_xor(s1[tt], o); s2[tt] += __shfl_xor(s2[tt], o); } }
#pragma unroll
      for (int tt = 0; tt < 16; ++tt) { const int t = 16 * wave + tt;
          float f[8] = {bflo(raw[tt].x), bfhi(raw[tt].x), bflo(raw[tt].y), bfhi(raw[tt].y), bflo(raw[tt].z), bfhi(raw[tt].z), bflo(raw[tt].w), bfhi(raw[tt].w)};
          const float mu = s1[tt] * (1.0f / 512.0f), var = fmaxf(s2[tt] * (1.0f / 512.0f) - mu * mu, 0.f), rstd = 1.0f / sqrtf(var + EPS);
#pragma unroll
          for (int j = 0; j < 8; ++j) f[j] = (f[j] - mu) * rstd * lg[j] + lb[j];
          v4u o; o.x = pk2(f[0], f[1]); o.y = pk2(f[2], f[3]); o.z = pk2(f[4], f[5]); o.w = pk2(f[6], f[7]);
          *(LAS v4u*)(lds + t * SGU_RS + 16 * lane) = o; } }
    __syncthreads();
    const int l16 = lane & 15, q4 = lane >> 4, qq = l16 >> 2, pp = l16 & 3, nks = (wave >> 1) + 1, irow = 16 * wave + l16;
    for (int h = 0; h < 4; ++h) {
        f32x4 acc[8];
#pragma unroll
        for (int nt = 0; nt < 8; ++nt) acc[nt] = (f32x4){0.f, 0.f, 0.f, 0.f};
        bf16x8 wf[4]; v2u uu[8];
#pragma unroll
        for (int ks = 0; ks < 4; ++ks) { const int kc = ks < nks ? ks : nks - 1; wf[ks] = *(const bf16x8*)(WM + ((size_t)(h * 128 + irow)) * 128 + 32 * kc + 8 * q4); }
#pragma unroll
        for (int nt = 0; nt < 8; ++nt) uu[nt] = __builtin_nontemporal_load((const v2u*)(ZG + (size_t)(r0 + irow) * 1024 + h * 128 + 16 * nt + 4 * q4));
        const float bs = a.in[I_BS][h * 128 + irow];
#pragma unroll
        for (int ks = 0; ks < 4; ++ks) { if (ks < nks) {
            const LAS unsigned char* vb = lds + (32 * ks + 8 * q4 + qq) * SGU_RS + (h * 128 + 4 * pp) * 2;
#pragma unroll
            for (int nt = 0; nt < 8; ++nt) { const s16x4 lo = ds_tr16(vb + nt * 32), hi = ds_tr16(vb + nt * 32 + 4 * SGU_RS);
                const bf16x8 vf = {lo[0], lo[1], lo[2], lo[3], hi[0], hi[1], hi[2], hi[3]};
                acc[nt] = __builtin_amdgcn_mfma_f32_16x16x32_bf16(vf, wf[ks], acc[nt], 0, 0, 0); } } }
#pragma unroll
        for (int nt = 0; nt < 8; ++nt) { const size_t o = (size_t)(r0 + irow) * 1024 + h * 128 + 16 * nt + 4 * q4;
            v2u w; w.x = pk2(bflo(uu[nt].x) * (acc[nt][0] + bs), bfhi(uu[nt].x) * (acc[nt][1] + bs)); w.y = pk2(bflo(uu[nt].y) * (acc[nt][2] + bs), bfhi(uu[nt].y) * (acc[nt][3] + bs)); *(v2u*)(Y + o) = w; }
    }
    __syncthreads();
}
__device__ __forceinline__ int f2i(float f) { return __builtin_bit_cast(int, f); }
__device__ __forceinline__ float i2f(int i) { return __builtin_bit_cast(float, i); }
__device__ __forceinline__ float kmax(float a, float b) { float r; asm("v_max_f32 %0, %1, %2" : "=v"(r) : "v"(a), "v"(b)); return r; }
__device__ __forceinline__ float kmin(float a, float b) { float r; asm("v_min_f32 %0, %1, %2" : "=v"(r) : "v"(a), "v"(b)); return r; }
__device__ __forceinline__ float mkkey(float s, int keep, int payload) { return i2f((f2i(s) & keep) | payload); }
__device__ __forceinline__ void sort16(float (&v)[16]) {
#define CE16(i, j) { const float x_ = v[i], y_ = v[j]; v[i] = kmax(x_, y_); v[j] = kmin(x_, y_); }
    CE16(0,1) CE16(2,3) CE16(0,2) CE16(1,3) CE16(1,2) CE16(4,5) CE16(6,7) CE16(4,6) CE16(5,7) CE16(5,6) CE16(0,4) CE16(2,6) CE16(2,4) CE16(1,5) CE16(3,7) CE16(3,5) CE16(1,2) CE16(3,4) CE16(5,6) CE16(8,9) CE16(10,11) CE16(8,10) CE16(9,11) CE16(9,10) CE16(12,13) CE16(14,15) CE16(12,14) CE16(13,15) CE16(13,14) CE16(8,12) CE16(10,14) CE16(10,12) CE16(9,13) CE16(11,15) CE16(11,13) CE16(9,10) CE16(11,12) CE16(13,14) CE16(0,8) CE16(4,12) CE16(4,8) CE16(2,10) CE16(6,14) CE16(6,10) CE16(2,4) CE16(6,8) CE16(10,12) CE16(1,9) CE16(5,13) CE16(5,9) CE16(3,11) CE16(7,15) CE16(7,11) CE16(3,5) CE16(7,9) CE16(11,13) CE16(1,2) CE16(3,4) CE16(5,6) CE16(7,8) CE16(9,10) CE16(11,12) CE16(13,14)
#undef CE16
}
__device__ __forceinline__ void merge16(float (&a)[16], const float (&b)[16]) {
#pragma unroll
    for (int i = 0; i < 16; ++i) a[i] = kmax(a[i], b[15 - i]);
#pragma unroll
    for (int j = 8; j > 0; j >>= 1)
#pragma unroll
        for (int i = 0; i < 16; ++i) { const int l = i ^ j; if (l > i) { const float x = a[i], y = a[l]; a[i] = kmax(x, y); a[l] = kmin(x, y); } }
}
constexpr int NCAND = 50;
constexpr int cand_a(int n) { int c = 0; for (int a = 0; a < 16; ++a) for (int b = 0; b < 16; ++b) if ((a + 1) * (b + 1) <= 16) { if (c == n) return a; ++c; } return 0; }
constexpr int cand_b(int n) { int c = 0; for (int a = 0; a < 16; ++a) for (int b = 0; b < 16; ++b) if ((a + 1) * (b + 1) <= 16) { if (c == n) return b; ++c; } return 0; }
template <int N> struct CandAB { static constexpr int a = cand_a(N), b = cand_b(N); };
template <int S> __device__ __forceinline__ float cand_key2(const float (&f1)[16], const float (&f2)[16], bool hf) {
    if constexpr (S < 25) { constexpr int a0 = CandAB<S>::a, b0 = CandAB<S>::b, a1 = CandAB<25 + S>::a, b1 = CandAB<25 + S>::b;
        const float s = (hf ? f1[a1] : f1[a0]) + (hf ? f2[b1] : f2[b0]); return mkkey(s, ~0xff, hf ? ((a1 << 4) | b1) : ((a0 << 4) | b0)); }
    else return i2f((int)0xff800000);
}
template <int G> __device__ __forceinline__ void cand_fill2(float (&v)[16], const float (&f1)[16], const float (&f2)[16], bool hf) {
    v[0] = cand_key2<G * 16 + 0>(f1, f2, hf); v[1] = cand_key2<G * 16 + 1>(f1, f2, hf); v[2] = cand_key2<G * 16 + 2>(f1, f2, hf); v[3] = cand_key2<G * 16 + 3>(f1, f2, hf);
    v[4] = cand_key2<G * 16 + 4>(f1, f2, hf); v[5] = cand_key2<G * 16 + 5>(f1, f2, hf); v[6] = cand_key2<G * 16 + 6>(f1, f2, hf); v[7] = cand_key2<G * 16 + 7>(f1, f2, hf);
    v[8] = cand_key2<G * 16 + 8>(f1, f2, hf); v[9] = cand_key2<G * 16 + 9>(f1, f2, hf); v[10] = cand_key2<G * 16 + 10>(f1, f2, hf); v[11] = cand_key2<G * 16 + 11>(f1, f2, hf);
    v[12] = cand_key2<G * 16 + 12>(f1, f2, hf); v[13] = cand_key2<G * 16 + 13>(f1, f2, hf); v[14] = cand_key2<G * 16 + 14>(f1, f2, hf); v[15] = cand_key2<G * 16 + 15>(f1, f2, hf);
}

__device__ __forceinline__ void peer_topk32(const bf16* Q, const bf16* KEYS, unsigned short* EO, float* GO, LAS unsigned char* wl  , int tok0, int lane) {
    const int l32 = lane & 31, hf = lane >> 5; const size_t tok = (size_t)tok0 + l32;
    for (int h = 0; h < 8; ++h) {
        float L0[16], L1[16];
#pragma unroll
        for (int c = 0; c < 2; ++c) {
            bf16x8 bq[4];
#pragma unroll
            for (int ks = 0; ks < 4; ++ks) bq[ks] = __builtin_nontemporal_load((const bf16x8*)(Q + tok * 1024 + h * 128 + c * 64 + ks * 16 + hf * 8));
            float T[16], S[16];
            { f32x16 acc = (f32x16){0.f, 0.f, 0.f, 0.f, 0.f, 0.f, 0.f, 0.f, 0.f, 0.f, 0.f, 0.f, 0.f, 0.f, 0.f, 0.f};
              const bf16* kp = KEYS + ((size_t)((h * 2 + c) * 128 + l32)) * 64 + hf * 8;
#pragma unroll
              for (int ks = 0; ks < 4; ++ks) { const bf16x8 ak = *(const bf16x8*)(kp + ks * 16); acc = __builtin_amdgcn_mfma_f32_32x32x16_bf16(ak, bq[ks], acc, 0, 0, 0); }
#pragma unroll
              for (int r = 0; r < 16; ++r) T[r] = mkkey(acc[r], ~0x7f, 8 * (r >> 2) + 4 * hf + (r & 3));
              sort16(T); }
            for (int mt = 1; mt < 4; ++mt) {
                f32x16 acc = (f32x16){0.f, 0.f, 0.f, 0.f, 0.f, 0.f, 0.f, 0.f, 0.f, 0.f, 0.f, 0.f, 0.f, 0.f, 0.f, 0.f};
                const bf16* kp = KEYS + ((size_t)((h * 2 + c) * 128 + mt * 32 + l32)) * 64 + hf * 8;
#pragma unroll
                for (int ks = 0; ks < 4; ++ks) { const bf16x8 ak = *(const bf16x8*)(kp + ks * 16); acc = __builtin_amdgcn_mfma_f32_32x32x16_bf16(ak, bq[ks], acc, 0, 0, 0); }
#pragma unroll
                for (int r = 0; r < 16; ++r) S[r] = mkkey(acc[r], ~0x7f, mt * 32 + 8 * (r >> 2) + 4 * hf + (r & 3));
                sort16(S); merge16(T, S); }
#pragma unroll
            for (int r = 0; r < 16; ++r) S[r] = __shfl_xor(T[r], 32);
            merge16(T, S);
            if (c == 0) {
#pragma unroll
                for (int r = 0; r < 16; ++r) L0[r] = T[r];
            } else {
#pragma unroll
                for (int r = 0; r < 16; ++r) L1[r] = T[r];
            }
        }
        float f1[16], f2[16];
#pragma unroll
        for (int r = 0; r < 16; ++r) { const int k0 = f2i(L0[r]), k1 = f2i(L1[r]); f1[r] = i2f(k0 & ~0x7f); f2[r] = i2f(k1 & ~0x7f); wl[lane * 36 + r] = (unsigned char)(k0 & 0x7f); wl[lane * 36 + 16 + r] = (unsigned char)(k1 & 0x7f); }
        float K[16], S2[16];
        cand_fill2<0>(K, f1, f2, hf != 0); sort16(K);
        cand_fill2<1>(S2, f1, f2, hf != 0); sort16(S2); merge16(K, S2);
#pragma unroll
        for (int r = 0; r < 16; ++r) S2[r] = __shfl_xor(K[r], 32);
        merge16(K, S2);
        float pe[16], ssum = 0.f; const float mx = i2f(f2i(K[0]) & ~0xff);
#pragma unroll
        for (int r = 0; r < 16; ++r) { pe[r] = __expf(i2f(f2i(K[r]) & ~0xff) - mx); ssum += pe[r]; }
        const float inv = 1.0f / ssum;
        int ev[16]; float gv[16];
#pragma unroll
        for (int j = 0; j < 16; ++j) { const int ab = f2i(K[j]) & 0xff; const int i1 = wl[lane * 36 + (ab >> 4)], i2 = wl[lane * 36 + 16 + (ab & 15)]; ev[j] = i1 * 128 + i2; gv[j] = pe[j] * inv; }
        if (hf == 0) { unsigned short* ed = EO + (tok * 8 + h) * 16; float* gd = GO + (tok * 8 + h) * 16;
            *(v4u*)(ed) = (v4u){(unsigned)ev[0] | ((unsigned)ev[1] << 16), (unsigned)ev[2] | ((unsigned)ev[3] << 16), (unsigned)ev[4] | ((unsigned)ev[5] << 16), (unsigned)ev[6] | ((unsigned)ev[7] << 16)};
            *(v4u*)(ed + 8) = (v4u){(unsigned)ev[8] | ((unsigned)ev[9] << 16), (unsigned)ev[10] | ((unsigned)ev[11] << 16), (unsigned)ev[12] | ((unsigned)ev[13] << 16), (unsigned)ev[14] | ((unsigned)ev[15] << 16)};
#pragma unroll
            for (int j = 0; j < 4; ++j) *(f32x4*)(gd + 4 * j) = (f32x4){gv[4 * j], gv[4 * j + 1], gv[4 * j + 2], gv[4 * j + 3]}; }
    }
}

typedef float f32x2_t __attribute__((ext_vector_type(2)));
typedef _Float16 h2_t __attribute__((ext_vector_type(2)));
__device__ __forceinline__ h2_t as_h2(unsigned u) { return __builtin_bit_cast(h2_t, u); }
template <bool HI> __device__ __forceinline__ h2_t cvt_h2_fp8(unsigned d) { const auto t = __builtin_amdgcn_cvt_scalef32_pk_f16_fp8((int)d, 1.0f, HI); return __builtin_bit_cast(h2_t, t); }
typedef int v4i __attribute__((ext_vector_type(4)));
__device__ __forceinline__ void cvt8x2(v4u r, f32x2_t (&f)[8]) {
    const unsigned w0 = r.x, w1 = r.y, w2 = r.z, w3 = r.w;
    f[0] = __builtin_amdgcn_cvt_pk_f32_fp8((int)w0, false); f[1] = __builtin_amdgcn_cvt_pk_f32_fp8((int)w0, true);
    f[2] = __builtin_amdgcn_cvt_pk_f32_fp8((int)w1, false); f[3] = __builtin_amdgcn_cvt_pk_f32_fp8((int)w1, true);
    f[4] = __builtin_amdgcn_cvt_pk_f32_fp8((int)w2, false); f[5] = __builtin_amdgcn_cvt_pk_f32_fp8((int)w2, true);
    f[6] = __builtin_amdgcn_cvt_pk_f32_fp8((int)w3, false); f[7] = __builtin_amdgcn_cvt_pk_f32_fp8((int)w3, true);
}
__device__ __forceinline__ void load_elist(const unsigned short* E, size_t tok, int h, int (&e)[16]) {
    const v4u* ep = (const v4u*)(E + tok * 128 + h * 16);
#pragma unroll
    for (int i = 0; i < 2; ++i) { const v4u v = ep[i]; const unsigned w[4] = {v.x, v.y, v.z, v.w};
#pragma unroll
        for (int c = 0; c < 4; ++c) { e[8 * i + 2 * c] = (int)(w[c] & 0xffffu); e[8 * i + 2 * c + 1] = (int)(w[c] >> 16); } }
}
__device__ __forceinline__ void issue_rows(v4u (&r)[16], const unsigned char* tb, unsigned poff, const int (&e)[16]) {
#pragma unroll
    for (int k = 0; k < 16; ++k) r[k] = *(const v4u*)(tb + ((unsigned)e[k] * 128u + poff));
}
template <int B2, int B1, int B0> __device__ __forceinline__ void treduce16(const float (&v)[16], int lane, float& o0, float& o1) {
    float q8[8], q4[4];
    { const bool hi = (lane & B2) != 0;
#pragma unroll
      for (int i = 0; i < 8; ++i) { const float keep = hi ? v[i + 8] : v[i], send = hi ? v[i] : v[i + 8]; q8[i] = keep + __shfl_xor(send, B2); } }
    { const bool hi = (lane & B1) != 0;
#pragma unroll
      for (int i = 0; i < 4; ++i) { const float keep = hi ? q8[i + 4] : q8[i], send = hi ? q8[i] : q8[i + 4]; q4[i] = keep + __shfl_xor(send, B1); } }
    { const bool hi = (lane & B0) != 0;
      { const float keep = hi ? q4[2] : q4[0], send = hi ? q4[0] : q4[2]; o0 = keep + __shfl_xor(send, B0); }
      { const float keep = hi ? q4[3] : q4[1], send = hi ? q4[1] : q4[3]; o1 = keep + __shfl_xor(send, B0); } }
}
__device__ __forceinline__ void treduce16i_p(const int (&v)[16], int lane, int& o0, int& o1) {
    int q8[8], q4[4];
    { const bool hi = (lane & 4) != 0;
#pragma unroll
      for (int i = 0; i < 8; ++i) { const int keep = hi ? v[i + 8] : v[i], send = hi ? v[i] : v[i + 8]; q8[i] = keep + __builtin_amdgcn_update_dpp(0, send, 0x141, 0xF, 0xF, false); } }
    { const bool hi = (lane & 2) != 0;
#pragma unroll
      for (int i = 0; i < 4; ++i) { const int keep = hi ? q8[i + 4] : q8[i], send = hi ? q8[i] : q8[i + 4]; q4[i] = keep + __builtin_amdgcn_update_dpp(0, send, 0x4E, 0xF, 0xF, false); } }
    { const bool hi = (lane & 1) != 0;
      { const int keep = hi ? q4[2] : q4[0], send = hi ? q4[0] : q4[2]; o0 = keep + __builtin_amdgcn_update_dpp(0, send, 0xB1, 0xF, 0xF, false); }
      { const int keep = hi ? q4[3] : q4[1], send = hi ? q4[1] : q4[3]; o1 = keep + __builtin_amdgcn_update_dpp(0, send, 0xB1, 0xF, 0xF, false); } }
}
__device__ __forceinline__ void treduce16f_h(const float (&v)[16], int lane, float& o0, float& o1) {
    float q8[8], q4[4];
    { const bool hi = (lane & 8) != 0;
#pragma unroll
      for (int i = 0; i < 8; ++i) { const float keep = hi ? v[i + 8] : v[i], send = hi ? v[i] : v[i + 8];
          q8[i] = keep + __builtin_bit_cast(float, __builtin_amdgcn_update_dpp(0, __builtin_bit_cast(int, send), 0x128, 0xF, 0xF, false)); } }
    { const bool hi = (lane & 16) != 0;
#pragma unroll
      for (int i = 0; i < 4; ++i) { const float keep = hi ? q8[i + 4] : q8[i], send = hi ? q8[i] : q8[i + 4];
          q4[i] = keep + __builtin_bit_cast(float, __builtin_amdgcn_ds_swizzle(__builtin_bit_cast(int, send), 0x401F)); } }
    { const bool hi = (lane & 32) != 0;
      { const float keep = hi ? q4[2] : q4[0], send = hi ? q4[0] : q4[2]; o0 = keep + __shfl_xor(send, 32); }
      { const float keep = hi ? q4[3] : q4[1], send = hi ? q4[1] : q4[3]; o1 = keep + __shfl_xor(send, 32); } }
}
__device__ __forceinline__ void upass_compute(const v4u (&r)[16], v4u hq, short* pa, int lane, v4u (&rn)[16], const unsigned char* tb, unsigned poff, const int (&en)[16]) {
    int part[16];
#pragma unroll
    for (int k = 0; k < 16; ++k) { rn[k] = *(const v4u*)(tb + ((unsigned)en[k] * 128u + poff));
        int s = __builtin_amdgcn_sdot4((int)r[k].x, (int)hq.x, 0, false); s = __builtin_amdgcn_sdot4((int)r[k].y, (int)hq.y, s, false); s = __builtin_amdgcn_sdot4((int)r[k].z, (int)hq.z, s, false); part[k] = __builtin_amdgcn_sdot4((int)r[k].w, (int)hq.w, s, false);
        __builtin_amdgcn_sched_barrier(0); }
    int o0, o1; treduce16i_p(part, lane, o0, o1);
    *(unsigned*)(pa + (lane >> 3) * 16 + 2 * (lane & 7)) = (unsigned)(((o0 + 32) >> 6) & 0xffff) | ((unsigned)((o1 + 32) >> 6) << 16);
}
__device__ __forceinline__ void vpass_compute(const v4u (&r)[16], const v4u (&wp)[2], bf16* xo  , const float* gt  , int lane, v4u (&rn)[16], const unsigned char* tb, unsigned poff, const int (&en)[16]) {
    h2_t o2[8];
#pragma unroll
    for (int i = 0; i < 8; ++i) o2[i] = (h2_t){(_Float16)0.f, (_Float16)0.f};
    const unsigned wq[8] = {wp[0].x, wp[0].y, wp[0].z, wp[0].w, wp[1].x, wp[1].y, wp[1].z, wp[1].w};
#pragma unroll
    for (int k = 0; k < 16; ++k) { rn[k] = *(const v4u*)(tb + ((unsigned)en[k] * 128u + poff));
        const unsigned d0 = r[k].x, d1 = r[k].y, d2 = r[k].z, d3 = r[k].w; const h2_t wpair = as_h2(wq[k >> 1]); const _Float16 wh = (k & 1) ? wpair.y : wpair.x; const h2_t ww = {wh, wh};
        o2[0] = __builtin_elementwise_fma(cvt_h2_fp8<false>(d0), ww, o2[0]); o2[1] = __builtin_elementwise_fma(cvt_h2_fp8<true>(d0), ww, o2[1]);
        o2[2] = __builtin_elementwise_fma(cvt_h2_fp8<false>(d1), ww, o2[2]); o2[3] = __builtin_elementwise_fma(cvt_h2_fp8<true>(d1), ww, o2[3]);
        o2[4] = __builtin_elementwise_fma(cvt_h2_fp8<false>(d2), ww, o2[4]); o2[5] = __builtin_elementwise_fma(cvt_h2_fp8<true>(d2), ww, o2[5]);
        o2[6] = __builtin_elementwise_fma(cvt_h2_fp8<false>(d3), ww, o2[6]); o2[7] = __builtin_elementwise_fma(cvt_h2_fp8<true>(d3), ww, o2[7]);
        __builtin_amdgcn_sched_barrier(0); }
    float v[16];
#pragma unroll
    for (int i = 0; i < 8; ++i) { v[2 * i] = (float)o2[i].x * (1.0f / 64.0f); v[2 * i + 1] = (float)o2[i].y * (1.0f / 64.0f); }
    float o0, o1; treduce16f_h(v, lane, o0, o1);
    const int c = 16 * (lane & 7) + 2 * (((lane >> 1) & 4) | ((lane >> 3) & 2) | ((lane >> 5) & 1));
    const unsigned xb = *(const unsigned*)(xo + c); const f32x2_t g = *(const f32x2_t*)(gt + c);
    const float a0 = bflo(xb) + g.x * o0, a1 = bfhi(xb) + g.y * o1;
    const unsigned ob = pk2(a0, a1);
    *(unsigned*)(xo + c) = ob;
}
template <bool UP> __device__ __forceinline__ void peer_pass(const Args& a, int wave, int lane_in) {
    int lane = lane_in; asm volatile("" : "+v"(lane));
    const int G = gridDim.x, bx = blockIdx.x;
    const bool sliced = (G % 8) == 0;
    const int nj = sliced ? 1 : 8, j0 = sliced ? (bx & 7) : 0;
    const int first = sliced ? ((bx >> 3) * NWAVES + wave) : (bx * NWAVES + wave), stride = sliced ? (G >> 3) * NWAVES : G * NWAVES;
    const int h = lane >> 3, p = lane & 7;
    const unsigned short* E = (const unsigned short*)(a.ws + WS_E); const unsigned char* HQ = a.ws + WS_H2Q; const _Float16* W = (const _Float16*)(a.ws + WS_W);
    short* PA = (short*)(a.ws + WS_PA); const float* MOD = (const float*)(a.ws + WS_MOD);
    const unsigned char* T8 = a.ws + (UP ? WS_UB : WS_VB);
    const int ntok = (M - first + stride - 1) / stride;
    for (int jj = 0; jj < nj; ++jj) { const int j = j0 + jj;
        const unsigned char* tb = T8 + (size_t)j * (16384 * 128);
        v4u RA[16], RB[16]; int en[16], en2[16];
        v4u hA0, hB0; v4u wA[2], wB[2];
        { const size_t t0 = (size_t)first; int e0[16]; load_elist(E, t0, h, e0); issue_rows(RA, tb, 16u * p, e0);
          if (UP) { hA0 = *(const v4u*)(HQ + t0 * 1024 + 128 * j + 16 * p); }
          else { wA[0] = *(const v4u*)(W + t0 * 128 + h * 16); wA[1] = *(const v4u*)(W + t0 * 128 + h * 16 + 8); }
          const size_t t1 = (size_t)first + (size_t)(ntok > 1 ? 1 : 0) * stride; load_elist(E, t1, h, en); }
        for (int u = 0; u < ntok; u += 2) {
            { const int u1 = (u + 1 < ntok) ? u + 1 : ntok - 1, u2 = (u + 2 < ntok) ? u + 2 : ntok - 1; const size_t t1 = (size_t)first + (size_t)u1 * stride, t2 = (size_t)first + (size_t)u2 * stride;
              load_elist(E, t2, h, en2);
              if (UP) { hB0 = *(const v4u*)(HQ + t1 * 1024 + 128 * j + 16 * p); }
              else { wB[0] = *(const v4u*)(W + t1 * 128 + h * 16); wB[1] = *(const v4u*)(W + t1 * 128 + h * 16 + 8); }
              const size_t t = (size_t)first + (size_t)u * stride;
              if (UP) upass_compute(RA, hA0, PA + ((size_t)j * M + t) * 128, lane, RB, tb, 16u * p, en);
              else vpass_compute(RA, wA, (bf16*)(a.ws + WS_X1B) + t * 1024 + 128 * j, MOD + (t >> 13) * NMODC + 5120 + 128 * j, lane, RB, tb, 16u * p, en); }
            if (u + 1 >= ntok) break;
            { const int u1 = (u + 2 < ntok) ? u + 2 : ntok - 1, u2 = (u + 3 < ntok) ? u + 3 : ntok - 1; const size_t t1 = (size_t)first + (size_t)u1 * stride, t2 = (size_t)first + (size_t)u2 * stride;
              load_elist(E, t2, h, en);
              if (UP) { hA0 = *(const v4u*)(HQ + t1 * 1024 + 128 * j + 16 * p); }
              else { wA[0] = *(const v4u*)(W + t1 * 128 + h * 16); wA[1] = *(const v4u*)(W + t1 * 128 + h * 16 + 8); }
              const size_t t = (size_t)first + (size_t)(u + 1) * stride;
              if (UP) upass_compute(RB, hB0, PA + ((size_t)j * M + t) * 128, lane, RA, tb, 16u * p, en2);
              else vpass_compute(RB, wB, (bf16*)(a.ws + WS_X1B) + t * 1024 + 128 * j, MOD + (t >> 13) * NMODC + 5120 + 128 * j, lane, RA, tb, 16u * p, en2); }
        }
    }
}
__device__ __forceinline__ void upass4(const Args& a, int wave, int lane_in) {
    int lane = lane_in; asm volatile("" : "+v"(lane));
    const int G = gridDim.x, bx = blockIdx.x;
    const bool sliced = (G % 8) == 0;
    const int nj = sliced ? 1 : 8, j0 = sliced ? (bx & 7) : 0;
    const int first = sliced ? ((bx >> 3) * NWAVES + wave) : (bx * NWAVES + wave), stride = sliced ? (G >> 3) * NWAVES : G * NWAVES;
    const int r = lane >> 2, p = lane & 3;
    const unsigned short* E = (const unsigned short*)(a.ws + WS_E); const unsigned char* HQh = a.ws + WS_H2Q; const unsigned char* HQl = a.ws + WS_H2Q + (size_t)32 * MiB; short* PA = (short*)(a.ws + WS_PA);
    const int ntok = (M - first + stride - 1) / stride;
    const int eoff = (r >> 1) * 16 + 8 * (r & 1);
    for (int jj = 0; jj < nj; ++jj) { const int j = j0 + jj;
        const unsigned char* tb = a.ws + WS_UB + (size_t)j * (16384 * 64);
        const unsigned poff = 16u * p;
        v4u R0[8], R1[8], R2[8], R3[8], hh0, hl0, hh1, hl1, hh2, hl2, hh3, hl3, eA, eB;
#define U4_ROWS(R, ev) do { const unsigned w_[4] = {ev.x, ev.y, ev.z, ev.w}; _Pragma("unroll") for (int c_ = 0; c_ < 4; ++c_) { R[2 * c_] = *(const v4u*)(tb + ((w_[c_] & 0xffffu) * 64u + poff)); R[2 * c_ + 1] = *(const v4u*)(tb + ((w_[c_] >> 16) * 64u + poff)); } } while (0)
#define U4_COMPUTE(R, hh, hl, t) do { int part[8]; _Pragma("unroll") for (int i_ = 0; i_ < 8; ++i_) { \
            int sh_ = __builtin_amdgcn_sdot8((int)R[i_].x, (int)hh.x, 0, false); sh_ = __builtin_amdgcn_sdot8((int)R[i_].y, (int)hh.y, sh_, false); sh_ = __builtin_amdgcn_sdot8((int)R[i_].z, (int)hh.z, sh_, false); sh_ = __builtin_amdgcn_sdot8((int)R[i_].w, (int)hh.w, sh_, false); \
            int sl_ = __builtin_amdgcn_sdot8((int)R[i_].x, (int)hl.x, 0, false); sl_ = __builtin_amdgcn_sdot8((int)R[i_].y, (int)hl.y, sl_, false); sl_ = __builtin_amdgcn_sdot8((int)R[i_].z, (int)hl.z, sl_, false); sl_ = __builtin_amdgcn_sdot8((int)R[i_].w, (int)hl.w, sl_, false); \
            part[i_] = 16 * sh_ + sl_; } \
        int q4_[4]; { const bool hi_ = (lane & 2) != 0; _Pragma("unroll") for (int i_ = 0; i_ < 4; ++i_) { const int keep_ = hi_ ? part[i_ + 4] : part[i_], send_ = hi_ ? part[i_] : part[i_ + 4]; q4_[i_] = keep_ + __builtin_amdgcn_update_dpp(0, send_, 0x4E, 0xF, 0xF, false); } } \
        int o0_, o1_; { const bool hi_ = (lane & 1) != 0; { const int keep_ = hi_ ? q4_[2] : q4_[0], send_ = hi_ ? q4_[0] : q4_[2]; o0_ = keep_ + __builtin_amdgcn_update_dpp(0, send_, 0xB1, 0xF, 0xF, false); } \
            { const int keep_ = hi_ ? q4_[3] : q4_[1], send_ = hi_ ? q4_[1] : q4_[3]; o1_ = keep_ + __builtin_amdgcn_update_dpp(0, send_, 0xB1, 0xF, 0xF, false); } } \
        *(unsigned*)(PA + ((size_t)j * M + (t)) * 128 + eoff + 2 * p) = (unsigned)(((o0_ + 2) >> 2) & 0xffff) | ((unsigned)((o1_ + 2) >> 2) << 16); } while (0)
#define U4_TOK(u_) ((size_t)first + (size_t)((u_) < ntok ? (u_) : ntok - 1) * stride)
#define U4_E(ev, u_) do { ev = *(const v4u*)(E + U4_TOK(u_) * 128 + eoff); } while (0)
#define U4_H(hh, hl, u_) do { const size_t t_ = U4_TOK(u_); hh = *(const v4u*)(HQh + t_ * 512 + 64 * j + poff); hl = *(const v4u*)(HQl + t_ * 512 + 64 * j + poff); } while (0)
        { v4u e0, e1, e2; U4_E(e0, 0); U4_E(e1, 1); U4_E(e2, 2); U4_E(eA, 3);
          U4_H(hh0, hl0, 0); U4_ROWS(R0, e0); U4_H(hh1, hl1, 1); U4_ROWS(R1, e1); U4_H(hh2, hl2, 2); U4_ROWS(R2, e2); }
        for (int u = 0; u < ntok; u += 4) {
            U4_E(eB, u + 4); U4_H(hh3, hl3, u + 3); U4_ROWS(R3, eA); U4_COMPUTE(R0, hh0, hl0, U4_TOK(u));
            if (u + 1 >= ntok) break;
            U4_E(eA, u + 5); U4_H(hh0, hl0, u + 4); U4_ROWS(R0, eB); U4_COMPUTE(R1, hh1, hl1, U4_TOK(u + 1));
            if (u + 2 >= ntok) break;
            U4_E(eB, u + 6); U4_H(hh1, hl1, u + 5); U4_ROWS(R1, eA); U4_COMPUTE(R2, hh2, hl2, U4_TOK(u + 2));
            if (u + 3 >= ntok) break;
            U4_E(eA, u + 7); U4_H(hh2, hl2, u + 6); U4_ROWS(R2, eB); U4_COMPUTE(R3, hh3, hl3, U4_TOK(u + 3));
        }
#undef U4_TOK
#undef U4_E
#undef U4_H
#undef U4_ROWS
#undef U4_COMPUTE
    }
}
typedef long i64_t;
typedef int v2i_t __attribute__((ext_vector_type(2)));
__device__ __forceinline__ i64_t ds_tr8(const LAS unsigned char* p) { const v2i_t r = __builtin_amdgcn_ds_read_tr8_b64_v2i32((LAS v2i_t*)p); return (i64_t)(unsigned)r.x | ((i64_t)(unsigned)r.y << 32); }
__device__ __forceinline__ void vpass_mfma(const Args& a, LAS unsigned char* lds, int wave, int lane_in) {
    int lane = lane_in; asm volatile("" : "+v"(lane));
    const int G = gridDim.x, bx = blockIdx.x;
    const bool sliced = (G % 8) == 0;
    const int nj = sliced ? 1 : 8, j0 = sliced ? (bx & 7) : 0;
    const int first = sliced ? ((bx >> 3) * NWAVES + wave) : (bx * NWAVES + wave), stride = sliced ? (G >> 3) * NWAVES : G * NWAVES;
    const int r = lane >> 2, p4 = lane & 3, n16 = lane & 15, qp = lane >> 4;
    const unsigned short* E = (const unsigned short*)(a.ws + WS_E); const unsigned char* W8 = a.ws + WS_W; const float* MOD = (const float*)(a.ws + WS_MOD);
    LAS unsigned char* slot = lds + wave * 16384;
    const int ntok = (M - first + stride - 1) / stride;
    const int eoff = (r >> 1) * 16 + 8 * (r & 1);
    const int wbase = (8 * r) * 128, hk = (r >> 2) & 1;
    const int rkey = (n16 >> 1) ^ (qp & 1), rbase = (32 * qp + (n16 >> 1)) * 128 + 8 * (n16 & 1);
    const bool even = (n16 & 1) == 0; const int ccol = 32 * qp + (even ? n16 : 15 + n16);
    for (int jj = 0; jj < nj; ++jj) { const int j = j0 + jj;
        const unsigned char* tb = a.ws + WS_VB + (size_t)j * (16384 * 128);
        const unsigned poff = 32u * p4;
        v4u RA[16], RB[16], wA, wB, en, en2;
#define VM_ROWS(R, ev) do { const unsigned w_[4] = {ev.x, ev.y, ev.z, ev.w}; _Pragma("unroll") for (int c_ = 0; c_ < 4; ++c_) { \
            const unsigned char* r0_ = tb + ((w_[c_] & 0xffffu) * 128u + poff); const unsigned char* r1_ = tb + ((w_[c_] >> 16) * 128u + poff); \
            R[4 * c_] = *(const v4u*)r0_; R[4 * c_ + 1] = *(const v4u*)(r0_ + 16); R[4 * c_ + 2] = *(const v4u*)r1_; R[4 * c_ + 3] = *(const v4u*)(r1_ + 16); } } while (0)
#define VM_W(wv, t) do { wv = *(const v4u*)(W8 + (size_t)(t) * 128 + 32 * qp + 16 * (n16 & 1)); } while (0)
#define VM_COMPUTE(R, wv, t) do { \
        _Pragma("unroll") for (int i_ = 0; i_ < 8; ++i_) { const int k_ = (i_ & 7) ^ hk; *(LAS v4u*)(slot + wbase + i_ * 128 + 16 * ((2 * p4) ^ k_)) = R[2 * i_]; *(LAS v4u*)(slot + wbase + i_ * 128 + 16 * ((2 * p4 + 1) ^ k_)) = R[2 * i_ + 1]; } \
        unsigned wq_[8]; { const unsigned o0_ = (unsigned)__builtin_amdgcn_update_dpp(0, (int)wv.x, 0xB1, 0xF, 0xF, false), o1_ = (unsigned)__builtin_amdgcn_update_dpp(0, (int)wv.y, 0xB1, 0xF, 0xF, false), \
              o2_ = (unsigned)__builtin_amdgcn_update_dpp(0, (int)wv.z, 0xB1, 0xF, 0xF, false), o3_ = (unsigned)__builtin_amdgcn_update_dpp(0, (int)wv.w, 0xB1, 0xF, 0xF, false); \
          wq_[0] = even ? wv.x : o0_; wq_[1] = even ? wv.y : o1_; wq_[2] = even ? wv.z : o2_; wq_[3] = even ? wv.w : o3_; wq_[4] = even ? o0_ : wv.x; wq_[5] = even ? o1_ : wv.y; wq_[6] = even ? o2_ : wv.z; wq_[7] = even ? o3_ : wv.w; } \
        f32x4 acc_[8]; _Pragma("unroll") for (int nt_ = 0; nt_ < 8; ++nt_) acc_[nt_] = (f32x4){0.f, 0.f, 0.f, 0.f}; \
        _Pragma("unroll") for (int ks_ = 0; ks_ < 4; ++ks_) { const i64_t aw_ = (i64_t)wq_[2 * ks_] | ((i64_t)wq_[2 * ks_ + 1] << 32); \
            _Pragma("unroll") for (int nt_ = 0; nt_ < 8; ++nt_) { const i64_t bv_ = ds_tr8(slot + rbase + ks_ * 1024 + 16 * (nt_ ^ rkey)); acc_[nt_] = __builtin_amdgcn_mfma_f32_16x16x32_fp8_fp8(aw_, bv_, acc_[nt_], 0, 0, 0); } } \
        const float e01_ = (qp & 1) ? acc_[2][0] : acc_[0][0], e23_ = (qp & 1) ? acc_[6][0] : acc_[4][0], o01_ = (qp & 1) ? acc_[3][0] : acc_[1][0], o23_ = (qp & 1) ? acc_[7][0] : acc_[5][0]; \
        const float se_ = (qp & 2) ? e23_ : e01_, so_ = (qp & 2) ? o23_ : o01_; \
        const float mine_ = even ? se_ : so_, send_ = even ? so_ : se_; \
        const float recv_ = __builtin_bit_cast(float, __builtin_amdgcn_update_dpp(0, __builtin_bit_cast(int, send_), 0xB1, 0xF, 0xF, false)); \
        const float lo_ = even ? mine_ : recv_, hi_ = even ? recv_ : mine_; \
        bf16* xo_ = (bf16*)(a.ws + WS_X1B) + (size_t)(t) * 1024 + 128 * j + ccol; const float* gt_ = MOD + ((size_t)(t) >> 13) * NMODC + 5120 + 128 * j + ccol; \
        const unsigned xb_ = *(const unsigned*)xo_; const f32x2_t g_ = *(const f32x2_t*)gt_; \
        *(unsigned*)xo_ = pk2(bflo(xb_) + g_.x * lo_ * (1.0f / 4096.0f), bfhi(xb_) + g_.y * hi_ * (1.0f / 4096.0f)); } while (0)
#define VM_TOK(u_) ((size_t)first + (size_t)((u_) < ntok ? (u_) : ntok - 1) * stride)
        { v4u e0 = *(const v4u*)(E + VM_TOK(0) * 128 + eoff); VM_ROWS(RA, e0); VM_W(wA, VM_TOK(0)); en = *(const v4u*)(E + VM_TOK(1) * 128 + eoff); }
        for (int u = 0; u < ntok; u += 2) {
            { en2 = *(const v4u*)(E + VM_TOK(u + 2) * 128 + eoff); VM_W(wB, VM_TOK(u + 1)); VM_ROWS(RB, en); VM_COMPUTE(RA, wA, VM_TOK(u)); }
            if (u + 1 >= ntok) break;
            { en = *(const v4u*)(E + VM_TOK(u + 3) * 128 + eoff); VM_W(wA, VM_TOK(u + 2)); VM_ROWS(RA, en2); VM_COMPUTE(RB, wB, VM_TOK(u + 1)); }
        }
#undef VM_ROWS
#undef VM_COMPUTE
#undef VM_W
#undef VM_TOK
    }
}
typedef int v8i_t __attribute__((ext_vector_type(8)));
__device__ __forceinline__ v2i_t ds_tr4(const LAS unsigned char* p) { return __builtin_amdgcn_ds_read_tr4_b64_v2i32((LAS v2i_t*)p); }
__device__ __forceinline__ void vpass_mfma4(const Args& a, LAS unsigned char* lds, int wave, int lane_in) {
    int lane = lane_in; asm volatile("" : "+v"(lane));
    const int G = gridDim.x, bx = blockIdx.x;
    const bool sliced = (G % 8) == 0;
    const int nj = sliced ? 1 : 8, j0 = sliced ? (bx & 7) : 0;
    const int first = sliced ? ((bx >> 3) * NWAVES + wave) : (bx * NWAVES + wave), stride = sliced ? (G >> 3) * NWAVES : G * NWAVES;
    const int r = lane >> 2, p4 = lane & 3, n16 = lane & 15, qp = lane >> 4;
    const unsigned short* E = (const unsigned short*)(a.ws + WS_E); const unsigned char* W8 = a.ws + WS_W; const float* MOD = (const float*)(a.ws + WS_MOD);
    LAS unsigned char* slot = lds + wave * 8192;
    const int ntok = (M - first + stride - 1) / stride;
    const int eoff = 8 * r;
    const int wbase = (8 * r) * 64;
    const int rkey = (n16 >> 2) & 3, rbase = (32 * qp + n16) * 64;
    const bool even = (n16 & 1) == 0; const int ccol = 32 * qp + (even ? n16 : 15 + n16);
    for (int jj = 0; jj < nj; ++jj) { const int j = j0 + jj;
        const unsigned char* tb = a.ws + WS_VB + (size_t)j * (16384 * 64);
        const unsigned poff = 16u * p4;
        v4u R0[8], R1[8], R2[8], R3[8], w0, w1, w2, w3, eA, eB;
#define V4_ROWS(R, ev) do { const unsigned w_[4] = {ev.x, ev.y, ev.z, ev.w}; _Pragma("unroll") for (int c_ = 0; c_ < 4; ++c_) { R[2 * c_] = *(const v4u*)(tb + ((w_[c_] & 0xffffu) * 64u + poff)); R[2 * c_ + 1] = *(const v4u*)(tb + ((w_[c_] >> 16) * 64u + poff)); } } while (0)
#define V4_TOK(u_) ((size_t)first + (size_t)((u_) < ntok ? (u_) : ntok - 1) * stride)
#define V4_E(ev, u_) do { ev = *(const v4u*)(E + V4_TOK(u_) * 128 + eoff); } while (0)
#define V4_W(wv, u_) do { wv = *(const v4u*)(W8 + V4_TOK(u_) * 128 + 16 * qp + 64 * (n16 & 1)); } while (0)
#define V4_COMPUTE(R, wv, t) do { \
        _Pragma("unroll") for (int i_ = 0; i_ < 8; ++i_) *(LAS v4u*)(slot + wbase + i_ * 64 + 16 * (p4 ^ ((2 * r + (i_ >> 2)) & 3))) = R[i_]; \
        v8i_t aw_; { const int o0_ = __builtin_amdgcn_update_dpp(0, (int)wv.x, 0xB1, 0xF, 0xF, false), o1_ = __builtin_amdgcn_update_dpp(0, (int)wv.y, 0xB1, 0xF, 0xF, false), \
              o2_ = __builtin_amdgcn_update_dpp(0, (int)wv.z, 0xB1, 0xF, 0xF, false), o3_ = __builtin_amdgcn_update_dpp(0, (int)wv.w, 0xB1, 0xF, 0xF, false); \
          aw_[0] = even ? (int)wv.x : o0_; aw_[1] = even ? (int)wv.y : o1_; aw_[2] = even ? (int)wv.z : o2_; aw_[3] = even ? (int)wv.w : o3_; \
          aw_[4] = even ? o0_ : (int)wv.x; aw_[5] = even ? o1_ : (int)wv.y; aw_[6] = even ? o2_ : (int)wv.z; aw_[7] = even ? o3_ : (int)wv.w; } \
        f32x4 acc_[8]; \
        _Pragma("unroll") for (int nt_ = 0; nt_ < 8; ++nt_) { const LAS unsigned char* rp_ = slot + rbase + 16 * ((nt_ >> 1) ^ rkey) + 8 * (nt_ & 1); \
            const v2i_t b0_ = ds_tr4(rp_), b1_ = ds_tr4(rp_ + 16 * 64); const v8i_t bv_ = {b0_.x, b0_.y, b1_.x, b1_.y, 0, 0, 0, 0}; \
            acc_[nt_] = __builtin_amdgcn_mfma_scale_f32_16x16x128_f8f6f4(aw_, bv_, (f32x4){0.f, 0.f, 0.f, 0.f}, 0, 4, 0, 0, 0, 0); } \
        const float e01_ = (qp & 1) ? acc_[2][0] : acc_[0][0], e23_ = (qp & 1) ? acc_[6][0] : acc_[4][0], o01_ = (qp & 1) ? acc_[3][0] : acc_[1][0], o23_ = (qp & 1) ? acc_[7][0] : acc_[5][0]; \
        const float se_ = (qp & 2) ? e23_ : e01_, so_ = (qp & 2) ? o23_ : o01_; \
        const float mine_ = even ? se_ : so_, send_ = even ? so_ : se_; \
        const float recv_ = __builtin_bit_cast(float, __builtin_amdgcn_update_dpp(0, __builtin_bit_cast(int, send_), 0xB1, 0xF, 0xF, false)); \
        const float lo_ = even ? mine_ : recv_, hi_ = even ? recv_ : mine_; \
        bf16* xo_ = (bf16*)(a.ws + WS_X1B) + (size_t)(t) * 1024 + 128 * j + ccol; const float* gt_ = MOD + ((size_t)(t) >> 13) * NMODC + 5120 + 128 * j + ccol; \
        const unsigned xb_ = *(const unsigned*)xo_; const f32x2_t g_ = *(const f32x2_t*)gt_; \
        *(unsigned*)xo_ = pk2(bflo(xb_) + g_.x * lo_ * (1.0f / 256.0f), bfhi(xb_) + g_.y * hi_ * (1.0f / 256.0f)); } while (0)
        { v4u e0, e1, e2; V4_E(e0, 0); V4_E(e1, 1); V4_E(e2, 2); V4_E(eA, 3);
          V4_W(w0, 0); V4_ROWS(R0, e0); V4_W(w1, 1); V4_ROWS(R1, e1); V4_W(w2, 2); V4_ROWS(R2, e2); }
        for (int u = 0; u < ntok; u += 4) {
            V4_E(eB, u + 4); V4_W(w3, u + 3); V4_ROWS(R3, eA); V4_COMPUTE(R0, w0, V4_TOK(u));
            if (u + 1 >= ntok) break;
            V4_E(eA, u + 5); V4_W(w0, u + 4); V4_ROWS(R0, eB); V4_COMPUTE(R1, w1, V4_TOK(u + 1));
            if (u + 2 >= ntok) break;
            V4_E(eB, u + 6); V4_W(w1, u + 5); V4_ROWS(R1, eA); V4_COMPUTE(R2, w2, V4_TOK(u + 2));
            if (u + 3 >= ntok) break;
            V4_E(eA, u + 7); V4_W(w2, u + 6); V4_ROWS(R2, eB); V4_COMPUTE(R3, w3, V4_TOK(u + 3));
        }
#undef V4_ROWS
#undef V4_TOK
#undef V4_E
#undef V4_W
#undef V4_COMPUTE
    }
}
__device__ __forceinline__ void vpass_wide(const Args& a, LAS unsigned char* lds, int wave, int lane_in, size_t xdst_off = WS_X1B) {
    int lane = lane_in; asm volatile("" : "+v"(lane));
    const int G = gridDim.x, bx = blockIdx.x;
    const bool sliced = (G % 8) == 0;
    const int nj = sliced ? 1 : 4, j0 = sliced ? ((bx & 7) >> 1) : 0;
    const int tmul = sliced ? 2 : 1, tadd = sliced ? (bx & 1) : 0;
    const int first = sliced ? ((bx >> 3) * NWAVES + wave) : (bx * NWAVES + wave), stride = sliced ? (G >> 3) * NWAVES : G * NWAVES;
    const int ntok = ((sliced ? M / 2 : M) - first + stride - 1) / stride;
    const int r8 = lane >> 3, p8 = lane & 7, n16 = lane & 15, qp = lane >> 4;
    const unsigned short* E = (const unsigned short*)(a.ws + WS_E); const unsigned char* W8 = a.ws + WS_W; const float* MOD = (const float*)(a.ws + WS_MOD);
    LAS unsigned char* slot = lds + wave * 16384;
    const int eoff = 16 * r8;
    const int wbase = (16 * r8) * 128;
    const int rkey = (n16 >> 1) & 7, rbase = (32 * qp + n16) * 128;
    const bool even = (n16 & 1) == 0;
    const int ccol0 = 16 * (4 * qp + (even ? 0 : 1)) + (even ? n16 : n16 - 1), ccol1 = ccol0 + 32;
    for (int jj = 0; jj < nj; ++jj) { const int j = j0 + jj;
        const unsigned char* tb = a.ws + WS_VB + (size_t)j * (16384 * 128);
        const unsigned poff = 16u * p8;
        v4u RA[16], RB[16], wA, wB, en, en2, fn, fn2; unsigned xA0, xA1, xB0, xB1; f32x2_t gA0, gA1, gB0, gB1;
#define VW_TOK(u_) ((size_t)tmul * ((size_t)first + (size_t)((u_) < ntok ? (u_) : ntok - 1) * stride) + tadd)
#define VW_ROWS(R, ev, fv) do { const unsigned w_[8] = {ev.x, ev.y, ev.z, ev.w, fv.x, fv.y, fv.z, fv.w}; _Pragma("unroll") for (int c_ = 0; c_ < 8; ++c_) { \
            R[2 * c_] = *(const v4u*)(tb + ((w_[c_] & 0xffffu) * 128u + poff)); R[2 * c_ + 1] = *(const v4u*)(tb + ((w_[c_] >> 16) * 128u + poff)); } } while (0)
#define VW_W(wv, u_) do { wv = *(const v4u*)(W8 + VW_TOK(u_) * 128 + 16 * qp + 64 * (n16 & 1)); } while (0)
#define VW_X(x0v, x1v, g0v, g1v, u_) do { const size_t t_ = VW_TOK(u_); const bf16* xi_ = (const bf16*)(a.ws + WS_X1B) + t_ * 1024 + 256 * j; const float* gt_ = MOD + (t_ >> 13) * NMODC + 5120 + 256 * j; \
        x0v = *(const unsigned*)(xi_ + ccol0); x1v = *(const unsigned*)(xi_ + ccol1); g0v = *(const f32x2_t*)(gt_ + ccol0); g1v = *(const f32x2_t*)(gt_ + ccol1); } while (0)
#define VW_COMPUTE(R, wv, xa_, xb_, ga_, gb_, t) do { \
        _Pragma("unroll") for (int i_ = 0; i_ < 16; ++i_) { *(LAS v4u*)(slot + wbase + i_ * 128 + 16 * (p8 ^ ((i_ >> 1) & 7))) = R[i_]; } \
        v8i_t aw_; { const int o0_ = __builtin_amdgcn_update_dpp(0, (int)wv.x, 0xB1, 0xF, 0xF, false), o1_ = __builtin_amdgcn_update_dpp(0, (int)wv.y, 0xB1, 0xF, 0xF, false), \
              o2_ = __builtin_amdgcn_update_dpp(0, (int)wv.z, 0xB1, 0xF, 0xF, false), o3_ = __builtin_amdgcn_update_dpp(0, (int)wv.w, 0xB1, 0xF, 0xF, false); \
          aw_[0] = even ? (int)wv.x : o0_; aw_[1] = even ? (int)wv.y : o1_; aw_[2] = even ? (int)wv.z : o2_; aw_[3] = even ? (int)wv.w : o3_; \
          aw_[4] = even ? o0_ : (int)wv.x; aw_[5] = even ? o1_ : (int)wv.y; aw_[6] = even ? o2_ : (int)wv.z; aw_[7] = even ? o3_ : (int)wv.w; } \
        float tv_[16]; \
        _Pragma("unroll") for (int nt_ = 0; nt_ < 16; ++nt_) { const LAS unsigned char* rp_ = slot + rbase + 16 * ((nt_ >> 1) ^ rkey) + 8 * (nt_ & 1); \
            const v2i_t b0_ = ds_tr4(rp_), b1_ = ds_tr4(rp_ + 16 * 128); const v8i_t bv_ = {b0_.x, b0_.y, b1_.x, b1_.y, 0, 0, 0, 0}; \
            const f32x4 c_ = __builtin_amdgcn_mfma_scale_f32_16x16x128_f8f6f4(aw_, bv_, (f32x4){0.f, 0.f, 0.f, 0.f}, 0, 4, 0, 0, 0, 0); tv_[nt_] = c_[0]; } \
          \
        float t0_ = (qp & 1) ? tv_[4] : tv_[0], t1_ = (qp & 1) ? tv_[5] : tv_[1], t2_ = (qp & 1) ? tv_[6] : tv_[2], t3_ = (qp & 1) ? tv_[7] : tv_[3]; \
        { const float u0_ = (qp & 1) ? tv_[12] : tv_[8], u1_ = (qp & 1) ? tv_[13] : tv_[9], u2_ = (qp & 1) ? tv_[14] : tv_[10], u3_ = (qp & 1) ? tv_[15] : tv_[11]; \
          t0_ = (qp & 2) ? u0_ : t0_; t1_ = (qp & 2) ? u1_ : t1_; t2_ = (qp & 2) ? u2_ : t2_; t3_ = (qp & 2) ? u3_ : t3_; } \
          \
        const float mA_ = even ? t0_ : t1_, mB_ = even ? t2_ : t3_, sA_ = even ? t1_ : t0_, sB_ = even ? t3_ : t2_; \
        const float rA_ = __builtin_bit_cast(float, __builtin_amdgcn_update_dpp(0, __builtin_bit_cast(int, sA_), 0xB1, 0xF, 0xF, false)); \
        const float rB_ = __builtin_bit_cast(float, __builtin_amdgcn_update_dpp(0, __builtin_bit_cast(int, sB_), 0xB1, 0xF, 0xF, false)); \
        const float loA_ = even ? mA_ : rA_, hiA_ = even ? rA_ : mA_, loB_ = even ? mB_ : rB_, hiB_ = even ? rB_ : mB_; \
        bf16* xo_ = (bf16*)(a.ws + xdst_off) + (size_t)(t) * 1024 + 256 * j; \
        *(unsigned*)(xo_ + ccol0) = pk2(bflo(xa_) + ga_.x * loA_ * (1.0f / 256.0f), bfhi(xa_) + ga_.y * hiA_ * (1.0f / 256.0f)); \
        *(unsigned*)(xo_ + ccol1) = pk2(bflo(xb_) + gb_.x * loB_ * (1.0f / 256.0f), bfhi(xb_) + gb_.y * hiB_ * (1.0f / 256.0f)); } while (0)
        { const v4u e0 = *(const v4u*)(E + VW_TOK(0) * 128 + eoff), f0 = *(const v4u*)(E + VW_TOK(0) * 128 + eoff + 8); VW_W(wA, 0); VW_X(xA0, xA1, gA0, gA1, 0); VW_ROWS(RA, e0, f0); en = *(const v4u*)(E + VW_TOK(1) * 128 + eoff); fn = *(const v4u*)(E + VW_TOK(1) * 128 + eoff + 8); }
        for (int u = 0; u < ntok; u += 2) {
            { en2 = *(const v4u*)(E + VW_TOK(u + 2) * 128 + eoff); fn2 = *(const v4u*)(E + VW_TOK(u + 2) * 128 + eoff + 8); VW_W(wB, u + 1); VW_X(xB0, xB1, gB0, gB1, u + 1); VW_ROWS(RB, en, fn); VW_COMPUTE(RA, wA, xA0, xA1, gA0, gA1, VW_TOK(u)); }
            if (u + 1 >= ntok) break;
            { en = *(const v4u*)(E + VW_TOK(u + 3) * 128 + eoff); fn = *(const v4u*)(E + VW_TOK(u + 3) * 128 + eoff + 8); VW_W(wA, u + 2); VW_X(xA0, xA1, gA0, gA1, u + 2); VW_ROWS(RA, en2, fn2); VW_COMPUTE(RB, wB, xB0, xB1, gB0, gB1, VW_TOK(u + 1)); }
        }
#undef VW_TOK
#undef VW_ROWS
#undef VW_W
#undef VW_X
#undef VW_COMPUTE
    }
}
__device__ __forceinline__ void upass_wide(const Args& a, LAS unsigned char* lds, int wave, int lane_in) {
    int lane = lane_in; asm volatile("" : "+v"(lane));
    const int G = gridDim.x, bx = blockIdx.x;
    const bool sliced = (G % 8) == 0;
    const int nj = sliced ? 1 : 4, j0 = sliced ? ((bx & 7) >> 1) : 0;
    const int tmul = sliced ? 2 : 1, tadd = sliced ? (bx & 1) : 0;
    const int first = sliced ? ((bx >> 3) * NWAVES + wave) : (bx * NWAVES + wave), stride = sliced ? (G >> 3) * NWAVES : G * NWAVES;
    const int ntok = ((sliced ? M / 2 : M) - first + stride - 1) / stride;
    const int r8 = lane >> 3, p8 = lane & 7, n16 = lane & 15, qp = lane >> 4;
    const unsigned short* E = (const unsigned short*)(a.ws + WS_E); const unsigned char* H8 = a.ws + WS_H2Q; bf16* PA = (bf16*)(a.ws + WS_PA);
    LAS unsigned char* slot = lds + wave * 16384;
    const int eoff = 16 * r8, wbase = (16 * r8) * 128;
    const int akey = (n16 >> 1) & 7, abase = n16 * 128;
    const bool even = (n16 & 1) == 0;
    for (int jj = 0; jj < nj; ++jj) { const int j = j0 + jj;
        const unsigned char* tb = a.ws + WS_UB + (size_t)j * (16384 * 128);
        const unsigned poff = 16u * p8;
        v4u RA[16], RB[16], haA, hbA, haB, hbB, en, en2, fn, fn2;
#define UW_TOK(u_) ((size_t)tmul * ((size_t)first + (size_t)((u_) < ntok ? (u_) : ntok - 1) * stride) + tadd)
#define UW_ROWS(R, ev, fv) do { const unsigned w_[8] = {ev.x, ev.y, ev.z, ev.w, fv.x, fv.y, fv.z, fv.w}; _Pragma("unroll") for (int c_ = 0; c_ < 8; ++c_) { \
            R[2 * c_] = *(const v4u*)(tb + ((w_[c_] & 0xffffu) * 128u + poff)); R[2 * c_ + 1] = *(const v4u*)(tb + ((w_[c_] >> 16) * 128u + poff)); } } while (0)
#define UW_H(ha, hb, u_) do { const unsigned char* hp_ = H8 + UW_TOK(u_) * 1024 + 256 * j + 16 * qp + 128 * (n16 & 1); ha = *(const v4u*)hp_; hb = *(const v4u*)(hp_ + 64); } while (0)
#define UW_COMPUTE(R, ha, hb, t) do { \
        _Pragma("unroll") for (int i_ = 0; i_ < 16; ++i_) { *(LAS v4u*)(slot + wbase + i_ * 128 + 16 * (p8 ^ ((i_ >> 1) & 7))) = R[i_]; } \
        v8i_t bh0_, bh1_; { const int mine_[8] = {(int)ha.x, (int)ha.y, (int)ha.z, (int)ha.w, (int)hb.x, (int)hb.y, (int)hb.z, (int)hb.w}; \
          _Pragma("unroll") for (int d_ = 0; d_ < 8; ++d_) { const int o_ = __builtin_amdgcn_update_dpp(0, mine_[d_], 0xB1, 0xF, 0xF, false); bh0_[d_] = even ? mine_[d_] : o_; bh1_[d_] = even ? o_ : mine_[d_]; } } \
        f32x4 acc_[8]; \
        _Pragma("unroll") for (int mb_ = 0; mb_ < 8; ++mb_) { \
            const v4u a0_ = *(const LAS v4u*)(slot + mb_ * 2048 + abase + 16 * (qp ^ akey)), a1_ = *(const LAS v4u*)(slot + mb_ * 2048 + abase + 16 * ((4 + qp) ^ akey)); \
            const v8i_t av0_ = {(int)a0_.x, (int)a0_.y, (int)a0_.z, (int)a0_.w, 0, 0, 0, 0}, av1_ = {(int)a1_.x, (int)a1_.y, (int)a1_.z, (int)a1_.w, 0, 0, 0, 0}; \
            f32x4 c_ = __builtin_amdgcn_mfma_scale_f32_16x16x128_f8f6f4(av0_, bh0_, (f32x4){0.f, 0.f, 0.f, 0.f}, 4, 0, 0, 0, 0, 0); \
            acc_[mb_] = __builtin_amdgcn_mfma_scale_f32_16x16x128_f8f6f4(av1_, bh1_, c_, 4, 0, 0, 0, 0, 0); } \
        const f32x4 s01_ = (n16 & 1) ? acc_[1] : acc_[0], s23_ = (n16 & 1) ? acc_[3] : acc_[2], s45_ = (n16 & 1) ? acc_[5] : acc_[4], s67_ = (n16 & 1) ? acc_[7] : acc_[6]; \
        const f32x4 s03_ = (n16 & 2) ? s23_ : s01_, s47_ = (n16 & 2) ? s67_ : s45_; const f32x4 sel_ = (n16 & 4) ? s47_ : s03_; \
        if (n16 < 8) *(v2u*)(PA + ((size_t)j * M + (t)) * 128 + n16 * 16 + 4 * qp) = (v2u){pg8::cvt_pk_bf16(sel_[0], sel_[1]), pg8::cvt_pk_bf16(sel_[2], sel_[3])}; } while (0)
        { const v4u e0 = *(const v4u*)(E + UW_TOK(0) * 128 + eoff), f0 = *(const v4u*)(E + UW_TOK(0) * 128 + eoff + 8); UW_ROWS(RA, e0, f0); UW_H(haA, hbA, 0); en = *(const v4u*)(E + UW_TOK(1) * 128 + eoff); fn = *(const v4u*)(E + UW_TOK(1) * 128 + eoff + 8); }
        for (int u = 0; u < ntok; u += 2) {
            { en2 = *(const v4u*)(E + UW_TOK(u + 2) * 128 + eoff); fn2 = *(const v4u*)(E + UW_TOK(u + 2) * 128 + eoff + 8); UW_H(haB, hbB, u + 1); UW_ROWS(RB, en, fn); UW_COMPUTE(RA, haA, hbA, UW_TOK(u)); }
            if (u + 1 >= ntok) break;
            { en = *(const v4u*)(E + UW_TOK(u + 3) * 128 + eoff); fn = *(const v4u*)(E + UW_TOK(u + 3) * 128 + eoff + 8); UW_H(haA, hbA, u + 2); UW_ROWS(RA, en2, fn2); UW_COMPUTE(RB, haB, hbB, UW_TOK(u + 1)); }
        }
#undef UW_TOK
#undef UW_ROWS
#undef UW_H
#undef UW_COMPUTE
    }
}
__device__ __forceinline__ void peer_reduce(const Args& a, LAS unsigned char* lds, int tid) {
    const unsigned short* E = (const unsigned short*)(a.ws + WS_E); const float* Gt = (const float*)(a.ws + WS_G); unsigned char* W = a.ws + WS_W; const bf16* PA = (const bf16*)(a.ws + WS_PA);
    const float* SU = (const float*)(a.ws + WS_SU); const float* SV = (const float*)(a.ws + WS_SV); const float* SH = (const float*)(a.ws + WS_SH);
    __syncthreads();
    for (int i = tid; i < 16384 / 4; i += 512) { const f32x4 u4 = *(const f32x4*)(SU + 4 * i), v4 = *(const f32x4*)(SV + 4 * i);
        *(LAS f32x4*)(lds + 32 * i) = (f32x4){u4.x, v4.x, u4.y, v4.y}; *(LAS f32x4*)(lds + 32 * i + 16) = (f32x4){u4.z, v4.z, u4.w, v4.w}; }
    __syncthreads();
    const size_t n4 = (size_t)M * 128 / 4, gth = (size_t)gridDim.x * 512;
    for (size_t i = (size_t)blockIdx.x * 512 + tid; i < n4; i += gth) {
        f32x4 s = {0.f, 0.f, 0.f, 0.f};
#pragma unroll
        for (int j = 0; j < 4; ++j) { const v2u pq = __builtin_nontemporal_load((const v2u*)(PA + (size_t)j * M * 128 + i * 4)); s += (f32x4){bflo(pq.x), bfhi(pq.x), bflo(pq.y), bfhi(pq.y)}; }
        const float sh = SH[i >> 5];
        const v2u ep = *(const v2u*)(E + i * 4); const f32x4 g = *(const f32x4*)(Gt + i * 4); f32x4 w;
        const f2_t t0 = *(const LAS f2_t*)(lds + 8 * (ep.x & 0xffffu)), t1 = *(const LAS f2_t*)(lds + 8 * (ep.x >> 16)), t2 = *(const LAS f2_t*)(lds + 8 * (ep.y & 0xffffu)), t3 = *(const LAS f2_t*)(lds + 8 * (ep.y >> 16));
        w.x = g.x * gelu_t(s.x * sh * t0.x) * t0.y; w.y = g.y * gelu_t(s.y * sh * t1.x) * t1.y; w.z = g.z * gelu_t(s.z * sh * t2.x) * t2.y; w.w = g.w * gelu_t(s.w * sh * t3.x) * t3.y;
        { const f32x4 ws_ = w * 256.0f; int pk = 0;
          pk = __builtin_amdgcn_cvt_pk_fp8_f32(fminf(fmaxf(ws_.x, -440.f), 440.f), fminf(fmaxf(ws_.y, -440.f), 440.f), pk, false);
          pk = __builtin_amdgcn_cvt_pk_fp8_f32(fminf(fmaxf(ws_.z, -440.f), 440.f), fminf(fmaxf(ws_.w, -440.f), 440.f), pk, true);
          *(unsigned*)(W + i * 4) = (unsigned)pk; } }
}
__device__ __forceinline__ void final_norm(const Args& a, int wave, int lane) {
    const float* gf = a.in[I_GFIN]; const bf16* X2 = (const bf16*)(a.ws + WS_X1B);
    f32x4 g[4];
#pragma unroll
    for (int q = 0; q < 2; ++q) { g[2 * q] = *(const f32x4*)(gf + 512 * q + 8 * lane); g[2 * q + 1] = *(const f32x4*)(gf + 512 * q + 8 * lane + 4); }
    for (size_t row = (size_t)blockIdx.x * NWAVES + wave; row < (size_t)M; row += (size_t)gridDim.x * NWAVES) {
        f32x4 x[4]; float ss = 0.f;
#pragma unroll
        for (int q = 0; q < 2; ++q) { const v4u r = __builtin_nontemporal_load((const v4u*)(X2 + row * 1024 + 512 * q + 8 * lane)); x[2 * q] = (f32x4){bflo(r.x), bfhi(r.x), bflo(r.y), bfhi(r.y)}; x[2 * q + 1] = (f32x4){bflo(r.z), bfhi(r.z), bflo(r.w), bfhi(r.w)}; }
#pragma unroll
        for (int i = 0; i < 4; ++i) ss += (x[i].x * x[i].x + x[i].y * x[i].y) + (x[i].z * x[i].z + x[i].w * x[i].w);
        const float rstd = 1.0f / sqrtf(wave_sum(ss) * (1.0f / 1024.0f) + EPS);
#pragma unroll
        for (int q = 0; q < 2; ++q) { float* o = a.out + row * 1024 + 512 * q + 8 * lane; __builtin_nontemporal_store(x[2 * q] * rstd * g[2 * q], (f32x4*)(o)); __builtin_nontemporal_store(x[2 * q + 1] * rstd * g[2 * q + 1], (f32x4*)(o + 4)); } }
}
__device__ __forceinline__ void phase_topk(const Args& a, LAS unsigned char* lds, int wave, int lane) {
    const bf16* Q = (const bf16*)(a.ws + WS_ZG); const bf16* KEYS = (const bf16*)(a.ws + WS_KEYS);
    const int G = gridDim.x, gw = blockIdx.x * NWAVES + wave, NGW = G * NWAVES;
    for (int grp = gw; grp < M / 32; grp += NGW) peer_topk32(Q, KEYS, (unsigned short*)(a.ws + WS_E), (float*)(a.ws + WS_G), lds + wave * 4096, grp * 32, lane);
}
#define XB_TMO      128
#define XB_XCNT(j)  (256  + 64 * (j))
#define XB_XSUB(j)  (1280 + 64 * (j))
#define XB_XGEN(j)  (2304 + 64 * (j))
#define XB_TOP      3328
#define XB_TOPGEN   3392
#define XCD_BAR_WORDS 3456
#define XB_SPIN_CAP (1u << 18)

__device__ __forceinline__ unsigned xb_ld(unsigned* p)              { return __hip_atomic_load(p, __ATOMIC_RELAXED, __HIP_MEMORY_SCOPE_AGENT); }
__device__ __forceinline__ unsigned xb_add(unsigned* p, unsigned v) { return __hip_atomic_fetch_add(p, v, __ATOMIC_RELAXED, __HIP_MEMORY_SCOPE_AGENT); }
__device__ __forceinline__ unsigned xb_xcc_id() { return (unsigned)__builtin_amdgcn_s_getreg((3 << 11) | 20) & 0xFu; }
#define XB_SPIN(cond, bar) do { unsigned _sp = 0; while (cond) { __builtin_amdgcn_s_sleep(1); \
    if ((++_sp & 255u) == 0u) { if (xb_ld(&(bar)[XB_TMO])) break; if (_sp > XB_SPIN_CAP) { atomicAdd(&(bar)[XB_TMO], 1u); break; } } } } while (0)

struct XcdBarrier {
    unsigned* bar; unsigned x;
    volatile LAS unsigned* st;
};

__device__ __forceinline__ XcdBarrier xcd_barrier_post(unsigned* bar, volatile LAS unsigned* st) {
    XcdBarrier b; b.bar = bar; b.x = xb_xcc_id(); b.st = st;
    if (threadIdx.x == 0) (void)xb_add(&bar[XB_XCNT(b.x)], 1u);
    return b;
}
__device__ __forceinline__ void xcd_barrier_complete(unsigned* bar, unsigned x, unsigned& nloc, unsigned& nx) {
    const unsigned G = gridDim.x * gridDim.y * gridDim.z;
    unsigned sum, cnt, mine, sp = 0u;
    for (;;) {
        sum = 0u; cnt = 0u; mine = 0u;
#pragma unroll
        for (unsigned j = 0; j < 16; ++j) { const unsigned c = xb_ld(&bar[XB_XCNT(j)]); sum += c; cnt += (c > 0u) ? 1u : 0u; mine = (j == x) ? c : mine; }
        if (sum == G) break;
        __builtin_amdgcn_s_sleep(1);
        if ((++sp & 255u) == 0u) { if (xb_ld(&bar[XB_TMO])) break; if (sp > XB_SPIN_CAP) { atomicAdd(&bar[XB_TMO], 1u); break; } }
    }
    nloc = mine > 0u ? mine : 1u; nx = cnt > 0u ? cnt : 1u;
}

__device__ __forceinline__ void xcd_barrier(const XcdBarrier& b) {
    asm volatile("s_waitcnt vmcnt(0)" ::: "memory");
    __syncthreads();
    if (threadIdx.x == 0) {
        unsigned* bar = b.bar;
        __builtin_amdgcn_s_waitcnt(0);
        unsigned nloc = b.st[0], nx = b.st[1];
        if (nloc == 0u) { xcd_barrier_complete(bar, b.x, nloc, nx); b.st[0] = nloc; b.st[1] = nx; }
        const unsigned old = xb_add(&bar[XB_XSUB(b.x)], 1u);
        const unsigned gen = old / nloc;
        if (old + 1u == (gen + 1u) * nloc) {
            __builtin_amdgcn_fence(__ATOMIC_RELEASE, "agent");
            asm volatile("s_waitcnt vmcnt(0)" ::: "memory");
            const unsigned og = xb_add(&bar[XB_TOP], 1u);
            const unsigned tg = og / nx;
            if (og + 1u == (tg + 1u) * nx) xb_add(&bar[XB_TOPGEN], 1u);
            else XB_SPIN(xb_ld(&bar[XB_TOPGEN]) == tg, bar);
            __builtin_amdgcn_fence(__ATOMIC_ACQUIRE, "agent");
            xb_add(&bar[XB_XGEN(b.x)], 1u);
            asm volatile("s_waitcnt vmcnt(0)" ::: "memory");
        } else {
            XB_SPIN(xb_ld(&bar[XB_XGEN(b.x)]) == gen, bar);
            __builtin_amdgcn_fence(__ATOMIC_ACQUIRE, "agent");
            asm volatile("s_waitcnt vmcnt(0)" ::: "memory");
        }
    }
    __syncthreads();
}
constexpr int N_PHASES = 13;
__global__ void __launch_bounds__(NWAVES * 64, 2) hybrid_fwd(Args a) {
    extern __shared__ __attribute__((aligned(16))) unsigned char lds_raw[];
    LAS unsigned char* lds = (LAS unsigned char*)lds_raw;
    const int tid = threadIdx.x, lane = tid & 63, wave = __builtin_amdgcn_readfirstlane(tid >> 6);
    const int G = gridDim.x, bx = blockIdx.x;
    unsigned char* ws = a.ws;
    const float* MOD = (const float*)(ws + WS_MOD);
    const int lo = a.ph_lo, hi = a.ph_hi;
    if (tid < 16) ((LAS unsigned*)(lds + LDS_MISC_OFF))[tid] = 0u;
    __syncthreads();
    XcdBarrier xbar = xcd_barrier_post((unsigned*)(ws + WS_BAR), (volatile LAS unsigned*)(lds + LDS_MISC_OFF));
#ifndef REP_MASK
#define REP_MASK 0
#endif
#define IN(k) (lo <= (k) && (k) < hi)
#ifndef REPN
#define REPN 1
#endif
#define REPS(k) (1 + REPN * ((REP_MASK >> (k)) & 1))
#define SEAM(k) do { if (IN(k) && IN((k) + 1)) xcd_barrier(xbar); } while (0)
    if (hi > N_PHASES) cg::this_grid().sync();

    if (IN(0)) for (int rep_ = 0; rep_ < REPS(0); ++rep_) { phase_prologue(a, lds, tid, wave, lane); } SEAM(0);
    if (IN(1)) for (int rep_ = 0; rep_ < REPS(1); ++rep_) { phase_norm_mod(a.in[I_X], a.in[I_GMIX], MOD, 0, 1024, (bf16*)(ws + WS_H), wave, lane); } SEAM(1);
    if (IN(2)) for (int rep_ = 0; rep_ < REPS(2); ++rep_) { pg8::Gemm g{(const pg8::bf16_t*)(ws + WS_H), (const pg8::bf16_t*)(ws + WS_WIN), M, INW, DM}; pg8::StaticOrder S; S.init(M, INW, G, bx);
        pg8::EpiIn E{(pg8::bf16_t*)(ws + WS_ZG), (pg8::bf16_t*)(ws + WS_ZS)};
        pg8::gemm_phase<pg8::EpiIn, pg8::StaticOrder, true, true>(lds, g, S, E); } SEAM(2);
    if (IN(3)) for (int rep_ = 0; rep_ < REPS(3); ++rep_) { for (int it = bx; it < 256; it += G) s5_item(a, lds, it, wave, lane);
        for (int it = bx; it < 512; it += G) sgu_item(a, lds, it, wave, lane); } SEAM(3);
    if (IN(4)) for (int rep_ = 0; rep_ < REPS(4); ++rep_) { pg8::Gemm g{(const pg8::bf16_t*)(ws + WS_YS), (const pg8::bf16_t*)(ws + WS_WGLU), M, 512, 512}; pg8::StaticOrder S; S.init(M, 512, G, bx);
        pg8::EpiGlu E{(const pg8::bf16_t*)(ws + WS_YS), a.in[I_BGLU], (pg8::bf16_t*)(ws + WS_Y)};
        pg8::gemm_phase<pg8::EpiGlu, pg8::StaticOrder, true, true>(lds, g, S, E); } SEAM(4);
    if (IN(5)) for (int rep_ = 0; rep_ < REPS(5); ++rep_) { pg8::Gemm g{(const pg8::bf16_t*)(ws + WS_Y), (const pg8::bf16_t*)(ws + WS_WOUT), M, DM, DM}; pg8::StaticOrder S; S.init(M, DM, G, bx);
        pg8::EpiOut E{a.in[I_X], MOD, (pg8::bf16_t*)(ws + WS_X1B)};
        pg8::gemm_phase<pg8::EpiOut, pg8::StaticOrder, true, true>(lds, g, S, E); } SEAM(5);
    if (IN(6)) for (int rep_ = 0; rep_ < REPS(6); ++rep_) { phase_norm_mod_bf((const bf16*)(ws + WS_X1B), a.in[I_GFFN], MOD, 3072, 4096, (bf16*)(ws + WS_H), ws + WS_H2Q, (float*)(ws + WS_SH), wave, lane); } SEAM(6);
    if (IN(7)) for (int rep_ = 0; rep_ < REPS(7); ++rep_) { pg8::Gemm g{(const pg8::bf16_t*)(ws + WS_H), (const pg8::bf16_t*)(ws + WS_WQ), M, DM, DM}; pg8::StaticOrder S; S.init(M, DM, G, bx);
        pg8::EpiPlain E{(pg8::bf16_t*)(ws + WS_ZG), 1024};
        pg8::gemm_phase<pg8::EpiPlain, pg8::StaticOrder, true, true>(lds, g, S, E); } SEAM(7);
    if (IN(8)) for (int rep_ = 0; rep_ < REPS(8); ++rep_) { phase_topk(a, lds, wave, lane); } SEAM(8);
    if (IN(9)) for (int rep_ = 0; rep_ < REPS(9); ++rep_) { upass_wide(a, lds, wave, lane); } SEAM(9);
    if (IN(10)) for (int rep_ = 0; rep_ < REPS(10); ++rep_) { peer_reduce(a, lds, tid); } SEAM(10);
    if (IN(11)) for (int rep_ = 0; rep_ < REPS(11); ++rep_) { vpass_wide(a, lds, wave, lane); } SEAM(11);
    if (IN(12)) for (int rep_ = 0; rep_ < REPS(12); ++rep_) { final_norm(a, wave, lane); }
#undef IN
#undef SEAM
}

extern "C" void kernel_launch(void* const* d_in, const int* in_sizes, int n_in, void* d_out, int out_size, void* d_ws, size_t ws_size, hipStream_t stream) {
    static int grid = 0;
    if (grid == 0) {
        if (n_in != 27 || in_sizes[0] != M * DM || out_size != M * DM || ws_size < WS_END) { fprintf(stderr, "kernel_launch: unexpected problem (n_in %d, in0 %d, out %d, ws %zu); nothing launched\n", n_in, n_in > 0 ? in_sizes[0] : -1, out_size, ws_size); grid = -1; return; }
        int dev = 0, cus = 0, per_cu = 0;
        if (hipGetDevice(&dev) != hipSuccess || hipDeviceGetAttribute(&cus, hipDeviceAttributeMultiprocessorCount, dev) != hipSuccess) { grid = -1; return; }
        if (hipFuncSetAttribute((const void*)hybrid_fwd, hipFuncAttributeMaxDynamicSharedMemorySize, LDS_BYTES) != hipSuccess) { fprintf(stderr, "kernel_launch: hipFuncSetAttribute failed\n"); grid = -1; return; }
        if (hipOccupancyMaxActiveBlocksPerMultiprocessor(&per_cu, (const void*)hybrid_fwd, NWAVES * 64, LDS_BYTES) != hipSuccess || per_cu < 1) { fprintf(stderr, "kernel_launch: occupancy query failed (%d)\n", per_cu); (void)hipGetLastError(); per_cu = 1; }
        grid = cus * 1;
        if (per_cu < 1) grid = -1;
    }
    if (grid < 0) return;
    if (hipMemsetAsync((char*)d_ws + WS_BAR, 0, 16384, stream) != hipSuccess) { fprintf(stderr, "kernel_launch: hipMemsetAsync failed\n"); return; }
    Args a{};
    for (int i = 0; i < 27; ++i) a.in[i] = (const float*)d_in[i];
    a.out = (float*)d_out; a.ws = (unsigned char*)d_ws;
#if N_LAUNCHES == 1
    a.ph_lo = 0; a.ph_hi = N_PHASES;
    void* args[] = {&a};
    hipError_t e = hipLaunchCooperativeKernel((const void*)hybrid_fwd, dim3(grid), dim3(NWAVES * 64), args, LDS_BYTES, stream);
    if (e != hipSuccess) fprintf(stderr, "kernel_launch: cooperative launch failed: %s (grid %d)\n", hipGetErrorString(e), grid);
#else
    for (int p = 0; p < N_PHASES; ++p) { a.ph_lo = p; a.ph_hi = p + 1;
        hipLaunchKernelGGL(hybrid_fwd, dim3(grid), dim3(NWAVES * 64), LDS_BYTES, stream, a);
        const hipError_t le = hipPeekAtLastError(); if (le != hipSuccess) { fprintf(stderr, "kernel_launch: launch %d failed: %s\n", p, hipGetErrorName(le)); break; } }
#endif
}
```

```cpp
#include <hip/hip_runtime.h>
#include <hip/hip_cooperative_groups.h>
#include <cstdio>
#include <cstdint>
namespace cg = cooperative_groups;

#ifndef N_LAUNCHES
#define N_LAUNCHES 1
#endif

#define GAS __attribute__((address_space(1)))
#define LAS __attribute__((address_space(3)))
namespace pg8 {
#define PG8_LAS __attribute__((address_space(3)))
typedef unsigned short bf16_t;
typedef short bf16x8 __attribute__((ext_vector_type(8)));
typedef float f32x4 __attribute__((ext_vector_type(4)));
typedef unsigned u32x4 __attribute__((ext_vector_type(4)));
constexpr int BM = 256, BK = 64, HALF = 128, HTB = HALF * BK * 2  , STAGE_BYTES = 8 * HTB, NXCD = 8, WGM = 8;

__host__ __device__ __forceinline__ int lds_byte(int r, int c) { const int st = (r >> 4) * 2 + (c >> 5), rr = r & 15, cc = c & 31, ob = rr * 64 + cc * 2; return st * 1024 + (ob ^ (((ob >> 9) & 1) << 5)); }
__host__ __device__ __forceinline__ void stage_rc(int b, int& R, int& C) { const int st = b / 1024, sb = b % 1024, swz = sb ^ (((sb >> 9) & 1) << 5); R = (st >> 1) * 16 + swz / 64; C = (st & 1) * 32 + (swz % 64) / 2; }
__host__ __device__ __forceinline__ int perm32(int rho) { const int n = rho >> 4, i = rho & 15; return 8 * (i >> 2) + 4 * n + (i & 3); }

struct Unit { int pm, pn; };
struct Gemm { const bf16_t* A; const bf16_t* Bt; int M, N, K; };

struct StaticOrder {
    int nM, nN, nwg, G, c;
    __host__ __device__ void init(int M, int N, int G_, int c_) { nM = M / BM; nN = N / BM; nwg = nM * nN; G = G_; c = c_; }
    __host__ __device__ bool next(int i, Unit& u) const {
        const long L = (long)i * G + c; if (L >= nwg) return false;
        int wgid = (int)L; { const int q = nwg / NXCD, r = nwg % NXCD, xcd = wgid % NXCD, off = wgid / NXCD; wgid = (xcd < r ? xcd * (q + 1) : r * (q + 1) + (xcd - r) * q) + off; }
        const int nig = WGM * nN, gid = wgid / nig, fm = gid * WGM, gsz = (nM - fm) < WGM ? (nM - fm) : WGM;
        u.pm = fm + ((wgid % nig) % gsz); u.pn = (wgid % nig) / gsz; return true;
    }
    __device__ __forceinline__ void a_ready(const Unit&) const {}
    __device__ __forceinline__ void done(const Unit&) const {}
};

typedef float f32x2 __attribute__((ext_vector_type(2)));
__device__ __forceinline__ unsigned cvt_pk_bf16(float lo, float hi) { unsigned r; asm volatile("v_cvt_pk_bf16_f32 %0, %1, %2" : "=v"(r) : "v"(lo), "v"(hi)); return r; }
__device__ __forceinline__ float bf_lo(unsigned u) { return __builtin_bit_cast(float, u << 16); }
__device__ __forceinline__ float bf_hi(unsigned u) { return __builtin_bit_cast(float, u & 0xffff0000u); }
__device__ __forceinline__ float gelu_t(float x) { const float t = x * (1.0f + 0.044715f * x * x) * (-2.3022082f); return x * __builtin_amdgcn_rcpf(1.0f + __builtin_amdgcn_exp2f(t)); }
__device__ __forceinline__ float sigmoid_f(float x) { return __builtin_amdgcn_rcpf(1.0f + __builtin_amdgcn_exp2f(x * -1.4426950409f)); }

struct EpiIn { static constexpr bool PERM = true, AFTER_DRAIN = false; bf16_t* ZG; bf16_t* ZS;
    __device__ __forceinline__ void operator()(const f32x4 (&acc)[2][2][4][2], const Unit& u, int wr, int wc, int fr, int fq) const {
        const int row0 = u.pm * BM + wr * 64 + fr, colt = u.pn * BM;
#pragma unroll
        for (int ai = 0; ai < 2; ++ai)
#pragma unroll
            for (int m = 0; m < 4; ++m) { const int row = row0 + ai * HALF + m * 16;
#pragma unroll
                for (int bj = 0; bj < 2; ++bj) { const int col = colt + bj * HALF + wc * 32 + 8 * fq; f32x4 v0 = acc[ai][bj][m][0], v1 = acc[ai][bj][m][1]; u32x4 w;
                    if (colt < 1024) {
                        w.x = cvt_pk_bf16(gelu_t(v0[0]), gelu_t(v0[1])); w.y = cvt_pk_bf16(gelu_t(v0[2]), gelu_t(v0[3])); w.z = cvt_pk_bf16(gelu_t(v1[0]), gelu_t(v1[1])); w.w = cvt_pk_bf16(gelu_t(v1[2]), gelu_t(v1[3]));
                        *(u32x4*)(ZG + (size_t)row * 1024 + col) = w;
                    } else {
                        w.x = cvt_pk_bf16(v0[0], v0[1]); w.y = cvt_pk_bf16(v0[2], v0[3]); w.z = cvt_pk_bf16(v1[0], v1[1]); w.w = cvt_pk_bf16(v1[2], v1[3]);
                        const int cs = col - 1024, g = cs >> 4, ch = cs & 15, b = row >> 13, s = row & 8191;
                        *(u32x4*)(ZS + ((((size_t)(b * 32 + g)) * 8192 + s) << 4) + ch) = w;
                    } } }
    }
};
struct EpiGlu { static constexpr bool PERM = true, AFTER_DRAIN = false; const bf16_t* YS; const float* bglu; bf16_t* Y;
    __device__ __forceinline__ void operator()(const f32x4 (&acc)[2][2][4][2], const Unit& u, int wr, int wc, int fr, int fq) const {
        const int row0 = u.pm * BM + wr * 64 + fr, colt = u.pn * BM;
#pragma unroll
        for (int bj = 0; bj < 2; ++bj) { const int col = colt + bj * HALF + wc * 32 + 8 * fq; const f32x4 b0 = *(const f32x4*)(bglu + col), b1 = *(const f32x4*)(bglu + col + 4);
#pragma unroll
            for (int ai = 0; ai < 2; ++ai)
#pragma unroll
                for (int m = 0; m < 4; ++m) { const int row = row0 + ai * HALF + m * 16; const f32x4 v0 = acc[ai][bj][m][0] + b0, v1 = acc[ai][bj][m][1] + b1;
                    const u32x4 ys = *(const u32x4*)(YS + (size_t)row * 512 + col); u32x4 w;
                    w.x = cvt_pk_bf16(bf_lo(ys.x) * sigmoid_f(v0[0]), bf_hi(ys.x) * sigmoid_f(v0[1])); w.y = cvt_pk_bf16(bf_lo(ys.y) * sigmoid_f(v0[2]), bf_hi(ys.y) * sigmoid_f(v0[3]));
                    w.z = cvt_pk_bf16(bf_lo(ys.z) * sigmoid_f(v1[0]), bf_hi(ys.z) * sigmoid_f(v1[1])); w.w = cvt_pk_bf16(bf_lo(ys.w) * sigmoid_f(v1[2]), bf_hi(ys.w) * sigmoid_f(v1[3]));
                    *(u32x4*)(Y + (size_t)row * 1024 + 512 + col) = w; } }
    }
};
struct EpiOut { static constexpr bool PERM = true, AFTER_DRAIN = false; const float* x; const float* mod; bf16_t* X1;
    __device__ __forceinline__ void operator()(const f32x4 (&acc)[2][2][4][2], const Unit& u, int wr, int wc, int fr, int fq) const {
        const int row0 = u.pm * BM + wr * 64 + fr, colt = u.pn * BM; const float* gt = mod + (size_t)((u.pm * BM) >> 13) * 6144 + 2048;
#pragma unroll
        for (int bj = 0; bj < 2; ++bj) { const int col = colt + bj * HALF + wc * 32 + 8 * fq; const f32x4 g0 = *(const f32x4*)(gt + col), g1 = *(const f32x4*)(gt + col + 4);
            f32x4 xv[8][2];
#pragma unroll
            for (int ai = 0; ai < 2; ++ai)
#pragma unroll
                for (int m = 0; m < 4; ++m) { const size_t o = (size_t)(row0 + ai * HALF + m * 16) * 1024 + col;
                    xv[ai * 4 + m][0] = __builtin_nontemporal_load((const f32x4*)(x + o)); xv[ai * 4 + m][1] = __builtin_nontemporal_load((const f32x4*)(x + o + 4)); }
            __builtin_amdgcn_sched_barrier(0);
#pragma unroll
            for (int ai = 0; ai < 2; ++ai)
#pragma unroll
                for (int m = 0; m < 4; ++m) { const size_t o = (size_t)(row0 + ai * HALF + m * 16) * 1024 + col;
                    const f32x4 v0 = xv[ai * 4 + m][0] + g0 * acc[ai][bj][m][0], v1 = xv[ai * 4 + m][1] + g1 * acc[ai][bj][m][1]; u32x4 w;
                    w.x = cvt_pk_bf16(v0[0], v0[1]); w.y = cvt_pk_bf16(v0[2], v0[3]); w.z = cvt_pk_bf16(v1[0], v1[1]); w.w = cvt_pk_bf16(v1[2], v1[3]);
                    *(u32x4*)(X1 + o) = w; }
            __builtin_amdgcn_sched_barrier(0); }
    }
};
struct EpiPlain { static constexpr bool PERM = true, AFTER_DRAIN = false; bf16_t* O; int ldc;
    __device__ __forceinline__ void operator()(const f32x4 (&acc)[2][2][4][2], const Unit& u, int wr, int wc, int fr, int fq) const {
        const int row0 = u.pm * BM + wr * 64 + fr, colt = u.pn * BM;
#pragma unroll
        for (int ai = 0; ai < 2; ++ai)
#pragma unroll
            for (int m = 0; m < 4; ++m) { const int row = row0 + ai * HALF + m * 16;
#pragma unroll
                for (int bj = 0; bj < 2; ++bj) { const int col = colt + bj * HALF + wc * 32 + 8 * fq; const f32x4 v0 = acc[ai][bj][m][0], v1 = acc[ai][bj][m][1]; u32x4 w;
                    w.x = cvt_pk_bf16(v0[0], v0[1]); w.y = cvt_pk_bf16(v0[2], v0[3]); w.z = cvt_pk_bf16(v1[0], v1[1]); w.w = cvt_pk_bf16(v1[2], v1[3]);
                    *(u32x4*)(O + (size_t)row * ldc + col) = w; } }
    }
};
template <class Epi, class Sched, bool ALIGN_EPI = false, bool SP2 = false>
__device__ __forceinline__ void gemm_phase(PG8_LAS unsigned char* lds, const Gemm g, const Sched& S, const Epi& E) {
    const int tid = threadIdx.x, wid = __builtin_amdgcn_readfirstlane(tid >> 6), lane = tid & 63, wr = wid >> 2, wc = wid & 3, fr = lane & 15, fq = lane >> 4;
    const int K = g.K, nt = K / BK;
    unsigned voffA[2], voffB[2];
#pragma unroll
    for (int i = 0; i < 2; ++i) { int R, C; stage_rc(tid * 16 + i * 8192, R, C); const int Rb = Epi::PERM ? ((R & ~31) + perm32(R & 31)) : R;
        voffA[i] = (unsigned)(R * K + C) * 2u; voffB[i] = (unsigned)(Rb * K + C) * 2u; }
    const size_t kstep = (size_t)(BK * 2);
    const size_t hstep = (size_t)HALF * K * 2;
    const size_t tstep = 2 * hstep;
    const unsigned ldsw = (unsigned)wid * 1024u;
    const int aoff = lds_byte(wr * 64 + fr, fq * 8), boff = lds_byte(wc * 32 + fr, fq * 8);
#define PG8_SA(b, h) (((b) * 2 + (h)) * HTB)
#define PG8_SB(b, h) ((4 + (b) * 2 + (h)) * HTB)
#define PG8_STAGE(bufoff, gbase, voff) do { _Pragma("unroll") for (int _i = 0; _i < 2; ++_i) \
        __builtin_amdgcn_global_load_lds((const unsigned*)((const char*)(gbase) + (voff)[_i]), (PG8_LAS unsigned*)(lds + (bufoff) + ldsw + _i * 8192), 16, 0, 0); } while (0)
#define PG8_LDA(dst, b, h) do { _Pragma("unroll") for (int m = 0; m < 4; ++m) _Pragma("unroll") for (int k = 0; k < 2; ++k) dst[m][k] = *(const PG8_LAS bf16x8*)(lds + PG8_SA(b, h) + aoff + m * 2048 + k * 1024); } while (0)
#define PG8_LDB(dst, b, h) do { _Pragma("unroll") for (int n = 0; n < 2; ++n) _Pragma("unroll") for (int k = 0; k < 2; ++k) dst[n][k] = *(const PG8_LAS bf16x8*)(lds + PG8_SB(b, h) + boff + n * 2048 + k * 1024); } while (0)
#define PG8_MMA(ai, bj, At, Bt) do { __builtin_amdgcn_s_setprio(1); _Pragma("unroll") for (int m = 0; m < 4; ++m) _Pragma("unroll") for (int n = 0; n < 2; ++n) _Pragma("unroll") for (int k = 0; k < 2; ++k) \
        acc[ai][bj][m][n] = __builtin_amdgcn_mfma_f32_16x16x32_bf16(Bt[n][k], At[m][k], acc[ai][bj][m][n], 0, 0, 0); __builtin_amdgcn_s_setprio(0); } while (0)
#define PG8_WAIT_V(n) asm volatile("s_waitcnt vmcnt(" #n ")" ::: "memory")
#define PG8_WAIT_L(n) asm volatile("s_waitcnt lgkmcnt(" #n ")" ::: "memory")
#define PG8_BAR __builtin_amdgcn_s_barrier()
#define PG8_SCHED __builtin_amdgcn_sched_barrier(0)
    Unit cur, nxt; int ui = 0;
    if (!S.next(0, cur)) return;
    f32x4 acc[2][2][4][2];
#pragma unroll
    for (int a = 0; a < 2; ++a)
#pragma unroll
        for (int b = 0; b < 2; ++b)
#pragma unroll
            for (int m = 0; m < 4; ++m)
#pragma unroll
                for (int n = 0; n < 2; ++n) acc[a][b][m][n] = (f32x4){0.f, 0.f, 0.f, 0.f};
    bf16x8 At[4][2], B0[2][2], B1[2][2];
    const char* cA = (const char*)g.A + (size_t)cur.pm * tstep; const char* cB = (const char*)g.Bt + (size_t)cur.pn * tstep;
    S.a_ready(cur);
    if constexpr (SP2) {
        PG8_STAGE(PG8_SB(0, 0), cB, voffB); PG8_STAGE(PG8_SB(0, 1), cB + hstep, voffB); PG8_STAGE(PG8_SA(0, 0), cA, voffA); PG8_STAGE(PG8_SA(0, 1), cA + hstep, voffA);
        if (wr == 1) PG8_BAR;
        PG8_WAIT_V(2); PG8_BAR;
        PG8_STAGE(PG8_SB(1, 0), cB + kstep, voffB); PG8_STAGE(PG8_SA(1, 0), cA + kstep, voffA); PG8_STAGE(PG8_SB(1, 1), cB + hstep + kstep, voffB);
        PG8_WAIT_V(6); PG8_BAR;
    } else {
        PG8_STAGE(PG8_SB(0, 0), cB, voffB); PG8_STAGE(PG8_SA(0, 0), cA, voffA); PG8_STAGE(PG8_SB(0, 1), cB + hstep, voffB); PG8_STAGE(PG8_SA(0, 1), cA + hstep, voffA);
        if (wr == 1) PG8_BAR;
        PG8_WAIT_V(4); PG8_BAR;
        PG8_STAGE(PG8_SB(1, 0), cB + kstep, voffB); PG8_STAGE(PG8_SA(1, 0), cA + kstep, voffA); PG8_STAGE(PG8_SB(1, 1), cB + hstep + kstep, voffB);
        PG8_WAIT_V(6); PG8_BAR;
    }
    for (;;) {
        const bool has_next = S.next(ui + 1, nxt);
        const char* nA = has_next ? (const char*)g.A + (size_t)nxt.pm * tstep : cA; const char* nB = has_next ? (const char*)g.Bt + (size_t)nxt.pn * tstep : cB;
        for (int t = 0; t < nt; t += 2) {
            const bool last = (t == nt - 2);
            const char* a1 = cA + (size_t)(t + 1) * kstep;
            const char* a2 = last ? nA : cA + (size_t)(t + 2) * kstep; const char* b2 = last ? nB : cB + (size_t)(t + 2) * kstep;
            const char* a3 = a2 + kstep; const char* b3 = b2 + kstep;
            if (last && has_next) S.a_ready(nxt);
            if constexpr (SP2) {
            PG8_LDB(B0, 0, 0); PG8_LDB(B1, 0, 1); PG8_SCHED; PG8_LDA(At, 0, 0); PG8_STAGE(PG8_SA(1, 1), a1 + hstep, voffA);
            PG8_WAIT_V(8); PG8_WAIT_L(0); PG8_BAR; PG8_MMA(0, 0, At, B0); PG8_MMA(0, 1, At, B1); PG8_BAR; PG8_SCHED;
            PG8_LDA(At, 0, 1); PG8_STAGE(PG8_SB(0, 0), b2, voffB); PG8_STAGE(PG8_SB(0, 1), b2 + hstep, voffB); PG8_STAGE(PG8_SA(0, 0), a2, voffA);
            PG8_WAIT_V(8); PG8_WAIT_L(0); PG8_BAR; PG8_MMA(1, 0, At, B0); PG8_MMA(1, 1, At, B1); PG8_BAR; PG8_SCHED;
            PG8_LDB(B0, 1, 0); PG8_LDB(B1, 1, 1); PG8_SCHED; PG8_LDA(At, 1, 0); PG8_STAGE(PG8_SA(0, 1), a2 + hstep, voffA);
            PG8_WAIT_V(8); PG8_WAIT_L(0); PG8_BAR; PG8_MMA(0, 0, At, B0); PG8_MMA(0, 1, At, B1); PG8_BAR; PG8_SCHED;
            PG8_LDA(At, 1, 1); PG8_STAGE(PG8_SB(1, 0), b3, voffB); PG8_STAGE(PG8_SB(1, 1), b3 + hstep, voffB); PG8_STAGE(PG8_SA(1, 0), a3, voffA);
            PG8_WAIT_V(8); PG8_WAIT_L(0); PG8_BAR; PG8_MMA(1, 0, At, B0); PG8_MMA(1, 1, At, B1); PG8_BAR; PG8_SCHED;
            } else {
            PG8_LDB(B0, 0, 0); PG8_SCHED; PG8_LDA(At, 0, 0); PG8_STAGE(PG8_SA(1, 1), a1 + hstep, voffA);
            PG8_WAIT_L(8); PG8_BAR; PG8_WAIT_L(0); PG8_MMA(0, 0, At, B0); PG8_BAR; PG8_SCHED;
            PG8_LDB(B1, 0, 1); PG8_STAGE(PG8_SB(0, 0), b2, voffB);
            PG8_BAR; PG8_WAIT_L(0); PG8_MMA(0, 1, At, B1); PG8_BAR;
            PG8_LDA(At, 0, 1); PG8_STAGE(PG8_SA(0, 0), a2, voffA);
            PG8_BAR; PG8_WAIT_L(0); PG8_MMA(1, 0, At, B0); PG8_BAR; PG8_SCHED;
            PG8_STAGE(PG8_SB(0, 1), b2 + hstep, voffB);
            PG8_WAIT_V(6); PG8_BAR; PG8_MMA(1, 1, At, B1); PG8_BAR;
            PG8_LDB(B0, 1, 0); PG8_SCHED; PG8_LDA(At, 1, 0); PG8_STAGE(PG8_SA(0, 1), a2 + hstep, voffA);
            PG8_WAIT_L(8); PG8_BAR; PG8_WAIT_L(0); PG8_MMA(0, 0, At, B0); PG8_BAR; PG8_SCHED;
            PG8_LDB(B1, 1, 1); PG8_STAGE(PG8_SB(1, 0), b3, voffB);
            PG8_BAR; PG8_WAIT_L(0); PG8_MMA(0, 1, At, B1); PG8_BAR;
            PG8_LDA(At, 1, 1); PG8_STAGE(PG8_SA(1, 0), a3, voffA);
            PG8_BAR; PG8_WAIT_L(0); PG8_MMA(1, 0, At, B0); PG8_BAR; PG8_SCHED;
            PG8_STAGE(PG8_SB(1, 1), b3 + hstep, voffB);
            PG8_WAIT_V(6); PG8_BAR; PG8_MMA(1, 1, At, B1); PG8_BAR;
            }
        }
        if constexpr (ALIGN_EPI) { if (wr == 0) PG8_BAR; }
        if constexpr (!Epi::AFTER_DRAIN) { E(acc, cur, wr, wc, fr, fq); S.done(cur); }
        if (!has_next) break;
#pragma unroll
        for (int a = 0; a < 2; ++a)
#pragma unroll
            for (int b = 0; b < 2; ++b)
#pragma unroll
                for (int m = 0; m < 4; ++m)
#pragma unroll
                    for (int n = 0; n < 2; ++n) acc[a][b][m][n] = (f32x4){0.f, 0.f, 0.f, 0.f};
        cur = nxt; cA = nA; cB = nB; ++ui;
        if constexpr (ALIGN_EPI) { if (wr == 1) PG8_BAR; }
    }
    PG8_WAIT_V(0);
    if constexpr (!ALIGN_EPI) { if (wr == 0) PG8_BAR; }
    PG8_BAR;
    if constexpr (Epi::AFTER_DRAIN) { E.fused(acc, cur, wr, wc, fr, fq, lds, wid, lane); S.done(cur); }
#undef PG8_SA
#undef PG8_SB
#undef PG8_STAGE
#undef PG8_LDA
#undef PG8_LDB
#undef PG8_MMA
#undef PG8_WAIT_V
#undef PG8_WAIT_L
#undef PG8_BAR
#undef PG8_SCHED
}
}
typedef unsigned short bf16;
typedef unsigned v4u __attribute__((ext_vector_type(4)));
typedef unsigned v2u __attribute__((ext_vector_type(2)));
typedef float f32x4 __attribute__((ext_vector_type(4)));
typedef float f2_t __attribute__((ext_vector_type(2)));
typedef float f32x16 __attribute__((ext_vector_type(16)));
typedef short bf16x8 __attribute__((ext_vector_type(8)));
typedef short s16x4 __attribute__((ext_vector_type(4)));
typedef __bf16 bf2_t __attribute__((ext_vector_type(2)));

constexpr int NWAVES = 8;
constexpr int DM = 1024, NB = 8, SEQ = 8192, M = NB * SEQ, INW = 1536, NMODC = 6144;
constexpr int LDS_BYTES = 160 * 1024, LDS_MISC_OFF = LDS_BYTES - 64;
constexpr size_t MiB = 1u << 20;
constexpr size_t WS_MOD = 0;
constexpr size_t WS_BAR = 208 * 1024;
constexpr size_t WS_SU = 256 * 1024;
constexpr size_t WS_SV = 384 * 1024;
constexpr size_t WS_WIN = 1 * MiB;
constexpr size_t WS_WGLU = 4 * MiB;
constexpr size_t WS_WOUT = 5 * MiB;
constexpr size_t WS_WQ = 7 * MiB;
constexpr size_t WS_KEYS = 9 * MiB;
constexpr size_t WS_WM = 9 * MiB + 512 * 1024;
constexpr size_t WS_UB = 16 * MiB;
constexpr size_t WS_VB = 48 * MiB;
constexpr size_t WS_H = 80 * MiB;
constexpr size_t WS_ZG = 208 * MiB;
constexpr size_t WS_ZS = 336 * MiB;
constexpr size_t WS_Y = 400 * MiB;
constexpr size_t WS_YS = 528 * MiB;
constexpr size_t WS_E = 592 * MiB;
constexpr size_t WS_G = 624 * MiB;
constexpr size_t WS_W = 656 * MiB;
constexpr size_t WS_SS = 688 * MiB;
constexpr size_t WS_PA = 336 * MiB;
constexpr size_t WS_X1B = 690 * MiB;
constexpr size_t WS_H2Q = 818 * MiB;
constexpr size_t WS_SH = 882 * MiB;
constexpr size_t WS_END = 883 * MiB;
constexpr float EPS = 1e-6f;

#define LDS_WAIT() asm volatile("s_waitcnt lgkmcnt(0)" ::: "memory")
__device__ __forceinline__ unsigned f2bf(float f) { unsigned u = __builtin_bit_cast(unsigned, f); return (u + 0x7fffu + ((u >> 16) & 1u)) >> 16; }
__device__ __forceinline__ unsigned pk2(float lo, float hi) { return f2bf(lo) | (f2bf(hi) << 16); }
__device__ __forceinline__ float bflo(unsigned u) { return __builtin_bit_cast(float, u << 16); }
__device__ __forceinline__ float bfhi(unsigned u) { return __builtin_bit_cast(float, u & 0xffff0000u); }
__device__ __forceinline__ float wave_sum(float v) {
#pragma unroll
    for (int o = 1; o < 64; o <<= 1) v += __shfl_xor(v, o);
    return v;
}
using pg8::gelu_t;
using pg8::sigmoid_f;

struct Args { const float* in[27]; float* out; unsigned char* ws; int ph_lo, ph_hi; };
enum { I_X = 0, I_C, I_WADA, I_BADA, I_GMIX, I_WIN, I_LNG, I_LNB, I_WS, I_BS, I_ARE, I_AIM, I_LOGDT, I_BRE, I_BIM, I_CRE, I_CIM, I_D, I_WGLU, I_BGLU, I_WOUT, I_GFFN, I_WQ, I_KEYS, I_PU, I_PV, I_GFIN };

__device__ __forceinline__ void p0_transpose_item(const float* W, int K, int N, bf16* WT, LAS float* scr, int item, int lane) {
    const int nblk = N / 32, kb = item / nblk, nb = item % nblk, k0 = 64 * kb, n0 = 32 * nb;
#pragma unroll 8
    for (int i = 0; i < 32; ++i) { const int kk = 2 * i + (lane >> 5); scr[kk * 33 + (lane & 31)] = W[(size_t)(k0 + kk) * N + n0 + (lane & 31)]; }
    LDS_WAIT(); asm volatile("" ::: "memory");
    const int c = lane & 7;
#pragma unroll
    for (int j = 0; j < 4; ++j) { const int n = (lane >> 3) + 8 * j; const LAS float* s = scr + (8 * c) * 33 + n;
        v4u o; o.x = pk2(s[0 * 33], s[1 * 33]); o.y = pk2(s[2 * 33], s[3 * 33]); o.z = pk2(s[4 * 33], s[5 * 33]); o.w = pk2(s[6 * 33], s[7 * 33]);
        *(v4u*)(WT + (size_t)(n0 + n) * K + k0 + 8 * c) = o; }
    LDS_WAIT(); asm volatile("" ::: "memory");
}
__device__ __forceinline__ void cvt_stream(const float* src, bf16* dst, size_t n8, size_t gtid, size_t gthreads) {
    for (size_t i = gtid; i < n8; i += gthreads) { const f32x4 a = *(const f32x4*)(src + i * 8), b = *(const f32x4*)(src + i * 8 + 4);
        v4u o; o.x = pk2(a.x, a.y); o.y = pk2(a.z, a.w); o.z = pk2(b.x, b.y); o.w = pk2(b.z, b.w); *(v4u*)(dst + i * 8) = o; }
}
__device__ __forceinline__ float wave_max(float v) {
#pragma unroll
    for (int o = 1; o < 64; o <<= 1) v = fmaxf(v, __shfl_xor(v, o));
    return v;
}
__device__ __forceinline__ void cvt_rows_fp8(const float* src, unsigned char* dst, float* inv, int gw, int NGW, int lane) {
    for (int row = gw; row < 16384; row += NGW) { const f32x4* p = (const f32x4*)(src + (size_t)row * 1024) + lane;
        f32x4 v[4]; float m = 0.f;
#pragma unroll
        for (int j = 0; j < 4; ++j) { v[j] = __builtin_nontemporal_load(p + 64 * j); m = fmaxf(fmaxf(m, fmaxf(fabsf(v[j].x), fabsf(v[j].y))), fmaxf(fabsf(v[j].z), fabsf(v[j].w))); }
        m = wave_max(m); const float sc = m > 0.f ? 240.0f / m : 1.0f;
#pragma unroll
        for (int j = 0; j < 4; ++j) { int pk = 0; pk = __builtin_amdgcn_cvt_pk_fp8_f32(v[j].x * sc, v[j].y * sc, pk, false); pk = __builtin_amdgcn_cvt_pk_fp8_f32(v[j].z * sc, v[j].w * sc, pk, true);
            const int c = 4 * lane + 256 * j; *(unsigned*)(dst + ((size_t)(c >> 7) * 16384 + row) * 128 + (c & 127)) = (unsigned)pk; }
        if (lane == 0) inv[row] = m > 0.f ? m * (1.0f / 240.0f) : 1.0f; }
}
__device__ __forceinline__ unsigned pack_i8x4(float a, float b, float c, float d) {
    const int ia = (int)rintf(a), ib = (int)rintf(b), ic = (int)rintf(c), id = (int)rintf(d);
    return (unsigned)(ia & 0xff) | ((unsigned)(ib & 0xff) << 8) | ((unsigned)(ic & 0xff) << 16) | ((unsigned)(id & 0xff) << 24);
}
__device__ __forceinline__ void cvt_rows_i8(const float* src, unsigned char* dst, float* inv, int gw, int NGW, int lane) {
    for (int row = gw; row < 16384; row += NGW) { const f32x4* p = (const f32x4*)(src + (size_t)row * 1024) + lane;
        f32x4 v[4]; float m = 0.f;
#pragma unroll
        for (int j = 0; j < 4; ++j) { v[j] = __builtin_nontemporal_load(p + 64 * j); m = fmaxf(fmaxf(m, fmaxf(fabsf(v[j].x), fabsf(v[j].y))), fmaxf(fabsf(v[j].z), fabsf(v[j].w))); }
        m = wave_max(m); const float sc = m > 0.f ? 127.0f / m : 1.0f;
#pragma unroll
        for (int j = 0; j < 4; ++j) { const int c = 4 * lane + 256 * j; *(unsigned*)(dst + ((size_t)(c >> 7) * 16384 + row) * 128 + (c & 127)) = pack_i8x4(v[j].x * sc, v[j].y * sc, v[j].z * sc, v[j].w * sc); }
        if (lane == 0) inv[row] = m > 0.f ? m * (1.0f / 127.0f) : 1.0f; }
}
__device__ __forceinline__ unsigned pack_i4x8(const float (&v)[8], float inv) {
    unsigned d = 0;
#pragma unroll
    for (int i = 0; i < 8; ++i) { int q = (int)rintf(v[i] * inv); q = q < -8 ? -8 : (q > 7 ? 7 : q); d |= (unsigned)(q & 15) << (4 * i); }
    return d;
}
__device__ __forceinline__ void cvt_rows_i4(const float* src, unsigned char* dst, float* invs, int gw, int NGW, int lane) {
    for (int row = gw; row < 16384; row += NGW) { const float* p = src + (size_t)row * 1024;
        float v[2][8]; float ss = 0.f;
#pragma unroll
        for (int q = 0; q < 2; ++q) { const f32x4 x0 = __builtin_nontemporal_load((const f32x4*)(p + 512 * q + 8 * lane)), x1 = __builtin_nontemporal_load((const f32x4*)(p + 512 * q + 8 * lane + 4));
            v[q][0] = x0.x; v[q][1] = x0.y; v[q][2] = x0.z; v[q][3] = x0.w; v[q][4] = x1.x; v[q][5] = x1.y; v[q][6] = x1.z; v[q][7] = x1.w;
#pragma unroll
            for (int i = 0; i < 8; ++i) ss += v[q][i] * v[q][i]; }
        const float rms = sqrtf(wave_sum(ss) * (1.0f / 1024.0f)); const float step = rms > 0.f ? rms * (2.5f / 7.5f) : 1.0f, inv = 1.0f / step;
#pragma unroll
        for (int q = 0; q < 2; ++q) { const int c = 512 * q + 8 * lane; *(unsigned*)(dst + ((size_t)(c >> 7) * 16384 + row) * 64 + ((c & 127) >> 1)) = pack_i4x8(v[q], inv); }
        if (lane == 0) invs[row] = step; }
}
template <int LOG2W> __device__ __forceinline__ void cvt_rows_fp4(const float* src, unsigned char* dst, float* invs, int gw, int NGW, int lane) {
    for (int base = gw; base < 16384; base += 4 * NGW) {
        float v[4][2][8]; float ss[4];
#pragma unroll
        for (int rr = 0; rr < 4; ++rr) { const int row = min(base + rr * NGW, 16383); const float* p = src + (size_t)row * 1024;
#pragma unroll
            for (int q = 0; q < 2; ++q) { const f32x4 x0 = __builtin_nontemporal_load((const f32x4*)(p + 512 * q + 8 * lane)), x1 = __builtin_nontemporal_load((const f32x4*)(p + 512 * q + 8 * lane + 4));
                v[rr][q][0] = x0.x; v[rr][q][1] = x0.y; v[rr][q][2] = x0.z; v[rr][q][3] = x0.w; v[rr][q][4] = x1.x; v[rr][q][5] = x1.y; v[rr][q][6] = x1.z; v[rr][q][7] = x1.w; } }
#pragma unroll
        for (int rr = 0; rr < 4; ++rr) { float s = 0.f;
#pragma unroll
            for (int q = 0; q < 2; ++q)
#pragma unroll
                for (int i = 0; i < 8; ++i) s += v[rr][q][i] * v[rr][q][i];
            ss[rr] = wave_sum(s); }
#pragma unroll
        for (int rr = 0; rr < 4; ++rr) { const int row = base + rr * NGW; if (row < 16384) {
            const float rms = sqrtf(ss[rr] * (1.0f / 1024.0f)); const float sc = rms > 0.f ? rms * 0.5f : 1.0f, inv = 1.0f / sc;
#pragma unroll
            for (int q = 0; q < 2; ++q) { float t[8];
#pragma unroll
                for (int i = 0; i < 8; ++i) t[i] = fminf(fmaxf(v[rr][q][i] * inv, -6.0f), 6.0f);
                unsigned d = 0;
                d = __builtin_amdgcn_cvt_scalef32_pk_fp4_f32(d, t[0], t[1], 1.0f, 0); d = __builtin_amdgcn_cvt_scalef32_pk_fp4_f32(d, t[2], t[3], 1.0f, 1);
                d = __builtin_amdgcn_cvt_scalef32_pk_fp4_f32(d, t[4], t[5], 1.0f, 2); d = __builtin_amdgcn_cvt_scalef32_pk_fp4_f32(d, t[6], t[7], 1.0f, 3);
                const int c = 512 * q + 8 * lane; constexpr int W = 1 << LOG2W; *(unsigned*)(dst + ((size_t)(c >> LOG2W) * 16384 + row) * (W / 2) + ((c & (W - 1)) >> 1)) = d; }
            if (lane == 0) invs[row] = sc; } }
    }
}
__device__ __forceinline__ void p0_mod_item(const float* c, const float* w_ada, const float* b_ada, float* mod, LAS float* scr, int item, int tid) {
    LAS float* cond = scr;
    LAS float* red = scr + 8 * 1024;
    for (int i = tid; i < 8 * 1024; i += 512) { const float v = c[i]; cond[i] = v * sigmoid_f(v); }
    __syncthreads();
    const int kq = tid >> 3, cq = tid & 7, j0 = item * 24 + cq * 3;
    float acc[8][3];
#pragma unroll
    for (int b = 0; b < 8; ++b) { acc[b][0] = 0.f; acc[b][1] = 0.f; acc[b][2] = 0.f; }
    for (int i = 0; i < 16; ++i) { const int k = kq + 64 * i; const float* wp = w_ada + (size_t)k * NMODC + j0; const float w0 = wp[0], w1 = wp[1], w2 = wp[2];
#pragma unroll
        for (int b = 0; b < 8; ++b) { const float s = cond[b * 1024 + k]; acc[b][0] += s * w0; acc[b][1] += s * w1; acc[b][2] += s * w2; } }
#pragma unroll
    for (int b = 0; b < 8; ++b)
#pragma unroll
        for (int e = 0; e < 3; ++e) red[kq * 192 + b * 24 + cq * 3 + e] = acc[b][e];
    __syncthreads();
    if (tid < 192) { float s = 0.f; for (int q = 0; q < 64; ++q) s += red[q * 192 + tid]; const int b = tid / 24, j = item * 24 + tid % 24; mod[b * NMODC + j] = s + b_ada[j]; }
    __syncthreads();
}
__device__ __forceinline__ void phase_prologue(const Args& a, LAS unsigned char* lds, int tid, int wave, int lane) {
    unsigned char* ws = a.ws; const int G = gridDim.x, bx = blockIdx.x;
    for (int it = bx; it < 256; it += G) p0_mod_item(a.in[I_C], a.in[I_WADA], a.in[I_BADA], (float*)(ws + WS_MOD), (LAS float*)lds, it, tid);
    LAS float* scr = (LAS float*)(lds + wave * 16384);
    const int gw = bx * NWAVES + wave, NGW = G * NWAVES;
    constexpr int I_IN = 16 * 48, I_GLU = 8 * 16, I_OUT = 16 * 32, I_Q = 16 * 32, NITEMS = I_IN + I_GLU + I_OUT + I_Q;
    for (int it = gw; it < NITEMS; it += NGW) { int r = it;
        if (r < I_IN) { p0_transpose_item(a.in[I_WIN], 1024, 1536, (bf16*)(ws + WS_WIN), scr, r, lane); continue; } r -= I_IN;
        if (r < I_GLU) { p0_transpose_item(a.in[I_WGLU], 512, 512, (bf16*)(ws + WS_WGLU), scr, r, lane); continue; } r -= I_GLU;
        if (r < I_OUT) { p0_transpose_item(a.in[I_WOUT], 1024, 1024, (bf16*)(ws + WS_WOUT), scr, r, lane); continue; } r -= I_OUT;
        p0_transpose_item(a.in[I_WQ], 1024, 1024, (bf16*)(ws + WS_WQ), scr, r, lane); }
    const size_t gtid = (size_t)bx * 512 + tid, gth = (size_t)G * 512;
    cvt_stream(a.in[I_KEYS], (bf16*)(ws + WS_KEYS), 8 * 2 * 128 * 64 / 8, gtid, gth);
    { const float* w = a.in[I_WS]; bf16* wm = (bf16*)(ws + WS_WM);
      for (size_t i = gtid; i < 4 * 128 * 128 / 8; i += gth) { const int e0 = (int)i * 8, ii = (e0 >> 7) & 127, j0 = e0 & 127; const f32x4 p = *(const f32x4*)(w + e0), q = *(const f32x4*)(w + e0 + 4);
          float v[8] = {p.x, p.y, p.z, p.w, q.x, q.y, q.z, q.w};
#pragma unroll
          for (int e = 0; e < 8; ++e) v[e] = (j0 + e <= ii) ? v[e] : 0.f;
          v4u o; o.x = pk2(v[0], v[1]); o.y = pk2(v[2], v[3]); o.z = pk2(v[4], v[5]); o.w = pk2(v[6], v[7]); *(v4u*)(wm + e0) = o; } }
    cvt_rows_fp4<8>(a.in[I_PU], ws + WS_UB, (float*)(ws + WS_SU), gw, NGW, lane); cvt_rows_fp4<8>(a.in[I_PV], ws + WS_VB, (float*)(ws + WS_SV), gw, NGW, lane);
}

__device__ __forceinline__ void phase_norm_mod(const float* x, const float* gw, const float* mod, int sh_off, int sc_off, bf16* H, int wave, int lane) {
    const int G = gridDim.x;
    for (int it = blockIdx.x; it < 256; it += G) { const int b = it >> 5; const float* mb = mod + (size_t)b * NMODC;
        f32x4 A[4], S[4];
#pragma unroll
        for (int j = 0; j < 4; ++j) { const int c0 = 4 * lane + 256 * j; const f32x4 g = *(const f32x4*)(gw + c0), sc = *(const f32x4*)(mb + sc_off + c0); A[j] = g * (sc + 1.0f); S[j] = *(const f32x4*)(mb + sh_off + c0); }
        for (int r = 0; r < 32; ++r) { const size_t row = (size_t)it * 256 + wave * 32 + r; const f32x4* xr = (const f32x4*)(x + row * 1024) + lane;
            f32x4 v[4]; float s = 0.f;
#pragma unroll
            for (int j = 0; j < 4; ++j) { v[j] = __builtin_nontemporal_load(xr + 64 * j); s += (v[j].x * v[j].x + v[j].y * v[j].y) + (v[j].z * v[j].z + v[j].w * v[j].w); }
            const float rstd = 1.0f / sqrtf(wave_sum(s) * (1.0f / 1024.0f) + EPS);
            unsigned long long* o8 = (unsigned long long*)(H + row * 1024) + lane;
#pragma unroll
            for (int j = 0; j < 4; ++j) { const f32x4 h = v[j] * rstd * A[j] + S[j]; o8[64 * j] = (unsigned long long)pk2(h.x, h.y) | ((unsigned long long)pk2(h.z, h.w) << 32); } } }
}
__device__ __forceinline__ void phase_norm_mod_bf(const bf16* x, const float* gw, const float* mod, int sh_off, int sc_off, bf16* H, unsigned char* HQ, float* SH, int wave, int lane) {
    const int G = gridDim.x;
    for (int it = blockIdx.x; it < 256; it += G) { const int b = it >> 5; const float* mb = mod + (size_t)b * NMODC;
        float A[16], S[16];
#pragma unroll
        for (int q = 0; q < 2; ++q)
#pragma unroll
            for (int j = 0; j < 8; ++j) { const int c = 512 * q + 8 * lane + j; A[8 * q + j] = gw[c] * (mb[sc_off + c] + 1.0f); S[8 * q + j] = mb[sh_off + c]; }
        for (int r = 0; r < 32; ++r) { const size_t row = (size_t)it * 256 + wave * 32 + r;
            const v4u r0 = *(const v4u*)(x + row * 1024 + 8 * lane), r1 = *(const v4u*)(x + row * 1024 + 512 + 8 * lane);
            float v[16] = {bflo(r0.x), bfhi(r0.x), bflo(r0.y), bfhi(r0.y), bflo(r0.z), bfhi(r0.z), bflo(r0.w), bfhi(r0.w), bflo(r1.x), bfhi(r1.x), bflo(r1.y), bfhi(r1.y), bflo(r1.z), bfhi(r1.z), bflo(r1.w), bfhi(r1.w)};
            float s = 0.f;
#pragma unroll
            for (int j = 0; j < 16; ++j) s += v[j] * v[j];
            const float rstd = 1.0f / sqrtf(wave_sum(s) * (1.0f / 1024.0f) + EPS);
#pragma unroll
            for (int j = 0; j < 16; ++j) v[j] = v[j] * rstd * A[j] + S[j];
            v4u o0, o1; o0.x = pk2(v[0], v[1]); o0.y = pk2(v[2], v[3]); o0.z = pk2(v[4], v[5]); o0.w = pk2(v[6], v[7]); o1.x = pk2(v[8], v[9]); o1.y = pk2(v[10], v[11]); o1.z = pk2(v[12], v[13]); o1.w = pk2(v[14], v[15]);
            *(v4u*)(H + row * 1024 + 8 * lane) = o0; *(v4u*)(H + row * 1024 + 512 + 8 * lane) = o1;
            float mx = 0.f;
#pragma unroll
            for (int j = 0; j < 16; ++j) mx = fmaxf(mx, fabsf(v[j]));
            mx = wave_max(mx); const float qs = mx > 0.f ? 200.0f / mx : 1.0f;
#pragma unroll
            for (int q = 0; q < 2; ++q) { int p0 = 0, p1 = 0;
                p0 = __builtin_amdgcn_cvt_pk_fp8_f32(v[8 * q] * qs, v[8 * q + 1] * qs, p0, false); p0 = __builtin_amdgcn_cvt_pk_fp8_f32(v[8 * q + 2] * qs, v[8 * q + 3] * qs, p0, true);
                p1 = __builtin_amdgcn_cvt_pk_fp8_f32(v[8 * q + 4] * qs, v[8 * q + 5] * qs, p1, false); p1 = __builtin_amdgcn_cvt_pk_fp8_f32(v[8 * q + 6] * qs, v[8 * q + 7] * qs, p1, true);
                *(v2u*)(HQ + row * 1024 + 512 * q + 8 * lane) = (v2u){(unsigned)p0, (unsigned)p1}; }
            if (lane == 0) SH[row] = mx > 0.f ? mx * (1.0f / 200.0f) : 1.0f; } }
}
__device__ __forceinline__ void sincos_f(float th, float& s, float& c) {
    const float q = rintf(th * 0.63661977236758f);
    float y = fmaf(q, -1.5707962513f, th); y = fmaf(q, -7.5497894159e-8f, y); y = fmaf(q, -5.3903029534e-15f, y);
    const float y2 = y * y;
    const float sp = y + y * y2 * (-1.6666667163e-1f + y2 * (8.3333337680e-3f + y2 * (-1.9841270114e-4f + y2 * 2.7557314297e-6f)));
    const float cp = 1.0f + y2 * (-0.5f + y2 * (4.1666667908e-2f + y2 * (-1.3888889225e-3f + y2 * (2.4801587642e-5f + y2 * -2.7557314297e-7f))));
    const int qi = (int)q & 3;
    s = (qi == 0) ? sp : (qi == 1) ? cp : (qi == 2) ? -sp : -cp;
    c = (qi == 0) ? cp : (qi == 1) ? -sp : (qi == 2) ? -cp : sp;
}
__device__ __forceinline__ void s5_disc(const float* are, const float* aim, float dt, int gp, float& abr, float& abi, float& cr, float& ci) {
    const float ar = fminf(are[gp], -1e-4f), ai = aim[gp];
    const float mag = expf(ar * dt); float sn, cs; sincos_f(ai * dt, sn, cs);
    abr = mag * cs; abi = mag * sn;
    const float nr = abr - 1.0f, ni = abi, den = 1.0f / (ar * ar + ai * ai);
    cr = (nr * ar + ni * ai) * den; ci = (ni * ar - nr * ai) * den;
}
constexpr int S5_X_LD = 136;
constexpr int S5_X_OFF = 0, S5_E_OFF = 128 * S5_X_LD * 2;
#define LDS_BARRIER() do { asm volatile("s_waitcnt lgkmcnt(0)" ::: "memory"); __builtin_amdgcn_s_barrier(); asm volatile("" ::: "memory"); } while (0)
#define CMAC_R(ar, ai, br, bi, cr) fmaf((ar), (br), fmaf(-(ai), (bi), (cr)))
#define CMAC_I(ar, ai, br, bi, ci) fmaf((ar), (bi), fmaf((ai), (br), (ci)))
#define CMUL_R(ar, ai, br, bi) ((ar) * (br) - (ai) * (bi))
#define CMUL_I(ar, ai, br, bi) ((ar) * (bi) + (ai) * (br))
__device__ __forceinline__ void s5_item(const Args& a, LAS unsigned char* lds, int item, int wave, int lane) {
    const int b = item >> 5, g = item & 31;
    const float dt = expf(a.in[I_LOGDT][g]);
    LAS bf16* X = (LAS bf16*)(lds + S5_X_OFF); LAS float* E = (LAS float*)(lds + S5_E_OFF);
    const int mt = wave >> 1, sh = wave & 1, l32 = lane & 31, hf = lane >> 5, p = 32 * sh + l32;
    float a1r, a1i, cr, ci; s5_disc(a.in[I_ARE], a.in[I_AIM], dt, g * 64 + p, a1r, a1i, cr, ci);
    const float a2r = CMUL_R(a1r, a1i, a1r, a1i), a2i = CMUL_I(a1r, a1i, a1r, a1i), a3r = CMUL_R(a2r, a2i, a1r, a1i), a3i = CMUL_I(a2r, a2i, a1r, a1i);
    const float a4r = CMUL_R(a2r, a2i, a2r, a2i), a4i = CMUL_I(a2r, a2i, a2r, a2i), a8r = CMUL_R(a4r, a4i, a4r, a4i), a8i = CMUL_I(a4r, a4i, a4r, a4i);
    const float a12r = CMUL_R(a8r, a8i, a4r, a4i), a12i = CMUL_I(a8r, a8i, a4r, a4i), a16r = CMUL_R(a8r, a8i, a8r, a8i), a16i = CMUL_I(a8r, a8i, a8r, a8i);
    const float a20r = CMUL_R(a16r, a16i, a4r, a4i), a20i = CMUL_I(a16r, a16i, a4r, a4i), a24r = CMUL_R(a16r, a16i, a8r, a8i), a24i = CMUL_I(a16r, a16i, a8r, a8i);
    const float a28r = CMUL_R(a24r, a24i, a4r, a4i), a28i = CMUL_I(a24r, a24i, a4r, a4i), a32r = CMUL_R(a16r, a16i, a16r, a16i), a32i = CMUL_I(a16r, a16i, a16r, a16i);
    const float pwr[4] = {a1r, a2r, a3r, a4r}, pwi[4] = {a1i, a2i, a3i, a4i};
    const float qkr[4] = {hf ? a4r : 1.0f, hf ? a12r : a8r, hf ? a20r : a16r, hf ? a28r : a24r}, qki[4] = {hf ? a4i : 0.0f, hf ? a12i : a8i, hf ? a20i : a16i, hf ? a28i : a24i};
    bf16x8 bfr_re, bfr_im;
    { const float* br = a.in[I_BRE] + (size_t)(g * 64 + p) * 16 + 8 * hf; const float* bi = a.in[I_BIM] + (size_t)(g * 64 + p) * 16 + 8 * hf;
      float vr[8], vi[8];
#pragma unroll
      for (int j = 0; j < 8; ++j) { vr[j] = cr * br[j] - ci * bi[j]; vi[j] = cr * bi[j] + ci * br[j]; }
      v4u o; o.x = pk2(vr[0], vr[1]); o.y = pk2(vr[2], vr[3]); o.z = pk2(vr[4], vr[5]); o.w = pk2(vr[6], vr[7]); bfr_re = __builtin_bit_cast(bf16x8, o);
      o.x = pk2(vi[0], vi[1]); o.y = pk2(vi[2], vi[3]); o.z = pk2(vi[4], vi[5]); o.w = pk2(vi[6], vi[7]); bfr_im = __builtin_bit_cast(bf16x8, o); }
    const int l16 = lane & 15, q4 = lane >> 4;
    bf16x8 cm[4];
#pragma unroll
    for (int ks = 0; ks < 4; ++ks) { const int s0 = 16 * ks + 4 * q4; const float* cre = a.in[I_CRE] + (size_t)(g * 16 + l16) * 64 + s0; const float* cim = a.in[I_CIM] + (size_t)(g * 16 + l16) * 64 + s0;
        v4u o; o.x = pk2(cre[0], -cim[0]); o.y = pk2(cre[1], -cim[1]); o.z = pk2(cre[2], -cim[2]); o.w = pk2(cre[3], -cim[3]); cm[ks] = __builtin_bit_cast(bf16x8, o); }
    float dsk[4];
#pragma unroll
    for (int r = 0; r < 4; ++r) dsk[r] = a.in[I_D][g * 16 + 4 * q4 + r];
    const bf16* ZS = (const bf16*)(a.ws + WS_ZS) + ((size_t)(b * 32 + g) * 8192) * 16;
    bf16* YS = (bf16*)(a.ws + WS_YS) + (size_t)b * 8192 * 512 + g * 16;
    float xinr = 0.f, xini = 0.f;
    bf16x8 ua_n = *(const bf16x8*)(ZS + (mt * 32 + l32) * 16 + hf * 8);
    v2u uu_n = *(const v2u*)(ZS + (16 * wave + l16) * 16 + 4 * q4);
    for (int ch = 0; ch < 64; ++ch) {
        const bf16x8 ua = ua_n; const v2u uu = uu_n;
        { const int cn = ch < 63 ? ch + 1 : 63; const bf16* zn = ZS + (size_t)cn * 128 * 16;
          ua_n = *(const bf16x8*)(zn + (mt * 32 + l32) * 16 + hf * 8); uu_n = *(const v2u*)(zn + (16 * wave + l16) * 16 + 4 * q4); }
        const f32x16 z16 = {0.f, 0.f, 0.f, 0.f, 0.f, 0.f, 0.f, 0.f, 0.f, 0.f, 0.f, 0.f, 0.f, 0.f, 0.f, 0.f};
        const f32x16 bre = __builtin_amdgcn_mfma_f32_32x32x16_bf16(ua, bfr_re, z16, 0, 0, 0), bim = __builtin_amdgcn_mfma_f32_32x32x16_bf16(ua, bfr_im, z16, 0, 0, 0);
        float xr[16], xi[16];
#pragma unroll
        for (int j = 0; j < 4; ++j) { xr[4 * j] = bre[4 * j]; xi[4 * j] = bim[4 * j];
#pragma unroll
            for (int i = 1; i < 4; ++i) { xr[4 * j + i] = CMAC_R(a1r, a1i, xr[4 * j + i - 1], xi[4 * j + i - 1], bre[4 * j + i]); xi[4 * j + i] = CMAC_I(a1r, a1i, xr[4 * j + i - 1], xi[4 * j + i - 1], bim[4 * j + i]); } }
        float clr[4], cli[4], ber, bei;
        { float pgr[4], pgi[4];
#pragma unroll
          for (int j = 0; j < 4; ++j) { pgr[j] = __shfl_xor(xr[4 * j + 3], 32); pgi[j] = __shfl_xor(xi[4 * j + 3], 32); }
          float cr_ = 0.f, ci_ = 0.f;
#pragma unroll
          for (int k = 0; k < 8; ++k) { const int j = k >> 1; const bool mine = (hf == (k & 1));
              if ((k & 1) == 0) { clr[j] = cr_; cli[j] = ci_; } else { clr[j] = mine ? cr_ : clr[j]; cli[j] = mine ? ci_ : cli[j]; }
              const float gr = mine ? xr[4 * j + 3] : pgr[j], gi = mine ? xi[4 * j + 3] : pgi[j];
              const float nr = CMAC_R(a4r, a4i, cr_, ci_, gr), ni = CMAC_I(a4r, a4i, cr_, ci_, gi); cr_ = nr; ci_ = ni; }
          ber = cr_; bei = ci_; }
        if (hf == 0) { E[(mt * 64 + p) * 2] = ber; E[(mt * 64 + p) * 2 + 1] = bei; }
        LDS_BARRIER();
        float mbr = 0.f, mbi = 0.f;
        { float cr_ = xinr, ci_ = xini;
#pragma unroll
          for (int m = 0; m < 4; ++m) { if (m == mt) { mbr = cr_; mbi = ci_; } const float er = E[(m * 64 + p) * 2], ei = E[(m * 64 + p) * 2 + 1];
              const float nr = CMAC_R(a32r, a32i, cr_, ci_, er), ni = CMAC_I(a32r, a32i, cr_, ci_, ei); cr_ = nr; ci_ = ni; }
          xinr = cr_; xini = ci_; }
#pragma unroll
        for (int j = 0; j < 4; ++j) { const float ckr = CMAC_R(qkr[j], qki[j], mbr, mbi, clr[j]), cki = CMAC_I(qkr[j], qki[j], mbr, mbi, cli[j]);
#pragma unroll
            for (int i = 0; i < 4; ++i) { const float fr = CMAC_R(pwr[i], pwi[i], ckr, cki, xr[4 * j + i]), fi = CMAC_I(pwr[i], pwi[i], ckr, cki, xi[4 * j + i]);
                *(LAS unsigned*)(X + (32 * mt + 8 * j + 4 * hf + i) * S5_X_LD + 2 * p) = pg8::cvt_pk_bf16(fr, fi); } }
        LDS_BARRIER();
        { f32x4 o = {0.f, 0.f, 0.f, 0.f};
#pragma unroll
          for (int ks = 0; ks < 4; ++ks) { const bf16x8 xa = *(const LAS bf16x8*)(X + (16 * wave + l16) * S5_X_LD + 32 * ks + 8 * q4); o = __builtin_amdgcn_mfma_f32_16x16x32_bf16(cm[ks], xa, o, 0, 0, 0); }
          const int t = 16 * wave + l16;
          const float y0 = gelu_t(o[0] + dsk[0] * bflo(uu.x)), y1 = gelu_t(o[1] + dsk[1] * bfhi(uu.x)), y2 = gelu_t(o[2] + dsk[2] * bflo(uu.y)), y3 = gelu_t(o[3] + dsk[3] * bfhi(uu.y));
          v2u w; w.x = pg8::cvt_pk_bf16(y0, y1); w.y = pg8::cvt_pk_bf16(y2, y3); *(v2u*)(YS + (size_t)(ch * 128 + t) * 512 + 4 * q4) = w; }
    }
    __syncthreads();
}

constexpr int SGU_RS = 1056;
typedef short v4i16_t __attribute__((ext_vector_type(4)));
__device__ __forceinline__ s16x4 ds_tr16(const LAS unsigned char* p) { return __builtin_bit_cast(s16x4, __builtin_amdgcn_ds_read_tr16_b64_v4i16((LAS v4i16_t*)p)); }
__device__ __forceinline__ void sgu_item(const Args& a, LAS unsigned char* lds, int item, int wave, int lane) {
    const bf16* ZG = (const bf16*)(a.ws + WS_ZG); bf16* Y = (bf16*)(a.ws + WS_Y); const bf16* WM = (const bf16*)(a.ws + WS_WM);
    const int r0 = item * 128;
    { float lg[8], lb[8];
#pragma unroll
      for (int j = 0; j < 8; ++j) { lg[j] = a.in[I_LNG][8 * lane + j]; lb[j] = a.in[I_LNB][8 * lane + j]; }
      v4u raw[16];
#pragma unroll
      for (int tt = 0; tt < 16; ++tt) raw[tt] = __builtin_nontemporal_load((const v4u*)(ZG + (size_t)(r0 + 16 * wave + tt) * 1024 + 512 + 8 * lane));
      float s1[16], s2[16];
#pragma unroll
      for (int tt = 0; tt < 16; ++tt) { const float f[8] = {bflo(raw[tt].x), bfhi(raw[tt].x), bflo(raw[tt].y), bfhi(raw[tt].y), bflo(raw[tt].z), bfhi(raw[tt].z), bflo(raw[tt].w), bfhi(raw[tt].w)};
          float a1 = 0.f, a2 = 0.f;
#pragma unroll
          for (int j = 0; j < 8; ++j) { a1 += f[j]; a2 += f[j] * f[j]; }
          s1[tt] = a1; s2[tt] = a2; }
#pragma unroll
      for (int o = 1; o < 64; o <<= 1) {
#pragma unroll
          for (int tt = 0; tt < 16; ++tt) { s1[tt] += __shfl_xor(s1[tt], o); s2[tt] += __shfl_xor(s2[tt], o); } }
#pragma unroll
      for (int tt = 0; tt < 16; ++tt) { const int t = 16 * wave + tt;
          float f[8] = {bflo(raw[tt].x), bfhi(raw[tt].x), bflo(raw[tt].y), bfhi(raw[tt].y), bflo(raw[tt].z), bfhi(raw[tt].z), bflo(raw[tt].w), bfhi(raw[tt].w)};
          const float mu = s1[tt] * (1.0f / 512.0f), var = fmaxf(s2[tt] * (1.0f / 512.0f) - mu * mu, 0.f), rstd = 1.0f / sqrtf(var + EPS);
#pragma unroll
          for (int j = 0; j < 8; ++j) f[j] = (f[j] - mu) * rstd * lg[j] + lb[j];
          v4u o; o.x = pk2(f[0], f[1]); o.y = pk2(f[2], f[3]); o.z = pk2(f[4], f[5]); o.w = pk2(f[6], f[7]);
          *(LAS v4u*)(lds + t * SGU_RS + 16 * lane) = o; } }
    __syncthreads();
    const int l16 = lane & 15, q4 = lane >> 4, qq = l16 >> 2, pp = l16 & 3, nks = (wave >> 1) + 1, irow = 16 * wave + l16;
    for (int h = 0; h < 4; ++h) {
        f32x4 acc[8];
#pragma unroll
        for (int nt = 0; nt < 8; ++nt) acc[nt] = (f32x4){0.f, 0.f, 0.f, 0.f};
        bf16x8 wf[4]; v2u uu[8];
#pragma unroll
        for (int ks = 0; ks < 4; ++ks) { const int kc = ks < nks ? ks : nks - 1; wf[ks] = *(const bf16x8*)(WM + ((size_t)(h * 128 + irow)) * 128 + 32 * kc + 8 * q4); }
#pragma unroll
        for (int nt = 0; nt < 8; ++nt) uu[nt] = __builtin_nontemporal_load((const v2u*)(ZG + (size_t)(r0 + irow) * 1024 + h * 128 + 16 * nt + 4 * q4));
        const float bs = a.in[I_BS][h * 128 + irow];
#pragma unroll
        for (int ks = 0; ks < 4; ++ks) { if (ks < nks) {
            const LAS unsigned char* vb = lds + (32 * ks + 8 * q4 + qq) * SGU_RS + (h * 128 + 4 * pp) * 2;
#pragma unroll
            for (int nt = 0; nt < 8; ++nt) { const s16x4 lo = ds_tr16(vb + nt * 32), hi = ds_tr16(vb + nt * 32 + 4 * SGU_RS);
                const bf16x8 vf = {lo[0], lo[1], lo[2], lo[3], hi[0], hi[1], hi[2], hi[3]};
                acc[nt] = __builtin_amdgcn_mfma_f32_16x16x32_bf16(vf, wf[ks], acc[nt], 0, 0, 0); } } }
#pragma unroll
        for (int nt = 0; nt < 8; ++nt) { const size_t o = (size_t)(r0 + irow) * 1024 + h * 128 + 16 * nt + 4 * q4;
            v2u w; w.x = pk2(bflo(uu[nt].x) * (acc[nt][0] + bs), bfhi(uu[nt].x) * (acc[nt][1] + bs)); w.y = pk2(bflo(uu[nt].y) * (acc[nt][2] + bs), bfhi(uu[nt].y) * (acc[nt][3] + bs)); *(v2u*)(Y + o) = w; }
    }
    __syncthreads();
}
__device__ __forceinline__ int f2i(float f) { return __builtin_bit_cast(int, f); }
__device__ __forceinline__ float i2f(int i) { return __builtin_bit_cast(float, i); }
__device__ __forceinline__ float kmax(float a, float b) { float r; asm("v_max_f32 %0, %1, %2" : "=v"(r) : "v"(a), "v"(b)); return r; }
__device__ __forceinline__ float kmin(float a, float b) { float r; asm("v_min_f32 %0, %1, %2" : "=v"(r) : "v"(a), "v"(b)); return r; }
__device__ __forceinline__ float mkkey(float s, int keep, int payload) { return i2f((f2i(s) & keep) | payload); }
__device__ __forceinline__ void sort16(float (&v)[16]) {
#define CE16(i, j) { const float x_ = v[i], y_ = v[j]; v[i] = kmax(x_, y_); v[j] = kmin(x_, y_); }
    CE16(0,1) CE16(2,3) CE16(0,2) CE16(1,3) CE16(1,2) CE16(4,5) CE16(6,7) CE16(4,6) CE16(5,7) CE16(5,6) CE16(0,4) CE16(2,6) CE16(2,4) CE16(1,5) CE16(3,7) CE16(3,5) CE16(1,2) CE16(3,4) CE16(5,6) CE16(8,9) CE16(10,11) CE16(8,10) CE16(9,11) CE16(9,10) CE16(12,13) CE16(14,15) CE16(12,14) CE16(13,15) CE16(13,14) CE16(8,12) CE16(10,14) CE16(10,12) CE16(9,13) CE16(11,15) CE16(11,13) CE16(9,10) CE16(11,12) CE16(13,14) CE16(0,8) CE16(4,12) CE16(4,8) CE16(2,10) CE16(6,14) CE16(6,10) CE16(2,4) CE16(6,8) CE16(10,12) CE16(1,9) CE16(5,13) CE16(5,9) CE16(3,11) CE16(7,15) CE16(7,11) CE16(3,5) CE16(7,9) CE16(11,13) CE16(1,2) CE16(3,4) CE16(5,6) CE16(7,8) CE16(9,10) CE16(11,12) CE16(13,14)
#undef CE16
}
__device__ __forceinline__ void merge16(float (&a)[16], const float (&b)[16]) {
#pragma unroll
    for (int i = 0; i < 16; ++i) a[i] = kmax(a[i], b[15 - i]);
#pragma unroll
    for (int j = 8; j > 0; j >>= 1)
#pragma unroll
        for (int i = 0; i < 16; ++i) { const int l = i ^ j; if (l > i) { const float x = a[i], y = a[l]; a[i] = kmax(x, y); a[l] = kmin(x, y); } }
}
constexpr int NCAND = 50;
constexpr int cand_a(int n) { int c = 0; for (int a = 0; a < 16; ++a) for (int b = 0; b < 16; ++b) if ((a + 1) * (b + 1) <= 16) { if (c == n) return a; ++c; } return 0; }
constexpr int cand_b(int n) { int c = 0; for (int a = 0; a < 16; ++a) for (int b = 0; b < 16; ++b) if ((a + 1) * (b + 1) <= 16) { if (c == n) return b; ++c; } return 0; }
template <int N> struct CandAB { static constexpr int a = cand_a(N), b = cand_b(N); };
template <int S> __device__ __forceinline__ float cand_key2(const float (&f1)[16], const float (&f2)[16], bool hf) {
    if constexpr (S < 25) { constexpr int a0 = CandAB<S>::a, b0 = CandAB<S>::b, a1 = CandAB<25 + S>::a, b1 = CandAB<25 + S>::b;
        const float s = (hf ? f1[a1] : f1[a0]) + (hf ? f2[b1] : f2[b0]); return mkkey(s, ~0xff, hf ? ((a1 << 4) | b1) : ((a0 << 4) | b0)); }
    else return i2f((int)0xff800000);
}
template <int G> __device__ __forceinline__ void cand_fill2(float (&v)[16], const float (&f1)[16], const float (&f2)[16], bool hf) {
    v[0] = cand_key2<G * 16 + 0>(f1, f2, hf); v[1] = cand_key2<G * 16 + 1>(f1, f2, hf); v[2] = cand_key2<G * 16 + 2>(f1, f2, hf); v[3] = cand_key2<G * 16 + 3>(f1, f2, hf);
    v[4] = cand_key2<G * 16 + 4>(f1, f2, hf); v[5] = cand_key2<G * 16 + 5>(f1, f2, hf); v[6] = cand_key2<G * 16 + 6>(f1, f2, hf); v[7] = cand_key2<G * 16 + 7>(f1, f2, hf);
    v[8] = cand_key2<G * 16 + 8>(f1, f2, hf); v[9] = cand_key2<G * 16 + 9>(f1, f2, hf); v[10] = cand_key2<G * 16 + 10>(f1, f2, hf); v[11] = cand_key2<G * 16 + 11>(f1, f2, hf);
    v[12] = cand_key2<G * 16 + 12>(f1, f2, hf); v[13] = cand_key2<G * 16 + 13>(f1, f2, hf); v[14] = cand_key2<G * 16 + 14>(f1, f2, hf); v[15] = cand_key2<G * 16 + 15>(f1, f2, hf);
}

__device__ __forceinline__ void peer_topk32(const bf16* Q, const bf16* KEYS, unsigned short* EO, float* GO, LAS unsigned char* wl  , int tok0, int lane) {
    const int l32 = lane & 31, hf = lane >> 5; const size_t tok = (size_t)tok0 + l32;
    const bf16* qrow = Q + tok * 1024 + hf * 8; const bf16* krow = KEYS + (size_t)l32 * 64 + hf * 8;
    bf16x8 bq[4], bqn[4], akn[4];
#pragma unroll
    for (int ks = 0; ks < 4; ++ks) { bq[ks] = __builtin_nontemporal_load((const bf16x8*)(qrow + ks * 16)); akn[ks] = *(const bf16x8*)(krow + ks * 16); }
    for (int h = 0; h < 8; ++h) {
        float L0[16], L1[16];
#pragma unroll
        for (int c = 0; c < 2; ++c) {
            const int hc = 2 * h + c, hn = hc < 15 ? hc + 1 : 15;
#pragma unroll
            for (int ks = 0; ks < 4; ++ks) bqn[ks] = __builtin_nontemporal_load((const bf16x8*)(qrow + hn * 64 + ks * 16));
            float T[16], S[16];
            { f32x16 acc = (f32x16){0.f, 0.f, 0.f, 0.f, 0.f, 0.f, 0.f, 0.f, 0.f, 0.f, 0.f, 0.f, 0.f, 0.f, 0.f, 0.f};
              const bf16x8 ak0 = akn[0], ak1 = akn[1], ak2 = akn[2], ak3 = akn[3];
              { const bf16* kn = krow + (size_t)(hc * 4 + 1) * (32 * 64);
#pragma unroll
                for (int ks = 0; ks < 4; ++ks) akn[ks] = *(const bf16x8*)(kn + ks * 16); }
              acc = __builtin_amdgcn_mfma_f32_32x32x16_bf16(ak0, bq[0], acc, 0, 0, 0); acc = __builtin_amdgcn_mfma_f32_32x32x16_bf16(ak1, bq[1], acc, 0, 0, 0);
              acc = __builtin_amdgcn_mfma_f32_32x32x16_bf16(ak2, bq[2], acc, 0, 0, 0); acc = __builtin_amdgcn_mfma_f32_32x32x16_bf16(ak3, bq[3], acc, 0, 0, 0);
#pragma unroll
              for (int r = 0; r < 16; ++r) T[r] = mkkey(acc[r], ~0x7f, 8 * (r >> 2) + 4 * hf + (r & 3));
              sort16(T); }
            for (int mt = 1; mt < 4; ++mt) {
                f32x16 acc = (f32x16){0.f, 0.f, 0.f, 0.f, 0.f, 0.f, 0.f, 0.f, 0.f, 0.f, 0.f, 0.f, 0.f, 0.f, 0.f, 0.f};
                const bf16x8 ak0 = akn[0], ak1 = akn[1], ak2 = akn[2], ak3 = akn[3];
                { const int tn = hc * 4 + mt + 1; const bf16* kn = krow + (size_t)(tn < 64 ? tn : 63) * (32 * 64);
#pragma unroll
                  for (int ks = 0; ks < 4; ++ks) akn[ks] = *(const bf16x8*)(kn + ks * 16); }
                acc = __builtin_amdgcn_mfma_f32_32x32x16_bf16(ak0, bq[0], acc, 0, 0, 0); acc = __builtin_amdgcn_mfma_f32_32x32x16_bf16(ak1, bq[1], acc, 0, 0, 0);
                acc = __builtin_amdgcn_mfma_f32_32x32x16_bf16(ak2, bq[2], acc, 0, 0, 0); acc = __builtin_amdgcn_mfma_f32_32x32x16_bf16(ak3, bq[3], acc, 0, 0, 0);
#pragma unroll
                for (int r = 0; r < 16; ++r) S[r] = mkkey(acc[r], ~0x7f, mt * 32 + 8 * (r >> 2) + 4 * hf + (r & 3));
                sort16(S); merge16(T, S); }
#pragma unroll
            for (int ks = 0; ks < 4; ++ks) bq[ks] = bqn[ks];
#pragma unroll
            for (int r = 0; r < 16; ++r) S[r] = __shfl_xor(T[r], 32);
            merge16(T, S);
            if (c == 0) {
#pragma unroll
                for (int r = 0; r < 16; ++r) L0[r] = T[r];
            } else {
#pragma unroll
                for (int r = 0; r < 16; ++r) L1[r] = T[r];
            }
        }
        float f1[16], f2[16];
#pragma unroll
        for (int r = 0; r < 16; ++r) { const int k0 = f2i(L0[r]), k1 = f2i(L1[r]); f1[r] = i2f(k0 & ~0x7f); f2[r] = i2f(k1 & ~0x7f); wl[lane * 36 + r] = (unsigned char)(k0 & 0x7f); wl[lane * 36 + 16 + r] = (unsigned char)(k1 & 0x7f); }
        float K[16], S2[16];
        cand_fill2<0>(K, f1, f2, hf != 0); sort16(K);
        cand_fill2<1>(S2, f1, f2, hf != 0); sort16(S2); merge16(K, S2);
#pragma unroll
        for (int r = 0; r < 16; ++r) S2[r] = __shfl_xor(K[r], 32);
        merge16(K, S2);
        float pe[16], ssum = 0.f; const float mx = i2f(f2i(K[0]) & ~0xff);
#pragma unroll
        for (int r = 0; r < 16; ++r) { pe[r] = __expf(i2f(f2i(K[r]) & ~0xff) - mx); ssum += pe[r]; }
        const float inv = 1.0f / ssum;
        int ev[16]; float gv[16];
#pragma unroll
        for (int j = 0; j < 16; ++j) { const int ab = f2i(K[j]) & 0xff; const int i1 = wl[lane * 36 + (ab >> 4)], i2 = wl[lane * 36 + 16 + (ab & 15)]; ev[j] = i1 * 128 + i2; gv[j] = pe[j] * inv; }
        if (hf == 0) { unsigned short* ed = EO + (tok * 8 + h) * 16; float* gd = GO + (tok * 8 + h) * 16;
            *(v4u*)(ed) = (v4u){(unsigned)ev[0] | ((unsigned)ev[1] << 16), (unsigned)ev[2] | ((unsigned)ev[3] << 16), (unsigned)ev[4] | ((unsigned)ev[5] << 16), (unsigned)ev[6] | ((unsigned)ev[7] << 16)};
            *(v4u*)(ed + 8) = (v4u){(unsigned)ev[8] | ((unsigned)ev[9] << 16), (unsigned)ev[10] | ((unsigned)ev[11] << 16), (unsigned)ev[12] | ((unsigned)ev[13] << 16), (unsigned)ev[14] | ((unsigned)ev[15] << 16)};
#pragma unroll
            for (int j = 0; j < 4; ++j) *(f32x4*)(gd + 4 * j) = (f32x4){gv[4 * j], gv[4 * j + 1], gv[4 * j + 2], gv[4 * j + 3]}; }
    }
}

typedef float f32x2_t __attribute__((ext_vector_type(2)));
typedef _Float16 h2_t __attribute__((ext_vector_type(2)));
__device__ __forceinline__ h2_t as_h2(unsigned u) { return __builtin_bit_cast(h2_t, u); }
template <bool HI> __device__ __forceinline__ h2_t cvt_h2_fp8(unsigned d) { const auto t = __builtin_amdgcn_cvt_scalef32_pk_f16_fp8((int)d, 1.0f, HI); return __builtin_bit_cast(h2_t, t); }
typedef int v4i __attribute__((ext_vector_type(4)));
__device__ __forceinline__ void cvt8x2(v4u r, f32x2_t (&f)[8]) {
    const unsigned w0 = r.x, w1 = r.y, w2 = r.z, w3 = r.w;
    f[0] = __builtin_amdgcn_cvt_pk_f32_fp8((int)w0, false); f[1] = __builtin_amdgcn_cvt_pk_f32_fp8((int)w0, true);
    f[2] = __builtin_amdgcn_cvt_pk_f32_fp8((int)w1, false); f[3] = __builtin_amdgcn_cvt_pk_f32_fp8((int)w1, true);
    f[4] = __builtin_amdgcn_cvt_pk_f32_fp8((int)w2, false); f[5] = __builtin_amdgcn_cvt_pk_f32_fp8((int)w2, true);
    f[6] = __builtin_amdgcn_cvt_pk_f32_fp8((int)w3, false); f[7] = __builtin_amdgcn_cvt_pk_f32_fp8((int)w3, true);
}
__device__ __forceinline__ void load_elist(const unsigned short* E, size_t tok, int h, int (&e)[16]) {
    const v4u* ep = (const v4u*)(E + tok * 128 + h * 16);
#pragma unroll
    for (int i = 0; i < 2; ++i) { const v4u v = ep[i]; const unsigned w[4] = {v.x, v.y, v.z, v.w};
#pragma unroll
        for (int c = 0; c < 4; ++c) { e[8 * i + 2 * c] = (int)(w[c] & 0xffffu); e[8 * i + 2 * c + 1] = (int)(w[c] >> 16); } }
}
__device__ __forceinline__ void issue_rows(v4u (&r)[16], const unsigned char* tb, unsigned poff, const int (&e)[16]) {
#pragma unroll
    for (int k = 0; k < 16; ++k) r[k] = *(const v4u*)(tb + ((unsigned)e[k] * 128u + poff));
}
template <int B2, int B1, int B0> __device__ __forceinline__ void treduce16(const float (&v)[16], int lane, float& o0, float& o1) {
    float q8[8], q4[4];
    { const bool hi = (lane & B2) != 0;
#pragma unroll
      for (int i = 0; i < 8; ++i) { const float keep = hi ? v[i + 8] : v[i], send = hi ? v[i] : v[i + 8]; q8[i] = keep + __shfl_xor(send, B2); } }
    { const bool hi = (lane & B1) != 0;
#pragma unroll
      for (int i = 0; i < 4; ++i) { const float keep = hi ? q8[i + 4] : q8[i], send = hi ? q8[i] : q8[i + 4]; q4[i] = keep + __shfl_xor(send, B1); } }
    { const bool hi = (lane & B0) != 0;
      { const float keep = hi ? q4[2] : q4[0], send = hi ? q4[0] : q4[2]; o0 = keep + __shfl_xor(send, B0); }
      { const float keep = hi ? q4[3] : q4[1], send = hi ? q4[1] : q4[3]; o1 = keep + __shfl_xor(send, B0); } }
}
__device__ __forceinline__ void treduce16i_p(const int (&v)[16], int lane, int& o0, int& o1) {
    int q8[8], q4[4];
    { const bool hi = (lane & 4) != 0;
#pragma unroll
      for (int i = 0; i < 8; ++i) { const int keep = hi ? v[i + 8] : v[i], send = hi ? v[i] : v[i + 8]; q8[i] = keep + __builtin_amdgcn_update_dpp(0, send, 0x141, 0xF, 0xF, false); } }
    { const bool hi = (lane & 2) != 0;
#pragma unroll
      for (int i = 0; i < 4; ++i) { const int keep = hi ? q8[i + 4] : q8[i], send = hi ? q8[i] : q8[i + 4]; q4[i] = keep + __builtin_amdgcn_update_dpp(0, send, 0x4E, 0xF, 0xF, false); } }
    { const bool hi = (lane & 1) != 0;
      { const int keep = hi ? q4[2] : q4[0], send = hi ? q4[0] : q4[2]; o0 = keep + __builtin_amdgcn_update_dpp(0, send, 0xB1, 0xF, 0xF, false); }
      { const int keep = hi ? q4[3] : q4[1], send = hi ? q4[1] : q4[3]; o1 = keep + __builtin_amdgcn_update_dpp(0, send, 0xB1, 0xF, 0xF, false); } }
}
__device__ __forceinline__ void treduce16f_h(const float (&v)[16], int lane, float& o0, float& o1) {
    float q8[8], q4[4];
    { const bool hi = (lane & 8) != 0;
#pragma unroll
      for (int i = 0; i < 8; ++i) { const float keep = hi ? v[i + 8] : v[i], send = hi ? v[i] : v[i + 8];
          q8[i] = keep + __builtin_bit_cast(float, __builtin_amdgcn_update_dpp(0, __builtin_bit_cast(int, send), 0x128, 0xF, 0xF, false)); } }
    { const bool hi = (lane & 16) != 0;
#pragma unroll
      for (int i = 0; i < 4; ++i) { const float keep = hi ? q8[i + 4] : q8[i], send = hi ? q8[i] : q8[i + 4];
          q4[i] = keep + __builtin_bit_cast(float, __builtin_amdgcn_ds_swizzle(__builtin_bit_cast(int, send), 0x401F)); } }
    { const bool hi = (lane & 32) != 0;
      { const float keep = hi ? q4[2] : q4[0], send = hi ? q4[0] : q4[2]; o0 = keep + __shfl_xor(send, 32); }
      { const float keep = hi ? q4[3] : q4[1], send = hi ? q4[1] : q4[3]; o1 = keep + __shfl_xor(send, 32); } }
}
__device__ __forceinline__ void upass_compute(const v4u (&r)[16], v4u hq, short* pa, int lane, v4u (&rn)[16], const unsigned char* tb, unsigned poff, const int (&en)[16]) {
    int part[16];
#pragma unroll
    for (int k = 0; k < 16; ++k) { rn[k] = *(const v4u*)(tb + ((unsigned)en[k] * 128u + poff));
        int s = __builtin_amdgcn_sdot4((int)r[k].x, (int)hq.x, 0, false); s = __builtin_amdgcn_sdot4((int)r[k].y, (int)hq.y, s, false); s = __builtin_amdgcn_sdot4((int)r[k].z, (int)hq.z, s, false); part[k] = __builtin_amdgcn_sdot4((int)r[k].w, (int)hq.w, s, false);
        __builtin_amdgcn_sched_barrier(0); }
    int o0, o1; treduce16i_p(part, lane, o0, o1);
    *(unsigned*)(pa + (lane >> 3) * 16 + 2 * (lane & 7)) = (unsigned)(((o0 + 32) >> 6) & 0xffff) | ((unsigned)((o1 + 32) >> 6) << 16);
}
__device__ __forceinline__ void vpass_compute(const v4u (&r)[16], const v4u (&wp)[2], bf16* xo  , const float* gt  , int lane, v4u (&rn)[16], const unsigned char* tb, unsigned poff, const int (&en)[16]) {
    h2_t o2[8];
#pragma unroll
    for (int i = 0; i < 8; ++i) o2[i] = (h2_t){(_Float16)0.f, (_Float16)0.f};
    const unsigned wq[8] = {wp[0].x, wp[0].y, wp[0].z, wp[0].w, wp[1].x, wp[1].y, wp[1].z, wp[1].w};
#pragma unroll
    for (int k = 0; k < 16; ++k) { rn[k] = *(const v4u*)(tb + ((unsigned)en[k] * 128u + poff));
        const unsigned d0 = r[k].x, d1 = r[k].y, d2 = r[k].z, d3 = r[k].w; const h2_t wpair = as_h2(wq[k >> 1]); const _Float16 wh = (k & 1) ? wpair.y : wpair.x; const h2_t ww = {wh, wh};
        o2[0] = __builtin_elementwise_fma(cvt_h2_fp8<false>(d0), ww, o2[0]); o2[1] = __builtin_elementwise_fma(cvt_h2_fp8<true>(d0), ww, o2[1]);
        o2[2] = __builtin_elementwise_fma(cvt_h2_fp8<false>(d1), ww, o2[2]); o2[3] = __builtin_elementwise_fma(cvt_h2_fp8<true>(d1), ww, o2[3]);
        o2[4] = __builtin_elementwise_fma(cvt_h2_fp8<false>(d2), ww, o2[4]); o2[5] = __builtin_elementwise_fma(cvt_h2_fp8<true>(d2), ww, o2[5]);
        o2[6] = __builtin_elementwise_fma(cvt_h2_fp8<false>(d3), ww, o2[6]); o2[7] = __builtin_elementwise_fma(cvt_h2_fp8<true>(d3), ww, o2[7]);
        __builtin_amdgcn_sched_barrier(0); }
    float v[16];
#pragma unroll
    for (int i = 0; i < 8; ++i) { v[2 * i] = (float)o2[i].x * (1.0f / 64.0f); v[2 * i + 1] = (float)o2[i].y * (1.0f / 64.0f); }
    float o0, o1; treduce16f_h(v, lane, o0, o1);
    const int c = 16 * (lane & 7) + 2 * (((lane >> 1) & 4) | ((lane >> 3) & 2) | ((lane >> 5) & 1));
    const unsigned xb = *(const unsigned*)(xo + c); const f32x2_t g = *(const f32x2_t*)(gt + c);
    const float a0 = bflo(xb) + g.x * o0, a1 = bfhi(xb) + g.y * o1;
    const unsigned ob = pk2(a0, a1);
    *(unsigned*)(xo + c) = ob;
}
template <bool UP> __device__ __forceinline__ void peer_pass(const Args& a, int wave, int lane_in) {
    int lane = lane_in; asm volatile("" : "+v"(lane));
    const int G = gridDim.x, bx = blockIdx.x;
    const bool sliced = (G % 8) == 0;
    const int nj = sliced ? 1 : 8, j0 = sliced ? (bx & 7) : 0;
    const int first = sliced ? ((bx >> 3) * NWAVES + wave) : (bx * NWAVES + wave), stride = sliced ? (G >> 3) * NWAVES : G * NWAVES;
    const int h = lane >> 3, p = lane & 7;
    const unsigned short* E = (const unsigned short*)(a.ws + WS_E); const unsigned char* HQ = a.ws + WS_H2Q; const _Float16* W = (const _Float16*)(a.ws + WS_W);
    short* PA = (short*)(a.ws + WS_PA); const float* MOD = (const float*)(a.ws + WS_MOD);
    const unsigned char* T8 = a.ws + (UP ? WS_UB : WS_VB);
    const int ntok = (M - first + stride - 1) / stride;
    for (int jj = 0; jj < nj; ++jj) { const int j = j0 + jj;
        const unsigned char* tb = T8 + (size_t)j * (16384 * 128);
        v4u RA[16], RB[16]; int en[16], en2[16];
        v4u hA0, hB0; v4u wA[2], wB[2];
        { const size_t t0 = (size_t)first; int e0[16]; load_elist(E, t0, h, e0); issue_rows(RA, tb, 16u * p, e0);
          if (UP) { hA0 = *(const v4u*)(HQ + t0 * 1024 + 128 * j + 16 * p); }
          else { wA[0] = *(const v4u*)(W + t0 * 128 + h * 16); wA[1] = *(const v4u*)(W + t0 * 128 + h * 16 + 8); }
          const size_t t1 = (size_t)first + (size_t)(ntok > 1 ? 1 : 0) * stride; load_elist(E, t1, h, en); }
        for (int u = 0; u < ntok; u += 2) {
            { const int u1 = (u + 1 < ntok) ? u + 1 : ntok - 1, u2 = (u + 2 < ntok) ? u + 2 : ntok - 1; const size_t t1 = (size_t)first + (size_t)u1 * stride, t2 = (size_t)first + (size_t)u2 * stride;
              load_elist(E, t2, h, en2);
              if (UP) { hB0 = *(const v4u*)(HQ + t1 * 1024 + 128 * j + 16 * p); }
              else { wB[0] = *(const v4u*)(W + t1 * 128 + h * 16); wB[1] = *(const v4u*)(W + t1 * 128 + h * 16 + 8); }
              const size_t t = (size_t)first + (size_t)u * stride;
              if (UP) upass_compute(RA, hA0, PA + ((size_t)j * M + t) * 128, lane, RB, tb, 16u * p, en);
              else vpass_compute(RA, wA, (bf16*)(a.ws + WS_X1B) + t * 1024 + 128 * j, MOD + (t >> 13) * NMODC + 5120 + 128 * j, lane, RB, tb, 16u * p, en); }
            if (u + 1 >= ntok) break;
            { const int u1 = (u + 2 < ntok) ? u + 2 : ntok - 1, u2 = (u + 3 < ntok) ? u + 3 : ntok - 1; const size_t t1 = (size_t)first + (size_t)u1 * stride, t2 = (size_t)first + (size_t)u2 * stride;
              load_elist(E, t2, h, en);
              if (UP) { hA0 = *(const v4u*)(HQ + t1 * 1024 + 128 * j + 16 * p); }
              else { wA[0] = *(const v4u*)(W + t1 * 128 + h * 16); wA[1] = *(const v4u*)(W + t1 * 128 + h * 16 + 8); }
              const size_t t = (size_t)first + (size_t)(u + 1) * stride;
              if (UP) upass_compute(RB, hB0, PA + ((size_t)j * M + t) * 128, lane, RA, tb, 16u * p, en2);
              else vpass_compute(RB, wB, (bf16*)(a.ws + WS_X1B) + t * 1024 + 128 * j, MOD + (t >> 13) * NMODC + 5120 + 128 * j, lane, RA, tb, 16u * p, en2); }
        }
    }
}
__device__ __forceinline__ void upass4(const Args& a, int wave, int lane_in) {
    int lane = lane_in; asm volatile("" : "+v"(lane));
    const int G = gridDim.x, bx = blockIdx.x;
    const bool sliced = (G % 8) == 0;
    const int nj = sliced ? 1 : 8, j0 = sliced ? (bx & 7) : 0;
    const int first = sliced ? ((bx >> 3) * NWAVES + wave) : (bx * NWAVES + wave), stride = sliced ? (G >> 3) * NWAVES : G * NWAVES;
    const int r = lane >> 2, p = lane & 3;
    const unsigned short* E = (const unsigned short*)(a.ws + WS_E); const unsigned char* HQh = a.ws + WS_H2Q; const unsigned char* HQl = a.ws + WS_H2Q + (size_t)32 * MiB; short* PA = (short*)(a.ws + WS_PA);
    const int ntok = (M - first + stride - 1) / stride;
    const int eoff = (r >> 1) * 16 + 8 * (r & 1);
    for (int jj = 0; jj < nj; ++jj) { const int j = j0 + jj;
        const unsigned char* tb = a.ws + WS_UB + (size_t)j * (16384 * 64);
        const unsigned poff = 16u * p;
        v4u R0[8], R1[8], R2[8], R3[8], hh0, hl0, hh1, hl1, hh2, hl2, hh3, hl3, eA, eB;
#define U4_ROWS(R, ev) do { const unsigned w_[4] = {ev.x, ev.y, ev.z, ev.w}; _Pragma("unroll") for (int c_ = 0; c_ < 4; ++c_) { R[2 * c_] = *(const v4u*)(tb + ((w_[c_] & 0xffffu) * 64u + poff)); R[2 * c_ + 1] = *(const v4u*)(tb + ((w_[c_] >> 16) * 64u + poff)); } } while (0)
#define U4_COMPUTE(R, hh, hl, t) do { int part[8]; _Pragma("unroll") for (int i_ = 0; i_ < 8; ++i_) { \
            int sh_ = __builtin_amdgcn_sdot8((int)R[i_].x, (int)hh.x, 0, false); sh_ = __builtin_amdgcn_sdot8((int)R[i_].y, (int)hh.y, sh_, false); sh_ = __builtin_amdgcn_sdot8((int)R[i_].z, (int)hh.z, sh_, false); sh_ = __builtin_amdgcn_sdot8((int)R[i_].w, (int)hh.w, sh_, false); \
            int sl_ = __builtin_amdgcn_sdot8((int)R[i_].x, (int)hl.x, 0, false); sl_ = __builtin_amdgcn_sdot8((int)R[i_].y, (int)hl.y, sl_, false); sl_ = __builtin_amdgcn_sdot8((int)R[i_].z, (int)hl.z, sl_, false); sl_ = __builtin_amdgcn_sdot8((int)R[i_].w, (int)hl.w, sl_, false); \
            part[i_] = 16 * sh_ + sl_; } \
        int q4_[4]; { const bool hi_ = (lane & 2) != 0; _Pragma("unroll") for (int i_ = 0; i_ < 4; ++i_) { const int keep_ = hi_ ? part[i_ + 4] : part[i_], send_ = hi_ ? part[i_] : part[i_ + 4]; q4_[i_] = keep_ + __builtin_amdgcn_update_dpp(0, send_, 0x4E, 0xF, 0xF, false); } } \
        int o0_, o1_; { const bool hi_ = (lane & 1) != 0; { const int keep_ = hi_ ? q4_[2] : q4_[0], send_ = hi_ ? q4_[0] : q4_[2]; o0_ = keep_ + __builtin_amdgcn_update_dpp(0, send_, 0xB1, 0xF, 0xF, false); } \
            { const int keep_ = hi_ ? q4_[3] : q4_[1], send_ = hi_ ? q4_[1] : q4_[3]; o1_ = keep_ + __builtin_amdgcn_update_dpp(0, send_, 0xB1, 0xF, 0xF, false); } } \
        *(unsigned*)(PA + ((size_t)j * M + (t)) * 128 + eoff + 2 * p) = (unsigned)(((o0_ + 2) >> 2) & 0xffff) | ((unsigned)((o1_ + 2) >> 2) << 16); } while (0)
#define U4_TOK(u_) ((size_t)first + (size_t)((u_) < ntok ? (u_) : ntok - 1) * stride)
#define U4_E(ev, u_) do { ev = *(const v4u*)(E + U4_TOK(u_) * 128 + eoff); } while (0)
#define U4_H(hh, hl, u_) do { const size_t t_ = U4_TOK(u_); hh = *(const v4u*)(HQh + t_ * 512 + 64 * j + poff); hl = *(const v4u*)(HQl + t_ * 512 + 64 * j + poff); } while (0)
        { v4u e0, e1, e2; U4_E(e0, 0); U4_E(e1, 1); U4_E(e2, 2); U4_E(eA, 3);
          U4_H(hh0, hl0, 0); U4_ROWS(R0, e0); U4_H(hh1, hl1, 1); U4_ROWS(R1, e1); U4_H(hh2, hl2, 2); U4_ROWS(R2, e2); }
        for (int u = 0; u < ntok; u += 4) {
            U4_E(eB, u + 4); U4_H(hh3, hl3, u + 3); U4_ROWS(R3, eA); U4_COMPUTE(R0, hh0, hl0, U4_TOK(u));
            if (u + 1 >= ntok) break;
            U4_E(eA, u + 5); U4_H(hh0, hl0, u + 4); U4_ROWS(R0, eB); U4_COMPUTE(R1, hh1, hl1, U4_TOK(u + 1));
            if (u + 2 >= ntok) break;
            U4_E(eB, u + 6); U4_H(hh1, hl1, u + 5); U4_ROWS(R1, eA); U4_COMPUTE(R2, hh2, hl2, U4_TOK(u + 2));
            if (u + 3 >= ntok) break;
            U4_E(eA, u + 7); U4_H(hh2, hl2, u + 6); U4_ROWS(R2, eB); U4_COMPUTE(R3, hh3, hl3, U4_TOK(u + 3));
        }
#undef U4_TOK
#undef U4_E
#undef U4_H
#undef U4_ROWS
#undef U4_COMPUTE
    }
}
typedef long i64_t;
typedef int v2i_t __attribute__((ext_vector_type(2)));
__device__ __forceinline__ i64_t ds_tr8(const LAS unsigned char* p) { const v2i_t r = __builtin_amdgcn_ds_read_tr8_b64_v2i32((LAS v2i_t*)p); return (i64_t)(unsigned)r.x | ((i64_t)(unsigned)r.y << 32); }
__device__ __forceinline__ void vpass_mfma(const Args& a, LAS unsigned char* lds, int wave, int lane_in) {
    int lane = lane_in; asm volatile("" : "+v"(lane));
    const int G = gridDim.x, bx = blockIdx.x;
    const bool sliced = (G % 8) == 0;
    const int nj = sliced ? 1 : 8, j0 = sliced ? (bx & 7) : 0;
    const int first = sliced ? ((bx >> 3) * NWAVES + wave) : (bx * NWAVES + wave), stride = sliced ? (G >> 3) * NWAVES : G * NWAVES;
    const int r = lane >> 2, p4 = lane & 3, n16 = lane & 15, qp = lane >> 4;
    const unsigned short* E = (const unsigned short*)(a.ws + WS_E); const unsigned char* W8 = a.ws + WS_W; const float* MOD = (const float*)(a.ws + WS_MOD);
    LAS unsigned char* slot = lds + wave * 16384;
    const int ntok = (M - first + stride - 1) / stride;
    const int eoff = (r >> 1) * 16 + 8 * (r & 1);
    const int wbase = (8 * r) * 128, hk = (r >> 2) & 1;
    const int rkey = (n16 >> 1) ^ (qp & 1), rbase = (32 * qp + (n16 >> 1)) * 128 + 8 * (n16 & 1);
    const bool even = (n16 & 1) == 0; const int ccol = 32 * qp + (even ? n16 : 15 + n16);
    for (int jj = 0; jj < nj; ++jj) { const int j = j0 + jj;
        const unsigned char* tb = a.ws + WS_VB + (size_t)j * (16384 * 128);
        const unsigned poff = 32u * p4;
        v4u RA[16], RB[16], wA, wB, en, en2;
#define VM_ROWS(R, ev) do { const unsigned w_[4] = {ev.x, ev.y, ev.z, ev.w}; _Pragma("unroll") for (int c_ = 0; c_ < 4; ++c_) { \
            const unsigned char* r0_ = tb + ((w_[c_] & 0xffffu) * 128u + poff); const unsigned char* r1_ = tb + ((w_[c_] >> 16) * 128u + poff); \
            R[4 * c_] = *(const v4u*)r0_; R[4 * c_ + 1] = *(const v4u*)(r0_ + 16); R[4 * c_ + 2] = *(const v4u*)r1_; R[4 * c_ + 3] = *(const v4u*)(r1_ + 16); } } while (0)
#define VM_W(wv, t) do { wv = *(const v4u*)(W8 + (size_t)(t) * 128 + 32 * qp + 16 * (n16 & 1)); } while (0)
#define VM_COMPUTE(R, wv, t) do { \
        _Pragma("unroll") for (int i_ = 0; i_ < 8; ++i_) { const int k_ = (i_ & 7) ^ hk; *(LAS v4u*)(slot + wbase + i_ * 128 + 16 * ((2 * p4) ^ k_)) = R[2 * i_]; *(LAS v4u*)(slot + wbase + i_ * 128 + 16 * ((2 * p4 + 1) ^ k_)) = R[2 * i_ + 1]; } \
        unsigned wq_[8]; { const unsigned o0_ = (unsigned)__builtin_amdgcn_update_dpp(0, (int)wv.x, 0xB1, 0xF, 0xF, false), o1_ = (unsigned)__builtin_amdgcn_update_dpp(0, (int)wv.y, 0xB1, 0xF, 0xF, false), \
              o2_ = (unsigned)__builtin_amdgcn_update_dpp(0, (int)wv.z, 0xB1, 0xF, 0xF, false), o3_ = (unsigned)__builtin_amdgcn_update_dpp(0, (int)wv.w, 0xB1, 0xF, 0xF, false); \
          wq_[0] = even ? wv.x : o0_; wq_[1] = even ? wv.y : o1_; wq_[2] = even ? wv.z : o2_; wq_[3] = even ? wv.w : o3_; wq_[4] = even ? o0_ : wv.x; wq_[5] = even ? o1_ : wv.y; wq_[6] = even ? o2_ : wv.z; wq_[7] = even ? o3_ : wv.w; } \
        f32x4 acc_[8]; _Pragma("unroll") for (int nt_ = 0; nt_ < 8; ++nt_) acc_[nt_] = (f32x4){0.f, 0.f, 0.f, 0.f}; \
        _Pragma("unroll") for (int ks_ = 0; ks_ < 4; ++ks_) { const i64_t aw_ = (i64_t)wq_[2 * ks_] | ((i64_t)wq_[2 * ks_ + 1] << 32); \
            _Pragma("unroll") for (int nt_ = 0; nt_ < 8; ++nt_) { const i64_t bv_ = ds_tr8(slot + rbase + ks_ * 1024 + 16 * (nt_ ^ rkey)); acc_[nt_] = __builtin_amdgcn_mfma_f32_16x16x32_fp8_fp8(aw_, bv_, acc_[nt_], 0, 0, 0); } } \
        const float e01_ = (qp & 1) ? acc_[2][0] : acc_[0][0], e23_ = (qp & 1) ? acc_[6][0] : acc_[4][0], o01_ = (qp & 1) ? acc_[3][0] : acc_[1][0], o23_ = (qp & 1) ? acc_[7][0] : acc_[5][0]; \
        const float se_ = (qp & 2) ? e23_ : e01_, so_ = (qp & 2) ? o23_ : o01_; \
        const float mine_ = even ? se_ : so_, send_ = even ? so_ : se_; \
        const float recv_ = __builtin_bit_cast(float, __builtin_amdgcn_update_dpp(0, __builtin_bit_cast(int, send_), 0xB1, 0xF, 0xF, false)); \
        const float lo_ = even ? mine_ : recv_, hi_ = even ? recv_ : mine_; \
        bf16* xo_ = (bf16*)(a.ws + WS_X1B) + (size_t)(t) * 1024 + 128 * j + ccol; const float* gt_ = MOD + ((size_t)(t) >> 13) * NMODC + 5120 + 128 * j + ccol; \
        const unsigned xb_ = *(const unsigned*)xo_; const f32x2_t g_ = *(const f32x2_t*)gt_; \
        *(unsigned*)xo_ = pk2(bflo(xb_) + g_.x * lo_ * (1.0f / 4096.0f), bfhi(xb_) + g_.y * hi_ * (1.0f / 4096.0f)); } while (0)
#define VM_TOK(u_) ((size_t)first + (size_t)((u_) < ntok ? (u_) : ntok - 1) * stride)
        { v4u e0 = *(const v4u*)(E + VM_TOK(0) * 128 + eoff); VM_ROWS(RA, e0); VM_W(wA, VM_TOK(0)); en = *(const v4u*)(E + VM_TOK(1) * 128 + eoff); }
        for (int u = 0; u < ntok; u += 2) {
            { en2 = *(const v4u*)(E + VM_TOK(u + 2) * 128 + eoff); VM_W(wB, VM_TOK(u + 1)); VM_ROWS(RB, en); VM_COMPUTE(RA, wA, VM_TOK(u)); }
            if (u + 1 >= ntok) break;
            { en = *(const v4u*)(E + VM_TOK(u + 3) * 128 + eoff); VM_W(wA, VM_TOK(u + 2)); VM_ROWS(RA, en2); VM_COMPUTE(RB, wB, VM_TOK(u + 1)); }
        }
#undef VM_ROWS
#undef VM_COMPUTE
#undef VM_W
#undef VM_TOK
    }
}
typedef int v8i_t __attribute__((ext_vector_type(8)));
__device__ __forceinline__ v2i_t ds_tr4(const LAS unsigned char* p) { return __builtin_amdgcn_ds_read_tr4_b64_v2i32((LAS v2i_t*)p); }
__device__ __forceinline__ void vpass_mfma4(const Args& a, LAS unsigned char* lds, int wave, int lane_in) {
    int lane = lane_in; asm volatile("" : "+v"(lane));
    const int G = gridDim.x, bx = blockIdx.x;
    const bool sliced = (G % 8) == 0;
    const int nj = sliced ? 1 : 8, j0 = sliced ? (bx & 7) : 0;
    const int first = sliced ? ((bx >> 3) * NWAVES + wave) : (bx * NWAVES + wave), stride = sliced ? (G >> 3) * NWAVES : G * NWAVES;
    const int r = lane >> 2, p4 = lane & 3, n16 = lane & 15, qp = lane >> 4;
    const unsigned short* E = (const unsigned short*)(a.ws + WS_E); const unsigned char* W8 = a.ws + WS_W; const float* MOD = (const float*)(a.ws + WS_MOD);
    LAS unsigned char* slot = lds + wave * 8192;
    const int ntok = (M - first + stride - 1) / stride;
    const int eoff = 8 * r;
    const int wbase = (8 * r) * 64;
    const int rkey = (n16 >> 2) & 3, rbase = (32 * qp + n16) * 64;
    const bool even = (n16 & 1) == 0; const int ccol = 32 * qp + (even ? n16 : 15 + n16);
    for (int jj = 0; jj < nj; ++jj) { const int j = j0 + jj;
        const unsigned char* tb = a.ws + WS_VB + (size_t)j * (16384 * 64);
        const unsigned poff = 16u * p4;
        v4u R0[8], R1[8], R2[8], R3[8], w0, w1, w2, w3, eA, eB;
#define V4_ROWS(R, ev) do { const unsigned w_[4] = {ev.x, ev.y, ev.z, ev.w}; _Pragma("unroll") for (int c_ = 0; c_ < 4; ++c_) { R[2 * c_] = *(const v4u*)(tb + ((w_[c_] & 0xffffu) * 64u + poff)); R[2 * c_ + 1] = *(const v4u*)(tb + ((w_[c_] >> 16) * 64u + poff)); } } while (0)
#define V4_TOK(u_) ((size_t)first + (size_t)((u_) < ntok ? (u_) : ntok - 1) * stride)
#define V4_E(ev, u_) do { ev = *(const v4u*)(E + V4_TOK(u_) * 128 + eoff); } while (0)
#define V4_W(wv, u_) do { wv = *(const v4u*)(W8 + V4_TOK(u_) * 128 + 16 * qp + 64 * (n16 & 1)); } while (0)
#define V4_COMPUTE(R, wv, t) do { \
        _Pragma("unroll") for (int i_ = 0; i_ < 8; ++i_) *(LAS v4u*)(slot + wbase + i_ * 64 + 16 * (p4 ^ ((2 * r + (i_ >> 2)) & 3))) = R[i_]; \
        v8i_t aw_; { const int o0_ = __builtin_amdgcn_update_dpp(0, (int)wv.x, 0xB1, 0xF, 0xF, false), o1_ = __builtin_amdgcn_update_dpp(0, (int)wv.y, 0xB1, 0xF, 0xF, false), \
              o2_ = __builtin_amdgcn_update_dpp(0, (int)wv.z, 0xB1, 0xF, 0xF, false), o3_ = __builtin_amdgcn_update_dpp(0, (int)wv.w, 0xB1, 0xF, 0xF, false); \
          aw_[0] = even ? (int)wv.x : o0_; aw_[1] = even ? (int)wv.y : o1_; aw_[2] = even ? (int)wv.z : o2_; aw_[3] = even ? (int)wv.w : o3_; \
          aw_[4] = even ? o0_ : (int)wv.x; aw_[5] = even ? o1_ : (int)wv.y; aw_[6] = even ? o2_ : (int)wv.z; aw_[7] = even ? o3_ : (int)wv.w; } \
        f32x4 acc_[8]; \
        _Pragma("unroll") for (int nt_ = 0; nt_ < 8; ++nt_) { const LAS unsigned char* rp_ = slot + rbase + 16 * ((nt_ >> 1) ^ rkey) + 8 * (nt_ & 1); \
            const v2i_t b0_ = ds_tr4(rp_), b1_ = ds_tr4(rp_ + 16 * 64); const v8i_t bv_ = {b0_.x, b0_.y, b1_.x, b1_.y, 0, 0, 0, 0}; \
            acc_[nt_] = __builtin_amdgcn_mfma_scale_f32_16x16x128_f8f6f4(aw_, bv_, (f32x4){0.f, 0.f, 0.f, 0.f}, 0, 4, 0, 0, 0, 0); } \
        const float e01_ = (qp & 1) ? acc_[2][0] : acc_[0][0], e23_ = (qp & 1) ? acc_[6][0] : acc_[4][0], o01_ = (qp & 1) ? acc_[3][0] : acc_[1][0], o23_ = (qp & 1) ? acc_[7][0] : acc_[5][0]; \
        const float se_ = (qp & 2) ? e23_ : e01_, so_ = (qp & 2) ? o23_ : o01_; \
        const float mine_ = even ? se_ : so_, send_ = even ? so_ : se_; \
        const float recv_ = __builtin_bit_cast(float, __builtin_amdgcn_update_dpp(0, __builtin_bit_cast(int, send_), 0xB1, 0xF, 0xF, false)); \
        const float lo_ = even ? mine_ : recv_, hi_ = even ? recv_ : mine_; \
        bf16* xo_ = (bf16*)(a.ws + WS_X1B) + (size_t)(t) * 1024 + 128 * j + ccol; const float* gt_ = MOD + ((size_t)(t) >> 13) * NMODC + 5120 + 128 * j + ccol; \
        const unsigned xb_ = *(const unsigned*)xo_; const f32x2_t g_ = *(const f32x2_t*)gt_; \
        *(unsigned*)xo_ = pk2(bflo(xb_) + g_.x * lo_ * (1.0f / 256.0f), bfhi(xb_) + g_.y * hi_ * (1.0f / 256.0f)); } while (0)
        { v4u e0, e1, e2; V4_E(e0, 0); V4_E(e1, 1); V4_E(e2, 2); V4_E(eA, 3);
          V4_W(w0, 0); V4_ROWS(R0, e0); V4_W(w1, 1); V4_ROWS(R1, e1); V4_W(w2, 2); V4_ROWS(R2, e2); }
        for (int u = 0; u < ntok; u += 4) {
            V4_E(eB, u + 4); V4_W(w3, u + 3); V4_ROWS(R3, eA); V4_COMPUTE(R0, w0, V4_TOK(u));
            if (u + 1 >= ntok) break;
            V4_E(eA, u + 5); V4_W(w0, u + 4); V4_ROWS(R0, eB); V4_COMPUTE(R1, w1, V4_TOK(u + 1));
            if (u + 2 >= ntok) break;
            V4_E(eB, u + 6); V4_W(w1, u + 5); V4_ROWS(R1, eA); V4_COMPUTE(R2, w2, V4_TOK(u + 2));
            if (u + 3 >= ntok) break;
            V4_E(eA, u + 7); V4_W(w2, u + 6); V4_ROWS(R2, eB); V4_COMPUTE(R3, w3, V4_TOK(u + 3));
        }
#undef V4_ROWS
#undef V4_TOK
#undef V4_E
#undef V4_W
#undef V4_COMPUTE
    }
}
__device__ __forceinline__ void vpass_wide(const Args& a, LAS unsigned char* lds, int wave, int lane_in, size_t xdst_off = WS_X1B) {
    int lane = lane_in; asm volatile("" : "+v"(lane));
    const int G = gridDim.x, bx = blockIdx.x;
    const bool sliced = (G % 8) == 0;
    const int nj = sliced ? 1 : 4, j0 = sliced ? ((bx & 7) >> 1) : 0;
    const int tmul = sliced ? 2 : 1, tadd = sliced ? (bx & 1) : 0;
    const int first = sliced ? ((bx >> 3) * NWAVES + wave) : (bx * NWAVES + wave), stride = sliced ? (G >> 3) * NWAVES : G * NWAVES;
    const int ntok = ((sliced ? M / 2 : M) - first + stride - 1) / stride;
    const int r8 = lane >> 3, p8 = lane & 7, n16 = lane & 15, qp = lane >> 4;
    const unsigned short* E = (const unsigned short*)(a.ws + WS_E); const unsigned char* W8 = a.ws + WS_W; const float* MOD = (const float*)(a.ws + WS_MOD);
    LAS unsigned char* slot = lds + wave * 16384;
    const int eoff = 16 * r8;
    const int wbase = (16 * r8) * 128;
    const int rkey = (n16 >> 1) & 7, rbase = (32 * qp + n16) * 128;
    const bool even = (n16 & 1) == 0;
    const int ccol0 = 16 * (4 * qp + (even ? 0 : 1)) + (even ? n16 : n16 - 1), ccol1 = ccol0 + 32;
    for (int jj = 0; jj < nj; ++jj) { const int j = j0 + jj;
        const unsigned char* tb = a.ws + WS_VB + (size_t)j * (16384 * 128);
        const unsigned poff = 16u * p8;
        v4u RA[16], RB[16], wA, wB, en, en2, fn, fn2; unsigned xA0, xA1, xB0, xB1; f32x2_t gA0, gA1, gB0, gB1;
#define VW_TOK(u_) ((size_t)tmul * ((size_t)first + (size_t)((u_) < ntok ? (u_) : ntok - 1) * stride) + tadd)
#define VW_ROWS(R, ev, fv) do { const unsigned w_[8] = {ev.x, ev.y, ev.z, ev.w, fv.x, fv.y, fv.z, fv.w}; _Pragma("unroll") for (int c_ = 0; c_ < 8; ++c_) { \
            R[2 * c_] = *(const v4u*)(tb + ((w_[c_] & 0xffffu) * 128u + poff)); R[2 * c_ + 1] = *(const v4u*)(tb + ((w_[c_] >> 16) * 128u + poff)); } } while (0)
#define VW_W(wv, u_) do { wv = *(const v4u*)(W8 + VW_TOK(u_) * 128 + 16 * qp + 64 * (n16 & 1)); } while (0)
#define VW_X(x0v, x1v, g0v, g1v, u_) do { const size_t t_ = VW_TOK(u_); const bf16* xi_ = (const bf16*)(a.ws + WS_X1B) + t_ * 1024 + 256 * j; const float* gt_ = MOD + (t_ >> 13) * NMODC + 5120 + 256 * j; \
        x0v = *(const unsigned*)(xi_ + ccol0); x1v = *(const unsigned*)(xi_ + ccol1); g0v = *(const f32x2_t*)(gt_ + ccol0); g1v = *(const f32x2_t*)(gt_ + ccol1); } while (0)
#define VW_COMPUTE(R, wv, xa_, xb_, ga_, gb_, t) do { \
        _Pragma("unroll") for (int i_ = 0; i_ < 16; ++i_) { *(LAS v4u*)(slot + wbase + i_ * 128 + 16 * (p8 ^ ((i_ >> 1) & 7))) = R[i_]; } \
        v8i_t aw_; { const int o0_ = __builtin_amdgcn_update_dpp(0, (int)wv.x, 0xB1, 0xF, 0xF, false), o1_ = __builtin_amdgcn_update_dpp(0, (int)wv.y, 0xB1, 0xF, 0xF, false), \
              o2_ = __builtin_amdgcn_update_dpp(0, (int)wv.z, 0xB1, 0xF, 0xF, false), o3_ = __builtin_amdgcn_update_dpp(0, (int)wv.w, 0xB1, 0xF, 0xF, false); \
          aw_[0] = even ? (int)wv.x : o0_; aw_[1] = even ? (int)wv.y : o1_; aw_[2] = even ? (int)wv.z : o2_; aw_[3] = even ? (int)wv.w : o3_; \
          aw_[4] = even ? o0_ : (int)wv.x; aw_[5] = even ? o1_ : (int)wv.y; aw_[6] = even ? o2_ : (int)wv.z; aw_[7] = even ? o3_ : (int)wv.w; } \
        float tv_[16]; \
        _Pragma("unroll") for (int nt_ = 0; nt_ < 16; ++nt_) { const LAS unsigned char* rp_ = slot + rbase + 16 * ((nt_ >> 1) ^ rkey) + 8 * (nt_ & 1); \
            const v2i_t b0_ = ds_tr4(rp_), b1_ = ds_tr4(rp_ + 16 * 128); const v8i_t bv_ = {b0_.x, b0_.y, b1_.x, b1_.y, 0, 0, 0, 0}; \
            const f32x4 c_ = __builtin_amdgcn_mfma_scale_f32_16x16x128_f8f6f4(aw_, bv_, (f32x4){0.f, 0.f, 0.f, 0.f}, 0, 4, 0, 0, 0, 0); tv_[nt_] = c_[0]; } \
          \
        float t0_ = (qp & 1) ? tv_[4] : tv_[0], t1_ = (qp & 1) ? tv_[5] : tv_[1], t2_ = (qp & 1) ? tv_[6] : tv_[2], t3_ = (qp & 1) ? tv_[7] : tv_[3]; \
        { const float u0_ = (qp & 1) ? tv_[12] : tv_[8], u1_ = (qp & 1) ? tv_[13] : tv_[9], u2_ = (qp & 1) ? tv_[14] : tv_[10], u3_ = (qp & 1) ? tv_[15] : tv_[11]; \
          t0_ = (qp & 2) ? u0_ : t0_; t1_ = (qp & 2) ? u1_ : t1_; t2_ = (qp & 2) ? u2_ : t2_; t3_ = (qp & 2) ? u3_ : t3_; } \
          \
        const float mA_ = even ? t0_ : t1_, mB_ = even ? t2_ : t3_, sA_ = even ? t1_ : t0_, sB_ = even ? t3_ : t2_; \
        const float rA_ = __builtin_bit_cast(float, __builtin_amdgcn_update_dpp(0, __builtin_bit_cast(int, sA_), 0xB1, 0xF, 0xF, false)); \
        const float rB_ = __builtin_bit_cast(float, __builtin_amdgcn_update_dpp(0, __builtin_bit_cast(int, sB_), 0xB1, 0xF, 0xF, false)); \
        const float loA_ = even ? mA_ : rA_, hiA_ = even ? rA_ : mA_, loB_ = even ? mB_ : rB_, hiB_ = even ? rB_ : mB_; \
        bf16* xo_ = (bf16*)(a.ws + xdst_off) + (size_t)(t) * 1024 + 256 * j; \
        *(unsigned*)(xo_ + ccol0) = pk2(bflo(xa_) + ga_.x * loA_ * (1.0f / 256.0f), bfhi(xa_) + ga_.y * hiA_ * (1.0f / 256.0f)); \
        *(unsigned*)(xo_ + ccol1) = pk2(bflo(xb_) + gb_.x * loB_ * (1.0f / 256.0f), bfhi(xb_) + gb_.y * hiB_ * (1.0f / 256.0f)); } while (0)
        { const v4u e0 = *(const v4u*)(E + VW_TOK(0) * 128 + eoff), f0 = *(const v4u*)(E + VW_TOK(0) * 128 + eoff + 8); VW_W(wA, 0); VW_X(xA0, xA1, gA0, gA1, 0); VW_ROWS(RA, e0, f0); en = *(const v4u*)(E + VW_TOK(1) * 128 + eoff); fn = *(const v4u*)(E + VW_TOK(1) * 128 + eoff + 8); }
        for (int u = 0; u < ntok; u += 2) {
            { en2 = *(const v4u*)(E + VW_TOK(u + 2) * 128 + eoff); fn2 = *(const v4u*)(E + VW_TOK(u + 2) * 128 + eoff + 8); VW_W(wB, u + 1); VW_X(xB0, xB1, gB0, gB1, u + 1); VW_ROWS(RB, en, fn); VW_COMPUTE(RA, wA, xA0, xA1, gA0, gA1, VW_TOK(u)); }
            if (u + 1 >= ntok) break;
            { en = *(const v4u*)(E + VW_TOK(u + 3) * 128 + eoff); fn = *(const v4u*)(E + VW_TOK(u + 3) * 128 + eoff + 8); VW_W(wA, u + 2); VW_X(xA0, xA1, gA0, gA1, u + 2); VW_ROWS(RA, en2, fn2); VW_COMPUTE(RB, wB, xB0, xB1, gB0, gB1, VW_TOK(u + 1)); }
        }
#undef VW_TOK
#undef VW_ROWS
#undef VW_W
#undef VW_X
#undef VW_COMPUTE
    }
}
__device__ __forceinline__ void upass_wide(const Args& a, LAS unsigned char* lds, int wave, int lane_in) {
    int lane = lane_in; asm volatile("" : "+v"(lane));
    const int G = gridDim.x, bx = blockIdx.x;
    const bool sliced = (G % 8) == 0;
    const int nj = sliced ? 1 : 4, j0 = sliced ? ((bx & 7) >> 1) : 0;
    const int tmul = sliced ? 2 : 1, tadd = sliced ? (bx & 1) : 0;
    const int first = sliced ? ((bx >> 3) * NWAVES + wave) : (bx * NWAVES + wave), stride = sliced ? (G >> 3) * NWAVES : G * NWAVES;
    const int ntok = ((sliced ? M / 2 : M) - first + stride - 1) / stride;
    const int r8 = lane >> 3, p8 = lane & 7, n16 = lane & 15, qp = lane >> 4;
    const unsigned short* E = (const unsigned short*)(a.ws + WS_E); const unsigned char* H8 = a.ws + WS_H2Q; bf16* PA = (bf16*)(a.ws + WS_PA);
    LAS unsigned char* slot = lds + wave * 16384;
    const int eoff = 16 * r8, wbase = (16 * r8) * 128;
    const int akey = (n16 >> 1) & 7, abase = n16 * 128;
    const bool even = (n16 & 1) == 0;
    for (int jj = 0; jj < nj; ++jj) { const int j = j0 + jj;
        const unsigned char* tb = a.ws + WS_UB + (size_t)j * (16384 * 128);
        const unsigned poff = 16u * p8;
        v4u RA[16], RB[16], haA, hbA, haB, hbB, en, en2, fn, fn2;
#define UW_TOK(u_) ((size_t)tmul * ((size_t)first + (size_t)((u_) < ntok ? (u_) : ntok - 1) * stride) + tadd)
#define UW_ROWS(R, ev, fv) do { const unsigned w_[8] = {ev.x, ev.y, ev.z, ev.w, fv.x, fv.y, fv.z, fv.w}; _Pragma("unroll") for (int c_ = 0; c_ < 8; ++c_) { \
            R[2 * c_] = *(const v4u*)(tb + ((w_[c_] & 0xffffu) * 128u + poff)); R[2 * c_ + 1] = *(const v4u*)(tb + ((w_[c_] >> 16) * 128u + poff)); } } while (0)
#define UW_H(ha, hb, u_) do { const unsigned char* hp_ = H8 + UW_TOK(u_) * 1024 + 256 * j + 16 * qp + 128 * (n16 & 1); ha = *(const v4u*)hp_; hb = *(const v4u*)(hp_ + 64); } while (0)
#define UW_COMPUTE(R, ha, hb, t) do { \
        _Pragma("unroll") for (int i_ = 0; i_ < 16; ++i_) { *(LAS v4u*)(slot + wbase + i_ * 128 + 16 * (p8 ^ ((i_ >> 1) & 7))) = R[i_]; } \
        v8i_t bh0_, bh1_; { const int mine_[8] = {(int)ha.x, (int)ha.y, (int)ha.z, (int)ha.w, (int)hb.x, (int)hb.y, (int)hb.z, (int)hb.w}; \
          _Pragma("unroll") for (int d_ = 0; d_ < 8; ++d_) { const int o_ = __builtin_amdgcn_update_dpp(0, mine_[d_], 0xB1, 0xF, 0xF, false); bh0_[d_] = even ? mine_[d_] : o_; bh1_[d_] = even ? o_ : mine_[d_]; } } \
        f32x4 acc_[8]; \
        _Pragma("unroll") for (int mb_ = 0; mb_ < 8; ++mb_) { \
            const v4u a0_ = *(const LAS v4u*)(slot + mb_ * 2048 + abase + 16 * (qp ^ akey)), a1_ = *(const LAS v4u*)(slot + mb_ * 2048 + abase + 16 * ((4 + qp) ^ akey)); \
            const v8i_t av0_ = {(int)a0_.x, (int)a0_.y, (int)a0_.z, (int)a0_.w, 0, 0, 0, 0}, av1_ = {(int)a1_.x, (int)a1_.y, (int)a1_.z, (int)a1_.w, 0, 0, 0, 0}; \
            f32x4 c_ = __builtin_amdgcn_mfma_scale_f32_16x16x128_f8f6f4(av0_, bh0_, (f32x4){0.f, 0.f, 0.f, 0.f}, 4, 0, 0, 0, 0, 0); \
            acc_[mb_] = __builtin_amdgcn_mfma_scale_f32_16x16x128_f8f6f4(av1_, bh1_, c_, 4, 0, 0, 0, 0, 0); } \
        const f32x4 s01_ = (n16 & 1) ? acc_[1] : acc_[0], s23_ = (n16 & 1) ? acc_[3] : acc_[2], s45_ = (n16 & 1) ? acc_[5] : acc_[4], s67_ = (n16 & 1) ? acc_[7] : acc_[6]; \
        const f32x4 s03_ = (n16 & 2) ? s23_ : s01_, s47_ = (n16 & 2) ? s67_ : s45_; const f32x4 sel_ = (n16 & 4) ? s47_ : s03_; \
        if (n16 < 8) *(v2u*)(PA + ((size_t)j * M + (t)) * 128 + n16 * 16 + 4 * qp) = (v2u){pg8::cvt_pk_bf16(sel_[0], sel_[1]), pg8::cvt_pk_bf16(sel_[2], sel_[3])}; } while (0)
        { const v4u e0 = *(const v4u*)(E + UW_TOK(0) * 128 + eoff), f0 = *(const v4u*)(E + UW_TOK(0) * 128 + eoff + 8); UW_ROWS(RA, e0, f0); UW_H(haA, hbA, 0); en = *(const v4u*)(E + UW_TOK(1) * 128 + eoff); fn = *(const v4u*)(E + UW_TOK(1) * 128 + eoff + 8); }
        for (int u = 0; u < ntok; u += 2) {
            { en2 = *(const v4u*)(E + UW_TOK(u + 2) * 128 + eoff); fn2 = *(const v4u*)(E + UW_TOK(u + 2) * 128 + eoff + 8); UW_H(haB, hbB, u + 1); UW_ROWS(RB, en, fn); UW_COMPUTE(RA, haA, hbA, UW_TOK(u)); }
            if (u + 1 >= ntok) break;
            { en = *(const v4u*)(E + UW_TOK(u + 3) * 128 + eoff); fn = *(const v4u*)(E + UW_TOK(u + 3) * 128 + eoff + 8); UW_H(haA, hbA, u + 2); UW_ROWS(RA, en2, fn2); UW_COMPUTE(RB, haB, hbB, UW_TOK(u + 1)); }
        }
#undef UW_TOK
#undef UW_ROWS
#undef UW_H
#undef UW_COMPUTE
    }
}
__device__ __forceinline__ void peer_reduce(const Args& a, LAS unsigned char* lds, int tid) {
    const unsigned short* E = (const unsigned short*)(a.ws + WS_E); const float* Gt = (const float*)(a.ws + WS_G); unsigned char* W = a.ws + WS_W; const bf16* PA = (const bf16*)(a.ws + WS_PA);
    const float* SU = (const float*)(a.ws + WS_SU); const float* SV = (const float*)(a.ws + WS_SV); const float* SH = (const float*)(a.ws + WS_SH);
    __syncthreads();
    for (int i = tid; i < 16384 / 4; i += 512) { const f32x4 u4 = *(const f32x4*)(SU + 4 * i), v4 = *(const f32x4*)(SV + 4 * i);
        *(LAS f32x4*)(lds + 32 * i) = (f32x4){u4.x, v4.x, u4.y, v4.y}; *(LAS f32x4*)(lds + 32 * i + 16) = (f32x4){u4.z, v4.z, u4.w, v4.w}; }
    __syncthreads();
    const size_t n4 = (size_t)M * 128 / 4, gth = (size_t)gridDim.x * 512;
    for (size_t i = (size_t)blockIdx.x * 512 + tid; i < n4; i += gth) {
        f32x4 s = {0.f, 0.f, 0.f, 0.f};
#pragma unroll
        for (int j = 0; j < 4; ++j) { const v2u pq = __builtin_nontemporal_load((const v2u*)(PA + (size_t)j * M * 128 + i * 4)); s += (f32x4){bflo(pq.x), bfhi(pq.x), bflo(pq.y), bfhi(pq.y)}; }
        const float sh = SH[i >> 5];
        const v2u ep = *(const v2u*)(E + i * 4); const f32x4 g = *(const f32x4*)(Gt + i * 4); f32x4 w;
        const f2_t t0 = *(const LAS f2_t*)(lds + 8 * (ep.x & 0xffffu)), t1 = *(const LAS f2_t*)(lds + 8 * (ep.x >> 16)), t2 = *(const LAS f2_t*)(lds + 8 * (ep.y & 0xffffu)), t3 = *(const LAS f2_t*)(lds + 8 * (ep.y >> 16));
        w.x = g.x * gelu_t(s.x * sh * t0.x) * t0.y; w.y = g.y * gelu_t(s.y * sh * t1.x) * t1.y; w.z = g.z * gelu_t(s.z * sh * t2.x) * t2.y; w.w = g.w * gelu_t(s.w * sh * t3.x) * t3.y;
        { const f32x4 ws_ = w * 256.0f; int pk = 0;
          pk = __builtin_amdgcn_cvt_pk_fp8_f32(fminf(fmaxf(ws_.x, -440.f), 440.f), fminf(fmaxf(ws_.y, -440.f), 440.f), pk, false);
          pk = __builtin_amdgcn_cvt_pk_fp8_f32(fminf(fmaxf(ws_.z, -440.f), 440.f), fminf(fmaxf(ws_.w, -440.f), 440.f), pk, true);
          *(unsigned*)(W + i * 4) = (unsigned)pk; } }
}
__device__ __forceinline__ void final_norm(const Args& a, int wave, int lane) {
    const float* gf = a.in[I_GFIN]; const bf16* X2 = (const bf16*)(a.ws + WS_X1B);
    f32x4 g[4];
#pragma unroll
    for (int q = 0; q < 2; ++q) { g[2 * q] = *(const f32x4*)(gf + 512 * q + 8 * lane); g[2 * q + 1] = *(const f32x4*)(gf + 512 * q + 8 * lane + 4); }
    for (size_t row = (size_t)blockIdx.x * NWAVES + wave; row < (size_t)M; row += (size_t)gridDim.x * NWAVES) {
        f32x4 x[4]; float ss = 0.f;
#pragma unroll
        for (int q = 0; q < 2; ++q) { const v4u r = __builtin_nontemporal_load((const v4u*)(X2 + row * 1024 + 512 * q + 8 * lane)); x[2 * q] = (f32x4){bflo(r.x), bfhi(r.x), bflo(r.y), bfhi(r.y)}; x[2 * q + 1] = (f32x4){bflo(r.z), bfhi(r.z), bflo(r.w), bfhi(r.w)}; }
#pragma unroll
        for (int i = 0; i < 4; ++i) ss += (x[i].x * x[i].x + x[i].y * x[i].y) + (x[i].z * x[i].z + x[i].w * x[i].w);
        const float rstd = 1.0f / sqrtf(wave_sum(ss) * (1.0f / 1024.0f) + EPS);
#pragma unroll
        for (int q = 0; q < 2; ++q) { float* o = a.out + row * 1024 + 512 * q + 8 * lane; __builtin_nontemporal_store(x[2 * q] * rstd * g[2 * q], (f32x4*)(o)); __builtin_nontemporal_store(x[2 * q + 1] * rstd * g[2 * q + 1], (f32x4*)(o + 4)); } }
}
__device__ __forceinline__ void phase_topk(const Args& a, LAS unsigned char* lds, int wave, int lane) {
    const bf16* Q = (const bf16*)(a.ws + WS_ZG); const bf16* KEYS = (const bf16*)(a.ws + WS_KEYS);
    const int G = gridDim.x, gw = blockIdx.x * NWAVES + wave, NGW = G * NWAVES;
    for (int grp = gw; grp < M / 32; grp += NGW) peer_topk32(Q, KEYS, (unsigned short*)(a.ws + WS_E), (float*)(a.ws + WS_G), lds + wave * 4096, grp * 32, lane);
}
#define XB_TMO      128
#define XB_XCNT(j)  (256  + 64 * (j))
#define XB_XSUB(j)  (1280 + 64 * (j))
#define XB_XGEN(j)  (2304 + 64 * (j))
#define XB_TOP      3328
#define XB_TOPGEN   3392
#define XCD_BAR_WORDS 3456
#define XB_SPIN_CAP (1u << 18)

__device__ __forceinline__ unsigned xb_ld(unsigned* p)              { return __hip_atomic_load(p, __ATOMIC_RELAXED, __HIP_MEMORY_SCOPE_AGENT); }
__device__ __forceinline__ unsigned xb_add(unsigned* p, unsigned v) { return __hip_atomic_fetch_add(p, v, __ATOMIC_RELAXED, __HIP_MEMORY_SCOPE_AGENT); }
__device__ __forceinline__ unsigned xb_xcc_id() { return (unsigned)__builtin_amdgcn_s_getreg((3 << 11) | 20) & 0xFu; }
#define XB_SPIN(cond, bar) do { unsigned _sp = 0; while (cond) { __builtin_amdgcn_s_sleep(1); \
    if ((++_sp & 255u) == 0u) { if (xb_ld(&(bar)[XB_TMO])) break; if (_sp > XB_SPIN_CAP) { atomicAdd(&(bar)[XB_TMO], 1u); break; } } } } while (0)

struct XcdBarrier {
    unsigned* bar; unsigned x;
    volatile LAS unsigned* st;
};

__device__ __forceinline__ XcdBarrier xcd_barrier_post(unsigned* bar, volatile LAS unsigned* st) {
    XcdBarrier b; b.bar = bar; b.x = xb_xcc_id(); b.st = st;
    if (threadIdx.x == 0) (void)xb_add(&bar[XB_XCNT(b.x)], 1u);
    return b;
}
__device__ __forceinline__ void xcd_barrier_complete(unsigned* bar, unsigned x, unsigned& nloc, unsigned& nx) {
    const unsigned G = gridDim.x * gridDim.y * gridDim.z;
    unsigned sum, cnt, mine, sp = 0u;
    for (;;) {
        sum = 0u; cnt = 0u; mine = 0u;
#pragma unroll
        for (unsigned j = 0; j < 16; ++j) { const unsigned c = xb_ld(&bar[XB_XCNT(j)]); sum += c; cnt += (c > 0u) ? 1u : 0u; mine = (j == x) ? c : mine; }
        if (sum == G) break;
        __builtin_amdgcn_s_sleep(1);
        if ((++sp & 255u) == 0u) { if (xb_ld(&bar[XB_TMO])) break; if (sp > XB_SPIN_CAP) { atomicAdd(&bar[XB_TMO], 1u); break; } }
    }
    nloc = mine > 0u ? mine : 1u; nx = cnt > 0u ? cnt : 1u;
}

__device__ __forceinline__ void xcd_barrier(const XcdBarrier& b) {
    asm volatile("s_waitcnt vmcnt(0)" ::: "memory");
    __syncthreads();
    if (threadIdx.x == 0) {
        unsigned* bar = b.bar;
        __builtin_amdgcn_s_waitcnt(0);
        unsigned nloc = b.st[0], nx = b.st[1];
        if (nloc == 0u) { xcd_barrier_complete(bar, b.x, nloc, nx); b.st[0] = nloc; b.st[1] = nx; }
        const unsigned old = xb_add(&bar[XB_XSUB(b.x)], 1u);
        const unsigned gen = old / nloc;
        if (old + 1u == (gen + 1u) * nloc) {
            __builtin_amdgcn_fence(__ATOMIC_RELEASE, "agent");
            asm volatile("s_waitcnt vmcnt(0)" ::: "memory");
            const unsigned og = xb_add(&bar[XB_TOP], 1u);
            const unsigned tg = og / nx;
            if (og + 1u == (tg + 1u) * nx) xb_add(&bar[XB_TOPGEN], 1u);
            else XB_SPIN(xb_ld(&bar[XB_TOPGEN]) == tg, bar);
            __builtin_amdgcn_fence(__ATOMIC_ACQUIRE, "agent");
            xb_add(&bar[XB_XGEN(b.x)], 1u);
            asm volatile("s_waitcnt vmcnt(0)" ::: "memory");
        } else {
            XB_SPIN(xb_ld(&bar[XB_XGEN(b.x)]) == gen, bar);
            __builtin_amdgcn_fence(__ATOMIC_ACQUIRE, "agent");
            asm volatile("s_waitcnt vmcnt(0)" ::: "memory");
        }
    }
    __syncthreads();
}
constexpr int N_PHASES = 13;
__global__ void __launch_bounds__(NWAVES * 64, 2) hybrid_fwd(Args a) {
    extern __shared__ __attribute__((aligned(16))) unsigned char lds_raw[];
    LAS unsigned char* lds = (LAS unsigned char*)lds_raw;
    const int tid = threadIdx.x, lane = tid & 63, wave = __builtin_amdgcn_readfirstlane(tid >> 6);
    const int G = gridDim.x, bx = blockIdx.x;
    unsigned char* ws = a.ws;
    const float* MOD = (const float*)(ws + WS_MOD);
    const int lo = a.ph_lo, hi = a.ph_hi;
    if (tid < 16) ((LAS unsigned*)(lds + LDS_MISC_OFF))[tid] = 0u;
    __syncthreads();
    XcdBarrier xbar = xcd_barrier_post((unsigned*)(ws + WS_BAR), (volatile LAS unsigned*)(lds + LDS_MISC_OFF));
#ifndef REP_MASK
#define REP_MASK 0
#endif
#define IN(k) (lo <= (k) && (k) < hi)
#ifndef REPN
#define REPN 1
#endif
#define REPS(k) (1 + REPN * ((REP_MASK >> (k)) & 1))
#define SEAM(k) do { if (IN(k) && IN((k) + 1)) xcd_barrier(xbar); } while (0)
    if (hi > N_PHASES) cg::this_grid().sync();

    if (IN(0)) for (int rep_ = 0; rep_ < REPS(0); ++rep_) { phase_prologue(a, lds, tid, wave, lane); } SEAM(0);
    if (IN(1)) for (int rep_ = 0; rep_ < REPS(1); ++rep_) { phase_norm_mod(a.in[I_X], a.in[I_GMIX], MOD, 0, 1024, (bf16*)(ws + WS_H), wave, lane); } SEAM(1);
    if (IN(2)) for (int rep_ = 0; rep_ < REPS(2); ++rep_) { pg8::Gemm g{(const pg8::bf16_t*)(ws + WS_H), (const pg8::bf16_t*)(ws + WS_WIN), M, INW, DM}; pg8::StaticOrder S; S.init(M, INW, G, bx);
        pg8::EpiIn E{(pg8::bf16_t*)(ws + WS_ZG), (pg8::bf16_t*)(ws + WS_ZS)};
        pg8::gemm_phase<pg8::EpiIn, pg8::StaticOrder, true, true>(lds, g, S, E); } SEAM(2);
    if (IN(3)) for (int rep_ = 0; rep_ < REPS(3); ++rep_) { for (int it = bx; it < 256; it += G) s5_item(a, lds, it, wave, lane);
        for (int it = bx; it < 512; it += G) sgu_item(a, lds, it, wave, lane); } SEAM(3);
    if (IN(4)) for (int rep_ = 0; rep_ < REPS(4); ++rep_) { pg8::Gemm g{(const pg8::bf16_t*)(ws + WS_YS), (const pg8::bf16_t*)(ws + WS_WGLU), M, 512, 512}; pg8::StaticOrder S; S.init(M, 512, G, bx);
        pg8::EpiGlu E{(const pg8::bf16_t*)(ws + WS_YS), a.in[I_BGLU], (pg8::bf16_t*)(ws + WS_Y)};
        pg8::gemm_phase<pg8::EpiGlu, pg8::StaticOrder, true, true>(lds, g, S, E); } SEAM(4);
    if (IN(5)) for (int rep_ = 0; rep_ < REPS(5); ++rep_) { pg8::Gemm g{(const pg8::bf16_t*)(ws + WS_Y), (const pg8::bf16_t*)(ws + WS_WOUT), M, DM, DM}; pg8::StaticOrder S; S.init(M, DM, G, bx);
        pg8::EpiOut E{a.in[I_X], MOD, (pg8::bf16_t*)(ws + WS_X1B)};
        pg8::gemm_phase<pg8::EpiOut, pg8::StaticOrder, true, true>(lds, g, S, E); } SEAM(5);
    if (IN(6)) for (int rep_ = 0; rep_ < REPS(6); ++rep_) { phase_norm_mod_bf((const bf16*)(ws + WS_X1B), a.in[I_GFFN], MOD, 3072, 4096, (bf16*)(ws + WS_H), ws + WS_H2Q, (float*)(ws + WS_SH), wave, lane); } SEAM(6);
    if (IN(7)) for (int rep_ = 0; rep_ < REPS(7); ++rep_) { pg8::Gemm g{(const pg8::bf16_t*)(ws + WS_H), (const pg8::bf16_t*)(ws + WS_WQ), M, DM, DM}; pg8::StaticOrder S; S.init(M, DM, G, bx);
        pg8::EpiPlain E{(pg8::bf16_t*)(ws + WS_ZG), 1024};
        pg8::gemm_phase<pg8::EpiPlain, pg8::StaticOrder, true, true>(lds, g, S, E); } SEAM(7);
    if (IN(8)) for (int rep_ = 0; rep_ < REPS(8); ++rep_) { phase_topk(a, lds, wave, lane); } SEAM(8);
    if (IN(9)) for (int rep_ = 0; rep_ < REPS(9); ++rep_) { upass_wide(a, lds, wave, lane); } SEAM(9);
    if (IN(10)) for (int rep_ = 0; rep_ < REPS(10); ++rep_) { peer_reduce(a, lds, tid); } SEAM(10);
    if (IN(11)) for (int rep_ = 0; rep_ < REPS(11); ++rep_) { vpass_wide(a, lds, wave, lane); } SEAM(11);
    if (IN(12)) for (int rep_ = 0; rep_ < REPS(12); ++rep_) { final_norm(a, wave, lane); }
#undef IN
#undef SEAM
}

extern "C" void kernel_launch(void* const* d_in, const int* in_sizes, int n_in, void* d_out, int out_size, void* d_ws, size_t ws_size, hipStream_t stream) {
    static int grid = 0;
    if (grid == 0) {
        if (n_in != 27 || in_sizes[0] != M * DM || out_size != M * DM || ws_size < WS_END) { fprintf(stderr, "kernel_launch: unexpected problem (n_in %d, in0 %d, out %d, ws %zu); nothing launched\n", n_in, n_in > 0 ? in_sizes[0] : -1, out_size, ws_size); grid = -1; return; }
        int dev = 0, cus = 0, per_cu = 0;
        if (hipGetDevice(&dev) != hipSuccess || hipDeviceGetAttribute(&cus, hipDeviceAttributeMultiprocessorCount, dev) != hipSuccess) { grid = -1; return; }
        if (hipFuncSetAttribute((const void*)hybrid_fwd, hipFuncAttributeMaxDynamicSharedMemorySize, LDS_BYTES) != hipSuccess) { fprintf(stderr, "kernel_launch: hipFuncSetAttribute failed\n"); grid = -1; return; }
        if (hipOccupancyMaxActiveBlocksPerMultiprocessor(&per_cu, (const void*)hybrid_fwd, NWAVES * 64, LDS_BYTES) != hipSuccess || per_cu < 1) { fprintf(stderr, "kernel_launch: occupancy query failed (%d)\n", per_cu); (void)hipGetLastError(); per_cu = 1; }
        grid = cus * 1;
        if (per_cu < 1) grid = -1;
    }
    if (grid < 0) return;
    if (hipMemsetAsync((char*)d_ws + WS_BAR, 0, 16384, stream) != hipSuccess) { fprintf(stderr, "kernel_launch: hipMemsetAsync failed\n"); return; }
    Args a{};
    for (int i = 0; i < 27; ++i) a.in[i] = (const float*)d_in[i];
    a.out = (float*)d_out; a.ws = (unsigned char*)d_ws;
#if N_LAUNCHES == 1
    a.ph_lo = 0; a.ph_hi = N_PHASES;
    void* args[] = {&a};
    hipError_t e = hipLaunchCooperativeKernel((const void*)hybrid_fwd, dim3(grid), dim3(NWAVES * 64), args, LDS_BYTES, stream);
    if (e != hipSuccess) fprintf(stderr, "kernel_launch: cooperative launch failed: %s (grid %d)\n", hipGetErrorString(e), grid);
#else
    for (int p = 0; p < N_PHASES; ++p) { a.ph_lo = p; a.ph_hi = p + 1;
        hipLaunchKernelGGL(hybrid_fwd, dim3(grid), dim3(NWAVES * 64), LDS_BYTES, stream, a);
        const hipError_t le = hipPeekAtLastError(); if (le != hipSuccess) { fprintf(stderr, "kernel_launch: launch %d failed: %s\n", p, hipGetErrorName(le)); break; } }
#endif
}
```

```cpp
#include <hip/hip_runtime.h>
#include <hip/hip_cooperative_groups.h>
#include <cstdio>
#include <cstdint>
namespace cg = cooperative_groups;

#ifndef N_LAUNCHES
#define N_LAUNCHES 1
#endif

#define GAS __attribute__((address_space(1)))
#define LAS __attribute__((address_space(3)))
namespace pg8 {
#define PG8_LAS __attribute__((address_space(3)))
typedef unsigned short bf16_t;
typedef short bf16x8 __attribute__((ext_vector_type(8)));
typedef float f32x4 __attribute__((ext_vector_type(4)));
typedef unsigned u32x4 __attribute__((ext_vector_type(4)));
constexpr int BM = 256, BK = 64, HALF = 128, HTB = HALF * BK * 2  , STAGE_BYTES = 8 * HTB, NXCD = 8, WGM = 8;

__host__ __device__ __forceinline__ int lds_byte(int r, int c) { const int st = (r >> 4) * 2 + (c >> 5), rr = r & 15, cc = c & 31, ob = rr * 64 + cc * 2; return st * 1024 + (ob ^ (((ob >> 9) & 1) << 5)); }
__host__ __device__ __forceinline__ void stage_rc(int b, int& R, int& C) { const int st = b / 1024, sb = b % 1024, swz = sb ^ (((sb >> 9) & 1) << 5); R = (st >> 1) * 16 + swz / 64; C = (st & 1) * 32 + (swz % 64) / 2; }
__host__ __device__ __forceinline__ int perm32(int rho) { const int n = rho >> 4, i = rho & 15; return 8 * (i >> 2) + 4 * n + (i & 3); }

struct Unit { int pm, pn; };
struct Gemm { const bf16_t* A; const bf16_t* Bt; int M, N, K; };

struct StaticOrder {
    int nM, nN, nwg, G, c;
    __host__ __device__ void init(int M, int N, int G_, int c_) { nM = M / BM; nN = N / BM; nwg = nM * nN; G = G_; c = c_; }
    __host__ __device__ bool next(int i, Unit& u) const {
        const long L = (long)i * G + c; if (L >= nwg) return false;
        int wgid = (int)L; { const int q = nwg / NXCD, r = nwg % NXCD, xcd = wgid % NXCD, off = wgid / NXCD; wgid = (xcd < r ? xcd * (q + 1) : r * (q + 1) + (xcd - r) * q) + off; }
        const int nig = WGM * nN, gid = wgid / nig, fm = gid * WGM, gsz = (nM - fm) < WGM ? (nM - fm) : WGM;
        u.pm = fm + ((wgid % nig) % gsz); u.pn = (wgid % nig) / gsz; return true;
    }
    __device__ __forceinline__ void a_ready(const Unit&) const {}
    __device__ __forceinline__ void done(const Unit&) const {}
};

typedef float f32x2 __attribute__((ext_vector_type(2)));
__device__ __forceinline__ unsigned cvt_pk_bf16(float lo, float hi) { unsigned r; asm volatile("v_cvt_pk_bf16_f32 %0, %1, %2" : "=v"(r) : "v"(lo), "v"(hi)); return r; }
__device__ __forceinline__ float bf_lo(unsigned u) { return __builtin_bit_cast(float, u << 16); }
__device__ __forceinline__ float bf_hi(unsigned u) { return __builtin_bit_cast(float, u & 0xffff0000u); }
__device__ __forceinline__ float gelu_t(float x) { const float t = x * (1.0f + 0.044715f * x * x) * (-2.3022082f); return x * __builtin_amdgcn_rcpf(1.0f + __builtin_amdgcn_exp2f(t)); }
__device__ __forceinline__ float sigmoid_f(float x) { return __builtin_amdgcn_rcpf(1.0f + __builtin_amdgcn_exp2f(x * -1.4426950409f)); }

struct EpiIn { static constexpr bool PERM = true, AFTER_DRAIN = false; bf16_t* ZG; bf16_t* ZS;
    __device__ __forceinline__ void operator()(const f32x4 (&acc)[2][2][4][2], const Unit& u, int wr, int wc, int fr, int fq) const {
        const int row0 = u.pm * BM + wr * 64 + fr, colt = u.pn * BM;
#pragma unroll
        for (int ai = 0; ai < 2; ++ai)
#pragma unroll
            for (int m = 0; m < 4; ++m) { const int row = row0 + ai * HALF + m * 16;
#pragma unroll
                for (int bj = 0; bj < 2; ++bj) { const int col = colt + bj * HALF + wc * 32 + 8 * fq; f32x4 v0 = acc[ai][bj][m][0], v1 = acc[ai][bj][m][1]; u32x4 w;
                    if (colt < 1024) {
                        w.x = cvt_pk_bf16(gelu_t(v0[0]), gelu_t(v0[1])); w.y = cvt_pk_bf16(gelu_t(v0[2]), gelu_t(v0[3])); w.z = cvt_pk_bf16(gelu_t(v1[0]), gelu_t(v1[1])); w.w = cvt_pk_bf16(gelu_t(v1[2]), gelu_t(v1[3]));
                        *(u32x4*)(ZG + (size_t)row * 1024 + col) = w;
                    } else {
                        w.x = cvt_pk_bf16(v0[0], v0[1]); w.y = cvt_pk_bf16(v0[2], v0[3]); w.z = cvt_pk_bf16(v1[0], v1[1]); w.w = cvt_pk_bf16(v1[2], v1[3]);
                        const int cs = col - 1024, g = cs >> 4, ch = cs & 15, b = row >> 13, s = row & 8191;
                        *(u32x4*)(ZS + ((((size_t)(b * 32 + g)) * 8192 + s) << 4) + ch) = w;
                    } } }
    }
};
struct EpiGlu { static constexpr bool PERM = true, AFTER_DRAIN = false; const bf16_t* YS; const float* bglu; bf16_t* Y;
    __device__ __forceinline__ void operator()(const f32x4 (&acc)[2][2][4][2], const Unit& u, int wr, int wc, int fr, int fq) const {
        const int row0 = u.pm * BM + wr * 64 + fr, colt = u.pn * BM;
#pragma unroll
        for (int bj = 0; bj < 2; ++bj) { const int col = colt + bj * HALF + wc * 32 + 8 * fq; const f32x4 b0 = *(const f32x4*)(bglu + col), b1 = *(const f32x4*)(bglu + col + 4);
#pragma unroll
            for (int ai = 0; ai < 2; ++ai)
#pragma unroll
                for (int m = 0; m < 4; ++m) { const int row = row0 + ai * HALF + m * 16; const f32x4 v0 = acc[ai][bj][m][0] + b0, v1 = acc[ai][bj][m][1] + b1;
                    const u32x4 ys = *(const u32x4*)(YS + (size_t)row * 512 + col); u32x4 w;
                    w.x = cvt_pk_bf16(bf_lo(ys.x) * sigmoid_f(v0[0]), bf_hi(ys.x) * sigmoid_f(v0[1])); w.y = cvt_pk_bf16(bf_lo(ys.y) * sigmoid_f(v0[2]), bf_hi(ys.y) * sigmoid_f(v0[3]));
                    w.z = cvt_pk_bf16(bf_lo(ys.z) * sigmoid_f(v1[0]), bf_hi(ys.z) * sigmoid_f(v1[1])); w.w = cvt_pk_bf16(bf_lo(ys.w) * sigmoid_f(v1[2]), bf_hi(ys.w) * sigmoid_f(v1[3]));
                    *(u32x4*)(Y + (size_t)row * 1024 + 512 + col) = w; } }
    }
};
struct EpiOut { static constexpr bool PERM = true, AFTER_DRAIN = false; const float* x; const float* mod; bf16_t* X1;
    __device__ __forceinline__ void operator()(const f32x4 (&acc)[2][2][4][2], const Unit& u, int wr, int wc, int fr, int fq) const {
        const int row0 = u.pm * BM + wr * 64 + fr, colt = u.pn * BM; const float* gt = mod + (size_t)((u.pm * BM) >> 13) * 6144 + 2048;
#pragma unroll
        for (int bj = 0; bj < 2; ++bj) { const int col = colt + bj * HALF + wc * 32 + 8 * fq; const f32x4 g0 = *(const f32x4*)(gt + col), g1 = *(const f32x4*)(gt + col + 4);
            f32x4 xv[8][2];
#pragma unroll
            for (int ai = 0; ai < 2; ++ai)
#pragma unroll
                for (int m = 0; m < 4; ++m) { const size_t o = (size_t)(row0 + ai * HALF + m * 16) * 1024 + col;
                    xv[ai * 4 + m][0] = __builtin_nontemporal_load((const f32x4*)(x + o)); xv[ai * 4 + m][1] = __builtin_nontemporal_load((const f32x4*)(x + o + 4)); }
            __builtin_amdgcn_sched_barrier(0);
#pragma unroll
            for (int ai = 0; ai < 2; ++ai)
#pragma unroll
                for (int m = 0; m < 4; ++m) { const size_t o = (size_t)(row0 + ai * HALF + m * 16) * 1024 + col;
                    const f32x4 v0 = xv[ai * 4 + m][0] + g0 * acc[ai][bj][m][0], v1 = xv[ai * 4 + m][1] + g1 * acc[ai][bj][m][1]; u32x4 w;
                    w.x = cvt_pk_bf16(v0[0], v0[1]); w.y = cvt_pk_bf16(v0[2], v0[3]); w.z = cvt_pk_bf16(v1[0], v1[1]); w.w = cvt_pk_bf16(v1[2], v1[3]);
                    *(u32x4*)(X1 + o) = w; }
            __builtin_amdgcn_sched_barrier(0); }
    }
};
struct EpiPlain { static constexpr bool PERM = true, AFTER_DRAIN = false; bf16_t* O; int ldc;
    __device__ __forceinline__ void operator()(const f32x4 (&acc)[2][2][4][2], const Unit& u, int wr, int wc, int fr, int fq) const {
        const int row0 = u.pm * BM + wr * 64 + fr, colt = u.pn * BM;
#pragma unroll
        for (int ai = 0; ai < 2; ++ai)
#pragma unroll
            for (int m = 0; m < 4; ++m) { const int row = row0 + ai * HALF + m * 16;
#pragma unroll
                for (int bj = 0; bj < 2; ++bj) { const int col = colt + bj * HALF + wc * 32 + 8 * fq; const f32x4 v0 = acc[ai][bj][m][0], v1 = acc[ai][bj][m][1]; u32x4 w;
                    w.x = cvt_pk_bf16(v0[0], v0[1]); w.y = cvt_pk_bf16(v0[2], v0[3]); w.z = cvt_pk_bf16(v1[0], v1[1]); w.w = cvt_pk_bf16(v1[2], v1[3]);
                    *(u32x4*)(O + (size_t)row * ldc + col) = w; } }
    }
};
template <class Epi, class Sched, bool ALIGN_EPI = false, bool SP2 = false>
__device__ __forceinline__ void gemm_phase(PG8_LAS unsigned char* lds, const Gemm g, const Sched& S, const Epi& E) {
    const int tid = threadIdx.x, wid = __builtin_amdgcn_readfirstlane(tid >> 6), lane = tid & 63, wr = wid >> 2, wc = wid & 3, fr = lane & 15, fq = lane >> 4;
    const int K = g.K, nt = K / BK;
    unsigned voffA[2], voffB[2];
#pragma unroll
    for (int i = 0; i < 2; ++i) { int R, C; stage_rc(tid * 16 + i * 8192, R, C); const int Rb = Epi::PERM ? ((R & ~31) + perm32(R & 31)) : R;
        voffA[i] = (unsigned)(R * K + C) * 2u; voffB[i] = (unsigned)(Rb * K + C) * 2u; }
    const size_t kstep = (size_t)(BK * 2);
    const size_t hstep = (size_t)HALF * K * 2;
    const size_t tstep = 2 * hstep;
    const unsigned ldsw = (unsigned)wid * 1024u;
    const int aoff = lds_byte(wr * 64 + fr, fq * 8), boff = lds_byte(wc * 32 + fr, fq * 8);
#define PG8_SA(b, h) (((b) * 2 + (h)) * HTB)
#define PG8_SB(b, h) ((4 + (b) * 2 + (h)) * HTB)
#define PG8_STAGE(bufoff, gbase, voff) do { _Pragma("unroll") for (int _i = 0; _i < 2; ++_i) \
        __builtin_amdgcn_global_load_lds((const unsigned*)((const char*)(gbase) + (voff)[_i]), (PG8_LAS unsigned*)(lds + (bufoff) + ldsw + _i * 8192), 16, 0, 0); } while (0)
#define PG8_LDA(dst, b, h) do { _Pragma("unroll") for (int m = 0; m < 4; ++m) _Pragma("unroll") for (int k = 0; k < 2; ++k) dst[m][k] = *(const PG8_LAS bf16x8*)(lds + PG8_SA(b, h) + aoff + m * 2048 + k * 1024); } while (0)
#define PG8_LDB(dst, b, h) do { _Pragma("unroll") for (int n = 0; n < 2; ++n) _Pragma("unroll") for (int k = 0; k < 2; ++k) dst[n][k] = *(const PG8_LAS bf16x8*)(lds + PG8_SB(b, h) + boff + n * 2048 + k * 1024); } while (0)
#define PG8_MMA(ai, bj, At, Bt) do { __builtin_amdgcn_s_setprio(1); _Pragma("unroll") for (int m = 0; m < 4; ++m) _Pragma("unroll") for (int n = 0; n < 2; ++n) _Pragma("unroll") for (int k = 0; k < 2; ++k) \
        acc[ai][bj][m][n] = __builtin_amdgcn_mfma_f32_16x16x32_bf16(Bt[n][k], At[m][k], acc[ai][bj][m][n], 0, 0, 0); __builtin_amdgcn_s_setprio(0); } while (0)
#define PG8_WAIT_V(n) asm volatile("s_waitcnt vmcnt(" #n ")" ::: "memory")
#define PG8_WAIT_L(n) asm volatile("s_waitcnt lgkmcnt(" #n ")" ::: "memory")
#define PG8_BAR __builtin_amdgcn_s_barrier()
#define PG8_SCHED __builtin_amdgcn_sched_barrier(0)
    Unit cur, nxt; int ui = 0;
    if (!S.next(0, cur)) return;
    f32x4 acc[2][2][4][2];
#pragma unroll
    for (int a = 0; a < 2; ++a)
#pragma unroll
        for (int b = 0; b < 2; ++b)
#pragma unroll
            for (int m = 0; m < 4; ++m)
#pragma unroll
                for (int n = 0; n < 2; ++n) acc[a][b][m][n] = (f32x4){0.f, 0.f, 0.f, 0.f};
    bf16x8 At[4][2], B0[2][2], B1[2][2];
    const char* cA = (const char*)g.A + (size_t)cur.pm * tstep; const char* cB = (const char*)g.Bt + (size_t)cur.pn * tstep;
    S.a_ready(cur);
    if constexpr (SP2) {
        PG8_STAGE(PG8_SB(0, 0), cB, voffB); PG8_STAGE(PG8_SB(0, 1), cB + hstep, voffB); PG8_STAGE(PG8_SA(0, 0), cA, voffA); PG8_STAGE(PG8_SA(0, 1), cA + hstep, voffA);
        if (wr == 1) PG8_BAR;
        PG8_WAIT_V(2); PG8_BAR;
        PG8_STAGE(PG8_SB(1, 0), cB + kstep, voffB); PG8_STAGE(PG8_SA(1, 0), cA + kstep, voffA); PG8_STAGE(PG8_SB(1, 1), cB + hstep + kstep, voffB);
        PG8_WAIT_V(6); PG8_BAR;
    } else {
        PG8_STAGE(PG8_SB(0, 0), cB, voffB); PG8_STAGE(PG8_SA(0, 0), cA, voffA); PG8_STAGE(PG8_SB(0, 1), cB + hstep, voffB); PG8_STAGE(PG8_SA(0, 1), cA + hstep, voffA);
        if (wr == 1) PG8_BAR;
        PG8_WAIT_V(4); PG8_BAR;
        PG8_STAGE(PG8_SB(1, 0), cB + kstep, voffB); PG8_STAGE(PG8_SA(1, 0), cA + kstep, voffA); PG8_STAGE(PG8_SB(1, 1), cB + hstep + kstep, voffB);
        PG8_WAIT_V(6); PG8_BAR;
    }
    for (;;) {
        const bool has_next = S.next(ui + 1, nxt);
        const char* nA = has_next ? (const char*)g.A + (size_t)nxt.pm * tstep : cA; const char* nB = has_next ? (const char*)g.Bt + (size_t)nxt.pn * tstep : cB;
        for (int t = 0; t < nt; t += 2) {
            const bool last = (t == nt - 2);
            const char* a1 = cA + (size_t)(t + 1) * kstep;
            const char* a2 = last ? nA : cA + (size_t)(t + 2) * kstep; const char* b2 = last ? nB : cB + (size_t)(t + 2) * kstep;
            const char* a3 = a2 + kstep; const char* b3 = b2 + kstep;
            if (last && has_next) S.a_ready(nxt);
            if constexpr (SP2) {
            PG8_LDB(B0, 0, 0); PG8_LDB(B1, 0, 1); PG8_SCHED; PG8_LDA(At, 0, 0); PG8_STAGE(PG8_SA(1, 1), a1 + hstep, voffA);
            PG8_WAIT_V(8); PG8_WAIT_L(0); PG8_BAR; PG8_MMA(0, 0, At, B0); PG8_MMA(0, 1, At, B1); PG8_BAR; PG8_SCHED;
            PG8_LDA(At, 0, 1); PG8_STAGE(PG8_SB(0, 0), b2, voffB); PG8_STAGE(PG8_SB(0, 1), b2 + hstep, voffB); PG8_STAGE(PG8_SA(0, 0), a2, voffA);
            PG8_WAIT_V(8); PG8_WAIT_L(0); PG8_BAR; PG8_MMA(1, 0, At, B0); PG8_MMA(1, 1, At, B1); PG8_BAR; PG8_SCHED;
            PG8_LDB(B0, 1, 0); PG8_LDB(B1, 1, 1); PG8_SCHED; PG8_LDA(At, 1, 0); PG8_STAGE(PG8_SA(0, 1), a2 + hstep, voffA);
            PG8_WAIT_V(8); PG8_WAIT_L(0); PG8_BAR; PG8_MMA(0, 0, At, B0); PG8_MMA(0, 1, At, B1); PG8_BAR; PG8_SCHED;
            PG8_LDA(At, 1, 1); PG8_STAGE(PG8_SB(1, 0), b3, voffB); PG8_STAGE(PG8_SB(1, 1), b3 + hstep, voffB); PG8_STAGE(PG8_SA(1, 0), a3, voffA);
            PG8_WAIT_V(8); PG8_WAIT_L(0); PG8_BAR; PG8_MMA(1, 0, At, B0); PG8_MMA(1, 1, At, B1); PG8_BAR; PG8_SCHED;
            } else {
            PG8_LDB(B0, 0, 0); PG8_SCHED; PG8_LDA(At, 0, 0); PG8_STAGE(PG8_SA(1, 1), a1 + hstep, voffA);
            PG8_WAIT_L(8); PG8_BAR; PG8_WAIT_L(0); PG8_MMA(0, 0, At, B0); PG8_BAR; PG8_SCHED;
            PG8_LDB(B1, 0, 1); PG8_STAGE(PG8_SB(0, 0), b2, voffB);
            PG8_BAR; PG8_WAIT_L(0); PG8_MMA(0, 1, At, B1); PG8_BAR;
            PG8_LDA(At, 0, 1); PG8_STAGE(PG8_SA(0, 0), a2, voffA);
            PG8_BAR; PG8_WAIT_L(0); PG8_MMA(1, 0, At, B0); PG8_BAR; PG8_SCHED;
            PG8_STAGE(PG8_SB(0, 1), b2 + hstep, voffB);
            PG8_WAIT_V(6); PG8_BAR; PG8_MMA(1, 1, At, B1); PG8_BAR;
            PG8_LDB(B0, 1, 0); PG8_SCHED; PG8_LDA(At, 1, 0); PG8_STAGE(PG8_SA(0, 1), a2 + hstep, voffA);
            PG8_WAIT_L(8); PG8_BAR; PG8_WAIT_L(0); PG8_MMA(0, 0, At, B0); PG8_BAR; PG8_SCHED;
            PG8_LDB(B1, 1, 1); PG8_STAGE(PG8_SB(1, 0), b3, voffB);
            PG8_BAR; PG8_WAIT_L(0); PG8_MMA(0, 1, At, B1); PG8_BAR;
            PG8_LDA(At, 1, 1); PG8_STAGE(PG8_SA(1, 0), a3, voffA);
            PG8_BAR; PG8_WAIT_L(0); PG8_MMA(1, 0, At, B0); PG8_BAR; PG8_SCHED;
            PG8_STAGE(PG8_SB(1, 1), b3 + hstep, voffB);
            PG8_WAIT_V(6); PG8_BAR; PG8_MMA(1, 1, At, B1); PG8_BAR;
            }
        }
        if constexpr (ALIGN_EPI) { if (wr == 0) PG8_BAR; }
        if constexpr (!Epi::AFTER_DRAIN) { E(acc, cur, wr, wc, fr, fq); S.done(cur); }
        if (!has_next) break;
#pragma unroll
        for (int a = 0; a < 2; ++a)
#pragma unroll
            for (int b = 0; b < 2; ++b)
#pragma unroll
                for (int m = 0; m < 4; ++m)
#pragma unroll
                    for (int n = 0; n < 2; ++n) acc[a][b][m][n] = (f32x4){0.f, 0.f, 0.f, 0.f};
        cur = nxt; cA = nA; cB = nB; ++ui;
        if constexpr (ALIGN_EPI) { if (wr == 1) PG8_BAR; }
    }
    PG8_WAIT_V(0);
    if constexpr (!ALIGN_EPI) { if (wr == 0) PG8_BAR; }
    PG8_BAR;
    if constexpr (Epi::AFTER_DRAIN) { E.fused(acc, cur, wr, wc, fr, fq, lds, wid, lane); S.done(cur); }
#undef PG8_SA
#undef PG8_SB
#undef PG8_STAGE
#undef PG8_LDA
#undef PG8_LDB
#undef PG8_MMA
#undef PG8_WAIT_V
#undef PG8_WAIT_L
#undef PG8_BAR
#undef PG8_SCHED
}
}
typedef unsigned short bf16;
typedef unsigned v4u __attribute__((ext_vector_type(4)));
typedef unsigned v2u __attribute__((ext_vector_type(2)));
typedef float f32x4 __attribute__((ext_vector_type(4)));
typedef float f2_t __attribute__((ext_vector_type(2)));
typedef float f32x16 __attribute__((ext_vector_type(16)));
typedef short bf16x8 __attribute__((ext_vector_type(8)));
typedef short s16x4 __attribute__((ext_vector_type(4)));
typedef __bf16 bf2_t __attribute__((ext_vector_type(2)));

constexpr int NWAVES = 8;
constexpr int DM = 1024, NB = 8, SEQ = 8192, M = NB * SEQ, INW = 1536, NMODC = 6144;
constexpr int LDS_BYTES = 160 * 1024, LDS_MISC_OFF = LDS_BYTES - 64;
constexpr size_t MiB = 1u << 20;
constexpr size_t WS_MOD = 0;
constexpr size_t WS_BAR = 208 * 1024;
constexpr size_t WS_SU = 256 * 1024;
constexpr size_t WS_SV = 384 * 1024;
constexpr size_t WS_WIN = 1 * MiB;
constexpr size_t WS_WGLU = 4 * MiB;
constexpr size_t WS_WOUT = 5 * MiB;
constexpr size_t WS_WQ = 7 * MiB;
constexpr size_t WS_KEYS = 9 * MiB;
constexpr size_t WS_WM = 9 * MiB + 512 * 1024;
constexpr size_t WS_UB = 16 * MiB;
constexpr size_t WS_VB = 48 * MiB;
constexpr size_t WS_H = 80 * MiB;
constexpr size_t WS_ZG = 208 * MiB;
constexpr size_t WS_ZS = 336 * MiB;
constexpr size_t WS_Y = 400 * MiB;
constexpr size_t WS_YS = 528 * MiB;
constexpr size_t WS_E = 592 * MiB;
constexpr size_t WS_G = 624 * MiB;
constexpr size_t WS_W = 656 * MiB;
constexpr size_t WS_SS = 688 * MiB;
constexpr size_t WS_PA = 336 * MiB;
constexpr size_t WS_X1B = 690 * MiB;
constexpr size_t WS_H2Q = 818 * MiB;
constexpr size_t WS_SH = 882 * MiB;
constexpr size_t WS_END = 883 * MiB;
constexpr float EPS = 1e-6f;

#define LDS_WAIT() asm volatile("s_waitcnt lgkmcnt(0)" ::: "memory")
__device__ __forceinline__ unsigned f2bf(float f) { unsigned u = __builtin_bit_cast(unsigned, f); return (u + 0x7fffu + ((u >> 16) & 1u)) >> 16; }
__device__ __forceinline__ unsigned pk2(float lo, float hi) { return f2bf(lo) | (f2bf(hi) << 16); }
__device__ __forceinline__ float bflo(unsigned u) { return __builtin_bit_cast(float, u << 16); }
__device__ __forceinline__ float bfhi(unsigned u) { return __builtin_bit_cast(float, u & 0xffff0000u); }
__device__ __forceinline__ float wave_sum(float v) {
#pragma unroll
    for (int o = 1; o < 64; o <<= 1) v += __shfl_xor(v, o);
    return v;
}
using pg8::gelu_t;
using pg8::sigmoid_f;

struct Args { const float* in[27]; float* out; unsigned char* ws; int ph_lo, ph_hi; };
enum { I_X = 0, I_C, I_WADA, I_BADA, I_GMIX, I_WIN, I_LNG, I_LNB, I_WS, I_BS, I_ARE, I_AIM, I_LOGDT, I_BRE, I_BIM, I_CRE, I_CIM, I_D, I_WGLU, I_BGLU, I_WOUT, I_GFFN, I_WQ, I_KEYS, I_PU, I_PV, I_GFIN };

__device__ __forceinline__ void p0_transpose_item(const float* W, int K, int N, bf16* WT, LAS float* scr, int item, int lane) {
    const int nblk = N / 32, kb = item / nblk, nb = item % nblk, k0 = 64 * kb, n0 = 32 * nb;
#pragma unroll 8
    for (int i = 0; i < 32; ++i) { const int kk = 2 * i + (lane >> 5); scr[kk * 33 + (lane & 31)] = W[(size_t)(k0 + kk) * N + n0 + (lane & 31)]; }
    LDS_WAIT(); asm volatile("" ::: "memory");
    const int c = lane & 7;
#pragma unroll
    for (int j = 0; j < 4; ++j) { const int n = (lane >> 3) + 8 * j; const LAS float* s = scr + (8 * c) * 33 + n;
        v4u o; o.x = pk2(s[0 * 33], s[1 * 33]); o.y = pk2(s[2 * 33], s[3 * 33]); o.z = pk2(s[4 * 33], s[5 * 33]); o.w = pk2(s[6 * 33], s[7 * 33]);
        *(v4u*)(WT + (size_t)(n0 + n) * K + k0 + 8 * c) = o; }
    LDS_WAIT(); asm volatile("" ::: "memory");
}
__device__ __forceinline__ void cvt_stream(const float* src, bf16* dst, size_t n8, size_t gtid, size_t gthreads) {
    for (size_t i = gtid; i < n8; i += gthreads) { const f32x4 a = *(const f32x4*)(src + i * 8), b = *(const f32x4*)(src + i * 8 + 4);
        v4u o; o.x = pk2(a.x, a.y); o.y = pk2(a.z, a.w); o.z = pk2(b.x, b.y); o.w = pk2(b.z, b.w); *(v4u*)(dst + i * 8) = o; }
}
__device__ __forceinline__ float wave_max(float v) {
#pragma unroll
    for (int o = 1; o < 64; o <<= 1) v = fmaxf(v, __shfl_xor(v, o));
    return v;
}
__device__ __forceinline__ void cvt_rows_fp8(const float* src, unsigned char* dst, float* inv, int gw, int NGW, int lane) {
    for (int row = gw; row < 16384; row += NGW) { const f32x4* p = (const f32x4*)(src + (size_t)row * 1024) + lane;
        f32x4 v[4]; float m = 0.f;
#pragma unroll
        for (int j = 0; j < 4; ++j) { v[j] = __builtin_nontemporal_load(p + 64 * j); m = fmaxf(fmaxf(m, fmaxf(fabsf(v[j].x), fabsf(v[j].y))), fmaxf(fabsf(v[j].z), fabsf(v[j].w))); }
        m = wave_max(m); const float sc = m > 0.f ? 240.0f / m : 1.0f;
#pragma unroll
        for (int j = 0; j < 4; ++j) { int pk = 0; pk = __builtin_amdgcn_cvt_pk_fp8_f32(v[j].x * sc, v[j].y * sc, pk, false); pk = __builtin_amdgcn_cvt_pk_fp8_f32(v[j].z * sc, v[j].w * sc, pk, true);
            const int c = 4 * lane + 256 * j; *(unsigned*)(dst + ((size_t)(c >> 7) * 16384 + row) * 128 + (c & 127)) = (unsigned)pk; }
        if (lane == 0) inv[row] = m > 0.f ? m * (1.0f / 240.0f) : 1.0f; }
}
__device__ __forceinline__ unsigned pack_i8x4(float a, float b, float c, float d) {
    const int ia = (int)rintf(a), ib = (int)rintf(b), ic = (int)rintf(c), id = (int)rintf(d);
    return (unsigned)(ia & 0xff) | ((unsigned)(ib & 0xff) << 8) | ((unsigned)(ic & 0xff) << 16) | ((unsigned)(id & 0xff) << 24);
}
__device__ __forceinline__ void cvt_rows_i8(const float* src, unsigned char* dst, float* inv, int gw, int NGW, int lane) {
    for (int row = gw; row < 16384; row += NGW) { const f32x4* p = (const f32x4*)(src + (size_t)row * 1024) + lane;
        f32x4 v[4]; float m = 0.f;
#pragma unroll
        for (int j = 0; j < 4; ++j) { v[j] = __builtin_nontemporal_load(p + 64 * j); m = fmaxf(fmaxf(m, fmaxf(fabsf(v[j].x), fabsf(v[j].y))), fmaxf(fabsf(v[j].z), fabsf(v[j].w))); }
        m = wave_max(m); const float sc = m > 0.f ? 127.0f / m : 1.0f;
#pragma unroll
        for (int j = 0; j < 4; ++j) { const int c = 4 * lane + 256 * j; *(unsigned*)(dst + ((size_t)(c >> 7) * 16384 + row) * 128 + (c & 127)) = pack_i8x4(v[j].x * sc, v[j].y * sc, v[j].z * sc, v[j].w * sc); }
        if (lane == 0) inv[row] = m > 0.f ? m * (1.0f / 127.0f) : 1.0f; }
}
__device__ __forceinline__ unsigned pack_i4x8(const float (&v)[8], float inv) {
    unsigned d = 0;
#pragma unroll
    for (int i = 0; i < 8; ++i) { int q = (int)rintf(v[i] * inv); q = q < -8 ? -8 : (q > 7 ? 7 : q); d |= (unsigned)(q & 15) << (4 * i); }
    return d;
}
__device__ __forceinline__ void cvt_rows_i4(const float* src, unsigned char* dst, float* invs, int gw, int NGW, int lane) {
    for (int row = gw; row < 16384; row += NGW) { const float* p = src + (size_t)row * 1024;
        float v[2][8]; float ss = 0.f;
#pragma unroll
        for (int q = 0; q < 2; ++q) { const f32x4 x0 = __builtin_nontemporal_load((const f32x4*)(p + 512 * q + 8 * lane)), x1 = __builtin_nontemporal_load((const f32x4*)(p + 512 * q + 8 * lane + 4));
            v[q][0] = x0.x; v[q][1] = x0.y; v[q][2] = x0.z; v[q][3] = x0.w; v[q][4] = x1.x; v[q][5] = x1.y; v[q][6] = x1.z; v[q][7] = x1.w;
#pragma unroll
            for (int i = 0; i < 8; ++i) ss += v[q][i] * v[q][i]; }
        const float rms = sqrtf(wave_sum(ss) * (1.0f / 1024.0f)); const float step = rms > 0.f ? rms * (2.5f / 7.5f) : 1.0f, inv = 1.0f / step;
#pragma unroll
        for (int q = 0; q < 2; ++q) { const int c = 512 * q + 8 * lane; *(unsigned*)(dst + ((size_t)(c >> 7) * 16384 + row) * 64 + ((c & 127) >> 1)) = pack_i4x8(v[q], inv); }
        if (lane == 0) invs[row] = step; }
}
template <int LOG2W> __device__ __forceinline__ void cvt_rows_fp4(const float* src, unsigned char* dst, float* invs, int gw, int NGW, int lane) {
    for (int base = gw; base < 16384; base += 4 * NGW) {
        float v[4][2][8]; float ss[4];
#pragma unroll
        for (int rr = 0; rr < 4; ++rr) { const int row = min(base + rr * NGW, 16383); const float* p = src + (size_t)row * 1024;
#pragma unroll
            for (int q = 0; q < 2; ++q) { const f32x4 x0 = __builtin_nontemporal_load((const f32x4*)(p + 512 * q + 8 * lane)), x1 = __builtin_nontemporal_load((const f32x4*)(p + 512 * q + 8 * lane + 4));
                v[rr][q][0] = x0.x; v[rr][q][1] = x0.y; v[rr][q][2] = x0.z; v[rr][q][3] = x0.w; v[rr][q][4] = x1.x; v[rr][q][5] = x1.y; v[rr][q][6] = x1.z; v[rr][q][7] = x1.w; } }
#pragma unroll
        for (int rr = 0; rr < 4; ++rr) { float s = 0.f;
#pragma unroll
            for (int q = 0; q < 2; ++q)
#pragma unroll
                for (int i = 0; i < 8; ++i) s += v[rr][q][i] * v[rr][q][i];
            ss[rr] = wave_sum(s); }
#pragma unroll
        for (int rr = 0; rr < 4; ++rr) { const int row = base + rr * NGW; if (row < 16384) {
            const float rms = sqrtf(ss[rr] * (1.0f / 1024.0f)); const float sc = rms > 0.f ? rms * 0.5f : 1.0f, inv = 1.0f / sc;
#pragma unroll
            for (int q = 0; q < 2; ++q) { float t[8];
#pragma unroll
                for (int i = 0; i < 8; ++i) t[i] = fminf(fmaxf(v[rr][q][i] * inv, -6.0f), 6.0f);
                unsigned d = 0;
                d = __builtin_amdgcn_cvt_scalef32_pk_fp4_f32(d, t[0], t[1], 1.0f, 0); d = __builtin_amdgcn_cvt_scalef32_pk_fp4_f32(d, t[2], t[3], 1.0f, 1);
                d = __builtin_amdgcn_cvt_scalef32_pk_fp4_f32(d, t[4], t[5], 1.0f, 2); d = __builtin_amdgcn_cvt_scalef32_pk_fp4_f32(d, t[6], t[7], 1.0f, 3);
                const int c = 512 * q + 8 * lane; constexpr int W = 1 << LOG2W; *(unsigned*)(dst + ((size_t)(c >> LOG2W) * 16384 + row) * (W / 2) + ((c & (W - 1)) >> 1)) = d; }
            if (lane == 0) invs[row] = sc; } }
    }
}
__device__ __forceinline__ void p0_mod_item(const float* c, const float* w_ada, const float* b_ada, float* mod, LAS float* scr, int item, int tid) {
    LAS float* cond = scr;
    LAS float* red = scr + 8 * 1024;
    for (int i = tid; i < 8 * 1024; i += 512) { const float v = c[i]; cond[i] = v * sigmoid_f(v); }
    __syncthreads();
    const int kq = tid >> 3, cq = tid & 7, j0 = item * 24 + cq * 3;
    float acc[8][3];
#pragma unroll
    for (int b = 0; b < 8; ++b) { acc[b][0] = 0.f; acc[b][1] = 0.f; acc[b][2] = 0.f; }
    for (int i = 0; i < 16; ++i) { const int k = kq + 64 * i; const float* wp = w_ada + (size_t)k * NMODC + j0; const float w0 = wp[0], w1 = wp[1], w2 = wp[2];
#pragma unroll
        for (int b = 0; b < 8; ++b) { const float s = cond[b * 1024 + k]; acc[b][0] += s * w0; acc[b][1] += s * w1; acc[b][2] += s * w2; } }
#pragma unroll
    for (int b = 0; b < 8; ++b)
#pragma unroll
        for (int e = 0; e < 3; ++e) red[kq * 192 + b * 24 + cq * 3 + e] = acc[b][e];
    __syncthreads();
    if (tid < 192) { float s = 0.f; for (int q = 0; q < 64; ++q) s += red[q * 192 + tid]; const int b = tid / 24, j = item * 24 + tid % 24; mod[b * NMODC + j] = s + b_ada[j]; }
    __syncthreads();
}
__device__ __forceinline__ void phase_prologue(const Args& a, LAS unsigned char* lds, int tid, int wave, int lane) {
    unsigned char* ws = a.ws; const int G = gridDim.x, bx = blockIdx.x;
    for (int it = bx; it < 256; it += G) p0_mod_item(a.in[I_C], a.in[I_WADA], a.in[I_BADA], (float*)(ws + WS_MOD), (LAS float*)lds, it, tid);
    LAS float* scr = (LAS float*)(lds + wave * 16384);
    const int gw = bx * NWAVES + wave, NGW = G * NWAVES;
    constexpr int I_IN = 16 * 48, I_GLU = 8 * 16, I_OUT = 16 * 32, I_Q = 16 * 32, NITEMS = I_IN + I_GLU + I_OUT + I_Q;
    for (int it = gw; it < NITEMS; it += NGW) { int r = it;
        if (r < I_IN) { p0_transpose_item(a.in[I_WIN], 1024, 1536, (bf16*)(ws + WS_WIN), scr, r, lane); continue; } r -= I_IN;
        if (r < I_GLU) { p0_transpose_item(a.in[I_WGLU], 512, 512, (bf16*)(ws + WS_WGLU), scr, r, lane); continue; } r -= I_GLU;
        if (r < I_OUT) { p0_transpose_item(a.in[I_WOUT], 1024, 1024, (bf16*)(ws + WS_WOUT), scr, r, lane); continue; } r -= I_OUT;
        p0_transpose_item(a.in[I_WQ], 1024, 1024, (bf16*)(ws + WS_WQ), scr, r, lane); }
    const size_t gtid = (size_t)bx * 512 + tid, gth = (size_t)G * 512;
    cvt_stream(a.in[I_KEYS], (bf16*)(ws + WS_KEYS), 8 * 2 * 128 * 64 / 8, gtid, gth);
    { const float* w = a.in[I_WS]; bf16* wm = (bf16*)(ws + WS_WM);
      for (size_t i = gtid; i < 4 * 128 * 128 / 8; i += gth) { const int e0 = (int)i * 8, ii = (e0 >> 7) & 127, j0 = e0 & 127; const f32x4 p = *(const f32x4*)(w + e0), q = *(const f32x4*)(w + e0 + 4);
          float v[8] = {p.x, p.y, p.z, p.w, q.x, q.y, q.z, q.w};
#pragma unroll
          for (int e = 0; e < 8; ++e) v[e] = (j0 + e <= ii) ? v[e] : 0.f;
          v4u o; o.x = pk2(v[0], v[1]); o.y = pk2(v[2], v[3]); o.z = pk2(v[4], v[5]); o.w = pk2(v[6], v[7]); *(v4u*)(wm + e0) = o; } }
    cvt_rows_fp4<8>(a.in[I_PU], ws + WS_UB, (float*)(ws + WS_SU), gw, NGW, lane); cvt_rows_fp4<8>(a.in[I_PV], ws + WS_VB, (float*)(ws + WS_SV), gw, NGW, lane);
}

__device__ __forceinline__ void phase_norm_mod(const float* x, const float* gw, const float* mod, int sh_off, int sc_off, bf16* H, int wave, int lane) {
    const int G = gridDim.x;
    for (int it = blockIdx.x; it < 256; it += G) { const int b = it >> 5; const float* mb = mod + (size_t)b * NMODC;
        f32x4 A[4], S[4];
#pragma unroll
        for (int j = 0; j < 4; ++j) { const int c0 = 4 * lane + 256 * j; const f32x4 g = *(const f32x4*)(gw + c0), sc = *(const f32x4*)(mb + sc_off + c0); A[j] = g * (sc + 1.0f); S[j] = *(const f32x4*)(mb + sh_off + c0); }
        for (int r = 0; r < 32; ++r) { const size_t row = (size_t)it * 256 + wave * 32 + r; const f32x4* xr = (const f32x4*)(x + row * 1024) + lane;
            f32x4 v[4]; float s = 0.f;
#pragma unroll
            for (int j = 0; j < 4; ++j) { v[j] = __builtin_nontemporal_load(xr + 64 * j); s += (v[j].x * v[j].x + v[j].y * v[j].y) + (v[j].z * v[j].z + v[j].w * v[j].w); }
            const float rstd = 1.0f / sqrtf(wave_sum(s) * (1.0f / 1024.0f) + EPS);
            unsigned long long* o8 = (unsigned long long*)(H + row * 1024) + lane;
#pragma unroll
            for (int j = 0; j < 4; ++j) { const f32x4 h = v[j] * rstd * A[j] + S[j]; o8[64 * j] = (unsigned long long)pk2(h.x, h.y) | ((unsigned long long)pk2(h.z, h.w) << 32); } } }
}
__device__ __forceinline__ void phase_norm_mod_bf(const bf16* x, const float* gw, const float* mod, int sh_off, int sc_off, bf16* H, unsigned char* HQ, float* SH, int wave, int lane) {
    const int G = gridDim.x;
    for (int it = blockIdx.x; it < 256; it += G) { const int b = it >> 5; const float* mb = mod + (size_t)b * NMODC;
        float A[16], S[16];
#pragma unroll
        for (int q = 0; q < 2; ++q)
#pragma unroll
            for (int j = 0; j < 8; ++j) { const int c = 512 * q + 8 * lane + j; A[8 * q + j] = gw[c] * (mb[sc_off + c] + 1.0f); S[8 * q + j] = mb[sh_off + c]; }
        for (int r = 0; r < 32; ++r) { const size_t row = (size_t)it * 256 + wave * 32 + r;
            const v4u r0 = *(const v4u*)(x + row * 1024 + 8 * lane), r1 = *(const v4u*)(x + row * 1024 + 512 + 8 * lane);
            float v[16] = {bflo(r0.x), bfhi(r0.x), bflo(r0.y), bfhi(r0.y), bflo(r0.z), bfhi(r0.z), bflo(r0.w), bfhi(r0.w), bflo(r1.x), bfhi(r1.x), bflo(r1.y), bfhi(r1.y), bflo(r1.z), bfhi(r1.z), bflo(r1.w), bfhi(r1.w)};
            float s = 0.f;
#pragma unroll
            for (int j = 0; j < 16; ++j) s += v[j] * v[j];
            const float rstd = 1.0f / sqrtf(wave_sum(s) * (1.0f / 1024.0f) + EPS);
#pragma unroll
            for (int j = 0; j < 16; ++j) v[j] = v[j] * rstd * A[j] + S[j];
            v4u o0, o1; o0.x = pk2(v[0], v[1]); o0.y = pk2(v[2], v[3]); o0.z = pk2(v[4], v[5]); o0.w = pk2(v[6], v[7]); o1.x = pk2(v[8], v[9]); o1.y = pk2(v[10], v[11]); o1.z = pk2(v[12], v[13]); o1.w = pk2(v[14], v[15]);
            *(v4u*)(H + row * 1024 + 8 * lane) = o0; *(v4u*)(H + row * 1024 + 512 + 8 * lane) = o1;
            float mx = 0.f;
#pragma unroll
            for (int j = 0; j < 16; ++j) mx = fmaxf(mx, fabsf(v[j]));
            mx = wave_max(mx); const float qs = mx > 0.f ? 200.0f / mx : 1.0f;
#pragma unroll
            for (int q = 0; q < 2; ++q) { int p0 = 0, p1 = 0;
                p0 = __builtin_amdgcn_cvt_pk_fp8_f32(v[8 * q] * qs, v[8 * q + 1] * qs, p0, false); p0 = __builtin_amdgcn_cvt_pk_fp8_f32(v[8 * q + 2] * qs, v[8 * q + 3] * qs, p0, true);
                p1 = __builtin_amdgcn_cvt_pk_fp8_f32(v[8 * q + 4] * qs, v[8 * q + 5] * qs, p1, false); p1 = __builtin_amdgcn_cvt_pk_fp8_f32(v[8 * q + 6] * qs, v[8 * q + 7] * qs, p1, true);
                *(v2u*)(HQ + row * 1024 + 512 * q + 8 * lane) = (v2u){(unsigned)p0, (unsigned)p1}; }
            if (lane == 0) SH[row] = mx > 0.f ? mx * (1.0f / 200.0f) : 1.0f; } }
}
__device__ __forceinline__ void sincos_f(float th, float& s, float& c) {
    const float q = rintf(th * 0.63661977236758f);
    float y = fmaf(q, -1.5707962513f, th); y = fmaf(q, -7.5497894159e-8f, y); y = fmaf(q, -5.3903029534e-15f, y);
    const float y2 = y * y;
    const float sp = y + y * y2 * (-1.6666667163e-1f + y2 * (8.3333337680e-3f + y2 * (-1.9841270114e-4f + y2 * 2.7557314297e-6f)));
    const float cp = 1.0f + y2 * (-0.5f + y2 * (4.1666667908e-2f + y2 * (-1.3888889225e-3f + y2 * (2.4801587642e-5f + y2 * -2.7557314297e-7f))));
    const int qi = (int)q & 3;
    s = (qi == 0) ? sp : (qi == 1) ? cp : (qi == 2) ? -sp : -cp;
    c = (qi == 0) ? cp : (qi == 1) ? -sp : (qi == 2) ? -cp : sp;
}
__device__ __forceinline__ void s5_disc(const float* are, const float* aim, float dt, int gp, float& abr, float& abi, float& cr, float& ci) {
    const float ar = fminf(are[gp], -1e-4f), ai = aim[gp];
    const float mag = expf(ar * dt); float sn, cs; sincos_f(ai * dt, sn, cs);
    abr = mag * cs; abi = mag * sn;
    const float nr = abr - 1.0f, ni = abi, den = 1.0f / (ar * ar + ai * ai);
    cr = (nr * ar + ni * ai) * den; ci = (ni * ar - nr * ai) * den;
}
constexpr int S5_X_LD = 136;
constexpr int S5_X_OFF = 0, S5_E_OFF = 128 * S5_X_LD * 2;
#define LDS_BARRIER() do { asm volatile("s_waitcnt lgkmcnt(0)" ::: "memory"); __builtin_amdgcn_s_barrier(); asm volatile("" ::: "memory"); } while (0)
#define CMAC_R(ar, ai, br, bi, cr) fmaf((ar), (br), fmaf(-(ai), (bi), (cr)))
#define CMAC_I(ar, ai, br, bi, ci) fmaf((ar), (bi), fmaf((ai), (br), (ci)))
#define CMUL_R(ar, ai, br, bi) ((ar) * (br) - (ai) * (bi))
#define CMUL_I(ar, ai, br, bi) ((ar) * (bi) + (ai) * (br))
__device__ __forceinline__ void s5_item(const Args& a, LAS unsigned char* lds, int item, int wave, int lane) {
    const int b = item >> 5, g = item & 31;
    const float dt = expf(a.in[I_LOGDT][g]);
    LAS bf16* X = (LAS bf16*)(lds + S5_X_OFF); LAS float* E = (LAS float*)(lds + S5_E_OFF);
    const int mt = wave >> 1, sh = wave & 1, l32 = lane & 31, hf = lane >> 5, p = 32 * sh + l32;
    float a1r, a1i, cr, ci; s5_disc(a.in[I_ARE], a.in[I_AIM], dt, g * 64 + p, a1r, a1i, cr, ci);
    const float a2r = CMUL_R(a1r, a1i, a1r, a1i), a2i = CMUL_I(a1r, a1i, a1r, a1i), a3r = CMUL_R(a2r, a2i, a1r, a1i), a3i = CMUL_I(a2r, a2i, a1r, a1i);
    const float a4r = CMUL_R(a2r, a2i, a2r, a2i), a4i = CMUL_I(a2r, a2i, a2r, a2i), a8r = CMUL_R(a4r, a4i, a4r, a4i), a8i = CMUL_I(a4r, a4i, a4r, a4i);
    const float a12r = CMUL_R(a8r, a8i, a4r, a4i), a12i = CMUL_I(a8r, a8i, a4r, a4i), a16r = CMUL_R(a8r, a8i, a8r, a8i), a16i = CMUL_I(a8r, a8i, a8r, a8i);
    const float a20r = CMUL_R(a16r, a16i, a4r, a4i), a20i = CMUL_I(a16r, a16i, a4r, a4i), a24r = CMUL_R(a16r, a16i, a8r, a8i), a24i = CMUL_I(a16r, a16i, a8r, a8i);
    const float a28r = CMUL_R(a24r, a24i, a4r, a4i), a28i = CMUL_I(a24r, a24i, a4r, a4i), a32r = CMUL_R(a16r, a16i, a16r, a16i), a32i = CMUL_I(a16r, a16i, a16r, a16i);
    const float pwr[4] = {a1r, a2r, a3r, a4r}, pwi[4] = {a1i, a2i, a3i, a4i};
    const float qkr[4] = {hf ? a4r : 1.0f, hf ? a12r : a8r, hf ? a20r : a16r, hf ? a28r : a24r}, qki[4] = {hf ? a4i : 0.0f, hf ? a12i : a8i, hf ? a20i : a16i, hf ? a28i : a24i};
    bf16x8 bfr_re, bfr_im;
    { const float* br = a.in[I_BRE] + (size_t)(g * 64 + p) * 16 + 8 * hf; const float* bi = a.in[I_BIM] + (size_t)(g * 64 + p) * 16 + 8 * hf;
      float vr[8], vi[8];
#pragma unroll
      for (int j = 0; j < 8; ++j) { vr[j] = cr * br[j] - ci * bi[j]; vi[j] = cr * bi[j] + ci * br[j]; }
      v4u o; o.x = pk2(vr[0], vr[1]); o.y = pk2(vr[2], vr[3]); o.z = pk2(vr[4], vr[5]); o.w = pk2(vr[6], vr[7]); bfr_re = __builtin_bit_cast(bf16x8, o);
      o.x = pk2(vi[0], vi[1]); o.y = pk2(vi[2], vi[3]); o.z = pk2(vi[4], vi[5]); o.w = pk2(vi[6], vi[7]); bfr_im = __builtin_bit_cast(bf16x8, o); }
    const int l16 = lane & 15, q4 = lane >> 4;
    bf16x8 cm[4];
#pragma unroll
    for (int ks = 0; ks < 4; ++ks) { const int s0 = 16 * ks + 4 * q4; const float* cre = a.in[I_CRE] + (size_t)(g * 16 + l16) * 64 + s0; const float* cim = a.in[I_CIM] + (size_t)(g * 16 + l16) * 64 + s0;
        v4u o; o.x = pk2(cre[0], -cim[0]); o.y = pk2(cre[1], -cim[1]); o.z = pk2(cre[2], -cim[2]); o.w = pk2(cre[3], -cim[3]); cm[ks] = __builtin_bit_cast(bf16x8, o); }
    float dsk[4];
#pragma unroll
    for (int r = 0; r < 4; ++r) dsk[r] = a.in[I_D][g * 16 + 4 * q4 + r];
    const bf16* ZS = (const bf16*)(a.ws + WS_ZS) + ((size_t)(b * 32 + g) * 8192) * 16;
    bf16* YS = (bf16*)(a.ws + WS_YS) + (size_t)b * 8192 * 512 + g * 16;
    float xinr = 0.f, xini = 0.f;
    bf16x8 ua_n = *(const bf16x8*)(ZS + (mt * 32 + l32) * 16 + hf * 8);
    v2u uu_n = *(const v2u*)(ZS + (16 * wave + l16) * 16 + 4 * q4);
    for (int ch = 0; ch < 64; ++ch) {
        const bf16x8 ua = ua_n; const v2u uu = uu_n;
        { const int cn = ch < 63 ? ch + 1 : 63; const bf16* zn = ZS + (size_t)cn * 128 * 16;
          ua_n = *(const bf16x8*)(zn + (mt * 32 + l32) * 16 + hf * 8); uu_n = *(const v2u*)(zn + (16 * wave + l16) * 16 + 4 * q4); }
        const f32x16 z16 = {0.f, 0.f, 0.f, 0.f, 0.f, 0.f, 0.f, 0.f, 0.f, 0.f, 0.f, 0.f, 0.f, 0.f, 0.f, 0.f};
        const f32x16 bre = __builtin_amdgcn_mfma_f32_32x32x16_bf16(ua, bfr_re, z16, 0, 0, 0), bim = __builtin_amdgcn_mfma_f32_32x32x16_bf16(ua, bfr_im, z16, 0, 0, 0);
        float xr[16], xi[16];
#pragma unroll
        for (int j = 0; j < 4; ++j) { xr[4 * j] = bre[4 * j]; xi[4 * j] = bim[4 * j];
#pragma unroll
            for (int i = 1; i < 4; ++i) { xr[4 * j + i] = CMAC_R(a1r, a1i, xr[4 * j + i - 1], xi[4 * j + i - 1], bre[4 * j + i]); xi[4 * j + i] = CMAC_I(a1r, a1i, xr[4 * j + i - 1], xi[4 * j + i - 1], bim[4 * j + i]); } }
        float clr[4], cli[4], ber, bei;
        { float pgr[4], pgi[4];
#pragma unroll
          for (int j = 0; j < 4; ++j) { pgr[j] = __shfl_xor(xr[4 * j + 3], 32); pgi[j] = __shfl_xor(xi[4 * j + 3], 32); }
          float cr_ = 0.f, ci_ = 0.f;
#pragma unroll
          for (int k = 0; k < 8; ++k) { const int j = k >> 1; const bool mine = (hf == (k & 1));
              if ((k & 1) == 0) { clr[j] = cr_; cli[j] = ci_; } else { clr[j] = mine ? cr_ : clr[j]; cli[j] = mine ? ci_ : cli[j]; }
              const float gr = mine ? xr[4 * j + 3] : pgr[j], gi = mine ? xi[4 * j + 3] : pgi[j];
              const float nr = CMAC_R(a4r, a4i, cr_, ci_, gr), ni = CMAC_I(a4r, a4i, cr_, ci_, gi); cr_ = nr; ci_ = ni; }
          ber = cr_; bei = ci_; }
        if (hf == 0) { E[(mt * 64 + p) * 2] = ber; E[(mt * 64 + p) * 2 + 1] = bei; }
        LDS_BARRIER();
        float mbr = 0.f, mbi = 0.f;
        { float cr_ = xinr, ci_ = xini;
#pragma unroll
          for (int m = 0; m < 4; ++m) { if (m == mt) { mbr = cr_; mbi = ci_; } const float er = E[(m * 64 + p) * 2], ei = E[(m * 64 + p) * 2 + 1];
              const float nr = CMAC_R(a32r, a32i, cr_, ci_, er), ni = CMAC_I(a32r, a32i, cr_, ci_, ei); cr_ = nr; ci_ = ni; }
          xinr = cr_; xini = ci_; }
#pragma unroll
        for (int j = 0; j < 4; ++j) { const float ckr = CMAC_R(qkr[j], qki[j], mbr, mbi, clr[j]), cki = CMAC_I(qkr[j], qki[j], mbr, mbi, cli[j]);
#pragma unroll
            for (int i = 0; i < 4; ++i) { const float fr = CMAC_R(pwr[i], pwi[i], ckr, cki, xr[4 * j + i]), fi = CMAC_I(pwr[i], pwi[i], ckr, cki, xi[4 * j + i]);
                *(LAS unsigned*)(X + (32 * mt + 8 * j + 4 * hf + i) * S5_X_LD + 2 * p) = pg8::cvt_pk_bf16(fr, fi); } }
        LDS_BARRIER();
        { f32x4 o = {0.f, 0.f, 0.f, 0.f};
#pragma unroll
          for (int ks = 0; ks < 4; ++ks) { const bf16x8 xa = *(const LAS bf16x8*)(X + (16 * wave + l16) * S5_X_LD + 32 * ks + 8 * q4); o = __builtin_amdgcn_mfma_f32_16x16x32_bf16(cm[ks], xa, o, 0, 0, 0); }
          const int t = 16 * wave + l16;
          const float y0 = gelu_t(o[0] + dsk[0] * bflo(uu.x)), y1 = gelu_t(o[1] + dsk[1] * bfhi(uu.x)), y2 = gelu_t(o[2] + dsk[2] * bflo(uu.y)), y3 = gelu_t(o[3] + dsk[3] * bfhi(uu.y));
          v2u w; w.x = pg8::cvt_pk_bf16(y0, y1); w.y = pg8::cvt_pk_bf16(y2, y3); *(v2u*)(YS + (size_t)(ch * 128 + t) * 512 + 4 * q4) = w; }
    }
    __syncthreads();
}

constexpr int SGU_RS = 1056;
typedef short v4i16_t __attribute__((ext_vector_type(4)));
__device__ __forceinline__ s16x4 ds_tr16(const LAS unsigned char* p) { return __builtin_bit_cast(s16x4, __builtin_amdgcn_ds_read_tr16_b64_v4i16((LAS v4i16_t*)p)); }
__device__ __forceinline__ void sgu_item(const Args& a, LAS unsigned char* lds, int item, int wave, int lane) {
    const bf16* ZG = (const bf16*)(a.ws + WS_ZG); bf16* Y = (bf16*)(a.ws + WS_Y); const bf16* WM = (const bf16*)(a.ws + WS_WM);
    const int r0 = item * 128;
    { float lg[8], lb[8];
#pragma unroll
      for (int j = 0; j < 8; ++j) { lg[j] = a.in[I_LNG][8 * lane + j]; lb[j] = a.in[I_LNB][8 * lane + j]; }
      v4u raw[16];
#pragma unroll
      for (int tt = 0; tt < 16; ++tt) raw[tt] = __builtin_nontemporal_load((const v4u*)(ZG + (size_t)(r0 + 16 * wave + tt) * 1024 + 512 + 8 * lane));
      float s1[16], s2[16];
#pragma unroll
      for (int tt = 0; tt < 16; ++tt) { const float f[8] = {bflo(raw[tt].x), bfhi(raw[tt].x), bflo(raw[tt].y), bfhi(raw[tt].y), bflo(raw[tt].z), bfhi(raw[tt].z), bflo(raw[tt].w), bfhi(raw[tt].w)};
          float a1 = 0.f, a2 = 0.f;
#pragma unroll
          for (int j = 0; j < 8; ++j) { a1 += f[j]; a2 += f[j] * f[j]; }
          s1[tt] = a1; s2[tt] = a2; }
#pragma unroll
      for (int o = 1; o < 64; o <<= 1) {
#pragma unroll
          for (int tt = 0; tt < 16; ++tt) { s1[tt] += __shfl_xor(s1[tt], o); s2[tt] += __shfl_xor(s2[tt], o); } }
#pragma unroll
      for (int tt = 0; tt < 16; ++tt) { const int t = 16 * wave + tt;
          float f[8] = {bflo(raw[tt].x), bfhi(raw[tt].x), bflo(raw[tt].y), bfhi(raw[tt].y), bflo(raw[tt].z), bfhi(raw[tt].z), bflo(raw[tt].w), bfhi(raw[tt].w)};
          const float mu = s1[tt] * (1.0f / 512.0f), var = fmaxf(s2[tt] * (1.0f / 512.0f) - mu * mu, 0.f), rstd = 1.0f / sqrtf(var + EPS);
#pragma unroll
          for (int j = 0; j < 8; ++j) f[j] = (f[j] - mu) * rstd * lg[j] + lb[j];
          v4u o; o.x = pk2(f[0], f[1]); o.y = pk2(f[2], f[3]); o.z = pk2(f[4], f[5]); o.w = pk2(f[6], f[7]);
          *(LAS v4u*)(lds + t * SGU_RS + 16 * lane) = o; } }
    __syncthreads();
    const int l16 = lane & 15, q4 = lane >> 4, qq = l16 >> 2, pp = l16 & 3, nks = (wave >> 1) + 1, irow = 16 * wave + l16;
    for (int h = 0; h < 4; ++h) {
        f32x4 acc[8];
#pragma unroll
        for (int nt = 0; nt < 8; ++nt) acc[nt] = (f32x4){0.f, 0.f, 0.f, 0.f};
        bf16x8 wf[4]; v2u uu[8];
#pragma unroll
        for (int ks = 0; ks < 4; ++ks) { const int kc = ks < nks ? ks : nks - 1; wf[ks] = *(const bf16x8*)(WM + ((size_t)(h * 128 + irow)) * 128 + 32 * kc + 8 * q4); }
#pragma unroll
        for (int nt = 0; nt < 8; ++nt) uu[nt] = __builtin_nontemporal_load((const v2u*)(ZG + (size_t)(r0 + irow) * 1024 + h * 128 + 16 * nt + 4 * q4));
        const float bs = a.in[I_BS][h * 128 + irow];
#pragma unroll
        for (int ks = 0; ks < 4; ++ks) { if (ks < nks) {
            const LAS unsigned char* vb = lds + (32 * ks + 8 * q4 + qq) * SGU_RS + (h * 128 + 4 * pp) * 2;
#pragma unroll
            for (int nt = 0; nt < 8; ++nt) { const s16x4 lo = ds_tr16(vb + nt * 32), hi = ds_tr16(vb + nt * 32 + 4 * SGU_RS);
                const bf16x8 vf = {lo[0], lo[1], lo[2], lo[3], hi[0], hi[1], hi[2], hi[3]};
                acc[nt] = __builtin_amdgcn_mfma_f32_16x16x32_bf16(vf, wf[ks], acc[nt], 0, 0, 0); } } }
#pragma unroll
        for (int nt = 0; nt < 8; ++nt) { const size_t o = (size_t)(r0 + irow) * 1024 + h * 128 + 16 * nt + 4 * q4;
            v2u w; w.x = pk2(bflo(uu[nt].x) * (acc[nt][0] + bs), bfhi(uu[nt].x) * (acc[nt][1] + bs)); w.y = pk2(bflo(uu[nt].y) * (acc[nt][2] + bs), bfhi(uu[nt].y) * (acc[nt][3] + bs)); *(v2u*)(Y + o) = w; }
    }
    __syncthreads();
}
__device__ __forceinline__ int f2i(float f) { return __builtin_bit_cast(int, f); }
__device__ __forceinline__ float i2f(int i) { return __builtin_bit_cast(float, i); }
__device__ __forceinline__ float kmax(float a, float b) { float r; asm("v_max_f32 %0, %1, %2" : "=v"(r) : "v"(a), "v"(b)); return r; }
__device__ __forceinline__ float kmin(float a, float b) { float r; asm("v_min_f32 %0, %1, %2" : "=v"(r) : "v"(a), "v"(b)); return r; }
__device__ __forceinline__ float mkkey(float s, int keep, int payload) { return i2f((f2i(s) & keep) | payload); }
__device__ __forceinline__ void sort16(float (&v)[16]) {
#define CE16(i, j) { const float x_ = v[i], y_ = v[j]; v[i] = kmax(x_, y_); v[j] = kmin(x_, y_); }
    CE16(0,1) CE16(2,3) CE16(0,2) CE16(1,3) CE16(1,2) CE16(4,5) CE16(6,7) CE16(4,6) CE16(5,7) CE16(5,6) CE16(0,4) CE16(2,6) CE16(2,4) CE16(1,5) CE16(3,7) CE16(3,5) CE16(1,2) CE16(3,4) CE16(5,6) CE16(8,9) CE16(10,11) CE16(8,10) CE16(9,11) CE16(9,10) CE16(12,13) CE16(14,15) CE16(12,14) CE16(13,15) CE16(13,14) CE16(8,12) CE16(10,14) CE16(10,12) CE16(9,13) CE16(11,15) CE16(11,13) CE16(9,10) CE16(11,12) CE16(13,14) CE16(0,8) CE16(4,12) CE16(4,8) CE16(2,10) CE16(6,14) CE16(6,10) CE16(2,4) CE16(6,8) CE16(10,12) CE16(1,9) CE16(5,13) CE16(5,9) CE16(3,11) CE16(7,15) CE16(7,11) CE16(3,5) CE16(7,9) CE16(11,13) CE16(1,2) CE16(3,4) CE16(5,6) CE16(7,8) CE16(9,10) CE16(11,12) CE16(13,14)
#undef CE16
}
__device__ __forceinline__ void merge16(float (&a)[16], const float (&b)[16]) {
#pragma unroll
    for (int i = 0; i < 16; ++i) a[i] = kmax(a[i], b[15 - i]);
#pragma unroll
    for (int j = 8; j > 0; j >>= 1)
#pragma unroll
        for (int i = 0; i < 16; ++i) { const int l = i ^ j; if (l > i) { const float x = a[i], y = a[l]; a[i] = kmax(x, y); a[l] = kmin(x, y); } }
}
constexpr int NCAND = 50;
constexpr int cand_a(int n) { int c = 0; for (int a = 0; a < 16; ++a) for (int b = 0; b < 16; ++b) if ((a + 1) * (b + 1) <= 16) { if (c == n) return a; ++c; } return 0; }
constexpr int cand_b(int n) { int c = 0; for (int a = 0; a < 16; ++a) for (int b = 0; b < 16; ++b) if ((a + 1) * (b + 1) <= 16) { if (c == n) return b; ++c; } return 0; }
template <int N> struct CandAB { static constexpr int a = cand_a(N), b = cand_b(N); };
template <int S> __device__ __forceinline__ float cand_key2(const float (&f1)[16], const float (&f2)[16], bool hf) {
    if constexpr (S < 25) { constexpr int a0 = CandAB<S>::a, b0 = CandAB<S>::b, a1 = CandAB<25 + S>::a, b1 = CandAB<25 + S>::b;
        const float s = (hf ? f1[a1] : f1[a0]) + (hf ? f2[b1] : f2[b0]); return mkkey(s, ~0xff, hf ? ((a1 << 4) | b1) : ((a0 << 4) | b0)); }
    else return i2f((int)0xff800000);
}
template <int G> __device__ __forceinline__ void cand_fill2(float (&v)[16], const float (&f1)[16], const float (&f2)[16], bool hf) {
    v[0] = cand_key2<G * 16 + 0>(f1, f2, hf); v[1] = cand_key2<G * 16 + 1>(f1, f2, hf); v[2] = cand_key2<G * 16 + 2>(f1, f2, hf); v[3] = cand_key2<G * 16 + 3>(f1, f2, hf);
    v[4] = cand_key2<G * 16 + 4>(f1, f2, hf); v[5] = cand_key2<G * 16 + 5>(f1, f2, hf); v[6] = cand_key2<G * 16 + 6>(f1, f2, hf); v[7] = cand_key2<G * 16 + 7>(f1, f2, hf);
    v[8] = cand_key2<G * 16 + 8>(f1, f2, hf); v[9] = cand_key2<G * 16 + 9>(f1, f2, hf); v[10] = cand_key2<G * 16 + 10>(f1, f2, hf); v[11] = cand_key2<G * 16 + 11>(f1, f2, hf);
    v[12] = cand_key2<G * 16 + 12>(f1, f2, hf); v[13] = cand_key2<G * 16 + 13>(f1, f2, hf); v[14] = cand_key2<G * 16 + 14>(f1, f2, hf); v[15] = cand_key2<G * 16 + 15>(f1, f2, hf);
}

__device__ __forceinline__ void peer_topk32(const bf16* Q, const bf16* KEYS, unsigned short* EO, float* GO, LAS unsigned char* wl  , int tok0, int lane) {
    const int l32 = lane & 31, hf = lane >> 5; const size_t tok = (size_t)tok0 + l32;
    const bf16* qrow = Q + tok * 1024 + hf * 8; const bf16* krow = KEYS + (size_t)l32 * 64 + hf * 8;
    bf16x8 bq[4], bqn[4], akn[4];
#pragma unroll
    for (int ks = 0; ks < 4; ++ks) { bq[ks] = __builtin_nontemporal_load((const bf16x8*)(qrow + ks * 16)); akn[ks] = *(const bf16x8*)(krow + ks * 16); }
    for (int h = 0; h < 8; ++h) {
        float L0[16], L1[16];
#pragma unroll
        for (int c = 0; c < 2; ++c) {
            const int hc = 2 * h + c, hn = hc < 15 ? hc + 1 : 15;
#pragma unroll
            for (int ks = 0; ks < 4; ++ks) bqn[ks] = __builtin_nontemporal_load((const bf16x8*)(qrow + hn * 64 + ks * 16));
            float T[16], S[16];
            { f32x16 acc = (f32x16){0.f, 0.f, 0.f, 0.f, 0.f, 0.f, 0.f, 0.f, 0.f, 0.f, 0.f, 0.f, 0.f, 0.f, 0.f, 0.f};
              const bf16x8 ak0 = akn[0], ak1 = akn[1], ak2 = akn[2], ak3 = akn[3];
              { const bf16* kn = krow + (size_t)(hc * 4 + 1) * (32 * 64);
#pragma unroll
                for (int ks = 0; ks < 4; ++ks) akn[ks] = *(const bf16x8*)(kn + ks * 16); }
              acc = __builtin_amdgcn_mfma_f32_32x32x16_bf16(ak0, bq[0], acc, 0, 0, 0); acc = __builtin_amdgcn_mfma_f32_32x32x16_bf16(ak1, bq[1], acc, 0, 0, 0);
              acc = __builtin_amdgcn_mfma_f32_32x32x16_bf16(ak2, bq[2], acc, 0, 0, 0); acc = __builtin_amdgcn_mfma_f32_32x32x16_bf16(ak3, bq[3], acc, 0, 0, 0);
#pragma unroll
              for (int r = 0; r < 16; ++r) T[r] = mkkey(acc[r], ~0x7f, 8 * (r >> 2) + 4 * hf + (r & 3));
              sort16(T); }
            for (int mt = 1; mt < 4; ++mt) {
                f32x16 acc = (f32x16){0.f, 0.f, 0.f, 0.f, 0.f, 0.f, 0.f, 0.f, 0.f, 0.f, 0.f, 0.f, 0.f, 0.f, 0.f, 0.f};
                const bf16x8 ak0 = akn[0], ak1 = akn[1], ak2 = akn[2], ak3 = akn[3];
                { const int tn = hc * 4 + mt + 1; const bf16* kn = krow + (size_t)(tn < 64 ? tn : 63) * (32 * 64);
#pragma unroll
                  for (int ks = 0; ks < 4; ++ks) akn[ks] = *(const bf16x8*)(kn + ks * 16); }
                acc = __builtin_amdgcn_mfma_f32_32x32x16_bf16(ak0, bq[0], acc, 0, 0, 0); acc = __builtin_amdgcn_mfma_f32_32x32x16_bf16(ak1, bq[1], acc, 0, 0, 0);
                acc = __builtin_amdgcn_mfma_f32_32x32x16_bf16(ak2, bq[2], acc, 0, 0, 0); acc = __builtin_amdgcn_mfma_f32_32x32x16_bf16(ak3, bq[3], acc, 0, 0, 0);
#pragma unroll
                for (int r = 0; r < 16; ++r) S[r] = mkkey(acc[r], ~0x7f, mt * 32 + 8 * (r >> 2) + 4 * hf + (r & 3));
                sort16(S); merge16(T, S); }
#pragma unroll
            for (int ks = 0; ks < 4; ++ks) bq[ks] = bqn[ks];
#pragma unroll
            for (int r = 0; r < 16; ++r) S[r] = __shfl_xor(T[r], 32);
            merge16(T, S);
            if (c == 0) {
#pragma unroll
                for (int r = 0; r < 16; ++r) L0[r] = T[r];
            } else {
#pragma unroll
                for (int r = 0; r < 16; ++r) L1[r] = T[r];
            }
        }
        float f1[16], f2[16];
#pragma unroll
        for (int r = 0; r < 16; ++r) { const int k0 = f2i(L0[r]), k1 = f2i(L1[r]); f1[r] = i2f(k0 & ~0x7f); f2[r] = i2f(k1 & ~0x7f); wl[lane * 36 + r] = (unsigned char)(k0 & 0x7f); wl[lane * 36 + 16 + r] = (unsigned char)(k1 & 0x7f); }
        float K[16], S2[16];
        cand_fill2<0>(K, f1, f2, hf != 0); sort16(K);
        cand_fill2<1>(S2, f1, f2, hf != 0); sort16(S2); merge16(K, S2);
#pragma unroll
        for (int r = 0; r < 16; ++r) S2[r] = __shfl_xor(K[r], 32);
        merge16(K, S2);
        float pe[16], ssum = 0.f; const float mx = i2f(f2i(K[0]) & ~0xff);
#pragma unroll
        for (int r = 0; r < 16; ++r) { pe[r] = __expf(i2f(f2i(K[r]) & ~0xff) - mx); ssum += pe[r]; }
        const float inv = 1.0f / ssum;
        int ev[16]; float gv[16];
#pragma unroll
        for (int j = 0; j < 16; ++j) { const int ab = f2i(K[j]) & 0xff; const int i1 = wl[lane * 36 + (ab >> 4)], i2 = wl[lane * 36 + 16 + (ab & 15)]; ev[j] = i1 * 128 + i2; gv[j] = pe[j] * inv; }
        if (hf == 0) { unsigned short* ed = EO + (tok * 8 + h) * 16; float* gd = GO + (tok * 8 + h) * 16;
            *(v4u*)(ed) = (v4u){(unsigned)ev[0] | ((unsigned)ev[1] << 16), (unsigned)ev[2] | ((unsigned)ev[3] << 16), (unsigned)ev[4] | ((unsigned)ev[5] << 16), (unsigned)ev[6] | ((unsigned)ev[7] << 16)};
            *(v4u*)(ed + 8) = (v4u){(unsigned)ev[8] | ((unsigned)ev[9] << 16), (unsigned)ev[10] | ((unsigned)ev[11] << 16), (unsigned)ev[12] | ((unsigned)ev[13] << 16), (unsigned)ev[14] | ((unsigned)ev[15] << 16)};
#pragma unroll
            for (int j = 0; j < 4; ++j) *(f32x4*)(gd + 4 * j) = (f32x4){gv[4 * j], gv[4 * j + 1], gv[4 * j + 2], gv[4 * j + 3]}; }
    }
}

typedef float f32x2_t __attribute__((ext_vector_type(2)));
typedef _Float16 h2_t __attribute__((ext_vector_type(2)));
__device__ __forceinline__ h2_t as_h2(unsigned u) { return __builtin_bit_cast(h2_t, u); }
template <bool HI> __device__ __forceinline__ h2_t cvt_h2_fp8(unsigned d) { const auto t = __builtin_amdgcn_cvt_scalef32_pk_f16_fp8((int)d, 1.0f, HI); return __builtin_bit_cast(h2_t, t); }
typedef int v4i __attribute__((ext_vector_type(4)));
__device__ __forceinline__ void cvt8x2(v4u r, f32x2_t (&f)[8]) {
    const unsigned w0 = r.x, w1 = r.y, w2 = r.z, w3 = r.w;
    f[0] = __builtin_amdgcn_cvt_pk_f32_fp8((int)w0, false); f[1] = __builtin_amdgcn_cvt_pk_f32_fp8((int)w0, true);
    f[2] = __builtin_amdgcn_cvt_pk_f32_fp8((int)w1, false); f[3] = __builtin_amdgcn_cvt_pk_f32_fp8((int)w1, true);
    f[4] = __builtin_amdgcn_cvt_pk_f32_fp8((int)w2, false); f[5] = __builtin_amdgcn_cvt_pk_f32_fp8((int)w2, true);
    f[6] = __builtin_amdgcn_cvt_pk_f32_fp8((int)w3, false); f[7] = __builtin_amdgcn_cvt_pk_f32_fp8((int)w3, true);
}
__device__ __forceinline__ void load_elist(const unsigned short* E, size_t tok, int h, int (&e)[16]) {
    const v4u* ep = (const v4u*)(E + tok * 128 + h * 16);
#pragma unroll
    for (int i = 0; i < 2; ++i) { const v4u v = ep[i]; const unsigned w[4] = {v.x, v.y, v.z, v.w};
#pragma unroll
        for (int c = 0; c < 4; ++c) { e[8 * i + 2 * c] = (int)(w[c] & 0xffffu); e[8 * i + 2 * c + 1] = (int)(w[c] >> 16); } }
}
__device__ __forceinline__ void issue_rows(v4u (&r)[16], const unsigned char* tb, unsigned poff, const int (&e)[16]) {
#pragma unroll
    for (int k = 0; k < 16; ++k) r[k] = *(const v4u*)(tb + ((unsigned)e[k] * 128u + poff));
}
template <int B2, int B1, int B0> __device__ __forceinline__ void treduce16(const float (&v)[16], int lane, float& o0, float& o1) {
    float q8[8], q4[4];
    { const bool hi = (lane & B2) != 0;
#pragma unroll
      for (int i = 0; i < 8; ++i) { const float keep = hi ? v[i + 8] : v[i], send = hi ? v[i] : v[i + 8]; q8[i] = keep + __shfl_xor(send, B2); } }
    { const bool hi = (lane & B1) != 0;
#pragma unroll
      for (int i = 0; i < 4; ++i) { const float keep = hi ? q8[i + 4] : q8[i], send = hi ? q8[i] : q8[i + 4]; q4[i] = keep + __shfl_xor(send, B1); } }
    { const bool hi = (lane & B0) != 0;
      { const float keep = hi ? q4[2] : q4[0], send = hi ? q4[0] : q4[2]; o0 = keep + __shfl_xor(send, B0); }
      { const float keep = hi ? q4[3] : q4[1], send = hi ? q4[1] : q4[3]; o1 = keep + __shfl_xor(send, B0); } }
}
__device__ __forceinline__ void treduce16i_p(const int (&v)[16], int lane, int& o0, int& o1) {
    int q8[8], q4[4];
    { const bool hi = (lane & 4) != 0;
#pragma unroll
      for (int i = 0; i < 8; ++i) { const int keep = hi ? v[i + 8] : v[i], send = hi ? v[i] : v[i + 8]; q8[i] = keep + __builtin_amdgcn_update_dpp(0, send, 0x141, 0xF, 0xF, false); } }
    { const bool hi = (lane & 2) != 0;
#pragma unroll
      for (int i = 0; i < 4; ++i) { const int keep = hi ? q8[i + 4] : q8[i], send = hi ? q8[i] : q8[i + 4]; q4[i] = keep + __builtin_amdgcn_update_dpp(0, send, 0x4E, 0xF, 0xF, false); } }
    { const bool hi = (lane & 1) != 0;
      { const int keep = hi ? q4[2] : q4[0], send = hi ? q4[0] : q4[2]; o0 = keep + __builtin_amdgcn_update_dpp(0, send, 0xB1, 0xF, 0xF, false); }
      { const int keep = hi ? q4[3] : q4[1], send = hi ? q4[1] : q4[3]; o1 = keep + __builtin_amdgcn_update_dpp(0, send, 0xB1, 0xF, 0xF, false); } }
}
__device__ __forceinline__ void treduce16f_h(const float (&v)[16], int lane, float& o0, float& o1) {
    float q8[8], q4[4];
    { const bool hi = (lane & 8) != 0;
#pragma unroll
      for (int i = 0; i < 8; ++i) { const float keep = hi ? v[i + 8] : v[i], send = hi ? v[i] : v[i + 8];
          q8[i] = keep + __builtin_bit_cast(float, __builtin_amdgcn_update_dpp(0, __builtin_bit_cast(int, send), 0x128, 0xF, 0xF, false)); } }
    { const bool hi = (lane & 16) != 0;
#pragma unroll
      for (int i = 0; i < 4; ++i) { const float keep = hi ? q8[i + 4] : q8[i], send = hi ? q8[i] : q8[i + 4];
          q4[i] = keep + __builtin_bit_cast(float, __builtin_amdgcn_ds_swizzle(__builtin_bit_cast(int, send), 0x401F)); } }
    { const bool hi = (lane & 32) != 0;
      { const float keep = hi ? q4[2] : q4[0], send = hi ? q4[0] : q4[2]; o0 = keep + __shfl_xor(send, 32); }
      { const float keep = hi ? q4[3] : q4[1], send = hi ? q4[1] : q4[3]; o1 = keep + __shfl_xor(send, 32); } }
}
__device__ __forceinline__ void upass_compute(const v4u (&r)[16], v4u hq, short* pa, int lane, v4u (&rn)[16], const unsigned char* tb, unsigned poff, const int (&en)[16]) {
    int part[16];
#pragma unroll
    for (int k = 0; k < 16; ++k) { rn[k] = *(const v4u*)(tb + ((unsigned)en[k] * 128u + poff));
        int s = __builtin_amdgcn_sdot4((int)r[k].x, (int)hq.x, 0, false); s = __builtin_amdgcn_sdot4((int)r[k].y, (int)hq.y, s, false); s = __builtin_amdgcn_sdot4((int)r[k].z, (int)hq.z, s, false); part[k] = __builtin_amdgcn_sdot4((int)r[k].w, (int)hq.w, s, false);
        __builtin_amdgcn_sched_barrier(0); }
    int o0, o1; treduce16i_p(part, lane, o0, o1);
    *(unsigned*)(pa + (lane >> 3) * 16 + 2 * (lane & 7)) = (unsigned)(((o0 + 32) >> 6) & 0xffff) | ((unsigned)((o1 + 32) >> 6) << 16);
}
__device__ __forceinline__ void vpass_compute(const v4u (&r)[16], const v4u (&wp)[2], bf16* xo  , const float* gt  , int lane, v4u (&rn)[16], const unsigned char* tb, unsigned poff, const int (&en)[16]) {
    h2_t o2[8];
#pragma unroll
    for (int i = 0; i < 8; ++i) o2[i] = (h2_t){(_Float16)0.f, (_Float16)0.f};
    const unsigned wq[8] = {wp[0].x, wp[0].y, wp[0].z, wp[0].w, wp[1].x, wp[1].y, wp[1].z, wp[1].w};
#pragma unroll
    for (int k = 0; k < 16; ++k) { rn[k] = *(const v4u*)(tb + ((unsigned)en[k] * 128u + poff));
        const unsigned d0 = r[k].x, d1 = r[k].y, d2 = r[k].z, d3 = r[k].w; const h2_t wpair = as_h2(wq[k >> 1]); const _Float16 wh = (k & 1) ? wpair.y : wpair.x; const h2_t ww = {wh, wh};
        o2[0] = __builtin_elementwise_fma(cvt_h2_fp8<false>(d0), ww, o2[0]); o2[1] = __builtin_elementwise_fma(cvt_h2_fp8<true>(d0), ww, o2[1]);
        o2[2] = __builtin_elementwise_fma(cvt_h2_fp8<false>(d1), ww, o2[2]); o2[3] = __builtin_elementwise_fma(cvt_h2_fp8<true>(d1), ww, o2[3]);
        o2[4] = __builtin_elementwise_fma(cvt_h2_fp8<false>(d2), ww, o2[4]); o2[5] = __builtin_elementwise_fma(cvt_h2_fp8<true>(d2), ww, o2[5]);
        o2[6] = __builtin_elementwise_fma(cvt_h2_fp8<false>(d3), ww, o2[6]); o2[7] = __builtin_elementwise_fma(cvt_h2_fp8<true>(d3), ww, o2[7]);
        __builtin_amdgcn_sched_barrier(0); }
    float v[16];
#pragma unroll
    for (int i = 0; i < 8; ++i) { v[2 * i] = (float)o2[i].x * (1.0f / 64.0f); v[2 * i + 1] = (float)o2[i].y * (1.0f / 64.0f); }
    float o0, o1; treduce16f_h(v, lane, o0, o1);
    const int c = 16 * (lane & 7) + 2 * (((lane >> 1) & 4) | ((lane >> 3) & 2) | ((lane >> 5) & 1));
    const unsigned xb = *(const unsigned*)(xo + c); const f32x2_t g = *(const f32x2_t*)(gt + c);
    const float a0 = bflo(xb) + g.x * o0, a1 = bfhi(xb) + g.y * o1;
    const unsigned ob = pk2(a0, a1);
    *(unsigned*)(xo + c) = ob;
}
template <bool UP> __device__ __forceinline__ void peer_pass(const Args& a, int wave, int lane_in) {
    int lane = lane_in; asm volatile("" : "+v"(lane));
    const int G = gridDim.x, bx = blockIdx.x;
    const bool sliced = (G % 8) == 0;
    const int nj = sliced ? 1 : 8, j0 = sliced ? (bx & 7) : 0;
    const int first = sliced ? ((bx >> 3) * NWAVES + wave) : (bx * NWAVES + wave), stride = sliced ? (G >> 3) * NWAVES : G * NWAVES;
    const int h = lane >> 3, p = lane & 7;
    const unsigned short* E = (const unsigned short*)(a.ws + WS_E); const unsigned char* HQ = a.ws + WS_H2Q; const _Float16* W = (const _Float16*)(a.ws + WS_W);
    short* PA = (short*)(a.ws + WS_PA); const float* MOD = (const float*)(a.ws + WS_MOD);
    const unsigned char* T8 = a.ws + (UP ? WS_UB : WS_VB);
    const int ntok = (M - first + stride - 1) / stride;
    for (int jj = 0; jj < nj; ++jj) { const int j = j0 + jj;
        const unsigned char* tb = T8 + (size_t)j * (16384 * 128);
        v4u RA[16], RB[16]; int en[16], en2[16];
        v4u hA0, hB0; v4u wA[2], wB[2];
        { const size_t t0 = (size_t)first; int e0[16]; load_elist(E, t0, h, e0); issue_rows(RA, tb, 16u * p, e0);
          if (UP) { hA0 = *(const v4u*)(HQ + t0 * 1024 + 128 * j + 16 * p); }
          else { wA[0] = *(const v4u*)(W + t0 * 128 + h * 16); wA[1] = *(const v4u*)(W + t0 * 128 + h * 16 + 8); }
          const size_t t1 = (size_t)first + (size_t)(ntok > 1 ? 1 : 0) * stride; load_elist(E, t1, h, en); }
        for (int u = 0; u < ntok; u += 2) {
            { const int u1 = (u + 1 < ntok) ? u + 1 : ntok - 1, u2 = (u + 2 < ntok) ? u + 2 : ntok - 1; const size_t t1 = (size_t)first + (size_t)u1 * stride, t2 = (size_t)first + (size_t)u2 * stride;
              load_elist(E, t2, h, en2);
              if (UP) { hB0 = *(const v4u*)(HQ + t1 * 1024 + 128 * j + 16 * p); }
              else { wB[0] = *(const v4u*)(W + t1 * 128 + h * 16); wB[1] = *(const v4u*)(W + t1 * 128 + h * 16 + 8); }
              const size_t t = (size_t)first + (size_t)u * stride;
              if (UP) upass_compute(RA, hA0, PA + ((size_t)j * M + t) * 128, lane, RB, tb, 16u * p, en);
              else vpass_compute(RA, wA, (bf16*)(a.ws + WS_X1B) + t * 1024 + 128 * j, MOD + (t >> 13) * NMODC + 5120 + 128 * j, lane, RB, tb, 16u * p, en); }
            if (u + 1 >= ntok) break;
            { const int u1 = (u + 2 < ntok) ? u + 2 : ntok - 1, u2 = (u + 3 < ntok) ? u + 3 : ntok - 1; const size_t t1 = (size_t)first + (size_t)u1 * stride, t2 = (size_t)first + (size_t)u2 * stride;
              load_elist(E, t2, h, en);
              if (UP) { hA0 = *(const v4u*)(HQ + t1 * 1024 + 128 * j + 16 * p); }
              else { wA[0] = *(const v4u*)(W + t1 * 128 + h * 16); wA[1] = *(const v4u*)(W + t1 * 128 + h * 16 + 8); }
              const size_t t = (size_t)first + (size_t)(u + 1) * stride;
              if (UP) upass_compute(RB, hB0, PA + ((size_t)j * M + t) * 128, lane, RA, tb, 16u * p, en2);
              else vpass_compute(RB, wB, (bf16*)(a.ws + WS_X1B) + t * 1024 + 128 * j, MOD + (t >> 13) * NMODC + 5120 + 128 * j, lane, RA, tb, 16u * p, en2); }
        }
    }
}
__device__ __forceinline__ void upass4(const Args& a, int wave, int lane_in) {
    int lane = lane_in; asm volatile("" : "+v"(lane));
    const int G = gridDim.x, bx = blockIdx.x;
    const bool sliced = (G % 8) == 0;
    const int nj = sliced ? 1 : 8, j0 = sliced ? (bx & 7) : 0;
    const int first = sliced ? ((bx >> 3) * NWAVES + wave) : (bx * NWAVES + wave), stride = sliced ? (G >> 3) * NWAVES : G * NWAVES;
    const int r = lane >> 2, p = lane & 3;
    const unsigned short* E = (const unsigned short*)(a.ws + WS_E); const unsigned char* HQh = a.ws + WS_H2Q; const unsigned char* HQl = a.ws + WS_H2Q + (size_t)32 * MiB; short* PA = (short*)(a.ws + WS_PA);
    const int ntok = (M - first + stride - 1) / stride;
    const int eoff = (r >> 1) * 16 + 8 * (r & 1);
    for (int jj = 0; jj < nj; ++jj) { const int j = j0 + jj;
        const unsigned char* tb = a.ws + WS_UB + (size_t)j * (16384 * 64);
        const unsigned poff = 16u * p;
        v4u R0[8], R1[8], R2[8], R3[8], hh0, hl0, hh1, hl1, hh2, hl2, hh3, hl3, eA, eB;
#define U4_ROWS(R, ev) do { const unsigned w_[4] = {ev.x, ev.y, ev.z, ev.w}; _Pragma("unroll") for (int c_ = 0; c_ < 4; ++c_) { R[2 * c_] = *(const v4u*)(tb + ((w_[c_] & 0xffffu) * 64u + poff)); R[2 * c_ + 1] = *(const v4u*)(tb + ((w_[c_] >> 16) * 64u + poff)); } } while (0)
#define U4_COMPUTE(R, hh, hl, t) do { int part[8]; _Pragma("unroll") for (int i_ = 0; i_ < 8; ++i_) { \
            int sh_ = __builtin_amdgcn_sdot8((int)R[i_].x, (int)hh.x, 0, false); sh_ = __builtin_amdgcn_sdot8((int)R[i_].y, (int)hh.y, sh_, false); sh_ = __builtin_amdgcn_sdot8((int)R[i_].z, (int)hh.z, sh_, false); sh_ = __builtin_amdgcn_sdot8((int)R[i_].w, (int)hh.w, sh_, false); \
            int sl_ = __builtin_amdgcn_sdot8((int)R[i_].x, (int)hl.x, 0, false); sl_ = __builtin_amdgcn_sdot8((int)R[i_].y, (int)hl.y, sl_, false); sl_ = __builtin_amdgcn_sdot8((int)R[i_].z, (int)hl.z, sl_, false); sl_ = __builtin_amdgcn_sdot8((int)R[i_].w, (int)hl.w, sl_, false); \
            part[i_] = 16 * sh_ + sl_; } \
        int q4_[4]; { const bool hi_ = (lane & 2) != 0; _Pragma("unroll") for (int i_ = 0; i_ < 4; ++i_) { const int keep_ = hi_ ? part[i_ + 4] : part[i_], send_ = hi_ ? part[i_] : part[i_ + 4]; q4_[i_] = keep_ + __builtin_amdgcn_update_dpp(0, send_, 0x4E, 0xF, 0xF, false); } } \
        int o0_, o1_; { const bool hi_ = (lane & 1) != 0; { const int keep_ = hi_ ? q4_[2] : q4_[0], send_ = hi_ ? q4_[0] : q4_[2]; o0_ = keep_ + __builtin_amdgcn_update_dpp(0, send_, 0xB1, 0xF, 0xF, false); } \
            { const int keep_ = hi_ ? q4_[3] : q4_[1], send_ = hi_ ? q4_[1] : q4_[3]; o1_ = keep_ + __builtin_amdgcn_update_dpp(0, send_, 0xB1, 0xF, 0xF, false); } } \
        *(unsigned*)(PA + ((size_t)j * M + (t)) * 128 + eoff + 2 * p) = (unsigned)(((o0_ + 2) >> 2) & 0xffff) | ((unsigned)((o1_ + 2) >> 2) << 16); } while (0)
#define U4_TOK(u_) ((size_t)first + (size_t)((u_) < ntok ? (u_) : ntok - 1) * stride)
#define U4_E(ev, u_) do { ev = *(const v4u*)(E + U4_TOK(u_) * 128 + eoff); } while (0)
#define U4_H(hh, hl, u_) do { const size_t t_ = U4_TOK(u_); hh = *(const v4u*)(HQh + t_ * 512 + 64 * j + poff); hl = *(const v4u*)(HQl + t_ * 512 + 64 * j + poff); } while (0)
        { v4u e0, e1, e2; U4_E(e0, 0); U4_E(e1, 1); U4_E(e2, 2); U4_E(eA, 3);
          U4_H(hh0, hl0, 0); U4_ROWS(R0, e0); U4_H(hh1, hl1, 1); U4_ROWS(R1, e1); U4_H(hh2, hl2, 2); U4_ROWS(R2, e2); }
        for (int u = 0; u < ntok; u += 4) {
            U4_E(eB, u + 4); U4_H(hh3, hl3, u + 3); U4_ROWS(R3, eA); U4_COMPUTE(R0, hh0, hl0, U4_TOK(u));
            if (u + 1 >= ntok) break;
            U4_E(eA, u + 5); U4_H(hh0, hl0, u + 4); U4_ROWS(R0, eB); U4_COMPUTE(R1, hh1, hl1, U4_TOK(u + 1));
            if (u + 2 >= ntok) break;
            U4_E(eB, u + 6); U4_H(hh1, hl1, u + 5); U4_ROWS(R1, eA); U4_COMPUTE(R2, hh2, hl2, U4_TOK(u + 2));
            if (u + 3 >= ntok) break;
            U4_E(eA, u + 7); U4_H(hh2, hl2, u + 6); U4_ROWS(R2, eB); U4_COMPUTE(R3, hh3, hl3, U4_TOK(u + 3));
        }
#undef U4_TOK
#undef U4_E
#undef U4_H
#undef U4_ROWS
#undef U4_COMPUTE
    }
}
typedef long i64_t;
typedef int v2i_t __attribute__((ext_vector_type(2)));
__device__ __forceinline__ i64_t ds_tr8(const LAS unsigned char* p) { const v2i_t r = __builtin_amdgcn_ds_read_tr8_b64_v2i32((LAS v2i_t*)p); return (i64_t)(unsigned)r.x | ((i64_t)(unsigned)r.y << 32); }
__device__ __forceinline__ void vpass_mfma(const Args& a, LAS unsigned char* lds, int wave, int lane_in) {
    int lane = lane_in; asm volatile("" : "+v"(lane));
    const int G = gridDim.x, bx = blockIdx.x;
    const bool sliced = (G % 8) == 0;
    const int nj = sliced ? 1 : 8, j0 = sliced ? (bx & 7) : 0;
    const int first = sliced ? ((bx >> 3) * NWAVES + wave) : (bx * NWAVES + wave), stride = sliced ? (G >> 3) * NWAVES : G * NWAVES;
    const int r = lane >> 2, p4 = lane & 3, n16 = lane & 15, qp = lane >> 4;
    const unsigned short* E = (const unsigned short*)(a.ws + WS_E); const unsigned char* W8 = a.ws + WS_W; const float* MOD = (const float*)(a.ws + WS_MOD);
    LAS unsigned char* slot = lds + wave * 16384;
    const int ntok = (M - first + stride - 1) / stride;
    const int eoff = (r >> 1) * 16 + 8 * (r & 1);
    const int wbase = (8 * r) * 128, hk = (r >> 2) & 1;
    const int rkey = (n16 >> 1) ^ (qp & 1), rbase = (32 * qp + (n16 >> 1)) * 128 + 8 * (n16 & 1);
    const bool even = (n16 & 1) == 0; const int ccol = 32 * qp + (even ? n16 : 15 + n16);
    for (int jj = 0; jj < nj; ++jj) { const int j = j0 + jj;
        const unsigned char* tb = a.ws + WS_VB + (size_t)j * (16384 * 128);
        const unsigned poff = 32u * p4;
        v4u RA[16], RB[16], wA, wB, en, en2;
#define VM_ROWS(R, ev) do { const unsigned w_[4] = {ev.x, ev.y, ev.z, ev.w}; _Pragma("unroll") for (int c_ = 0; c_ < 4; ++c_) { \
            const unsigned char* r0_ = tb + ((w_[c_] & 0xffffu) * 128u + poff); const unsigned char* r1_ = tb + ((w_[c_] >> 16) * 128u + poff); \
            R[4 * c_] = *(const v4u*)r0_; R[4 * c_ + 1] = *(const v4u*)(r0_ + 16); R[4 * c_ + 2] = *(const v4u*)r1_; R[4 * c_ + 3] = *(const v4u*)(r1_ + 16); } } while (0)
#define VM_W(wv, t) do { wv = *(const v4u*)(W8 + (size_t)(t) * 128 + 32 * qp + 16 * (n16 & 1)); } while (0)
#define VM_COMPUTE(R, wv, t) do { \
        _Pragma("unroll") for (int i_ = 0; i_ < 8; ++i_) { const int k_ = (i_ & 7) ^ hk; *(LAS v4u*)(slot + wbase + i_ * 128 + 16 * ((2 * p4) ^ k_)) = R[2 * i_]; *(LAS v4u*)(slot + wbase + i_ * 128 + 16 * ((2 * p4 + 1) ^ k_)) = R[2 * i_ + 1]; } \
        unsigned wq_[8]; { const unsigned o0_ = (unsigned)__builtin_amdgcn_update_dpp(0, (int)wv.x, 0xB1, 0xF, 0xF, false), o1_ = (unsigned)__builtin_amdgcn_update_dpp(0, (int)wv.y, 0xB1, 0xF, 0xF, false), \
              o2_ = (unsigned)__builtin_amdgcn_update_dpp(0, (int)wv.z, 0xB1, 0xF, 0xF, false), o3_ = (unsigned)__builtin_amdgcn_update_dpp(0, (int)wv.w, 0xB1, 0xF, 0xF, false); \
          wq_[0] = even ? wv.x : o0_; wq_[1] = even ? wv.y : o1_; wq_[2] = even ? wv.z : o2_; wq_[3] = even ? wv.w : o3_; wq_[4] = even ? o0_ : wv.x; wq_[5] = even ? o1_ : wv.y; wq_[6] = even ? o2_ : wv.z; wq_[7] = even ? o3_ : wv.w; } \
        f32x4 acc_[8]; _Pragma("unroll") for (int nt_ = 0; nt_ < 8; ++nt_) acc_[nt_] = (f32x4){0.f, 0.f, 0.f, 0.f}; \
        _Pragma("unroll") for (int ks_ = 0; ks_ < 4; ++ks_) { const i64_t aw_ = (i64_t)wq_[2 * ks_] | ((i64_t)wq_[2 * ks_ + 1] << 32); \
            _Pragma("unroll") for (int nt_ = 0; nt_ < 8; ++nt_) { const i64_t bv_ = ds_tr8(slot + rbase + ks_ * 1024 + 16 * (nt_ ^ rkey)); acc_[nt_] = __builtin_amdgcn_mfma_f32_16x16x32_fp8_fp8(aw_, bv_, acc_[nt_], 0, 0, 0); } } \
        const float e01_ = (qp & 1) ? acc_[2][0] : acc_[0][0], e23_ = (qp & 1) ? acc_[6][0] : acc_[4][0], o01_ = (qp & 1) ? acc_[3][0] : acc_[1][0], o23_ = (qp & 1) ? acc_[7][0] : acc_[5][0]; \
        const float se_ = (qp & 2) ? e23_ : e01_, so_ = (qp & 2) ? o23_ : o01_; \
        const float mine_ = even ? se_ : so_, send_ = even ? so_ : se_; \
        const float recv_ = __builtin_bit_cast(float, __builtin_amdgcn_update_dpp(0, __builtin_bit_cast(int, send_), 0xB1, 0xF, 0xF, false)); \
        const float lo_ = even ? mine_ : recv_, hi_ = even ? recv_ : mine_; \
        bf16* xo_ = (bf16*)(a.ws + WS_X1B) + (size_t)(t) * 1024 + 128 * j + ccol; const float* gt_ = MOD + ((size_t)(t) >> 13) * NMODC + 5120 + 128 * j + ccol; \
        const unsigned xb_ = *(const unsigned*)xo_; const f32x2_t g_ = *(const f32x2_t*)gt_; \
        *(unsigned*)xo_ = pk2(bflo(xb_) + g_.x * lo_ * (1.0f / 4096.0f), bfhi(xb_) + g_.y * hi_ * (1.0f / 4096.0f)); } while (0)
#define VM_TOK(u_) ((size_t)first + (size_t)((u_) < ntok ? (u_) : ntok - 1) * stride)
        { v4u e0 = *(const v4u*)(E + VM_TOK(0) * 128 + eoff); VM_ROWS(RA, e0); VM_W(wA, VM_TOK(0)); en = *(const v4u*)(E + VM_TOK(1) * 128 + eoff); }
        for (int u = 0; u < ntok; u += 2) {
            { en2 = *(const v4u*)(E + VM_TOK(u + 2) * 128 + eoff); VM_W(wB, VM_TOK(u + 1)); VM_ROWS(RB, en); VM_COMPUTE(RA, wA, VM_TOK(u)); }
            if (u + 1 >= ntok) break;
            { en = *(const v4u*)(E + VM_TOK(u + 3) * 128 + eoff); VM_W(wA, VM_TOK(u + 2)); VM_ROWS(RA, en2); VM_COMPUTE(RB, wB, VM_TOK(u + 1)); }
        }
#undef VM_ROWS
#undef VM_COMPUTE
#undef VM_W
#undef VM_TOK
    }
}
typedef int v8i_t __attribute__((ext_vector_type(8)));
__device__ __forceinline__ v2i_t ds_tr4(const LAS unsigned char* p) { return __builtin_amdgcn_ds_read_tr4_b64_v2i32((LAS v2i_t*)p); }
__device__ __forceinline__ void vpass_mfma4(const Args& a, LAS unsigned char* lds, int wave, int lane_in) {
    int lane = lane_in; asm volatile("" : "+v"(lane));
    const int G = gridDim.x, bx = blockIdx.x;
    const bool sliced = (G % 8) == 0;
    const int nj = sliced ? 1 : 8, j0 = sliced ? (bx & 7) : 0;
    const int first = sliced ? ((bx >> 3) * NWAVES + wave) : (bx * NWAVES + wave), stride = sliced ? (G >> 3) * NWAVES : G * NWAVES;
    const int r = lane >> 2, p4 = lane & 3, n16 = lane & 15, qp = lane >> 4;
    const unsigned short* E = (const unsigned short*)(a.ws + WS_E); const unsigned char* W8 = a.ws + WS_W; const float* MOD = (const float*)(a.ws + WS_MOD);
    LAS unsigned char* slot = lds + wave * 8192;
    const int ntok = (M - first + stride - 1) / stride;
    const int eoff = 8 * r;
    const int wbase = (8 * r) * 64;
    const int rkey = (n16 >> 2) & 3, rbase = (32 * qp + n16) * 64;
    const bool even = (n16 & 1) == 0; const int ccol = 32 * qp + (even ? n16 : 15 + n16);
    for (int jj = 0; jj < nj; ++jj) { const int j = j0 + jj;
        const unsigned char* tb = a.ws + WS_VB + (size_t)j * (16384 * 64);
        const unsigned poff = 16u * p4;
        v4u R0[8], R1[8], R2[8], R3[8], w0, w1, w2, w3, eA, eB;
#define V4_ROWS(R, ev) do { const unsigned w_[4] = {ev.x, ev.y, ev.z, ev.w}; _Pragma("unroll") for (int c_ = 0; c_ < 4; ++c_) { R[2 * c_] = *(const v4u*)(tb + ((w_[c_] & 0xffffu) * 64u + poff)); R[2 * c_ + 1] = *(const v4u*)(tb + ((w_[c_] >> 16) * 64u + poff)); } } while (0)
#define V4_TOK(u_) ((size_t)first + (size_t)((u_) < ntok ? (u_) : ntok - 1) * stride)
#define V4_E(ev, u_) do { ev = *(const v4u*)(E + V4_TOK(u_) * 128 + eoff); } while (0)
#define V4_W(wv, u_) do { wv = *(const v4u*)(W8 + V4_TOK(u_) * 128 + 16 * qp + 64 * (n16 & 1)); } while (0)
#define V4_COMPUTE(R, wv, t) do { \
        _Pragma("unroll") for (int i_ = 0; i_ < 8; ++i_) *(LAS v4u*)(slot + wbase + i_ * 64 + 16 * (p4 ^ ((2 * r + (i_ >> 2)) & 3))) = R[i_]; \
        v8i_t aw_; { const int o0_ = __builtin_amdgcn_update_dpp(0, (int)wv.x, 0xB1, 0xF, 0xF, false), o1_ = __builtin_amdgcn_update_dpp(0, (int)wv.y, 0xB1, 0xF, 0xF, false), \
              o2_ = __builtin_amdgcn_update_dpp(0, (int)wv.z, 0xB1, 0xF, 0xF, false), o3_ = __builtin_amdgcn_update_dpp(0, (int)wv.w, 0xB1, 0xF, 0xF, false); \
          aw_[0] = even ? (int)wv.x : o0_; aw_[1] = even ? (int)wv.y : o1_; aw_[2] = even ? (int)wv.z : o2_; aw_[3] = even ? (int)wv.w : o3_; \
          aw_[4] = even ? o0_ : (int)wv.x; aw_[5] = even ? o1_ : (int)wv.y; aw_[6] = even ? o2_ : (int)wv.z; aw_[7] = even ? o3_ : (int)wv.w; } \
        f32x4 acc_[8]; \
        _Pragma("unroll") for (int nt_ = 0; nt_ < 8; ++nt_) { const LAS unsigned char* rp_ = slot + rbase + 16 * ((nt_ >> 1) ^ rkey) + 8 * (nt_ & 1); \
            const v2i_t b0_ = ds_tr4(rp_), b1_ = ds_tr4(rp_ + 16 * 64); const v8i_t bv_ = {b0_.x, b0_.y, b1_.x, b1_.y, 0, 0, 0, 0}; \
            acc_[nt_] = __builtin_amdgcn_mfma_scale_f32_16x16x128_f8f6f4(aw_, bv_, (f32x4){0.f, 0.f, 0.f, 0.f}, 0, 4, 0, 0, 0, 0); } \
        const float e01_ = (qp & 1) ? acc_[2][0] : acc_[0][0], e23_ = (qp & 1) ? acc_[6][0] : acc_[4][0], o01_ = (qp & 1) ? acc_[3][0] : acc_[1][0], o23_ = (qp & 1) ? acc_[7][0] : acc_[5][0]; \
        const float se_ = (qp & 2) ? e23_ : e01_, so_ = (qp & 2) ? o23_ : o01_; \
        const float mine_ = even ? se_ : so_, send_ = even ? so_ : se_; \
        const float recv_ = __builtin_bit_cast(float, __builtin_amdgcn_update_dpp(0, __builtin_bit_cast(int, send_), 0xB1, 0xF, 0xF, false)); \
        const float lo_ = even ? mine_ : recv_, hi_ = even ? recv_ : mine_; \
        bf16* xo_ = (bf16*)(a.ws + WS_X1B) + (size_t)(t) * 1024 + 128 * j + ccol; const float* gt_ = MOD + ((size_t)(t) >> 13) * NMODC + 5120 + 128 * j + ccol; \
        const unsigned xb_ = *(const unsigned*)xo_; const f32x2_t g_ = *(const f32x2_t*)gt_; \
        *(unsigned*)xo_ = pk2(bflo(xb_) + g_.x * lo_ * (1.0f / 256.0f), bfhi(xb_) + g_.y * hi_ * (1.0f / 256.0f)); } while (0)
        { v4u e0, e1, e2; V4_E(e0, 0); V4_E(e1, 1); V4_E(e2, 2); V4_E(eA, 3);
          V4_W(w0, 0); V4_ROWS(R0, e0); V4_W(w1, 1); V4_ROWS(R1, e1); V4_W(w2, 2); V4_ROWS(R2, e2); }
        for (int u = 0; u < ntok; u += 4) {
            V4_E(eB, u + 4); V4_W(w3, u + 3); V4_ROWS(R3, eA); V4_COMPUTE(R0, w0, V4_TOK(u));
            if (u + 1 >= ntok) break;
            V4_E(eA, u + 5); V4_W(w0, u + 4); V4_ROWS(R0, eB); V4_COMPUTE(R1, w1, V4_TOK(u + 1));
            if (u + 2 >= ntok) break;
            V4_E(eB, u + 6); V4_W(w1, u + 5); V4_ROWS(R1, eA); V4_COMPUTE(R2, w2, V4_TOK(u + 2));
            if (u + 3 >= ntok) break;
            V4_E(eA, u + 7); V4_W(w2, u + 6); V4_ROWS(R2, eB); V4_COMPUTE(R3, w3, V4_TOK(u + 3));
        }
#undef V4_ROWS
#undef V4_TOK
#undef V4_E
#undef V4_W
#undef V4_COMPUTE
    }
}
__device__ __forceinline__ void vpass_wide(const Args& a, LAS unsigned char* lds, int wave, int lane_in, size_t xdst_off = WS_X1B) {
    int lane = lane_in; asm volatile("" : "+v"(lane));
    const int G = gridDim.x, bx = blockIdx.x;
    const bool sliced = (G % 8) == 0;
    const int nj = sliced ? 1 : 4, j0 = sliced ? ((bx & 7) >> 1) : 0;
    const int tmul = sliced ? 2 : 1, tadd = sliced ? (bx & 1) : 0;
    const int first = sliced ? ((bx >> 3) * NWAVES + wave) : (bx * NWAVES + wave), stride = sliced ? (G >> 3) * NWAVES : G * NWAVES;
    const int ntok = ((sliced ? M / 2 : M) - first + stride - 1) / stride;
    const int r8 = lane >> 3, p8 = lane & 7, n16 = lane & 15, qp = lane >> 4;
    const unsigned short* E = (const unsigned short*)(a.ws + WS_E); const unsigned char* W8 = a.ws + WS_W; const float* MOD = (const float*)(a.ws + WS_MOD);
    LAS unsigned char* slot = lds + wave * 16384;
    const int eoff = 16 * r8;
    const int wbase = (16 * r8) * 128;
    const int rkey = (n16 >> 1) & 7, rbase = (32 * qp + n16) * 128;
    const int kbw = ((r8 >> 1) ^ r8) & 1, qb = qp & 1;
    const bool even = (n16 & 1) == 0;
    const int ccol0 = 16 * (4 * qp + (even ? 0 : 1)) + (even ? n16 : n16 - 1), ccol1 = ccol0 + 32;
    for (int jj = 0; jj < nj; ++jj) { const int j = j0 + jj;
        const unsigned char* tb = a.ws + WS_VB + (size_t)j * (16384 * 128);
        const unsigned poff = 16u * p8;
        v4u RA[16], RB[16], wA, wB, en, en2, fn, fn2;
#define VW_TOK(u_) ((size_t)tmul * ((size_t)first + (size_t)((u_) < ntok ? (u_) : ntok - 1) * stride) + tadd)
#define VW_ROWS(R, ev, fv) do { const unsigned w_[8] = {ev.x, ev.y, ev.z, ev.w, fv.x, fv.y, fv.z, fv.w}; _Pragma("unroll") for (int c_ = 0; c_ < 8; ++c_) { \
            R[2 * c_] = *(const v4u*)(tb + ((w_[c_] & 0xffffu) * 128u + poff)); R[2 * c_ + 1] = *(const v4u*)(tb + ((w_[c_] >> 16) * 128u + poff)); } } while (0)
#define VW_W(wv, u_) do { wv = *(const v4u*)(W8 + VW_TOK(u_) * 128 + 16 * qp + 64 * (n16 & 1)); } while (0)
#define VW_COMPUTE(R, wv, t) do { \
        _Pragma("unroll") for (int i_ = 0; i_ < 16; ++i_) { LAS unsigned char* wp_ = slot + wbase + i_ * 128 + 16 * (p8 ^ ((i_ >> 1) & 7)); *(LAS v2u*)(wp_ + 8 * kbw) = (v2u){R[i_].x, R[i_].y}; *(LAS v2u*)(wp_ + 8 - 8 * kbw) = (v2u){R[i_].z, R[i_].w}; } \
        v8i_t aw_; { const int o0_ = __builtin_amdgcn_update_dpp(0, (int)wv.x, 0xB1, 0xF, 0xF, false), o1_ = __builtin_amdgcn_update_dpp(0, (int)wv.y, 0xB1, 0xF, 0xF, false), \
              o2_ = __builtin_amdgcn_update_dpp(0, (int)wv.z, 0xB1, 0xF, 0xF, false), o3_ = __builtin_amdgcn_update_dpp(0, (int)wv.w, 0xB1, 0xF, 0xF, false); \
          aw_[0] = even ? (int)wv.x : o0_; aw_[1] = even ? (int)wv.y : o1_; aw_[2] = even ? (int)wv.z : o2_; aw_[3] = even ? (int)wv.w : o3_; \
          aw_[4] = even ? o0_ : (int)wv.x; aw_[5] = even ? o1_ : (int)wv.y; aw_[6] = even ? o2_ : (int)wv.z; aw_[7] = even ? o3_ : (int)wv.w; } \
        float tv_[16]; \
        _Pragma("unroll") for (int nt_ = 0; nt_ < 16; ++nt_) { const LAS unsigned char* rp_ = slot + rbase + 16 * ((nt_ >> 1) ^ rkey); const int h0_ = 8 * ((nt_ & 1) ^ qb); \
            const v2i_t b0_ = ds_tr4(rp_ + h0_), b1_ = ds_tr4(rp_ + 16 * 128 + 8 - h0_); const v8i_t bv_ = {b0_.x, b0_.y, b1_.x, b1_.y, 0, 0, 0, 0}; \
            const f32x4 c_ = __builtin_amdgcn_mfma_scale_f32_16x16x128_f8f6f4(aw_, bv_, (f32x4){0.f, 0.f, 0.f, 0.f}, 0, 4, 0, 0, 0, 0); tv_[nt_] = c_[0]; } \
          \
        float t0_ = (qp & 1) ? tv_[4] : tv_[0], t1_ = (qp & 1) ? tv_[5] : tv_[1], t2_ = (qp & 1) ? tv_[6] : tv_[2], t3_ = (qp & 1) ? tv_[7] : tv_[3]; \
        { const float u0_ = (qp & 1) ? tv_[12] : tv_[8], u1_ = (qp & 1) ? tv_[13] : tv_[9], u2_ = (qp & 1) ? tv_[14] : tv_[10], u3_ = (qp & 1) ? tv_[15] : tv_[11]; \
          t0_ = (qp & 2) ? u0_ : t0_; t1_ = (qp & 2) ? u1_ : t1_; t2_ = (qp & 2) ? u2_ : t2_; t3_ = (qp & 2) ? u3_ : t3_; } \
          \
        const float mA_ = even ? t0_ : t1_, mB_ = even ? t2_ : t3_, sA_ = even ? t1_ : t0_, sB_ = even ? t3_ : t2_; \
        const float rA_ = __builtin_bit_cast(float, __builtin_amdgcn_update_dpp(0, __builtin_bit_cast(int, sA_), 0xB1, 0xF, 0xF, false)); \
        const float rB_ = __builtin_bit_cast(float, __builtin_amdgcn_update_dpp(0, __builtin_bit_cast(int, sB_), 0xB1, 0xF, 0xF, false)); \
        const float loA_ = even ? mA_ : rA_, hiA_ = even ? rA_ : mA_, loB_ = even ? mB_ : rB_, hiB_ = even ? rB_ : mB_; \
        bf16* xo_ = (bf16*)(a.ws + xdst_off) + (size_t)(t) * 1024 + 256 * j; const bf16* xi_ = (const bf16*)(a.ws + WS_X1B) + (size_t)(t) * 1024 + 256 * j; const float* gt_ = MOD + ((size_t)(t) >> 13) * NMODC + 5120 + 256 * j; \
        const unsigned xa_ = *(const unsigned*)(xi_ + ccol0), xb_ = *(const unsigned*)(xi_ + ccol1); const f32x2_t ga_ = *(const f32x2_t*)(gt_ + ccol0), gb_ = *(const f32x2_t*)(gt_ + ccol1); \
        *(unsigned*)(xo_ + ccol0) = pk2(bflo(xa_) + ga_.x * loA_ * (1.0f / 256.0f), bfhi(xa_) + ga_.y * hiA_ * (1.0f / 256.0f)); \
        *(unsigned*)(xo_ + ccol1) = pk2(bflo(xb_) + gb_.x * loB_ * (1.0f / 256.0f), bfhi(xb_) + gb_.y * hiB_ * (1.0f / 256.0f)); } while (0)
        { const v4u e0 = *(const v4u*)(E + VW_TOK(0) * 128 + eoff), f0 = *(const v4u*)(E + VW_TOK(0) * 128 + eoff + 8); VW_W(wA, 0); VW_ROWS(RA, e0, f0); en = *(const v4u*)(E + VW_TOK(1) * 128 + eoff); fn = *(const v4u*)(E + VW_TOK(1) * 128 + eoff + 8); }
        for (int u = 0; u < ntok; u += 2) {
            { en2 = *(const v4u*)(E + VW_TOK(u + 2) * 128 + eoff); fn2 = *(const v4u*)(E + VW_TOK(u + 2) * 128 + eoff + 8); VW_W(wB, u + 1); VW_ROWS(RB, en, fn); VW_COMPUTE(RA, wA, VW_TOK(u)); }
            if (u + 1 >= ntok) break;
            { en = *(const v4u*)(E + VW_TOK(u + 3) * 128 + eoff); fn = *(const v4u*)(E + VW_TOK(u + 3) * 128 + eoff + 8); VW_W(wA, u + 2); VW_ROWS(RA, en2, fn2); VW_COMPUTE(RB, wB, VW_TOK(u + 1)); }
        }
#undef VW_TOK
#undef VW_ROWS
#undef VW_W
#undef VW_COMPUTE
    }
}
__device__ __forceinline__ void upass_wide(const Args& a, LAS unsigned char* lds, int wave, int lane_in) {
    int lane = lane_in; asm volatile("" : "+v"(lane));
    const int G = gridDim.x, bx = blockIdx.x;
    const bool sliced = (G % 8) == 0;
    const int nj = sliced ? 1 : 4, j0 = sliced ? ((bx & 7) >> 1) : 0;
    const int tmul = sliced ? 2 : 1, tadd = sliced ? (bx & 1) : 0;
    const int first = sliced ? ((bx >> 3) * NWAVES + wave) : (bx * NWAVES + wave), stride = sliced ? (G >> 3) * NWAVES : G * NWAVES;
    const int ntok = ((sliced ? M / 2 : M) - first + stride - 1) / stride;
    const int r8 = lane >> 3, p8 = lane & 7, n16 = lane & 15, qp = lane >> 4;
    const unsigned short* E = (const unsigned short*)(a.ws + WS_E); const unsigned char* H8 = a.ws + WS_H2Q; bf16* PA = (bf16*)(a.ws + WS_PA);
    LAS unsigned char* slot = lds + wave * 16384;
    const int eoff = 16 * r8, wbase = (16 * r8) * 128;
    const int akey = (n16 >> 1) & 7, abase = n16 * 128;
    const bool even = (n16 & 1) == 0;
    for (int jj = 0; jj < nj; ++jj) { const int j = j0 + jj;
        const unsigned char* tb = a.ws + WS_UB + (size_t)j * (16384 * 128);
        const unsigned poff = 16u * p8;
        v4u RA[16], RB[16], haA, hbA, haB, hbB, en, en2, fn, fn2;
#define UW_TOK(u_) ((size_t)tmul * ((size_t)first + (size_t)((u_) < ntok ? (u_) : ntok - 1) * stride) + tadd)
#define UW_ROWS(R, ev, fv) do { const unsigned w_[8] = {ev.x, ev.y, ev.z, ev.w, fv.x, fv.y, fv.z, fv.w}; _Pragma("unroll") for (int c_ = 0; c_ < 8; ++c_) { \
            R[2 * c_] = *(const v4u*)(tb + ((w_[c_] & 0xffffu) * 128u + poff)); R[2 * c_ + 1] = *(const v4u*)(tb + ((w_[c_] >> 16) * 128u + poff)); } } while (0)
#define UW_H(ha, hb, u_) do { const unsigned char* hp_ = H8 + UW_TOK(u_) * 1024 + 256 * j + 16 * qp + 128 * (n16 & 1); ha = *(const v4u*)hp_; hb = *(const v4u*)(hp_ + 64); } while (0)
#define UW_COMPUTE(R, ha, hb, t) do { \
        _Pragma("unroll") for (int i_ = 0; i_ < 16; ++i_) { *(LAS v4u*)(slot + wbase + i_ * 128 + 16 * (p8 ^ ((i_ >> 1) & 7))) = R[i_]; } \
        v8i_t bh0_, bh1_; { const int mine_[8] = {(int)ha.x, (int)ha.y, (int)ha.z, (int)ha.w, (int)hb.x, (int)hb.y, (int)hb.z, (int)hb.w}; \
          _Pragma("unroll") for (int d_ = 0; d_ < 8; ++d_) { const int o_ = __builtin_amdgcn_update_dpp(0, mine_[d_], 0xB1, 0xF, 0xF, false); bh0_[d_] = even ? mine_[d_] : o_; bh1_[d_] = even ? o_ : mine_[d_]; } } \
        f32x4 acc_[8]; \
        _Pragma("unroll") for (int mb_ = 0; mb_ < 8; ++mb_) { \
            const v4u a0_ = *(const LAS v4u*)(slot + mb_ * 2048 + abase + 16 * (qp ^ akey)), a1_ = *(const LAS v4u*)(slot + mb_ * 2048 + abase + 16 * ((4 + qp) ^ akey)); \
            const v8i_t av0_ = {(int)a0_.x, (int)a0_.y, (int)a0_.z, (int)a0_.w, 0, 0, 0, 0}, av1_ = {(int)a1_.x, (int)a1_.y, (int)a1_.z, (int)a1_.w, 0, 0, 0, 0}; \
            f32x4 c_ = __builtin_amdgcn_mfma_scale_f32_16x16x128_f8f6f4(av0_, bh0_, (f32x4){0.f, 0.f, 0.f, 0.f}, 4, 0, 0, 0, 0, 0); \
            acc_[mb_] = __builtin_amdgcn_mfma_scale_f32_16x16x128_f8f6f4(av1_, bh1_, c_, 4, 0, 0, 0, 0, 0); } \
        const f32x4 s01_ = (n16 & 1) ? acc_[1] : acc_[0], s23_ = (n16 & 1) ? acc_[3] : acc_[2], s45_ = (n16 & 1) ? acc_[5] : acc_[4], s67_ = (n16 & 1) ? acc_[7] : acc_[6]; \
        const f32x4 s03_ = (n16 & 2) ? s23_ : s01_, s47_ = (n16 & 2) ? s67_ : s45_; const f32x4 sel_ = (n16 & 4) ? s47_ : s03_; \
        if (n16 < 8) *(v2u*)(PA + ((size_t)j * M + (t)) * 128 + n16 * 16 + 4 * qp) = (v2u){pg8::cvt_pk_bf16(sel_[0], sel_[1]), pg8::cvt_pk_bf16(sel_[2], sel_[3])}; } while (0)
        { const v4u e0 = *(const v4u*)(E + UW_TOK(0) * 128 + eoff), f0 = *(const v4u*)(E + UW_TOK(0) * 128 + eoff + 8); UW_ROWS(RA, e0, f0); UW_H(haA, hbA, 0); en = *(const v4u*)(E + UW_TOK(1) * 128 + eoff); fn = *(const v4u*)(E + UW_TOK(1) * 128 + eoff + 8); }
        for (int u = 0; u < ntok; u += 2) {
            { en2 = *(const v4u*)(E + UW_TOK(u + 2) * 128 + eoff); fn2 = *(const v4u*)(E + UW_TOK(u + 2) * 128 + eoff + 8); UW_H(haB, hbB, u + 1); UW_ROWS(RB, en, fn); UW_COMPUTE(RA, haA, hbA, UW_TOK(u)); }
            if (u + 1 >= ntok) break;
            { en = *(const v4u*)(E + UW_TOK(u + 3) * 128 + eoff); fn = *(const v4u*)(E + UW_TOK(u + 3) * 128 + eoff + 8); UW_H(haA, hbA, u + 2); UW_ROWS(RA, en2, fn2); UW_COMPUTE(RB, haB, hbB, UW_TOK(u + 1)); }
        }
#undef UW_TOK
#undef UW_ROWS
#undef UW_H
#undef UW_COMPUTE
    }
}
__device__ __forceinline__ void peer_reduce(const Args& a, LAS unsigned char* lds, int tid) {
    const unsigned short* E = (const unsigned short*)(a.ws + WS_E); const float* Gt = (const float*)(a.ws + WS_G); unsigned char* W = a.ws + WS_W; const bf16* PA = (const bf16*)(a.ws + WS_PA);
    const float* SU = (const float*)(a.ws + WS_SU); const float* SV = (const float*)(a.ws + WS_SV); const float* SH = (const float*)(a.ws + WS_SH);
    __syncthreads();
    for (int i = tid; i < 16384 / 4; i += 512) { const f32x4 u4 = *(const f32x4*)(SU + 4 * i), v4 = *(const f32x4*)(SV + 4 * i);
        *(LAS f32x4*)(lds + 32 * i) = (f32x4){u4.x, v4.x, u4.y, v4.y}; *(LAS f32x4*)(lds + 32 * i + 16) = (f32x4){u4.z, v4.z, u4.w, v4.w}; }
    __syncthreads();
    const size_t n4 = (size_t)M * 128 / 4, gth = (size_t)gridDim.x * 512;
    for (size_t i = (size_t)blockIdx.x * 512 + tid; i < n4; i += gth) {
        f32x4 s = {0.f, 0.f, 0.f, 0.f};
#pragma unroll
        for (int j = 0; j < 4; ++j) { const v2u pq = __builtin_nontemporal_load((const v2u*)(PA + (size_t)j * M * 128 + i * 4)); s += (f32x4){bflo(pq.x), bfhi(pq.x), bflo(pq.y), bfhi(pq.y)}; }
        const float sh = SH[i >> 5];
        const v2u ep = *(const v2u*)(E + i * 4); const f32x4 g = *(const f32x4*)(Gt + i * 4); f32x4 w;
        const f2_t t0 = *(const LAS f2_t*)(lds + 8 * (ep.x & 0xffffu)), t1 = *(const LAS f2_t*)(lds + 8 * (ep.x >> 16)), t2 = *(const LAS f2_t*)(lds + 8 * (ep.y & 0xffffu)), t3 = *(const LAS f2_t*)(lds + 8 * (ep.y >> 16));
        w.x = g.x * gelu_t(s.x * sh * t0.x) * t0.y; w.y = g.y * gelu_t(s.y * sh * t1.x) * t1.y; w.z = g.z * gelu_t(s.z * sh * t2.x) * t2.y; w.w = g.w * gelu_t(s.w * sh * t3.x) * t3.y;
        { const f32x4 ws_ = w * 256.0f; int pk = 0;
          pk = __builtin_amdgcn_cvt_pk_fp8_f32(fminf(fmaxf(ws_.x, -440.f), 440.f), fminf(fmaxf(ws_.y, -440.f), 440.f), pk, false);
          pk = __builtin_amdgcn_cvt_pk_fp8_f32(fminf(fmaxf(ws_.z, -440.f), 440.f), fminf(fmaxf(ws_.w, -440.f), 440.f), pk, true);
          *(unsigned*)(W + i * 4) = (unsigned)pk; } }
}
__device__ __forceinline__ void final_norm(const Args& a, int wave, int lane) {
    const float* gf = a.in[I_GFIN]; const bf16* X2 = (const bf16*)(a.ws + WS_X1B);
    f32x4 g[4];
#pragma unroll
    for (int q = 0; q < 2; ++q) { g[2 * q] = *(const f32x4*)(gf + 512 * q + 8 * lane); g[2 * q + 1] = *(const f32x4*)(gf + 512 * q + 8 * lane + 4); }
    for (size_t row = (size_t)blockIdx.x * NWAVES + wave; row < (size_t)M; row += (size_t)gridDim.x * NWAVES) {
        f32x4 x[4]; float ss = 0.f;
#pragma unroll
        for (int q = 0; q < 2; ++q) { const v4u r = __builtin_nontemporal_load((const v4u*)(X2 + row * 1024 + 512 * q + 8 * lane)); x[2 * q] = (f32x4){bflo(r.x), bfhi(r.x), bflo(r.y), bfhi(r.y)}; x[2 * q + 1] = (f32x4){bflo(r.z), bfhi(r.z), bflo(r.w), bfhi(r.w)}; }
#pragma unroll
        for (int i = 0; i < 4; ++i) ss += (x[i].x * x[i].x + x[i].y * x[i].y) + (x[i].z * x[i].z + x[i].w * x[i].w);
        const float rstd = 1.0f / sqrtf(wave_sum(ss) * (1.0f / 1024.0f) + EPS);
#pragma unroll
        for (int q = 0; q < 2; ++q) { float* o = a.out + row * 1024 + 512 * q + 8 * lane; __builtin_nontemporal_store(x[2 * q] * rstd * g[2 * q], (f32x4*)(o)); __builtin_nontemporal_store(x[2 * q + 1] * rstd * g[2 * q + 1], (f32x4*)(o + 4)); } }
}
__device__ __forceinline__ void phase_topk(const Args& a, LAS unsigned char* lds, int wave, int lane) {
    const bf16* Q = (const bf16*)(a.ws + WS_ZG); const bf16* KEYS = (const bf16*)(a.ws + WS_KEYS);
    const int G = gridDim.x, gw = blockIdx.x * NWAVES + wave, NGW = G * NWAVES;
    for (int grp = gw; grp < M / 32; grp += NGW) peer_topk32(Q, KEYS, (unsigned short*)(a.ws + WS_E), (float*)(a.ws + WS_G), lds + wave * 4096, grp * 32, lane);
}
#define XB_TMO      128
#define XB_XCNT(j)  (256  + 64 * (j))
#define XB_XSUB(j)  (1280 + 64 * (j))
#define XB_XGEN(j)  (2304 + 64 * (j))
#define XB_TOP      3328
#define XB_TOPGEN   3392
#define XCD_BAR_WORDS 3456
#define XB_SPIN_CAP (1u << 18)

__device__ __forceinline__ unsigned xb_ld(unsigned* p)              { return __hip_atomic_load(p, __ATOMIC_RELAXED, __HIP_MEMORY_SCOPE_AGENT); }
__device__ __forceinline__ unsigned xb_add(unsigned* p, unsigned v) { return __hip_atomic_fetch_add(p, v, __ATOMIC_RELAXED, __HIP_MEMORY_SCOPE_AGENT); }
__device__ __forceinline__ unsigned xb_xcc_id() { return (unsigned)__builtin_amdgcn_s_getreg((3 << 11) | 20) & 0xFu; }
#define XB_SPIN(cond, bar) do { unsigned _sp = 0; while (cond) { __builtin_amdgcn_s_sleep(1); \
    if ((++_sp & 255u) == 0u) { if (xb_ld(&(bar)[XB_TMO])) break; if (_sp > XB_SPIN_CAP) { atomicAdd(&(bar)[XB_TMO], 1u); break; } } } } while (0)

struct XcdBarrier {
    unsigned* bar; unsigned x;
    volatile LAS unsigned* st;
};

__device__ __forceinline__ XcdBarrier xcd_barrier_post(unsigned* bar, volatile LAS unsigned* st) {
    XcdBarrier b; b.bar = bar; b.x = xb_xcc_id(); b.st = st;
    if (threadIdx.x == 0) (void)xb_add(&bar[XB_XCNT(b.x)], 1u);
    return b;
}
__device__ __forceinline__ void xcd_barrier_complete(unsigned* bar, unsigned x, unsigned& nloc, unsigned& nx) {
    const unsigned G = gridDim.x * gridDim.y * gridDim.z;
    unsigned sum, cnt, mine, sp = 0u;
    for (;;) {
        sum = 0u; cnt = 0u; mine = 0u;
#pragma unroll
        for (unsigned j = 0; j < 16; ++j) { const unsigned c = xb_ld(&bar[XB_XCNT(j)]); sum += c; cnt += (c > 0u) ? 1u : 0u; mine = (j == x) ? c : mine; }
        if (sum == G) break;
        __builtin_amdgcn_s_sleep(1);
        if ((++sp & 255u) == 0u) { if (xb_ld(&bar[XB_TMO])) break; if (sp > XB_SPIN_CAP) { atomicAdd(&bar[XB_TMO], 1u); break; } }
    }
    nloc = mine > 0u ? mine : 1u; nx = cnt > 0u ? cnt : 1u;
}

__device__ __forceinline__ void xcd_barrier(const XcdBarrier& b) {
    asm volatile("s_waitcnt vmcnt(0)" ::: "memory");
    __syncthreads();
    if (threadIdx.x == 0) {
        unsigned* bar = b.bar;
        __builtin_amdgcn_s_waitcnt(0);
        unsigned nloc = b.st[0], nx = b.st[1];
        if (nloc == 0u) { xcd_barrier_complete(bar, b.x, nloc, nx); b.st[0] = nloc; b.st[1] = nx; }
        const unsigned old = xb_add(&bar[XB_XSUB(b.x)], 1u);
        const unsigned gen = old / nloc;
        if (old + 1u == (gen + 1u) * nloc) {
            __builtin_amdgcn_fence(__ATOMIC_RELEASE, "agent");
            asm volatile("s_waitcnt vmcnt(0)" ::: "memory");
            const unsigned og = xb_add(&bar[XB_TOP], 1u);
            const unsigned tg = og / nx;
            if (og + 1u == (tg + 1u) * nx) xb_add(&bar[XB_TOPGEN], 1u);
            else XB_SPIN(xb_ld(&bar[XB_TOPGEN]) == tg, bar);
            __builtin_amdgcn_fence(__ATOMIC_ACQUIRE, "agent");
            xb_add(&bar[XB_XGEN(b.x)], 1u);
            asm volatile("s_waitcnt vmcnt(0)" ::: "memory");
        } else {
            XB_SPIN(xb_ld(&bar[XB_XGEN(b.x)]) == gen, bar);
            __builtin_amdgcn_fence(__ATOMIC_ACQUIRE, "agent");
            asm volatile("s_waitcnt vmcnt(0)" ::: "memory");
        }
    }
    __syncthreads();
}
constexpr int N_PHASES = 13;
__global__ void __launch_bounds__(NWAVES * 64, 2) hybrid_fwd(Args a) {
    extern __shared__ __attribute__((aligned(16))) unsigned char lds_raw[];
    LAS unsigned char* lds = (LAS unsigned char*)lds_raw;
    const int tid = threadIdx.x, lane = tid & 63, wave = __builtin_amdgcn_readfirstlane(tid >> 6);
    const int G = gridDim.x, bx = blockIdx.x;
    unsigned char* ws = a.ws;
    const float* MOD = (const float*)(ws + WS_MOD);
    const int lo = a.ph_lo, hi = a.ph_hi;
    if (tid < 16) ((LAS unsigned*)(lds + LDS_MISC_OFF))[tid] = 0u;
    __syncthreads();
    XcdBarrier xbar = xcd_barrier_post((unsigned*)(ws + WS_BAR), (volatile LAS unsigned*)(lds + LDS_MISC_OFF));
#ifndef REP_MASK
#define REP_MASK 0
#endif
#define IN(k) (lo <= (k) && (k) < hi)
#ifndef REPN
#define REPN 1
#endif
#define REPS(k) (1 + REPN * ((REP_MASK >> (k)) & 1))
#define SEAM(k) do { if (IN(k) && IN((k) + 1)) xcd_barrier(xbar); } while (0)
    if (hi > N_PHASES) cg::this_grid().sync();

    if (IN(0)) for (int rep_ = 0; rep_ < REPS(0); ++rep_) { phase_prologue(a, lds, tid, wave, lane); } SEAM(0);
    if (IN(1)) for (int rep_ = 0; rep_ < REPS(1); ++rep_) { phase_norm_mod(a.in[I_X], a.in[I_GMIX], MOD, 0, 1024, (bf16*)(ws + WS_H), wave, lane); } SEAM(1);
    if (IN(2)) for (int rep_ = 0; rep_ < REPS(2); ++rep_) { pg8::Gemm g{(const pg8::bf16_t*)(ws + WS_H), (const pg8::bf16_t*)(ws + WS_WIN), M, INW, DM}; pg8::StaticOrder S; S.init(M, INW, G, bx);
        pg8::EpiIn E{(pg8::bf16_t*)(ws + WS_ZG), (pg8::bf16_t*)(ws + WS_ZS)};
        pg8::gemm_phase<pg8::EpiIn, pg8::StaticOrder, true, true>(lds, g, S, E); } SEAM(2);
    if (IN(3)) for (int rep_ = 0; rep_ < REPS(3); ++rep_) { for (int it = bx; it < 256; it += G) s5_item(a, lds, it, wave, lane);
        for (int it = bx; it < 512; it += G) sgu_item(a, lds, it, wave, lane); } SEAM(3);
    if (IN(4)) for (int rep_ = 0; rep_ < REPS(4); ++rep_) { pg8::Gemm g{(const pg8::bf16_t*)(ws + WS_YS), (const pg8::bf16_t*)(ws + WS_WGLU), M, 512, 512}; pg8::StaticOrder S; S.init(M, 512, G, bx);
        pg8::EpiGlu E{(const pg8::bf16_t*)(ws + WS_YS), a.in[I_BGLU], (pg8::bf16_t*)(ws + WS_Y)};
        pg8::gemm_phase<pg8::EpiGlu, pg8::StaticOrder, true, true>(lds, g, S, E); } SEAM(4);
    if (IN(5)) for (int rep_ = 0; rep_ < REPS(5); ++rep_) { pg8::Gemm g{(const pg8::bf16_t*)(ws + WS_Y), (const pg8::bf16_t*)(ws + WS_WOUT), M, DM, DM}; pg8::StaticOrder S; S.init(M, DM, G, bx);
        pg8::EpiOut E{a.in[I_X], MOD, (pg8::bf16_t*)(ws + WS_X1B)};
        pg8::gemm_phase<pg8::EpiOut, pg8::StaticOrder, true, true>(lds, g, S, E); } SEAM(5);
    if (IN(6)) for (int rep_ = 0; rep_ < REPS(6); ++rep_) { phase_norm_mod_bf((const bf16*)(ws + WS_X1B), a.in[I_GFFN], MOD, 3072, 4096, (bf16*)(ws + WS_H), ws + WS_H2Q, (float*)(ws + WS_SH), wave, lane); } SEAM(6);
    if (IN(7)) for (int rep_ = 0; rep_ < REPS(7); ++rep_) { pg8::Gemm g{(const pg8::bf16_t*)(ws + WS_H), (const pg8::bf16_t*)(ws + WS_WQ), M, DM, DM}; pg8::StaticOrder S; S.init(M, DM, G, bx);
        pg8::EpiPlain E{(pg8::bf16_t*)(ws + WS_ZG), 1024};
        pg8::gemm_phase<pg8::EpiPlain, pg8::StaticOrder, true, true>(lds, g, S, E); } SEAM(7);
    if (IN(8)) for (int rep_ = 0; rep_ < REPS(8); ++rep_) { phase_topk(a, lds, wave, lane); } SEAM(8);
    if (IN(9)) for (int rep_ = 0; rep_ < REPS(9); ++rep_) { upass_wide(a, lds, wave, lane); } SEAM(9);
    if (IN(10)) for (int rep_ = 0; rep_ < REPS(10); ++rep_) { peer_reduce(a, lds, tid); } SEAM(10);
    if (IN(11)) for (int rep_ = 0; rep_ < REPS(11); ++rep_) { vpass_wide(a, lds, wave, lane); } SEAM(11);
    if (IN(12)) for (int rep_ = 0; rep_ < REPS(12); ++rep_) { final_norm(a, wave, lane); }
#undef IN
#undef SEAM
}

extern "C" void kernel_launch(void* const* d_in, const int* in_sizes, int n_in, void* d_out, int out_size, void* d_ws, size_t ws_size, hipStream_t stream) {
    static int grid = 0;
    if (grid == 0) {
        if (n_in != 27 || in_sizes[0] != M * DM || out_size != M * DM || ws_size < WS_END) { fprintf(stderr, "kernel_launch: unexpected problem (n_in %d, in0 %d, out %d, ws %zu); nothing launched\n", n_in, n_in > 0 ? in_sizes[0] : -1, out_size, ws_size); grid = -1; return; }
        int dev = 0, cus = 0, per_cu = 0;
        if (hipGetDevice(&dev) != hipSuccess || hipDeviceGetAttribute(&cus, hipDeviceAttributeMultiprocessorCount, dev) != hipSuccess) { grid = -1; return; }
        if (hipFuncSetAttribute((const void*)hybrid_fwd, hipFuncAttributeMaxDynamicSharedMemorySize, LDS_BYTES) != hipSuccess) { fprintf(stderr, "kernel_launch: hipFuncSetAttribute failed\n"); grid = -1; return; }
        if (hipOccupancyMaxActiveBlocksPerMultiprocessor(&per_cu, (const void*)hybrid_fwd, NWAVES * 64, LDS_BYTES) != hipSuccess || per_cu < 1) { fprintf(stderr, "kernel_launch: occupancy query failed (%d)\n", per_cu); (void)hipGetLastError(); per_cu = 1; }
        grid = cus * 1;
        if (per_cu < 1) grid = -1;
    }
    if (grid < 0) return;
    if (hipMemsetAsync((char*)d_ws + WS_BAR, 0, 16384, stream) != hipSuccess) { fprintf(stderr, "kernel_launch: hipMemsetAsync failed\n"); return; }
    Args a{};
    for (int i = 0; i < 27; ++i) a.in[i] = (const float*)d_in[i];
    a.out = (float*)d_out; a.ws = (unsigned char*)d_ws;
#if N_LAUNCHES == 1
    a.ph_lo = 0; a.ph_hi = N_PHASES;
    void* args[] = {&a};
    hipError_t e = hipLaunchCooperativeKernel((const void*)hybrid_fwd, dim3(grid), dim3(NWAVES * 64), args, LDS_BYTES, stream);
    if (e != hipSuccess) fprintf(stderr, "kernel_launch: cooperative launch failed: %s (grid %d)\n", hipGetErrorString(e), grid);
#else
    for (int p = 0; p < N_PHASES; ++p) { a.ph_lo = p; a.ph_hi = p + 1;
        hipLaunchKernelGGL(hybrid_fwd, dim3(grid), dim3(NWAVES * 64), LDS_BYTES, stream, a);
        const hipError_t le = hipPeekAtLastError(); if (le != hipSuccess) { fprintf(stderr, "kernel_launch: launch %d failed: %s\n", p, hipGetErrorName(le)); break; } }
#endif
}
```

```cpp
#include <hip/hip_runtime.h>
#include <hip/hip_cooperative_groups.h>
#include <cstdio>
#include <cstdint>
namespace cg = cooperative_groups;

#ifndef N_LAUNCHES
#define N_LAUNCHES 1
#endif

#define GAS __attribute__((address_space(1)))
#define LAS __attribute__((address_space(3)))
namespace pg8 {
#define PG8_LAS __attribute__((address_space(3)))
typedef unsigned short bf16_t;
typedef short bf16x8 __attribute__((ext_vector_type(8)));
typedef float f32x4 __attribute__((ext_vector_type(4)));
typedef unsigned u32x4 __attribute__((ext_vector_type(4)));
constexpr int BM = 256, BK = 64, HALF = 128, HTB = HALF * BK * 2  , STAGE_BYTES = 8 * HTB, NXCD = 8, WGM = 8;

__host__ __device__ __forceinline__ int lds_byte(int r, int c) { const int st = (r >> 4) * 2 + (c >> 5), rr = r & 15, cc = c & 31, ob = rr * 64 + cc * 2; return st * 1024 + (ob ^ (((ob >> 9) & 1) << 5)); }
__host__ __device__ __forceinline__ void stage_rc(int b, int& R, int& C) { const int st = b / 1024, sb = b % 1024, swz = sb ^ (((sb >> 9) & 1) << 5); R = (st >> 1) * 16 + swz / 64; C = (st & 1) * 32 + (swz % 64) / 2; }
__host__ __device__ __forceinline__ int perm32(int rho) { const int n = rho >> 4, i = rho & 15; return 8 * (i >> 2) + 4 * n + (i & 3); }

struct Unit { int pm, pn; };
struct Gemm { const bf16_t* A; const bf16_t* Bt; int M, N, K; };

struct StaticOrder {
    int nM, nN, nwg, G, c;
    __host__ __device__ void init(int M, int N, int G_, int c_) { nM = M / BM; nN = N / BM; nwg = nM * nN; G = G_; c = c_; }
    __host__ __device__ bool next(int i, Unit& u) const {
        const long L = (long)i * G + c; if (L >= nwg) return false;
        int wgid = (int)L; { const int q = nwg / NXCD, r = nwg % NXCD, xcd = wgid % NXCD, off = wgid / NXCD; wgid = (xcd < r ? xcd * (q + 1) : r * (q + 1) + (xcd - r) * q) + off; }
        const int nig = WGM * nN, gid = wgid / nig, fm = gid * WGM, gsz = (nM - fm) < WGM ? (nM - fm) : WGM;
        u.pm = fm + ((wgid % nig) % gsz); u.pn = (wgid % nig) / gsz; return true;
    }
    __device__ __forceinline__ void a_ready(const Unit&) const {}
    __device__ __forceinline__ void done(const Unit&) const {}
};

typedef float f32x2 __attribute__((ext_vector_type(2)));
__device__ __forceinline__ unsigned cvt_pk_bf16(float lo, float hi) { unsigned r; asm volatile("v_cvt_pk_bf16_f32 %0, %1, %2" : "=v"(r) : "v"(lo), "v"(hi)); return r; }
__device__ __forceinline__ float bf_lo(unsigned u) { return __builtin_bit_cast(float, u << 16); }
__device__ __forceinline__ float bf_hi(unsigned u) { return __builtin_bit_cast(float, u & 0xffff0000u); }
__device__ __forceinline__ float gelu_t(float x) { const float t = x * (1.0f + 0.044715f * x * x) * (-2.3022082f); return x * __builtin_amdgcn_rcpf(1.0f + __builtin_amdgcn_exp2f(t)); }
__device__ __forceinline__ float sigmoid_f(float x) { return __builtin_amdgcn_rcpf(1.0f + __builtin_amdgcn_exp2f(x * -1.4426950409f)); }

struct EpiIn { static constexpr bool PERM = true, AFTER_DRAIN = false; bf16_t* ZG; bf16_t* ZS;
    __device__ __forceinline__ void operator()(const f32x4 (&acc)[2][2][4][2], const Unit& u, int wr, int wc, int fr, int fq) const {
        const int row0 = u.pm * BM + wr * 64 + fr, colt = u.pn * BM;
#pragma unroll
        for (int ai = 0; ai < 2; ++ai)
#pragma unroll
            for (int m = 0; m < 4; ++m) { const int row = row0 + ai * HALF + m * 16;
#pragma unroll
                for (int bj = 0; bj < 2; ++bj) { const int col = colt + bj * HALF + wc * 32 + 8 * fq; f32x4 v0 = acc[ai][bj][m][0], v1 = acc[ai][bj][m][1]; u32x4 w;
                    if (colt < 1024) {
                        w.x = cvt_pk_bf16(gelu_t(v0[0]), gelu_t(v0[1])); w.y = cvt_pk_bf16(gelu_t(v0[2]), gelu_t(v0[3])); w.z = cvt_pk_bf16(gelu_t(v1[0]), gelu_t(v1[1])); w.w = cvt_pk_bf16(gelu_t(v1[2]), gelu_t(v1[3]));
                        *(u32x4*)(ZG + (size_t)row * 1024 + col) = w;
                    } else {
                        w.x = cvt_pk_bf16(v0[0], v0[1]); w.y = cvt_pk_bf16(v0[2], v0[3]); w.z = cvt_pk_bf16(v1[0], v1[1]); w.w = cvt_pk_bf16(v1[2], v1[3]);
                        const int cs = col - 1024, g = cs >> 4, ch = cs & 15, b = row >> 13, s = row & 8191;
                        *(u32x4*)(ZS + ((((size_t)(b * 32 + g)) * 8192 + s) << 4) + ch) = w;
                    } } }
    }
};
struct EpiGlu { static constexpr bool PERM = true, AFTER_DRAIN = false; const bf16_t* YS; const float* bglu; bf16_t* Y;
    __device__ __forceinline__ void operator()(const f32x4 (&acc)[2][2][4][2], const Unit& u, int wr, int wc, int fr, int fq) const {
        const int row0 = u.pm * BM + wr * 64 + fr, colt = u.pn * BM;
#pragma unroll
        for (int bj = 0; bj < 2; ++bj) { const int col = colt + bj * HALF + wc * 32 + 8 * fq; const f32x4 b0 = *(const f32x4*)(bglu + col), b1 = *(const f32x4*)(bglu + col + 4);
#pragma unroll
            for (int ai = 0; ai < 2; ++ai)
#pragma unroll
                for (int m = 0; m < 4; ++m) { const int row = row0 + ai * HALF + m * 16; const f32x4 v0 = acc[ai][bj][m][0] + b0, v1 = acc[ai][bj][m][1] + b1;
                    const u32x4 ys = *(const u32x4*)(YS + (size_t)row * 512 + col); u32x4 w;
                    w.x = cvt_pk_bf16(bf_lo(ys.x) * sigmoid_f(v0[0]), bf_hi(ys.x) * sigmoid_f(v0[1])); w.y = cvt_pk_bf16(bf_lo(ys.y) * sigmoid_f(v0[2]), bf_hi(ys.y) * sigmoid_f(v0[3]));
                    w.z = cvt_pk_bf16(bf_lo(ys.z) * sigmoid_f(v1[0]), bf_hi(ys.z) * sigmoid_f(v1[1])); w.w = cvt_pk_bf16(bf_lo(ys.w) * sigmoid_f(v1[2]), bf_hi(ys.w) * sigmoid_f(v1[3]));
                    *(u32x4*)(Y + (size_t)row * 1024 + 512 + col) = w; } }
    }
};
struct EpiOut { static constexpr bool PERM = true, AFTER_DRAIN = false; const float* x; const float* mod; bf16_t* X1;
    __device__ __forceinline__ void operator()(const f32x4 (&acc)[2][2][4][2], const Unit& u, int wr, int wc, int fr, int fq) const {
        const int row0 = u.pm * BM + wr * 64 + fr, colt = u.pn * BM; const float* gt = mod + (size_t)((u.pm * BM) >> 13) * 6144 + 2048;
#pragma unroll
        for (int bj = 0; bj < 2; ++bj) { const int col = colt + bj * HALF + wc * 32 + 8 * fq; const f32x4 g0 = *(const f32x4*)(gt + col), g1 = *(const f32x4*)(gt + col + 4);
            f32x4 xv[8][2];
#pragma unroll
            for (int ai = 0; ai < 2; ++ai)
#pragma unroll
                for (int m = 0; m < 4; ++m) { const size_t o = (size_t)(row0 + ai * HALF + m * 16) * 1024 + col;
                    xv[ai * 4 + m][0] = __builtin_nontemporal_load((const f32x4*)(x + o)); xv[ai * 4 + m][1] = __builtin_nontemporal_load((const f32x4*)(x + o + 4)); }
            __builtin_amdgcn_sched_barrier(0);
#pragma unroll
            for (int ai = 0; ai < 2; ++ai)
#pragma unroll
                for (int m = 0; m < 4; ++m) { const size_t o = (size_t)(row0 + ai * HALF + m * 16) * 1024 + col;
                    const f32x4 v0 = xv[ai * 4 + m][0] + g0 * acc[ai][bj][m][0], v1 = xv[ai * 4 + m][1] + g1 * acc[ai][bj][m][1]; u32x4 w;
                    w.x = cvt_pk_bf16(v0[0], v0[1]); w.y = cvt_pk_bf16(v0[2], v0[3]); w.z = cvt_pk_bf16(v1[0], v1[1]); w.w = cvt_pk_bf16(v1[2], v1[3]);
                    *(u32x4*)(X1 + o) = w; }
            __builtin_amdgcn_sched_barrier(0); }
    }
};
struct EpiPlain { static constexpr bool PERM = true, AFTER_DRAIN = false; bf16_t* O; int ldc;
    __device__ __forceinline__ void operator()(const f32x4 (&acc)[2][2][4][2], const Unit& u, int wr, int wc, int fr, int fq) const {
        const int row0 = u.pm * BM + wr * 64 + fr, colt = u.pn * BM;
#pragma unroll
        for (int ai = 0; ai < 2; ++ai)
#pragma unroll
            for (int m = 0; m < 4; ++m) { const int row = row0 + ai * HALF + m * 16;
#pragma unroll
                for (int bj = 0; bj < 2; ++bj) { const int col = colt + bj * HALF + wc * 32 + 8 * fq; const f32x4 v0 = acc[ai][bj][m][0], v1 = acc[ai][bj][m][1]; u32x4 w;
                    w.x = cvt_pk_bf16(v0[0], v0[1]); w.y = cvt_pk_bf16(v0[2], v0[3]); w.z = cvt_pk_bf16(v1[0], v1[1]); w.w = cvt_pk_bf16(v1[2], v1[3]);
                    *(u32x4*)(O + (size_t)row * ldc + col) = w; } }
    }
};
template <class Epi, class Sched, bool ALIGN_EPI = false, bool SP2 = false>
__device__ __forceinline__ void gemm_phase(PG8_LAS unsigned char* lds, const Gemm g, const Sched& S, const Epi& E) {
    const int tid = threadIdx.x, wid = __builtin_amdgcn_readfirstlane(tid >> 6), lane = tid & 63, wr = wid >> 2, wc = wid & 3, fr = lane & 15, fq = lane >> 4;
    const int K = g.K, nt = K / BK;
    unsigned voffA[2], voffB[2];
#pragma unroll
    for (int i = 0; i < 2; ++i) { int R, C; stage_rc(tid * 16 + i * 8192, R, C); const int Rb = Epi::PERM ? ((R & ~31) + perm32(R & 31)) : R;
        voffA[i] = (unsigned)(R * K + C) * 2u; voffB[i] = (unsigned)(Rb * K + C) * 2u; }
    const size_t kstep = (size_t)(BK * 2);
    const size_t hstep = (size_t)HALF * K * 2;
    const size_t tstep = 2 * hstep;
    const unsigned ldsw = (unsigned)wid * 1024u;
    const int aoff = lds_byte(wr * 64 + fr, fq * 8), boff = lds_byte(wc * 32 + fr, fq * 8);
#define PG8_SA(b, h) (((b) * 2 + (h)) * HTB)
#define PG8_SB(b, h) ((4 + (b) * 2 + (h)) * HTB)
#define PG8_STAGE(bufoff, gbase, voff) do { _Pragma("unroll") for (int _i = 0; _i < 2; ++_i) \
        __builtin_amdgcn_global_load_lds((const unsigned*)((const char*)(gbase) + (voff)[_i]), (PG8_LAS unsigned*)(lds + (bufoff) + ldsw + _i * 8192), 16, 0, 0); } while (0)
#define PG8_LDA(dst, b, h) do { _Pragma("unroll") for (int m = 0; m < 4; ++m) _Pragma("unroll") for (int k = 0; k < 2; ++k) dst[m][k] = *(const PG8_LAS bf16x8*)(lds + PG8_SA(b, h) + aoff + m * 2048 + k * 1024); } while (0)
#define PG8_LDB(dst, b, h) do { _Pragma("unroll") for (int n = 0; n < 2; ++n) _Pragma("unroll") for (int k = 0; k < 2; ++k) dst[n][k] = *(const PG8_LAS bf16x8*)(lds + PG8_SB(b, h) + boff + n * 2048 + k * 1024); } while (0)
#define PG8_MMA(ai, bj, At, Bt) do { __builtin_amdgcn_s_setprio(1); _Pragma("unroll") for (int m = 0; m < 4; ++m) _Pragma("unroll") for (int n = 0; n < 2; ++n) _Pragma("unroll") for (int k = 0; k < 2; ++k) \
        acc[ai][bj][m][n] = __builtin_amdgcn_mfma_f32_16x16x32_bf16(Bt[n][k], At[m][k], acc[ai][bj][m][n], 0, 0, 0); __builtin_amdgcn_s_setprio(0); } while (0)
#define PG8_WAIT_V(n) asm volatile("s_waitcnt vmcnt(" #n ")" ::: "memory")
#define PG8_WAIT_L(n) asm volatile("s_waitcnt lgkmcnt(" #n ")" ::: "memory")
#define PG8_BAR __builtin_amdgcn_s_barrier()
#define PG8_SCHED __builtin_amdgcn_sched_barrier(0)
    Unit cur, nxt; int ui = 0;
    if (!S.next(0, cur)) return;
    f32x4 acc[2][2][4][2];
#pragma unroll
    for (int a = 0; a < 2; ++a)
#pragma unroll
        for (int b = 0; b < 2; ++b)
#pragma unroll
            for (int m = 0; m < 4; ++m)
#pragma unroll
                for (int n = 0; n < 2; ++n) acc[a][b][m][n] = (f32x4){0.f, 0.f, 0.f, 0.f};
    bf16x8 At[4][2], B0[2][2], B1[2][2];
    const char* cA = (const char*)g.A + (size_t)cur.pm * tstep; const char* cB = (const char*)g.Bt + (size_t)cur.pn * tstep;
    S.a_ready(cur);
    if constexpr (SP2) {
        PG8_STAGE(PG8_SB(0, 0), cB, voffB); PG8_STAGE(PG8_SB(0, 1), cB + hstep, voffB); PG8_STAGE(PG8_SA(0, 0), cA, voffA); PG8_STAGE(PG8_SA(0, 1), cA + hstep, voffA);
        if (wr == 1) PG8_BAR;
        PG8_WAIT_V(2); PG8_BAR;
        PG8_STAGE(PG8_SB(1, 0), cB + kstep, voffB); PG8_STAGE(PG8_SA(1, 0), cA + kstep, voffA); PG8_STAGE(PG8_SB(1, 1), cB + hstep + kstep, voffB);
        PG8_WAIT_V(6); PG8_BAR;
    } else {
        PG8_STAGE(PG8_SB(0, 0), cB, voffB); PG8_STAGE(PG8_SA(0, 0), cA, voffA); PG8_STAGE(PG8_SB(0, 1), cB + hstep, voffB); PG8_STAGE(PG8_SA(0, 1), cA + hstep, voffA);
        if (wr == 1) PG8_BAR;
        PG8_WAIT_V(4); PG8_BAR;
        PG8_STAGE(PG8_SB(1, 0), cB + kstep, voffB); PG8_STAGE(PG8_SA(1, 0), cA + kstep, voffA); PG8_STAGE(PG8_SB(1, 1), cB + hstep + kstep, voffB);
        PG8_WAIT_V(6); PG8_BAR;
    }
    for (;;) {
        const bool has_next = S.next(ui + 1, nxt);
        const char* nA = has_next ? (const char*)g.A + (size_t)nxt.pm * tstep : cA; const char* nB = has_next ? (const char*)g.Bt + (size_t)nxt.pn * tstep : cB;
        for (int t = 0; t < nt; t += 2) {
            const bool last = (t == nt - 2);
            const char* a1 = cA + (size_t)(t + 1) * kstep;
            const char* a2 = last ? nA : cA + (size_t)(t + 2) * kstep; const char* b2 = last ? nB : cB + (size_t)(t + 2) * kstep;
            const char* a3 = a2 + kstep; const char* b3 = b2 + kstep;
            if (last && has_next) S.a_ready(nxt);
            if constexpr (SP2) {
            PG8_LDB(B0, 0, 0); PG8_LDB(B1, 0, 1); PG8_SCHED; PG8_LDA(At, 0, 0); PG8_STAGE(PG8_SA(1, 1), a1 + hstep, voffA);
            PG8_WAIT_V(8); PG8_WAIT_L(0); PG8_BAR; PG8_MMA(0, 0, At, B0); PG8_MMA(0, 1, At, B1); PG8_BAR; PG8_SCHED;
            PG8_LDA(At, 0, 1); PG8_STAGE(PG8_SB(0, 0), b2, voffB); PG8_STAGE(PG8_SB(0, 1), b2 + hstep, voffB); PG8_STAGE(PG8_SA(0, 0), a2, voffA);
            PG8_WAIT_V(8); PG8_WAIT_L(0); PG8_BAR; PG8_MMA(1, 0, At, B0); PG8_MMA(1, 1, At, B1); PG8_BAR; PG8_SCHED;
            PG8_LDB(B0, 1, 0); PG8_LDB(B1, 1, 1); PG8_SCHED; PG8_LDA(At, 1, 0); PG8_STAGE(PG8_SA(0, 1), a2 + hstep, voffA);
            PG8_WAIT_V(8); PG8_WAIT_L(0); PG8_BAR; PG8_MMA(0, 0, At, B0); PG8_MMA(0, 1, At, B1); PG8_BAR; PG8_SCHED;
            PG8_LDA(At, 1, 1); PG8_STAGE(PG8_SB(1, 0), b3, voffB); PG8_STAGE(PG8_SB(1, 1), b3 + hstep, voffB); PG8_STAGE(PG8_SA(1, 0), a3, voffA);
            PG8_WAIT_V(8); PG8_WAIT_L(0); PG8_BAR; PG8_MMA(1, 0, At, B0); PG8_MMA(1, 1, At, B1); PG8_BAR; PG8_SCHED;
            } else {
            PG8_LDB(B0, 0, 0); PG8_SCHED; PG8_LDA(At, 0, 0); PG8_STAGE(PG8_SA(1, 1), a1 + hstep, voffA);
            PG8_WAIT_L(8); PG8_BAR; PG8_WAIT_L(0); PG8_MMA(0, 0, At, B0); PG8_BAR; PG8_SCHED;
            PG8_LDB(B1, 0, 1); PG8_STAGE(PG8_SB(0, 0), b2, voffB);
            PG8_BAR; PG8_WAIT_L(0); PG8_MMA(0, 1, At, B1); PG8_BAR;
            PG8_LDA(At, 0, 1); PG8_STAGE(PG8_SA(0, 0), a2, voffA);
            PG8_BAR; PG8_WAIT_L(0); PG8_MMA(1, 0, At, B0); PG8_BAR; PG8_SCHED;
            PG8_STAGE(PG8_SB(0, 1), b2 + hstep, voffB);
            PG8_WAIT_V(6); PG8_BAR; PG8_MMA(1, 1, At, B1); PG8_BAR;
            PG8_LDB(B0, 1, 0); PG8_SCHED; PG8_LDA(At, 1, 0); PG8_STAGE(PG8_SA(0, 1), a2 + hstep, voffA);
            PG8_WAIT_L(8); PG8_BAR; PG8_WAIT_L(0); PG8_MMA(0, 0, At, B0); PG8_BAR; PG8_SCHED;
            PG8_LDB(B1, 1, 1); PG8_STAGE(PG8_SB(1, 0), b3, voffB);
            PG8_BAR; PG8_WAIT_L(0); PG8_MMA(0, 1, At, B1); PG8_BAR;
            PG8_LDA(At, 1, 1); PG8_STAGE(PG8_SA(1, 0), a3, voffA);
            PG8_BAR; PG8_WAIT_L(0); PG8_MMA(1, 0, At, B0); PG8_BAR; PG8_SCHED;
            PG8_STAGE(PG8_SB(1, 1), b3 + hstep, voffB);
            PG8_WAIT_V(6); PG8_BAR; PG8_MMA(1, 1, At, B1); PG8_BAR;
            }
        }
        if constexpr (ALIGN_EPI) { if (wr == 0) PG8_BAR; }
        if constexpr (!Epi::AFTER_DRAIN) { E(acc, cur, wr, wc, fr, fq); S.done(cur); }
        if (!has_next) break;
#pragma unroll
        for (int a = 0; a < 2; ++a)
#pragma unroll
            for (int b = 0; b < 2; ++b)
#pragma unroll
                for (int m = 0; m < 4; ++m)
#pragma unroll
                    for (int n = 0; n < 2; ++n) acc[a][b][m][n] = (f32x4){0.f, 0.f, 0.f, 0.f};
        cur = nxt; cA = nA; cB = nB; ++ui;
        if constexpr (ALIGN_EPI) { if (wr == 1) PG8_BAR; }
    }
    PG8_WAIT_V(0);
    if constexpr (!ALIGN_EPI) { if (wr == 0) PG8_BAR; }
    PG8_BAR;
    if constexpr (Epi::AFTER_DRAIN) { E.fused(acc, cur, wr, wc, fr, fq, lds, wid, lane); S.done(cur); }
#undef PG8_SA
#undef PG8_SB
#undef PG8_STAGE
#undef PG8_LDA
#undef PG8_LDB
#undef PG8_MMA
#undef PG8_WAIT_V
#undef PG8_WAIT_L
#undef PG8_BAR
#undef PG8_SCHED
}
}
typedef unsigned short bf16;
typedef unsigned v4u __attribute__((ext_vector_type(4)));
typedef unsigned v2u __attribute__((ext_vector_type(2)));
typedef float f32x4 __attribute__((ext_vector_type(4)));
typedef float f2_t __attribute__((ext_vector_type(2)));
typedef float f32x16 __attribute__((ext_vector_type(16)));
typedef short bf16x8 __attribute__((ext_vector_type(8)));
typedef short s16x4 __attribute__((ext_vector_type(4)));
typedef __bf16 bf2_t __attribute__((ext_vector_type(2)));

constexpr int NWAVES = 8;
constexpr int DM = 1024, NB = 8, SEQ = 8192, M = NB * SEQ, INW = 1536, NMODC = 6144;
constexpr int LDS_BYTES = 160 * 1024, LDS_MISC_OFF = LDS_BYTES - 64;
constexpr size_t MiB = 1u << 20;
constexpr size_t WS_MOD = 0;
constexpr size_t WS_BAR = 208 * 1024;
constexpr size_t WS_SU = 256 * 1024;
constexpr size_t WS_SV = 384 * 1024;
constexpr size_t WS_WIN = 1 * MiB;
constexpr size_t WS_WGLU = 4 * MiB;
constexpr size_t WS_WOUT = 5 * MiB;
constexpr size_t WS_WQ = 7 * MiB;
constexpr size_t WS_KEYS = 9 * MiB;
constexpr size_t WS_WM = 9 * MiB + 512 * 1024;
constexpr size_t WS_UB = 16 * MiB;
constexpr size_t WS_VB = 48 * MiB;
constexpr size_t WS_H = 80 * MiB;
constexpr size_t WS_ZG = 208 * MiB;
constexpr size_t WS_ZS = 336 * MiB;
constexpr size_t WS_Y = 400 * MiB;
constexpr size_t WS_YS = 528 * MiB;
constexpr size_t WS_E = 592 * MiB;
constexpr size_t WS_G = 624 * MiB;
constexpr size_t WS_W = 656 * MiB;
constexpr size_t WS_SS = 688 * MiB;
constexpr size_t WS_PA = 336 * MiB;
constexpr size_t WS_X1B = 690 * MiB;
constexpr size_t WS_H2Q = 818 * MiB;
constexpr size_t WS_SH = 882 * MiB;
constexpr size_t WS_END = 883 * MiB;
constexpr float EPS = 1e-6f;

#define LDS_WAIT() asm volatile("s_waitcnt lgkmcnt(0)" ::: "memory")
__device__ __forceinline__ unsigned f2bf(float f) { unsigned u = __builtin_bit_cast(unsigned, f); return (u + 0x7fffu + ((u >> 16) & 1u)) >> 16; }
__device__ __forceinline__ unsigned pk2(float lo, float hi) { return f2bf(lo) | (f2bf(hi) << 16); }
__device__ __forceinline__ float bflo(unsigned u) { return __builtin_bit_cast(float, u << 16); }
__device__ __forceinline__ float bfhi(unsigned u) { return __builtin_bit_cast(float, u & 0xffff0000u); }
__device__ __forceinline__ float wave_sum(float v) {
#pragma unroll
    for (int o = 1; o < 64; o <<= 1) v += __shfl_xor(v, o);
    return v;
}
using pg8::gelu_t;
using pg8::sigmoid_f;

struct Args { const float* in[27]; float* out; unsigned char* ws; int ph_lo, ph_hi; };
enum { I_X = 0, I_C, I_WADA, I_BADA, I_GMIX, I_WIN, I_LNG, I_LNB, I_WS, I_BS, I_ARE, I_AIM, I_LOGDT, I_BRE, I_BIM, I_CRE, I_CIM, I_D, I_WGLU, I_BGLU, I_WOUT, I_GFFN, I_WQ, I_KEYS, I_PU, I_PV, I_GFIN };

__device__ __forceinline__ void p0_transpose_item(const float* W, int K, int N, bf16* WT, LAS float* scr, int item, int lane) {
    const int nblk = N / 32, kb = item / nblk, nb = item % nblk, k0 = 64 * kb, n0 = 32 * nb;
#pragma unroll 8
    for (int i = 0; i < 32; ++i) { const int kk = 2 * i + (lane >> 5); scr[kk * 33 + (lane & 31)] = W[(size_t)(k0 + kk) * N + n0 + (lane & 31)]; }
    LDS_WAIT(); asm volatile("" ::: "memory");
    const int c = lane & 7;
#pragma unroll
    for (int j = 0; j < 4; ++j) { const int n = (lane >> 3) + 8 * j; const LAS float* s = scr + (8 * c) * 33 + n;
        v4u o; o.x = pk2(s[0 * 33], s[1 * 33]); o.y = pk2(s[2 * 33], s[3 * 33]); o.z = pk2(s[4 * 33], s[5 * 33]); o.w = pk2(s[6 * 33], s[7 * 33]);
        *(v4u*)(WT + (size_t)(n0 + n) * K + k0 + 8 * c) = o; }
    LDS_WAIT(); asm volatile("" ::: "memory");
}
__device__ __forceinline__ void cvt_stream(const float* src, bf16* dst, size_t n8, size_t gtid, size_t gthreads) {
    for (size_t i = gtid; i < n8; i += gthreads) { const f32x4 a = *(const f32x4*)(src + i * 8), b = *(const f32x4*)(src + i * 8 + 4);
        v4u o; o.x = pk2(a.x, a.y); o.y = pk2(a.z, a.w); o.z = pk2(b.x, b.y); o.w = pk2(b.z, b.w); *(v4u*)(dst + i * 8) = o; }
}
__device__ __forceinline__ float wave_max(float v) {
#pragma unroll
    for (int o = 1; o < 64; o <<= 1) v = fmaxf(v, __shfl_xor(v, o));
    return v;
}
__device__ __forceinline__ void cvt_rows_fp8(const float* src, unsigned char* dst, float* inv, int gw, int NGW, int lane) {
    for (int row = gw; row < 16384; row += NGW) { const f32x4* p = (const f32x4*)(src + (size_t)row * 1024) + lane;
        f32x4 v[4]; float m = 0.f;
#pragma unroll
        for (int j = 0; j < 4; ++j) { v[j] = __builtin_nontemporal_load(p + 64 * j); m = fmaxf(fmaxf(m, fmaxf(fabsf(v[j].x), fabsf(v[j].y))), fmaxf(fabsf(v[j].z), fabsf(v[j].w))); }
        m = wave_max(m); const float sc = m > 0.f ? 240.0f / m : 1.0f;
#pragma unroll
        for (int j = 0; j < 4; ++j) { int pk = 0; pk = __builtin_amdgcn_cvt_pk_fp8_f32(v[j].x * sc, v[j].y * sc, pk, false); pk = __builtin_amdgcn_cvt_pk_fp8_f32(v[j].z * sc, v[j].w * sc, pk, true);
            const int c = 4 * lane + 256 * j; *(unsigned*)(dst + ((size_t)(c >> 7) * 16384 + row) * 128 + (c & 127)) = (unsigned)pk; }
        if (lane == 0) inv[row] = m > 0.f ? m * (1.0f / 240.0f) : 1.0f; }
}
__device__ __forceinline__ unsigned pack_i8x4(float a, float b, float c, float d) {
    const int ia = (int)rintf(a), ib = (int)rintf(b), ic = (int)rintf(c), id = (int)rintf(d);
    return (unsigned)(ia & 0xff) | ((unsigned)(ib & 0xff) << 8) | ((unsigned)(ic & 0xff) << 16) | ((unsigned)(id & 0xff) << 24);
}
__device__ __forceinline__ void cvt_rows_i8(const float* src, unsigned char* dst, float* inv, int gw, int NGW, int lane) {
    for (int row = gw; row < 16384; row += NGW) { const f32x4* p = (const f32x4*)(src + (size_t)row * 1024) + lane;
        f32x4 v[4]; float m = 0.f;
#pragma unroll
        for (int j = 0; j < 4; ++j) { v[j] = __builtin_nontemporal_load(p + 64 * j); m = fmaxf(fmaxf(m, fmaxf(fabsf(v[j].x), fabsf(v[j].y))), fmaxf(fabsf(v[j].z), fabsf(v[j].w))); }
        m = wave_max(m); const float sc = m > 0.f ? 127.0f / m : 1.0f;
#pragma unroll
        for (int j = 0; j < 4; ++j) { const int c = 4 * lane + 256 * j; *(unsigned*)(dst + ((size_t)(c >> 7) * 16384 + row) * 128 + (c & 127)) = pack_i8x4(v[j].x * sc, v[j].y * sc, v[j].z * sc, v[j].w * sc); }
        if (lane == 0) inv[row] = m > 0.f ? m * (1.0f / 127.0f) : 1.0f; }
}
__device__ __forceinline__ unsigned pack_i4x8(const float (&v)[8], float inv) {
    unsigned d = 0;
#pragma unroll
    for (int i = 0; i < 8; ++i) { int q = (int)rintf(v[i] * inv); q = q < -8 ? -8 : (q > 7 ? 7 : q); d |= (unsigned)(q & 15) << (4 * i); }
    return d;
}
__device__ __forceinline__ void cvt_rows_i4(const float* src, unsigned char* dst, float* invs, int gw, int NGW, int lane) {
    for (int row = gw; row < 16384; row += NGW) { const float* p = src + (size_t)row * 1024;
        float v[2][8]; float ss = 0.f;
#pragma unroll
        for (int q = 0; q < 2; ++q) { const f32x4 x0 = __builtin_nontemporal_load((const f32x4*)(p + 512 * q + 8 * lane)), x1 = __builtin_nontemporal_load((const f32x4*)(p + 512 * q + 8 * lane + 4));
            v[q][0] = x0.x; v[q][1] = x0.y; v[q][2] = x0.z; v[q][3] = x0.w; v[q][4] = x1.x; v[q][5] = x1.y; v[q][6] = x1.z; v[q][7] = x1.w;
#pragma unroll
            for (int i = 0; i < 8; ++i) ss += v[q][i] * v[q][i]; }
        const float rms = sqrtf(wave_sum(ss) * (1.0f / 1024.0f)); const float step = rms > 0.f ? rms * (2.5f / 7.5f) : 1.0f, inv = 1.0f / step;
#pragma unroll
        for (int q = 0; q < 2; ++q) { const int c = 512 * q + 8 * lane; *(unsigned*)(dst + ((size_t)(c >> 7) * 16384 + row) * 64 + ((c & 127) >> 1)) = pack_i4x8(v[q], inv); }
        if (lane == 0) invs[row] = step; }
}
template <int LOG2W> __device__ __forceinline__ void cvt_rows_fp4(const float* src, unsigned char* dst, float* invs, int gw, int NGW, int lane) {
    for (int base = gw; base < 16384; base += 4 * NGW) {
        float v[4][2][8]; float ss[4];
#pragma unroll
        for (int rr = 0; rr < 4; ++rr) { const int row = min(base + rr * NGW, 16383); const float* p = src + (size_t)row * 1024;
#pragma unroll
            for (int q = 0; q < 2; ++q) { const f32x4 x0 = __builtin_nontemporal_load((const f32x4*)(p + 512 * q + 8 * lane)), x1 = __builtin_nontemporal_load((const f32x4*)(p + 512 * q + 8 * lane + 4));
                v[rr][q][0] = x0.x; v[rr][q][1] = x0.y; v[rr][q][2] = x0.z; v[rr][q][3] = x0.w; v[rr][q][4] = x1.x; v[rr][q][5] = x1.y; v[rr][q][6] = x1.z; v[rr][q][7] = x1.w; } }
#pragma unroll
        for (int rr = 0; rr < 4; ++rr) { float s = 0.f;
#pragma unroll
            for (int q = 0; q < 2; ++q)
#pragma unroll
                for (int i = 0; i < 8; ++i) s += v[rr][q][i] * v[rr][q][i];
            ss[rr] = wave_sum(s); }
#pragma unroll
        for (int rr = 0; rr < 4; ++rr) { const int row = base + rr * NGW; if (row < 16384) {
            const float rms = sqrtf(ss[rr] * (1.0f / 1024.0f)); const float sc = rms > 0.f ? rms * 0.5f : 1.0f, inv = 1.0f / sc;
#pragma unroll
            for (int q = 0; q < 2; ++q) { float t[8];
#pragma unroll
                for (int i = 0; i < 8; ++i) t[i] = fminf(fmaxf(v[rr][q][i] * inv, -6.0f), 6.0f);
                unsigned d = 0;
                d = __builtin_amdgcn_cvt_scalef32_pk_fp4_f32(d, t[0], t[1], 1.0f, 0); d = __builtin_amdgcn_cvt_scalef32_pk_fp4_f32(d, t[2], t[3], 1.0f, 1);
                d = __builtin_amdgcn_cvt_scalef32_pk_fp4_f32(d, t[4], t[5], 1.0f, 2); d = __builtin_amdgcn_cvt_scalef32_pk_fp4_f32(d, t[6], t[7], 1.0f, 3);
                const int c = 512 * q + 8 * lane; constexpr int W = 1 << LOG2W; *(unsigned*)(dst + ((size_t)(c >> LOG2W) * 16384 + row) * (W / 2) + ((c & (W - 1)) >> 1)) = d; }
            if (lane == 0) invs[row] = sc; } }
    }
}
__device__ __forceinline__ void p0_mod_item(const float* c, const float* w_ada, const float* b_ada, float* mod, LAS float* scr, int item, int tid) {
    LAS float* cond = scr;
    LAS float* red = scr + 8 * 1024;
    for (int i = tid; i < 8 * 1024; i += 512) { const float v = c[i]; cond[i] = v * sigmoid_f(v); }
    __syncthreads();
    const int kq = tid >> 3, cq = tid & 7, j0 = item * 24 + cq * 3;
    float acc[8][3];
#pragma unroll
    for (int b = 0; b < 8; ++b) { acc[b][0] = 0.f; acc[b][1] = 0.f; acc[b][2] = 0.f; }
    for (int i = 0; i < 16; ++i) { const int k = kq + 64 * i; const float* wp = w_ada + (size_t)k * NMODC + j0; const float w0 = wp[0], w1 = wp[1], w2 = wp[2];
#pragma unroll
        for (int b = 0; b < 8; ++b) { const float s = cond[b * 1024 + k]; acc[b][0] += s * w0; acc[b][1] += s * w1; acc[b][2] += s * w2; } }
#pragma unroll
    for (int b = 0; b < 8; ++b)
#pragma unroll
        for (int e = 0; e < 3; ++e) red[kq * 192 + b * 24 + cq * 3 + e] = acc[b][e];
    __syncthreads();
    if (tid < 192) { float s = 0.f; for (int q = 0; q < 64; ++q) s += red[q * 192 + tid]; const int b = tid / 24, j = item * 24 + tid % 24; mod[b * NMODC + j] = s + b_ada[j]; }
    __syncthreads();
}
__device__ __forceinline__ void phase_prologue(const Args& a, LAS unsigned char* lds, int tid, int wave, int lane) {
    unsigned char* ws = a.ws; const int G = gridDim.x, bx = blockIdx.x;
    for (int it = bx; it < 256; it += G) p0_mod_item(a.in[I_C], a.in[I_WADA], a.in[I_BADA], (float*)(ws + WS_MOD), (LAS float*)lds, it, tid);
    LAS float* scr = (LAS float*)(lds + wave * 16384);
    const int gw = bx * NWAVES + wave, NGW = G * NWAVES;
    constexpr int I_IN = 16 * 48, I_GLU = 8 * 16, I_OUT = 16 * 32, I_Q = 16 * 32, NITEMS = I_IN + I_GLU + I_OUT + I_Q;
    for (int it = gw; it < NITEMS; it += NGW) { int r = it;
        if (r < I_IN) { p0_transpose_item(a.in[I_WIN], 1024, 1536, (bf16*)(ws + WS_WIN), scr, r, lane); continue; } r -= I_IN;
        if (r < I_GLU) { p0_transpose_item(a.in[I_WGLU], 512, 512, (bf16*)(ws + WS_WGLU), scr, r, lane); continue; } r -= I_GLU;
        if (r < I_OUT) { p0_transpose_item(a.in[I_WOUT], 1024, 1024, (bf16*)(ws + WS_WOUT), scr, r, lane); continue; } r -= I_OUT;
        p0_transpose_item(a.in[I_WQ], 1024, 1024, (bf16*)(ws + WS_WQ), scr, r, lane); }
    const size_t gtid = (size_t)bx * 512 + tid, gth = (size_t)G * 512;
    cvt_stream(a.in[I_KEYS], (bf16*)(ws + WS_KEYS), 8 * 2 * 128 * 64 / 8, gtid, gth);
    { const float* w = a.in[I_WS]; bf16* wm = (bf16*)(ws + WS_WM);
      for (size_t i = gtid; i < 4 * 128 * 128 / 8; i += gth) { const int e0 = (int)i * 8, ii = (e0 >> 7) & 127, j0 = e0 & 127; const f32x4 p = *(const f32x4*)(w + e0), q = *(const f32x4*)(w + e0 + 4);
          float v[8] = {p.x, p.y, p.z, p.w, q.x, q.y, q.z, q.w};
#pragma unroll
          for (int e = 0; e < 8; ++e) v[e] = (j0 + e <= ii) ? v[e] : 0.f;
          v4u o; o.x = pk2(v[0], v[1]); o.y = pk2(v[2], v[3]); o.z = pk2(v[4], v[5]); o.w = pk2(v[6], v[7]); *(v4u*)(wm + e0) = o; } }
    cvt_rows_fp4<8>(a.in[I_PU], ws + WS_UB, (float*)(ws + WS_SU), gw, NGW, lane); cvt_rows_fp4<8>(a.in[I_PV], ws + WS_VB, (float*)(ws + WS_SV), gw, NGW, lane);
}

__device__ __forceinline__ void phase_norm_mod(const float* x, const float* gw, const float* mod, int sh_off, int sc_off, bf16* H, int wave, int lane) {
    const int G = gridDim.x;
    for (int it = blockIdx.x; it < 256; it += G) { const int b = it >> 5; const float* mb = mod + (size_t)b * NMODC;
        f32x4 A[4], S[4];
#pragma unroll
        for (int j = 0; j < 4; ++j) { const int c0 = 4 * lane + 256 * j; const f32x4 g = *(const f32x4*)(gw + c0), sc = *(const f32x4*)(mb + sc_off + c0); A[j] = g * (sc + 1.0f); S[j] = *(const f32x4*)(mb + sh_off + c0); }
        for (int r = 0; r < 32; ++r) { const size_t row = (size_t)it * 256 + wave * 32 + r; const f32x4* xr = (const f32x4*)(x + row * 1024) + lane;
            f32x4 v[4]; float s = 0.f;
#pragma unroll
            for (int j = 0; j < 4; ++j) { v[j] = __builtin_nontemporal_load(xr + 64 * j); s += (v[j].x * v[j].x + v[j].y * v[j].y) + (v[j].z * v[j].z + v[j].w * v[j].w); }
            const float rstd = 1.0f / sqrtf(wave_sum(s) * (1.0f / 1024.0f) + EPS);
            unsigned long long* o8 = (unsigned long long*)(H + row * 1024) + lane;
#pragma unroll
            for (int j = 0; j < 4; ++j) { const f32x4 h = v[j] * rstd * A[j] + S[j]; o8[64 * j] = (unsigned long long)pk2(h.x, h.y) | ((unsigned long long)pk2(h.z, h.w) << 32); } } }
}
__device__ __forceinline__ void phase_norm_mod_bf(const bf16* x, const float* gw, const float* mod, int sh_off, int sc_off, bf16* H, unsigned char* HQ, float* SH, int wave, int lane) {
    const int G = gridDim.x;
    for (int it = blockIdx.x; it < 256; it += G) { const int b = it >> 5; const float* mb = mod + (size_t)b * NMODC;
        float A[16], S[16];
#pragma unroll
        for (int q = 0; q < 2; ++q)
#pragma unroll
            for (int j = 0; j < 8; ++j) { const int c = 512 * q + 8 * lane + j; A[8 * q + j] = gw[c] * (mb[sc_off + c] + 1.0f); S[8 * q + j] = mb[sh_off + c]; }
        for (int r = 0; r < 32; ++r) { const size_t row = (size_t)it * 256 + wave * 32 + r;
            const v4u r0 = *(const v4u*)(x + row * 1024 + 8 * lane), r1 = *(const v4u*)(x + row * 1024 + 512 + 8 * lane);
            float v[16] = {bflo(r0.x), bfhi(r0.x), bflo(r0.y), bfhi(r0.y), bflo(r0.z), bfhi(r0.z), bflo(r0.w), bfhi(r0.w), bflo(r1.x), bfhi(r1.x), bflo(r1.y), bfhi(r1.y), bflo(r1.z), bfhi(r1.z), bflo(r1.w), bfhi(r1.w)};
            float s = 0.f;
#pragma unroll
            for (int j = 0; j < 16; ++j) s += v[j] * v[j];
            const float rstd = 1.0f / sqrtf(wave_sum(s) * (1.0f / 1024.0f) + EPS);
#pragma unroll
            for (int j = 0; j < 16; ++j) v[j] = v[j] * rstd * A[j] + S[j];
            v4u o0, o1; o0.x = pk2(v[0], v[1]); o0.y = pk2(v[2], v[3]); o0.z = pk2(v[4], v[5]); o0.w = pk2(v[6], v[7]); o1.x = pk2(v[8], v[9]); o1.y = pk2(v[10], v[11]); o1.z = pk2(v[12], v[13]); o1.w = pk2(v[14], v[15]);
            *(v4u*)(H + row * 1024 + 8 * lane) = o0; *(v4u*)(H + row * 1024 + 512 + 8 * lane) = o1;
            float mx = 0.f;
#pragma unroll
            for (int j = 0; j < 16; ++j) mx = fmaxf(mx, fabsf(v[j]));
            mx = wave_max(mx); const float qs = mx > 0.f ? 200.0f / mx : 1.0f;
#pragma unroll
            for (int q = 0; q < 2; ++q) { int p0 = 0, p1 = 0;
                p0 = __builtin_amdgcn_cvt_pk_fp8_f32(v[8 * q] * qs, v[8 * q + 1] * qs, p0, false); p0 = __builtin_amdgcn_cvt_pk_fp8_f32(v[8 * q + 2] * qs, v[8 * q + 3] * qs, p0, true);
                p1 = __builtin_amdgcn_cvt_pk_fp8_f32(v[8 * q + 4] * qs, v[8 * q + 5] * qs, p1, false); p1 = __builtin_amdgcn_cvt_pk_fp8_f32(v[8 * q + 6] * qs, v[8 * q + 7] * qs, p1, true);
                *(v2u*)(HQ + row * 1024 + 512 * q + 8 * lane) = (v2u){(unsigned)p0, (unsigned)p1}; }
            if (lane == 0) SH[row] = mx > 0.f ? mx * (1.0f / 200.0f) : 1.0f; } }
}
__device__ __forceinline__ void sincos_f(float th, float& s, float& c) {
    const float q = rintf(th * 0.63661977236758f);
    float y = fmaf(q, -1.5707962513f, th); y = fmaf(q, -7.5497894159e-8f, y); y = fmaf(q, -5.3903029534e-15f, y);
    const float y2 = y * y;
    const float sp = y + y * y2 * (-1.6666667163e-1f + y2 * (8.3333337680e-3f + y2 * (-1.9841270114e-4f + y2 * 2.7557314297e-6f)));
    const float cp = 1.0f + y2 * (-0.5f + y2 * (4.1666667908e-2f + y2 * (-1.3888889225e-3f + y2 * (2.4801587642e-5f + y2 * -2.7557314297e-7f))));
    const int qi = (int)q & 3;
    s = (qi == 0) ? sp : (qi == 1) ? cp : (qi == 2) ? -sp : -cp;
    c = (qi == 0) ? cp : (qi == 1) ? -sp : (qi == 2) ? -cp : sp;
}
__device__ __forceinline__ void s5_disc(const float* are, const float* aim, float dt, int gp, float& abr, float& abi, float& cr, float& ci) {
    const float ar = fminf(are[gp], -1e-4f), ai = aim[gp];
    const float mag = expf(ar * dt); float sn, cs; sincos_f(ai * dt, sn, cs);
    abr = mag * cs; abi = mag * sn;
    const float nr = abr - 1.0f, ni = abi, den = 1.0f / (ar * ar + ai * ai);
    cr = (nr * ar + ni * ai) * den; ci = (ni * ar - nr * ai) * den;
}
constexpr int S5_X_LD = 136;
constexpr int S5_X_OFF = 0, S5_E_OFF = 128 * S5_X_LD * 2;
#define LDS_BARRIER() do { asm volatile("s_waitcnt lgkmcnt(0)" ::: "memory"); __builtin_amdgcn_s_barrier(); asm volatile("" ::: "memory"); } while (0)
#define CMAC_R(ar, ai, br, bi, cr) fmaf((ar), (br), fmaf(-(ai), (bi), (cr)))
#define CMAC_I(ar, ai, br, bi, ci) fmaf((ar), (bi), fmaf((ai), (br), (ci)))
#define CMUL_R(ar, ai, br, bi) ((ar) * (br) - (ai) * (bi))
#define CMUL_I(ar, ai, br, bi) ((ar) * (bi) + (ai) * (br))
__device__ __forceinline__ void s5_item(const Args& a, LAS unsigned char* lds, int item, int wave, int lane) {
    const int b = item >> 5, g = item & 31;
    const float dt = expf(a.in[I_LOGDT][g]);
    LAS bf16* X = (LAS bf16*)(lds + S5_X_OFF); LAS float* E = (LAS float*)(lds + S5_E_OFF);
    const int mt = wave >> 1, sh = wave & 1, l32 = lane & 31, hf = lane >> 5, p = 32 * sh + l32;
    float a1r, a1i, cr, ci; s5_disc(a.in[I_ARE], a.in[I_AIM], dt, g * 64 + p, a1r, a1i, cr, ci);
    const float a2r = CMUL_R(a1r, a1i, a1r, a1i), a2i = CMUL_I(a1r, a1i, a1r, a1i), a3r = CMUL_R(a2r, a2i, a1r, a1i), a3i = CMUL_I(a2r, a2i, a1r, a1i);
    const float a4r = CMUL_R(a2r, a2i, a2r, a2i), a4i = CMUL_I(a2r, a2i, a2r, a2i), a8r = CMUL_R(a4r, a4i, a4r, a4i), a8i = CMUL_I(a4r, a4i, a4r, a4i);
    const float a12r = CMUL_R(a8r, a8i, a4r, a4i), a12i = CMUL_I(a8r, a8i, a4r, a4i), a16r = CMUL_R(a8r, a8i, a8r, a8i), a16i = CMUL_I(a8r, a8i, a8r, a8i);
    const float a20r = CMUL_R(a16r, a16i, a4r, a4i), a20i = CMUL_I(a16r, a16i, a4r, a4i), a24r = CMUL_R(a16r, a16i, a8r, a8i), a24i = CMUL_I(a16r, a16i, a8r, a8i);
    const float a28r = CMUL_R(a24r, a24i, a4r, a4i), a28i = CMUL_I(a24r, a24i, a4r, a4i), a32r = CMUL_R(a16r, a16i, a16r, a16i), a32i = CMUL_I(a16r, a16i, a16r, a16i);
    const float pwr[4] = {a1r, a2r, a3r, a4r}, pwi[4] = {a1i, a2i, a3i, a4i};
    const float qkr[4] = {hf ? a4r : 1.0f, hf ? a12r : a8r, hf ? a20r : a16r, hf ? a28r : a24r}, qki[4] = {hf ? a4i : 0.0f, hf ? a12i : a8i, hf ? a20i : a16i, hf ? a28i : a24i};
    bf16x8 bfr_re, bfr_im;
    { const float* br = a.in[I_BRE] + (size_t)(g * 64 + p) * 16 + 8 * hf; const float* bi = a.in[I_BIM] + (size_t)(g * 64 + p) * 16 + 8 * hf;
      float vr[8], vi[8];
#pragma unroll
      for (int j = 0; j < 8; ++j) { vr[j] = cr * br[j] - ci * bi[j]; vi[j] = cr * bi[j] + ci * br[j]; }
      v4u o; o.x = pk2(vr[0], vr[1]); o.y = pk2(vr[2], vr[3]); o.z = pk2(vr[4], vr[5]); o.w = pk2(vr[6], vr[7]); bfr_re = __builtin_bit_cast(bf16x8, o);
      o.x = pk2(vi[0], vi[1]); o.y = pk2(vi[2], vi[3]); o.z = pk2(vi[4], vi[5]); o.w = pk2(vi[6], vi[7]); bfr_im = __builtin_bit_cast(bf16x8, o); }
    const int l16 = lane & 15, q4 = lane >> 4;
    bf16x8 cm[4];
#pragma unroll
    for (int ks = 0; ks < 4; ++ks) { const int s0 = 16 * ks + 4 * q4; const float* cre = a.in[I_CRE] + (size_t)(g * 16 + l16) * 64 + s0; const float* cim = a.in[I_CIM] + (size_t)(g * 16 + l16) * 64 + s0;
        v4u o; o.x = pk2(cre[0], -cim[0]); o.y = pk2(cre[1], -cim[1]); o.z = pk2(cre[2], -cim[2]); o.w = pk2(cre[3], -cim[3]); cm[ks] = __builtin_bit_cast(bf16x8, o); }
    float dsk[4];
#pragma unroll
    for (int r = 0; r < 4; ++r) dsk[r] = a.in[I_D][g * 16 + 4 * q4 + r];
    const bf16* ZS = (const bf16*)(a.ws + WS_ZS) + ((size_t)(b * 32 + g) * 8192) * 16;
    bf16* YS = (bf16*)(a.ws + WS_YS) + (size_t)b * 8192 * 512 + g * 16;
    float xinr = 0.f, xini = 0.f;
    bf16x8 ua_n = *(const bf16x8*)(ZS + (mt * 32 + l32) * 16 + hf * 8);
    v2u uu_n = *(const v2u*)(ZS + (16 * wave + l16) * 16 + 4 * q4);
    for (int ch = 0; ch < 64; ++ch) {
        const bf16x8 ua = ua_n; const v2u uu = uu_n;
        { const int cn = ch < 63 ? ch + 1 : 63; const bf16* zn = ZS + (size_t)cn * 128 * 16;
          ua_n = *(const bf16x8*)(zn + (mt * 32 + l32) * 16 + hf * 8); uu_n = *(const v2u*)(zn + (16 * wave + l16) * 16 + 4 * q4); }
        const f32x16 z16 = {0.f, 0.f, 0.f, 0.f, 0.f, 0.f, 0.f, 0.f, 0.f, 0.f, 0.f, 0.f, 0.f, 0.f, 0.f, 0.f};
        const f32x16 bre = __builtin_amdgcn_mfma_f32_32x32x16_bf16(ua, bfr_re, z16, 0, 0, 0), bim = __builtin_amdgcn_mfma_f32_32x32x16_bf16(ua, bfr_im, z16, 0, 0, 0);
        float xr[16], xi[16];
#pragma unroll
        for (int j = 0; j < 4; ++j) { xr[4 * j] = bre[4 * j]; xi[4 * j] = bim[4 * j];
#pragma unroll
            for (int i = 1; i < 4; ++i) { xr[4 * j + i] = CMAC_R(a1r, a1i, xr[4 * j + i - 1], xi[4 * j + i - 1], bre[4 * j + i]); xi[4 * j + i] = CMAC_I(a1r, a1i, xr[4 * j + i - 1], xi[4 * j + i - 1], bim[4 * j + i]); } }
        float clr[4], cli[4], ber, bei;
        { float pgr[4], pgi[4];
#pragma unroll
          for (int j = 0; j < 4; ++j) { pgr[j] = __shfl_xor(xr[4 * j + 3], 32); pgi[j] = __shfl_xor(xi[4 * j + 3], 32); }
          float cr_ = 0.f, ci_ = 0.f;
#pragma unroll
          for (int k = 0; k < 8; ++k) { const int j = k >> 1; const bool mine = (hf == (k & 1));
              if ((k & 1) == 0) { clr[j] = cr_; cli[j] = ci_; } else { clr[j] = mine ? cr_ : clr[j]; cli[j] = mine ? ci_ : cli[j]; }
              const float gr = mine ? xr[4 * j + 3] : pgr[j], gi = mine ? xi[4 * j + 3] : pgi[j];
              const float nr = CMAC_R(a4r, a4i, cr_, ci_, gr), ni = CMAC_I(a4r, a4i, cr_, ci_, gi); cr_ = nr; ci_ = ni; }
          ber = cr_; bei = ci_; }
        if (hf == 0) { E[(mt * 64 + p) * 2] = ber; E[(mt * 64 + p) * 2 + 1] = bei; }
        LDS_BARRIER();
        float mbr = 0.f, mbi = 0.f;
        { float cr_ = xinr, ci_ = xini;
#pragma unroll
          for (int m = 0; m < 4; ++m) { if (m == mt) { mbr = cr_; mbi = ci_; } const float er = E[(m * 64 + p) * 2], ei = E[(m * 64 + p) * 2 + 1];
              const float nr = CMAC_R(a32r, a32i, cr_, ci_, er), ni = CMAC_I(a32r, a32i, cr_, ci_, ei); cr_ = nr; ci_ = ni; }
          xinr = cr_; xini = ci_; }
#pragma unroll
        for (int j = 0; j < 4; ++j) { const float ckr = CMAC_R(qkr[j], qki[j], mbr, mbi, clr[j]), cki = CMAC_I(qkr[j], qki[j], mbr, mbi, cli[j]);
#pragma unroll
            for (int i = 0; i < 4; ++i) { const float fr = CMAC_R(pwr[i], pwi[i], ckr, cki, xr[4 * j + i]), fi = CMAC_I(pwr[i], pwi[i], ckr, cki, xi[4 * j + i]);
                *(LAS unsigned*)(X + (32 * mt + 8 * j + 4 * hf + i) * S5_X_LD + 2 * p) = pg8::cvt_pk_bf16(fr, fi); } }
        LDS_BARRIER();
        { f32x4 o = {0.f, 0.f, 0.f, 0.f};
#pragma unroll
          for (int ks = 0; ks < 4; ++ks) { const bf16x8 xa = *(const LAS bf16x8*)(X + (16 * wave + l16) * S5_X_LD + 32 * ks + 8 * q4); o = __builtin_amdgcn_mfma_f32_16x16x32_bf16(cm[ks], xa, o, 0, 0, 0); }
          const int t = 16 * wave + l16;
          const float y0 = gelu_t(o[0] + dsk[0] * bflo(uu.x)), y1 = gelu_t(o[1] + dsk[1] * bfhi(uu.x)), y2 = gelu_t(o[2] + dsk[2] * bflo(uu.y)), y3 = gelu_t(o[3] + dsk[3] * bfhi(uu.y));
          v2u w; w.x = pg8::cvt_pk_bf16(y0, y1); w.y = pg8::cvt_pk_bf16(y2, y3); *(v2u*)(YS + (size_t)(ch * 128 + t) * 512 + 4 * q4) = w; }
    }
    __syncthreads();
}

constexpr int SGU_RS = 1056;
typedef short v4i16_t __attribute__((ext_vector_type(4)));
__device__ __forceinline__ s16x4 ds_tr16(const LAS unsigned char* p) { return __builtin_bit_cast(s16x4, __builtin_amdgcn_ds_read_tr16_b64_v4i16((LAS v4i16_t*)p)); }
__device__ __forceinline__ void sgu_item(const Args& a, LAS unsigned char* lds, int item, int wave, int lane) {
    const bf16* ZG = (const bf16*)(a.ws + WS_ZG); bf16* Y = (bf16*)(a.ws + WS_Y); const bf16* WM = (const bf16*)(a.ws + WS_WM);
    const int r0 = item * 128;
    { float lg[8], lb[8];
#pragma unroll
      for (int j = 0; j < 8; ++j) { lg[j] = a.in[I_LNG][8 * lane + j]; lb[j] = a.in[I_LNB][8 * lane + j]; }
      v4u raw[16];
#pragma unroll
      for (int tt = 0; tt < 16; ++tt) raw[tt] = __builtin_nontemporal_load((const v4u*)(ZG + (size_t)(r0 + 16 * wave + tt) * 1024 + 512 + 8 * lane));
      float s1[16], s2[16];
#pragma unroll
      for (int tt = 0; tt < 16; ++tt) { const float f[8] = {bflo(raw[tt].x), bfhi(raw[tt].x), bflo(raw[tt].y), bfhi(raw[tt].y), bflo(raw[tt].z), bfhi(raw[tt].z), bflo(raw[tt].w), bfhi(raw[tt].w)};
          float a1 = 0.f, a2 = 0.f;
#pragma unroll
          for (int j = 0; j < 8; ++j) { a1 += f[j]; a2 += f[j] * f[j]; }
          s1[tt] = a1; s2[tt] = a2; }
#pragma unroll
      for (int o = 1; o < 64; o <<= 1) {
#pragma unroll
          for (int tt = 0; tt < 16; ++tt) { s1[tt] += __shfl_xor(s1[tt], o); s2[tt] += __shfl_xor(s2[tt], o); } }
#pragma unroll
      for (int tt = 0; tt < 16; ++tt) { const int t = 16 * wave + tt;
          float f[8] = {bflo(raw[tt].x), bfhi(raw[tt].x), bflo(raw[tt].y), bfhi(raw[tt].y), bflo(raw[tt].z), bfhi(raw[tt].z), bflo(raw[tt].w), bfhi(raw[tt].w)};
          const float mu = s1[tt] * (1.0f / 512.0f), var = fmaxf(s2[tt] * (1.0f / 512.0f) - mu * mu, 0.f), rstd = 1.0f / sqrtf(var + EPS);
#pragma unroll
          for (int j = 0; j < 8; ++j) f[j] = (f[j] - mu) * rstd * lg[j] + lb[j];
          v4u o; o.x = pk2(f[0], f[1]); o.y = pk2(f[2], f[3]); o.z = pk2(f[4], f[5]); o.w = pk2(f[6], f[7]);
          *(LAS v4u*)(lds + t * SGU_RS + 16 * lane) = o; } }
    __syncthreads();
    const int l16 = lane & 15, q4 = lane >> 4, qq = l16 >> 2, pp = l16 & 3, nks = (wave >> 1) + 1, irow = 16 * wave + l16;
    for (int h = 0; h < 4; ++h) {
        f32x4 acc[8];
#pragma unroll
        for (int nt = 0; nt < 8; ++nt) acc[nt] = (f32x4){0.f, 0.f, 0.f, 0.f};
        bf16x8 wf[4]; v2u uu[8];
#pragma unroll
        for (int ks = 0; ks < 4; ++ks) { const int kc = ks < nks ? ks : nks - 1; wf[ks] = *(const bf16x8*)(WM + ((size_t)(h * 128 + irow)) * 128 + 32 * kc + 8 * q4); }
#pragma unroll
        for (int nt = 0; nt < 8; ++nt) uu[nt] = __builtin_nontemporal_load((const v2u*)(ZG + (size_t)(r0 + irow) * 1024 + h * 128 + 16 * nt + 4 * q4));
        const float bs = a.in[I_BS][h * 128 + irow];
#pragma unroll
        for (int ks = 0; ks < 4; ++ks) { if (ks < nks) {
            const LAS unsigned char* vb = lds + (32 * ks + 8 * q4 + qq) * SGU_RS + (h * 128 + 4 * pp) * 2;
#pragma unroll
            for (int nt = 0; nt < 8; ++nt) { const s16x4 lo = ds_tr16(vb + nt * 32), hi = ds_tr16(vb + nt * 32 + 4 * SGU_RS);
                const bf16x8 vf = {lo[0], lo[1], lo[2], lo[3], hi[0], hi[1], hi[2], hi[3]};
                acc[nt] = __builtin_amdgcn_mfma_f32_16x16x32_bf16(vf, wf[ks], acc[nt], 0, 0, 0); } } }
#pragma unroll
        for (int nt = 0; nt < 8; ++nt) { const size_t o = (size_t)(r0 + irow) * 1024 + h * 128 + 16 * nt + 4 * q4;
            v2u w; w.x = pk2(bflo(uu[nt].x) * (acc[nt][0] + bs), bfhi(uu[nt].x) * (acc[nt][1] + bs)); w.y = pk2(bflo(uu[nt].y) * (acc[nt][2] + bs), bfhi(uu[nt].y) * (acc[nt][3] + bs)); *(v2u*)(Y + o) = w; }
    }
    __syncthreads();
}
__device__ __forceinline__ int f2i(float f) { return __builtin_bit_cast(int, f); }
__device__ __forceinline__ float i2f(int i) { return __builtin_bit_cast(float, i); }
__device__ __forceinline__ float kmax(float a, float b) { float r; asm("v_max_f32 %0, %1, %2" : "=v"(r) : "v"(a), "v"(b)); return r; }
__device__ __forceinline__ float kmin(float a, float b) { float r; asm("v_min_f32 %0, %1, %2" : "=v"(r) : "v"(a), "v"(b)); return r; }
__device__ __forceinline__ float mkkey(float s, int keep, int payload) { return i2f((f2i(s) & keep) | payload); }
__device__ __forceinline__ void sort16(float (&v)[16]) {
#define CE16(i, j) { const float x_ = v[i], y_ = v[j]; v[i] = kmax(x_, y_); v[j] = kmin(x_, y_); }
    CE16(0,1) CE16(2,3) CE16(0,2) CE16(1,3) CE16(1,2) CE16(4,5) CE16(6,7) CE16(4,6) CE16(5,7) CE16(5,6) CE16(0,4) CE16(2,6) CE16(2,4) CE16(1,5) CE16(3,7) CE16(3,5) CE16(1,2) CE16(3,4) CE16(5,6) CE16(8,9) CE16(10,11) CE16(8,10) CE16(9,11) CE16(9,10) CE16(12,13) CE16(14,15) CE16(12,14) CE16(13,15) CE16(13,14) CE16(8,12) CE16(10,14) CE16(10,12) CE16(9,13) CE16(11,15) CE16(11,13) CE16(9,10) CE16(11,12) CE16(13,14) CE16(0,8) CE16(4,12) CE16(4,8) CE16(2,10) CE16(6,14) CE16(6,10) CE16(2,4) CE16(6,8) CE16(10,12) CE16(1,9) CE16(5,13) CE16(5,9) CE16(3,11) CE16(7,15) CE16(7,11) CE16(3,5) CE16(7,9) CE16(11,13) CE16(1,2) CE16(3,4) CE16(5,6) CE16(7,8) CE16(9,10) CE16(11,12) CE16(13,14)
#undef CE16
}
__device__ __forceinline__ void merge16(float (&a)[16], const float (&b)[16]) {
#pragma unroll
    for (int i = 0; i < 16; ++i) a[i] = kmax(a[i], b[15 - i]);
#pragma unroll
    for (int j = 8; j > 0; j >>= 1)
#pragma unroll
        for (int i = 0; i < 16; ++i) { const int l = i ^ j; if (l > i) { const float x = a[i], y = a[l]; a[i] = kmax(x, y); a[l] = kmin(x, y); } }
}
constexpr int NCAND = 50;
constexpr int cand_a(int n) { int c = 0; for (int a = 0; a < 16; ++a) for (int b = 0; b < 16; ++b) if ((a + 1) * (b + 1) <= 16) { if (c == n) return a; ++c; } return 0; }
constexpr int cand_b(int n) { int c = 0; for (int a = 0; a < 16; ++a) for (int b = 0; b < 16; ++b) if ((a + 1) * (b + 1) <= 16) { if (c == n) return b; ++c; } return 0; }
template <int N> struct CandAB { static constexpr int a = cand_a(N), b = cand_b(N); };
template <int S> __device__ __forceinline__ float cand_key2(const float (&f1)[16], const float (&f2)[16], bool hf) {
    if constexpr (S < 25) { constexpr int a0 = CandAB<S>::a, b0 = CandAB<S>::b, a1 = CandAB<25 + S>::a, b1 = CandAB<25 + S>::b;
        const float s = (hf ? f1[a1] : f1[a0]) + (hf ? f2[b1] : f2[b0]); return mkkey(s, ~0xff, hf ? ((a1 << 4) | b1) : ((a0 << 4) | b0)); }
    else return i2f((int)0xff800000);
}
template <int G> __device__ __forceinline__ void cand_fill2(float (&v)[16], const float (&f1)[16], const float (&f2)[16], bool hf) {
    v[0] = cand_key2<G * 16 + 0>(f1, f2, hf); v[1] = cand_key2<G * 16 + 1>(f1, f2, hf); v[2] = cand_key2<G * 16 + 2>(f1, f2, hf); v[3] = cand_key2<G * 16 + 3>(f1, f2, hf);
    v[4] = cand_key2<G * 16 + 4>(f1, f2, hf); v[5] = cand_key2<G * 16 + 5>(f1, f2, hf); v[6] = cand_key2<G * 16 + 6>(f1, f2, hf); v[7] = cand_key2<G * 16 + 7>(f1, f2, hf);
    v[8] = cand_key2<G * 16 + 8>(f1, f2, hf); v[9] = cand_key2<G * 16 + 9>(f1, f2, hf); v[10] = cand_key2<G * 16 + 10>(f1, f2, hf); v[11] = cand_key2<G * 16 + 11>(f1, f2, hf);
    v[12] = cand_key2<G * 16 + 12>(f1, f2, hf); v[13] = cand_key2<G * 16 + 13>(f1, f2, hf); v[14] = cand_key2<G * 16 + 14>(f1, f2, hf); v[15] = cand_key2<G * 16 + 15>(f1, f2, hf);
}

__device__ __forceinline__ void peer_topk32(const bf16* Q, const bf16* KEYS, unsigned short* EO, float* GO, LAS unsigned char* wl  , int tok0, int lane) {
    const int l32 = lane & 31, hf = lane >> 5; const size_t tok = (size_t)tok0 + l32;
    const bf16* qrow = Q + tok * 1024 + hf * 8; const bf16* krow = KEYS + (size_t)l32 * 64 + hf * 8;
    bf16x8 bq[4], bqn[4], akn[4];
#pragma unroll
    for (int ks = 0; ks < 4; ++ks) { bq[ks] = __builtin_nontemporal_load((const bf16x8*)(qrow + ks * 16)); akn[ks] = *(const bf16x8*)(krow + ks * 16); }
    for (int h = 0; h < 8; ++h) {
        float L0[16], L1[16];
#pragma unroll
        for (int c = 0; c < 2; ++c) {
            const int hc = 2 * h + c, hn = hc < 15 ? hc + 1 : 15;
#pragma unroll
            for (int ks = 0; ks < 4; ++ks) bqn[ks] = __builtin_nontemporal_load((const bf16x8*)(qrow + hn * 64 + ks * 16));
            float T[16], S[16];
            { f32x16 acc = (f32x16){0.f, 0.f, 0.f, 0.f, 0.f, 0.f, 0.f, 0.f, 0.f, 0.f, 0.f, 0.f, 0.f, 0.f, 0.f, 0.f};
              const bf16x8 ak0 = akn[0], ak1 = akn[1], ak2 = akn[2], ak3 = akn[3];
              { const bf16* kn = krow + (size_t)(hc * 4 + 1) * (32 * 64);
#pragma unroll
                for (int ks = 0; ks < 4; ++ks) akn[ks] = *(const bf16x8*)(kn + ks * 16); }
              acc = __builtin_amdgcn_mfma_f32_32x32x16_bf16(ak0, bq[0], acc, 0, 0, 0); acc = __builtin_amdgcn_mfma_f32_32x32x16_bf16(ak1, bq[1], acc, 0, 0, 0);
              acc = __builtin_amdgcn_mfma_f32_32x32x16_bf16(ak2, bq[2], acc, 0, 0, 0); acc = __builtin_amdgcn_mfma_f32_32x32x16_bf16(ak3, bq[3], acc, 0, 0, 0);
#pragma unroll
              for (int r = 0; r < 16; ++r) T[r] = mkkey(acc[r], ~0x7f, 8 * (r >> 2) + 4 * hf + (r & 3));
              sort16(T); }
            for (int mt = 1; mt < 4; ++mt) {
                f32x16 acc = (f32x16){0.f, 0.f, 0.f, 0.f, 0.f, 0.f, 0.f, 0.f, 0.f, 0.f, 0.f, 0.f, 0.f, 0.f, 0.f, 0.f};
                const bf16x8 ak0 = akn[0], ak1 = akn[1], ak2 = akn[2], ak3 = akn[3];
                { const int tn = hc * 4 + mt + 1; const bf16* kn = krow + (size_t)(tn < 64 ? tn : 63) * (32 * 64);
#pragma unroll
                  for (int ks = 0; ks < 4; ++ks) akn[ks] = *(const bf16x8*)(kn + ks * 16); }
                acc = __builtin_amdgcn_mfma_f32_32x32x16_bf16(ak0, bq[0], acc, 0, 0, 0); acc = __builtin_amdgcn_mfma_f32_32x32x16_bf16(ak1, bq[1], acc, 0, 0, 0);
                acc = __builtin_amdgcn_mfma_f32_32x32x16_bf16(ak2, bq[2], acc, 0, 0, 0); acc = __builtin_amdgcn_mfma_f32_32x32x16_bf16(ak3, bq[3], acc, 0, 0, 0);
#pragma unroll
                for (int r = 0; r < 16; ++r) S[r] = mkkey(acc[r], ~0x7f, mt * 32 + 8 * (r >> 2) + 4 * hf + (r & 3));
                sort16(S); merge16(T, S); }
#pragma unroll
            for (int ks = 0; ks < 4; ++ks) bq[ks] = bqn[ks];
#pragma unroll
            for (int r = 0; r < 16; ++r) S[r] = __shfl_xor(T[r], 32);
            merge16(T, S);
            if (c == 0) {
#pragma unroll
                for (int r = 0; r < 16; ++r) L0[r] = T[r];
            } else {
#pragma unroll
                for (int r = 0; r < 16; ++r) L1[r] = T[r];
            }
        }
        float f1[16], f2[16];
#pragma unroll
        for (int r = 0; r < 16; ++r) { const int k0 = f2i(L0[r]), k1 = f2i(L1[r]); f1[r] = i2f(k0 & ~0x7f); f2[r] = i2f(k1 & ~0x7f); wl[lane * 36 + r] = (unsigned char)(k0 & 0x7f); wl[lane * 36 + 16 + r] = (unsigned char)(k1 & 0x7f); }
        float K[16], S2[16];
        cand_fill2<0>(K, f1, f2, hf != 0); sort16(K);
        cand_fill2<1>(S2, f1, f2, hf != 0); sort16(S2); merge16(K, S2);
#pragma unroll
        for (int r = 0; r < 16; ++r) S2[r] = __shfl_xor(K[r], 32);
        merge16(K, S2);
        float pe[16], ssum = 0.f; const float mx = i2f(f2i(K[0]) & ~0xff);
#pragma unroll
        for (int r = 0; r < 16; ++r) { pe[r] = __expf(i2f(f2i(K[r]) & ~0xff) - mx); ssum += pe[r]; }
        const float inv = 1.0f / ssum;
        int ev[16]; float gv[16];
#pragma unroll
        for (int j = 0; j < 16; ++j) { const int ab = f2i(K[j]) & 0xff; const int i1 = wl[lane * 36 + (ab >> 4)], i2 = wl[lane * 36 + 16 + (ab & 15)]; ev[j] = i1 * 128 + i2; gv[j] = pe[j] * inv; }
        if (hf == 0) { unsigned short* ed = EO + (tok * 8 + h) * 16; float* gd = GO + (tok * 8 + h) * 16;
            *(v4u*)(ed) = (v4u){(unsigned)ev[0] | ((unsigned)ev[1] << 16), (unsigned)ev[2] | ((unsigned)ev[3] << 16), (unsigned)ev[4] | ((unsigned)ev[5] << 16), (unsigned)ev[6] | ((unsigned)ev[7] << 16)};
            *(v4u*)(ed + 8) = (v4u){(unsigned)ev[8] | ((unsigned)ev[9] << 16), (unsigned)ev[10] | ((unsigned)ev[11] << 16), (unsigned)ev[12] | ((unsigned)ev[13] << 16), (unsigned)ev[14] | ((unsigned)ev[15] << 16)};
#pragma unroll
            for (int j = 0; j < 4; ++j) *(f32x4*)(gd + 4 * j) = (f32x4){gv[4 * j], gv[4 * j + 1], gv[4 * j + 2], gv[4 * j + 3]}; }
    }
}

typedef float f32x2_t __attribute__((ext_vector_type(2)));
typedef _Float16 h2_t __attribute__((ext_vector_type(2)));
__device__ __forceinline__ h2_t as_h2(unsigned u) { return __builtin_bit_cast(h2_t, u); }
template <bool HI> __device__ __forceinline__ h2_t cvt_h2_fp8(unsigned d) { const auto t = __builtin_amdgcn_cvt_scalef32_pk_f16_fp8((int)d, 1.0f, HI); return __builtin_bit_cast(h2_t, t); }
typedef int v4i __attribute__((ext_vector_type(4)));
__device__ __forceinline__ void cvt8x2(v4u r, f32x2_t (&f)[8]) {
    const unsigned w0 = r.x, w1 = r.y, w2 = r.z, w3 = r.w;
    f[0] = __builtin_amdgcn_cvt_pk_f32_fp8((int)w0, false); f[1] = __builtin_amdgcn_cvt_pk_f32_fp8((int)w0, true);
    f[2] = __builtin_amdgcn_cvt_pk_f32_fp8((int)w1, false); f[3] = __builtin_amdgcn_cvt_pk_f32_fp8((int)w1, true);
    f[4] = __builtin_amdgcn_cvt_pk_f32_fp8((int)w2, false); f[5] = __builtin_amdgcn_cvt_pk_f32_fp8((int)w2, true);
    f[6] = __builtin_amdgcn_cvt_pk_f32_fp8((int)w3, false); f[7] = __builtin_amdgcn_cvt_pk_f32_fp8((int)w3, true);
}
__device__ __forceinline__ void load_elist(const unsigned short* E, size_t tok, int h, int (&e)[16]) {
    const v4u* ep = (const v4u*)(E + tok * 128 + h * 16);
#pragma unroll
    for (int i = 0; i < 2; ++i) { const v4u v = ep[i]; const unsigned w[4] = {v.x, v.y, v.z, v.w};
#pragma unroll
        for (int c = 0; c < 4; ++c) { e[8 * i + 2 * c] = (int)(w[c] & 0xffffu); e[8 * i + 2 * c + 1] = (int)(w[c] >> 16); } }
}
__device__ __forceinline__ void issue_rows(v4u (&r)[16], const unsigned char* tb, unsigned poff, const int (&e)[16]) {
#pragma unroll
    for (int k = 0; k < 16; ++k) r[k] = *(const v4u*)(tb + ((unsigned)e[k] * 128u + poff));
}
template <int B2, int B1, int B0> __device__ __forceinline__ void treduce16(const float (&v)[16], int lane, float& o0, float& o1) {
    float q8[8], q4[4];
    { const bool hi = (lane & B2) != 0;
#pragma unroll
      for (int i = 0; i < 8; ++i) { const float keep = hi ? v[i + 8] : v[i], send = hi ? v[i] : v[i + 8]; q8[i] = keep + __shfl_xor(send, B2); } }
    { const bool hi = (lane & B1) != 0;
#pragma unroll
      for (int i = 0; i < 4; ++i) { const float keep = hi ? q8[i + 4] : q8[i], send = hi ? q8[i] : q8[i + 4]; q4[i] = keep + __shfl_xor(send, B1); } }
    { const bool hi = (lane & B0) != 0;
      { const float keep = hi ? q4[2] : q4[0], send = hi ? q4[0] : q4[2]; o0 = keep + __shfl_xor(send, B0); }
      { const float keep = hi ? q4[3] : q4[1], send = hi ? q4[1] : q4[3]; o1 = keep + __shfl_xor(send, B0); } }
}
__device__ __forceinline__ void treduce16i_p(const int (&v)[16], int lane, int& o0, int& o1) {
    int q8[8], q4[4];
    { const bool hi = (lane & 4) != 0;
#pragma unroll
      for (int i = 0; i < 8; ++i) { const int keep = hi ? v[i + 8] : v[i], send = hi ? v[i] : v[i + 8]; q8[i] = keep + __builtin_amdgcn_update_dpp(0, send, 0x141, 0xF, 0xF, false); } }
    { const bool hi = (lane & 2) != 0;
#pragma unroll
      for (int i = 0; i < 4; ++i) { const int keep = hi ? q8[i + 4] : q8[i], send = hi ? q8[i] : q8[i + 4]; q4[i] = keep + __builtin_amdgcn_update_dpp(0, send, 0x4E, 0xF, 0xF, false); } }
    { const bool hi = (lane & 1) != 0;
      { const int keep = hi ? q4[2] : q4[0], send = hi ? q4[0] : q4[2]; o0 = keep + __builtin_amdgcn_update_dpp(0, send, 0xB1, 0xF, 0xF, false); }
      { const int keep = hi ? q4[3] : q4[1], send = hi ? q4[1] : q4[3]; o1 = keep + __builtin_amdgcn_update_dpp(0, send, 0xB1, 0xF, 0xF, false); } }
}
__device__ __forceinline__ void treduce16f_h(const float (&v)[16], int lane, float& o0, float& o1) {
    float q8[8], q4[4];
    { const bool hi = (lane & 8) != 0;
#pragma unroll
      for (int i = 0; i < 8; ++i) { const float keep = hi ? v[i + 8] : v[i], send = hi ? v[i] : v[i + 8];
          q8[i] = keep + __builtin_bit_cast(float, __builtin_amdgcn_update_dpp(0, __builtin_bit_cast(int, send), 0x128, 0xF, 0xF, false)); } }
    { const bool hi = (lane & 16) != 0;
#pragma unroll
      for (int i = 0; i < 4; ++i) { const float keep = hi ? q8[i + 4] : q8[i], send = hi ? q8[i] : q8[i + 4];
          q4[i] = keep + __builtin_bit_cast(float, __builtin_amdgcn_ds_swizzle(__builtin_bit_cast(int, send), 0x401F)); } }
    { const bool hi = (lane & 32) != 0;
      { const float keep = hi ? q4[2] : q4[0], send = hi ? q4[0] : q4[2]; o0 = keep + __shfl_xor(send, 32); }
      { const float keep = hi ? q4[3] : q4[1], send = hi ? q4[1] : q4[3]; o1 = keep + __shfl_xor(send, 32); } }
}
__device__ __forceinline__ void upass_compute(const v4u (&r)[16], v4u hq, short* pa, int lane, v4u (&rn)[16], const unsigned char* tb, unsigned poff, const int (&en)[16]) {
    int part[16];
#pragma unroll
    for (int k = 0; k < 16; ++k) { rn[k] = *(const v4u*)(tb + ((unsigned)en[k] * 128u + poff));
        int s = __builtin_amdgcn_sdot4((int)r[k].x, (int)hq.x, 0, false); s = __builtin_amdgcn_sdot4((int)r[k].y, (int)hq.y, s, false); s = __builtin_amdgcn_sdot4((int)r[k].z, (int)hq.z, s, false); part[k] = __builtin_amdgcn_sdot4((int)r[k].w, (int)hq.w, s, false);
        __builtin_amdgcn_sched_barrier(0); }
    int o0, o1; treduce16i_p(part, lane, o0, o1);
    *(unsigned*)(pa + (lane >> 3) * 16 + 2 * (lane & 7)) = (unsigned)(((o0 + 32) >> 6) & 0xffff) | ((unsigned)((o1 + 32) >> 6) << 16);
}
__device__ __forceinline__ void vpass_compute(const v4u (&r)[16], const v4u (&wp)[2], bf16* xo  , const float* gt  , int lane, v4u (&rn)[16], const unsigned char* tb, unsigned poff, const int (&en)[16]) {
    h2_t o2[8];
#pragma unroll
    for (int i = 0; i < 8; ++i) o2[i] = (h2_t){(_Float16)0.f, (_Float16)0.f};
    const unsigned wq[8] = {wp[0].x, wp[0].y, wp[0].z, wp[0].w, wp[1].x, wp[1].y, wp[1].z, wp[1].w};
#pragma unroll
    for (int k = 0; k < 16; ++k) { rn[k] = *(const v4u*)(tb + ((unsigned)en[k] * 128u + poff));
        const unsigned d0 = r[k].x, d1 = r[k].y, d2 = r[k].z, d3 = r[k].w; const h2_t wpair = as_h2(wq[k >> 1]); const _Float16 wh = (k & 1) ? wpair.y : wpair.x; const h2_t ww = {wh, wh};
        o2[0] = __builtin_elementwise_fma(cvt_h2_fp8<false>(d0), ww, o2[0]); o2[1] = __builtin_elementwise_fma(cvt_h2_fp8<true>(d0), ww, o2[1]);
        o2[2] = __builtin_elementwise_fma(cvt_h2_fp8<false>(d1), ww, o2[2]); o2[3] = __builtin_elementwise_fma(cvt_h2_fp8<true>(d1), ww, o2[3]);
        o2[4] = __builtin_elementwise_fma(cvt_h2_fp8<false>(d2), ww, o2[4]); o2[5] = __builtin_elementwise_fma(cvt_h2_fp8<true>(d2), ww, o2[5]);
        o2[6] = __builtin_elementwise_fma(cvt_h2_fp8<false>(d3), ww, o2[6]); o2[7] = __builtin_elementwise_fma(cvt_h2_fp8<true>(d3), ww, o2[7]);
        __builtin_amdgcn_sched_barrier(0); }
    float v[16];
#pragma unroll
    for (int i = 0; i < 8; ++i) { v[2 * i] = (float)o2[i].x * (1.0f / 64.0f); v[2 * i + 1] = (float)o2[i].y * (1.0f / 64.0f); }
    float o0, o1; treduce16f_h(v, lane, o0, o1);
    const int c = 16 * (lane & 7) + 2 * (((lane >> 1) & 4) | ((lane >> 3) & 2) | ((lane >> 5) & 1));
    const unsigned xb = *(const unsigned*)(xo + c); const f32x2_t g = *(const f32x2_t*)(gt + c);
    const float a0 = bflo(xb) + g.x * o0, a1 = bfhi(xb) + g.y * o1;
    const unsigned ob = pk2(a0, a1);
    *(unsigned*)(xo + c) = ob;
}
template <bool UP> __device__ __forceinline__ void peer_pass(const Args& a, int wave, int lane_in) {
    int lane = lane_in; asm volatile("" : "+v"(lane));
    const int G = gridDim.x, bx = blockIdx.x;
    const bool sliced = (G % 8) == 0;
    const int nj = sliced ? 1 : 8, j0 = sliced ? (bx & 7) : 0;
    const int first = sliced ? ((bx >> 3) * NWAVES + wave) : (bx * NWAVES + wave), stride = sliced ? (G >> 3) * NWAVES : G * NWAVES;
    const int h = lane >> 3, p = lane & 7;
    const unsigned short* E = (const unsigned short*)(a.ws + WS_E); const unsigned char* HQ = a.ws + WS_H2Q; const _Float16* W = (const _Float16*)(a.ws + WS_W);
    short* PA = (short*)(a.ws + WS_PA); const float* MOD = (const float*)(a.ws + WS_MOD);
    const unsigned char* T8 = a.ws + (UP ? WS_UB : WS_VB);
    const int ntok = (M - first + stride - 1) / stride;
    for (int jj = 0; jj < nj; ++jj) { const int j = j0 + jj;
        const unsigned char* tb = T8 + (size_t)j * (16384 * 128);
        v4u RA[16], RB[16]; int en[16], en2[16];
        v4u hA0, hB0; v4u wA[2], wB[2];
        { const size_t t0 = (size_t)first; int e0[16]; load_elist(E, t0, h, e0); issue_rows(RA, tb, 16u * p, e0);
          if (UP) { hA0 = *(const v4u*)(HQ + t0 * 1024 + 128 * j + 16 * p); }
          else { wA[0] = *(const v4u*)(W + t0 * 128 + h * 16); wA[1] = *(const v4u*)(W + t0 * 128 + h * 16 + 8); }
          const size_t t1 = (size_t)first + (size_t)(ntok > 1 ? 1 : 0) * stride; load_elist(E, t1, h, en); }
        for (int u = 0; u < ntok; u += 2) {
            { const int u1 = (u + 1 < ntok) ? u + 1 : ntok - 1, u2 = (u + 2 < ntok) ? u + 2 : ntok - 1; const size_t t1 = (size_t)first + (size_t)u1 * stride, t2 = (size_t)first + (size_t)u2 * stride;
              load_elist(E, t2, h, en2);
              if (UP) { hB0 = *(const v4u*)(HQ + t1 * 1024 + 128 * j + 16 * p); }
              else { wB[0] = *(const v4u*)(W + t1 * 128 + h * 16); wB[1] = *(const v4u*)(W + t1 * 128 + h * 16 + 8); }
              const size_t t = (size_t)first + (size_t)u * stride;
              if (UP) upass_compute(RA, hA0, PA + ((size_t)j * M + t) * 128, lane, RB, tb, 16u * p, en);
              else vpass_compute(RA, wA, (bf16*)(a.ws + WS_X1B) + t * 1024 + 128 * j, MOD + (t >> 13) * NMODC + 5120 + 128 * j, lane, RB, tb, 16u * p, en); }
            if (u + 1 >= ntok) break;
            { const int u1 = (u + 2 < ntok) ? u + 2 : ntok - 1, u2 = (u + 3 < ntok) ? u + 3 : ntok - 1; const size_t t1 = (size_t)first + (size_t)u1 * stride, t2 = (size_t)first + (size_t)u2 * stride;
              load_elist(E, t2, h, en);
              if (UP) { hA0 = *(const v4u*)(HQ + t1 * 1024 + 128 * j + 16 * p); }
              else { wA[0] = *(const v4u*)(W + t1 * 128 + h * 16); wA[1] = *(const v4u*)(W + t1 * 128 + h * 16 + 8); }
              const size_t t = (size_t)first + (size_t)(u + 1) * stride;
              if (UP) upass_compute(RB, hB0, PA + ((size_t)j * M + t) * 128, lane, RA, tb, 16u * p, en2);
              else vpass_compute(RB, wB, (bf16*)(a.ws + WS_X1B) + t * 1024 + 128 * j, MOD + (t >> 13) * NMODC + 5120 + 128 * j, lane, RA, tb, 16u * p, en2); }
        }
    }
}
__device__ __forceinline__ void upass4(const Args& a, int wave, int lane_in) {
    int lane = lane_in; asm volatile("" : "+v"(lane));
    const int G = gridDim.x, bx = blockIdx.x;
    const bool sliced = (G % 8) == 0;
    const int nj = sliced ? 1 : 8, j0 = sliced ? (bx & 7) : 0;
    const int first = sliced ? ((bx >> 3) * NWAVES + wave) : (bx * NWAVES + wave), stride = sliced ? (G >> 3) * NWAVES : G * NWAVES;
    const int r = lane >> 2, p = lane & 3;
    const unsigned short* E = (const unsigned short*)(a.ws + WS_E); const unsigned char* HQh = a.ws + WS_H2Q; const unsigned char* HQl = a.ws + WS_H2Q + (size_t)32 * MiB; short* PA = (short*)(a.ws + WS_PA);
    const int ntok = (M - first + stride - 1) / stride;
    const int eoff = (r >> 1) * 16 + 8 * (r & 1);
    for (int jj = 0; jj < nj; ++jj) { const int j = j0 + jj;
        const unsigned char* tb = a.ws + WS_UB + (size_t)j * (16384 * 64);
        const unsigned poff = 16u * p;
        v4u R0[8], R1[8], R2[8], R3[8], hh0, hl0, hh1, hl1, hh2, hl2, hh3, hl3, eA, eB;
#define U4_ROWS(R, ev) do { const unsigned w_[4] = {ev.x, ev.y, ev.z, ev.w}; _Pragma("unroll") for (int c_ = 0; c_ < 4; ++c_) { R[2 * c_] = *(const v4u*)(tb + ((w_[c_] & 0xffffu) * 64u + poff)); R[2 * c_ + 1] = *(const v4u*)(tb + ((w_[c_] >> 16) * 64u + poff)); } } while (0)
#define U4_COMPUTE(R, hh, hl, t) do { int part[8]; _Pragma("unroll") for (int i_ = 0; i_ < 8; ++i_) { \
            int sh_ = __builtin_amdgcn_sdot8((int)R[i_].x, (int)hh.x, 0, false); sh_ = __builtin_amdgcn_sdot8((int)R[i_].y, (int)hh.y, sh_, false); sh_ = __builtin_amdgcn_sdot8((int)R[i_].z, (int)hh.z, sh_, false); sh_ = __builtin_amdgcn_sdot8((int)R[i_].w, (int)hh.w, sh_, false); \
            int sl_ = __builtin_amdgcn_sdot8((int)R[i_].x, (int)hl.x, 0, false); sl_ = __builtin_amdgcn_sdot8((int)R[i_].y, (int)hl.y, sl_, false); sl_ = __builtin_amdgcn_sdot8((int)R[i_].z, (int)hl.z, sl_, false); sl_ = __builtin_amdgcn_sdot8((int)R[i_].w, (int)hl.w, sl_, false); \
            part[i_] = 16 * sh_ + sl_; } \
        int q4_[4]; { const bool hi_ = (lane & 2) != 0; _Pragma("unroll") for (int i_ = 0; i_ < 4; ++i_) { const int keep_ = hi_ ? part[i_ + 4] : part[i_], send_ = hi_ ? part[i_] : part[i_ + 4]; q4_[i_] = keep_ + __builtin_amdgcn_update_dpp(0, send_, 0x4E, 0xF, 0xF, false); } } \
        int o0_, o1_; { const bool hi_ = (lane & 1) != 0; { const int keep_ = hi_ ? q4_[2] : q4_[0], send_ = hi_ ? q4_[0] : q4_[2]; o0_ = keep_ + __builtin_amdgcn_update_dpp(0, send_, 0xB1, 0xF, 0xF, false); } \
            { const int keep_ = hi_ ? q4_[3] : q4_[1], send_ = hi_ ? q4_[1] : q4_[3]; o1_ = keep_ + __builtin_amdgcn_update_dpp(0, send_, 0xB1, 0xF, 0xF, false); } } \
        *(unsigned*)(PA + ((size_t)j * M + (t)) * 128 + eoff + 2 * p) = (unsigned)(((o0_ + 2) >> 2) & 0xffff) | ((unsigned)((o1_ + 2) >> 2) << 16); } while (0)
#define U4_TOK(u_) ((size_t)first + (size_t)((u_) < ntok ? (u_) : ntok - 1) * stride)
#define U4_E(ev, u_) do { ev = *(const v4u*)(E + U4_TOK(u_) * 128 + eoff); } while (0)
#define U4_H(hh, hl, u_) do { const size_t t_ = U4_TOK(u_); hh = *(const v4u*)(HQh + t_ * 512 + 64 * j + poff); hl = *(const v4u*)(HQl + t_ * 512 + 64 * j + poff); } while (0)
        { v4u e0, e1, e2; U4_E(e0, 0); U4_E(e1, 1); U4_E(e2, 2); U4_E(eA, 3);
          U4_H(hh0, hl0, 0); U4_ROWS(R0, e0); U4_H(hh1, hl1, 1); U4_ROWS(R1, e1); U4_H(hh2, hl2, 2); U4_ROWS(R2, e2); }
        for (int u = 0; u < ntok; u += 4) {
            U4_E(eB, u + 4); U4_H(hh3, hl3, u + 3); U4_ROWS(R3, eA); U4_COMPUTE(R0, hh0, hl0, U4_TOK(u));
            if (u + 1 >= ntok) break;
            U4_E(eA, u + 5); U4_H(hh0, hl0, u + 4); U4_ROWS(R0, eB); U4_COMPUTE(R1, hh1, hl1, U4_TOK(u + 1));
            if (u + 2 >= ntok) break;
            U4_E(eB, u + 6); U4_H(hh1, hl1, u + 5); U4_ROWS(R1, eA); U4_COMPUTE(R2, hh2, hl2, U4_TOK(u + 2));
            if (u + 3 >= ntok) break;
            U4_E(eA, u + 7); U4_H(hh2, hl2, u + 6); U4_ROWS(R2, eB); U4_COMPUTE(R3, hh3, hl3, U4_TOK(u + 3));
        }
#undef U4_TOK
#undef U4_E
#undef U4_H
#undef U4_ROWS
#undef U4_COMPUTE
    }
}
typedef long i64_t;
typedef int v2i_t __attribute__((ext_vector_type(2)));
__device__ __forceinline__ i64_t ds_tr8(const LAS unsigned char* p) { const v2i_t r = __builtin_amdgcn_ds_read_tr8_b64_v2i32((LAS v2i_t*)p); return (i64_t)(unsigned)r.x | ((i64_t)(unsigned)r.y << 32); }
__device__ __forceinline__ void vpass_mfma(const Args& a, LAS unsigned char* lds, int wave, int lane_in) {
    int lane = lane_in; asm volatile("" : "+v"(lane));
    const int G = gridDim.x, bx = blockIdx.x;
    const bool sliced = (G % 8) == 0;
    const int nj = sliced ? 1 : 8, j0 = sliced ? (bx & 7) : 0;
    const int first = sliced ? ((bx >> 3) * NWAVES + wave) : (bx * NWAVES + wave), stride = sliced ? (G >> 3) * NWAVES : G * NWAVES;
    const int r = lane >> 2, p4 = lane & 3, n16 = lane & 15, qp = lane >> 4;
    const unsigned short* E = (const unsigned short*)(a.ws + WS_E); const unsigned char* W8 = a.ws + WS_W; const float* MOD = (const float*)(a.ws + WS_MOD);
    LAS unsigned char* slot = lds + wave * 16384;
    const int ntok = (M - first + stride - 1) / stride;
    const int eoff = (r >> 1) * 16 + 8 * (r & 1);
    const int wbase = (8 * r) * 128, hk = (r >> 2) & 1;
    const int rkey = (n16 >> 1) ^ (qp & 1), rbase = (32 * qp + (n16 >> 1)) * 128 + 8 * (n16 & 1);
    const bool even = (n16 & 1) == 0; const int ccol = 32 * qp + (even ? n16 : 15 + n16);
    for (int jj = 0; jj < nj; ++jj) { const int j = j0 + jj;
        const unsigned char* tb = a.ws + WS_VB + (size_t)j * (16384 * 128);
        const unsigned poff = 32u * p4;
        v4u RA[16], RB[16], wA, wB, en, en2;
#define VM_ROWS(R, ev) do { const unsigned w_[4] = {ev.x, ev.y, ev.z, ev.w}; _Pragma("unroll") for (int c_ = 0; c_ < 4; ++c_) { \
            const unsigned char* r0_ = tb + ((w_[c_] & 0xffffu) * 128u + poff); const unsigned char* r1_ = tb + ((w_[c_] >> 16) * 128u + poff); \
            R[4 * c_] = *(const v4u*)r0_; R[4 * c_ + 1] = *(const v4u*)(r0_ + 16); R[4 * c_ + 2] = *(const v4u*)r1_; R[4 * c_ + 3] = *(const v4u*)(r1_ + 16); } } while (0)
#define VM_W(wv, t) do { wv = *(const v4u*)(W8 + (size_t)(t) * 128 + 32 * qp + 16 * (n16 & 1)); } while (0)
#define VM_COMPUTE(R, wv, t) do { \
        _Pragma("unroll") for (int i_ = 0; i_ < 8; ++i_) { const int k_ = (i_ & 7) ^ hk; *(LAS v4u*)(slot + wbase + i_ * 128 + 16 * ((2 * p4) ^ k_)) = R[2 * i_]; *(LAS v4u*)(slot + wbase + i_ * 128 + 16 * ((2 * p4 + 1) ^ k_)) = R[2 * i_ + 1]; } \
        unsigned wq_[8]; { const unsigned o0_ = (unsigned)__builtin_amdgcn_update_dpp(0, (int)wv.x, 0xB1, 0xF, 0xF, false), o1_ = (unsigned)__builtin_amdgcn_update_dpp(0, (int)wv.y, 0xB1, 0xF, 0xF, false), \
              o2_ = (unsigned)__builtin_amdgcn_update_dpp(0, (int)wv.z, 0xB1, 0xF, 0xF, false), o3_ = (unsigned)__builtin_amdgcn_update_dpp(0, (int)wv.w, 0xB1, 0xF, 0xF, false); \
          wq_[0] = even ? wv.x : o0_; wq_[1] = even ? wv.y : o1_; wq_[2] = even ? wv.z : o2_; wq_[3] = even ? wv.w : o3_; wq_[4] = even ? o0_ : wv.x; wq_[5] = even ? o1_ : wv.y; wq_[6] = even ? o2_ : wv.z; wq_[7] = even ? o3_ : wv.w; } \
        f32x4 acc_[8]; _Pragma("unroll") for (int nt_ = 0; nt_ < 8; ++nt_) acc_[nt_] = (f32x4){0.f, 0.f, 0.f, 0.f}; \
        _Pragma("unroll") for (int ks_ = 0; ks_ < 4; ++ks_) { const i64_t aw_ = (i64_t)wq_[2 * ks_] | ((i64_t)wq_[2 * ks_ + 1] << 32); \
            _Pragma("unroll") for (int nt_ = 0; nt_ < 8; ++nt_) { const i64_t bv_ = ds_tr8(slot + rbase + ks_ * 1024 + 16 * (nt_ ^ rkey)); acc_[nt_] = __builtin_amdgcn_mfma_f32_16x16x32_fp8_fp8(aw_, bv_, acc_[nt_], 0, 0, 0); } } \
        const float e01_ = (qp & 1) ? acc_[2][0] : acc_[0][0], e23_ = (qp & 1) ? acc_[6][0] : acc_[4][0], o01_ = (qp & 1) ? acc_[3][0] : acc_[1][0], o23_ = (qp & 1) ? acc_[7][0] : acc_[5][0]; \
        const float se_ = (qp & 2) ? e23_ : e01_, so_ = (qp & 2) ? o23_ : o01_; \
        const float mine_ = even ? se_ : so_, send_ = even ? so_ : se_; \
        const float recv_ = __builtin_bit_cast(float, __builtin_amdgcn_update_dpp(0, __builtin_bit_cast(int, send_), 0xB1, 0xF, 0xF, false)); \
        const float lo_ = even ? mine_ : recv_, hi_ = even ? recv_ : mine_; \
        bf16* xo_ = (bf16*)(a.ws + WS_X1B) + (size_t)(t) * 1024 + 128 * j + ccol; const float* gt_ = MOD + ((size_t)(t) >> 13) * NMODC + 5120 + 128 * j + ccol; \
        const unsigned xb_ = *(const unsigned*)xo_; const f32x2_t g_ = *(const f32x2_t*)gt_; \
        *(unsigned*)xo_ = pk2(bflo(xb_) + g_.x * lo_ * (1.0f / 4096.0f), bfhi(xb_) + g_.y * hi_ * (1.0f / 4096.0f)); } while (0)
#define VM_TOK(u_) ((size_t)first + (size_t)((u_) < ntok ? (u_) : ntok - 1) * stride)
        { v4u e0 = *(const v4u*)(E + VM_TOK(0) * 128 + eoff); VM_ROWS(RA, e0); VM_W(wA, VM_TOK(0)); en = *(const v4u*)(E + VM_TOK(1) * 128 + eoff); }
        for (int u = 0; u < ntok; u += 2) {
            { en2 = *(const v4u*)(E + VM_TOK(u + 2) * 128 + eoff); VM_W(wB, VM_TOK(u + 1)); VM_ROWS(RB, en); VM_COMPUTE(RA, wA, VM_TOK(u)); }
            if (u + 1 >= ntok) break;
            { en = *(const v4u*)(E + VM_TOK(u + 3) * 128 + eoff); VM_W(wA, VM_TOK(u + 2)); VM_ROWS(RA, en2); VM_COMPUTE(RB, wB, VM_TOK(u + 1)); }
        }
#undef VM_ROWS
#undef VM_COMPUTE
#undef VM_W
#undef VM_TOK
    }
}
typedef int v8i_t __attribute__((ext_vector_type(8)));
__device__ __forceinline__ v2i_t ds_tr4(const LAS unsigned char* p) { return __builtin_amdgcn_ds_read_tr4_b64_v2i32((LAS v2i_t*)p); }
__device__ __forceinline__ void vpass_mfma4(const Args& a, LAS unsigned char* lds, int wave, int lane_in) {
    int lane = lane_in; asm volatile("" : "+v"(lane));
    const int G = gridDim.x, bx = blockIdx.x;
    const bool sliced = (G % 8) == 0;
    const int nj = sliced ? 1 : 8, j0 = sliced ? (bx & 7) : 0;
    const int first = sliced ? ((bx >> 3) * NWAVES + wave) : (bx * NWAVES + wave), stride = sliced ? (G >> 3) * NWAVES : G * NWAVES;
    const int r = lane >> 2, p4 = lane & 3, n16 = lane & 15, qp = lane >> 4;
    const unsigned short* E = (const unsigned short*)(a.ws + WS_E); const unsigned char* W8 = a.ws + WS_W; const float* MOD = (const float*)(a.ws + WS_MOD);
    LAS unsigned char* slot = lds + wave * 8192;
    const int ntok = (M - first + stride - 1) / stride;
    const int eoff = 8 * r;
    const int wbase = (8 * r) * 64;
    const int rkey = (n16 >> 2) & 3, rbase = (32 * qp + n16) * 64;
    const bool even = (n16 & 1) == 0; const int ccol = 32 * qp + (even ? n16 : 15 + n16);
    for (int jj = 0; jj < nj; ++jj) { const int j = j0 + jj;
        const unsigned char* tb = a.ws + WS_VB + (size_t)j * (16384 * 64);
        const unsigned poff = 16u * p4;
        v4u R0[8], R1[8], R2[8], R3[8], w0, w1, w2, w3, eA, eB;
#define V4_ROWS(R, ev) do { const unsigned w_[4] = {ev.x, ev.y, ev.z, ev.w}; _Pragma("unroll") for (int c_ = 0; c_ < 4; ++c_) { R[2 * c_] = *(const v4u*)(tb + ((w_[c_] & 0xffffu) * 64u + poff)); R[2 * c_ + 1] = *(const v4u*)(tb + ((w_[c_] >> 16) * 64u + poff)); } } while (0)
#define V4_TOK(u_) ((size_t)first + (size_t)((u_) < ntok ? (u_) : ntok - 1) * stride)
#define V4_E(ev, u_) do { ev = *(const v4u*)(E + V4_TOK(u_) * 128 + eoff); } while (0)
#define V4_W(wv, u_) do { wv = *(const v4u*)(W8 + V4_TOK(u_) * 128 + 16 * qp + 64 * (n16 & 1)); } while (0)
#define V4_COMPUTE(R, wv, t) do { \
        _Pragma("unroll") for (int i_ = 0; i_ < 8; ++i_) *(LAS v4u*)(slot + wbase + i_ * 64 + 16 * (p4 ^ ((2 * r + (i_ >> 2)) & 3))) = R[i_]; \
        v8i_t aw_; { const int o0_ = __builtin_amdgcn_update_dpp(0, (int)wv.x, 0xB1, 0xF, 0xF, false), o1_ = __builtin_amdgcn_update_dpp(0, (int)wv.y, 0xB1, 0xF, 0xF, false), \
              o2_ = __builtin_amdgcn_update_dpp(0, (int)wv.z, 0xB1, 0xF, 0xF, false), o3_ = __builtin_amdgcn_update_dpp(0, (int)wv.w, 0xB1, 0xF, 0xF, false); \
          aw_[0] = even ? (int)wv.x : o0_; aw_[1] = even ? (int)wv.y : o1_; aw_[2] = even ? (int)wv.z : o2_; aw_[3] = even ? (int)wv.w : o3_; \
          aw_[4] = even ? o0_ : (int)wv.x; aw_[5] = even ? o1_ : (int)wv.y; aw_[6] = even ? o2_ : (int)wv.z; aw_[7] = even ? o3_ : (int)wv.w; } \
        f32x4 acc_[8]; \
        _Pragma("unroll") for (int nt_ = 0; nt_ < 8; ++nt_) { const LAS unsigned char* rp_ = slot + rbase + 16 * ((nt_ >> 1) ^ rkey) + 8 * (nt_ & 1); \
            const v2i_t b0_ = ds_tr4(rp_), b1_ = ds_tr4(rp_ + 16 * 64); const v8i_t bv_ = {b0_.x, b0_.y, b1_.x, b1_.y, 0, 0, 0, 0}; \
            acc_[nt_] = __builtin_amdgcn_mfma_scale_f32_16x16x128_f8f6f4(aw_, bv_, (f32x4){0.f, 0.f, 0.f, 0.f}, 0, 4, 0, 0, 0, 0); } \
        const float e01_ = (qp & 1) ? acc_[2][0] : acc_[0][0], e23_ = (qp & 1) ? acc_[6][0] : acc_[4][0], o01_ = (qp & 1) ? acc_[3][0] : acc_[1][0], o23_ = (qp & 1) ? acc_[7][0] : acc_[5][0]; \
        const float se_ = (qp & 2) ? e23_ : e01_, so_ = (qp & 2) ? o23_ : o01_; \
        const float mine_ = even ? se_ : so_, send_ = even ? so_ : se_; \
        const float recv_ = __builtin_bit_cast(float, __builtin_amdgcn_update_dpp(0, __builtin_bit_cast(int, send_), 0xB1, 0xF, 0xF, false)); \
        const float lo_ = even ? mine_ : recv_, hi_ = even ? recv_ : mine_; \
        bf16* xo_ = (bf16*)(a.ws + WS_X1B) + (size_t)(t) * 1024 + 128 * j + ccol; const float* gt_ = MOD + ((size_t)(t) >> 13) * NMODC + 5120 + 128 * j + ccol; \
        const unsigned xb_ = *(const unsigned*)xo_; const f32x2_t g_ = *(const f32x2_t*)gt_; \
        *(unsigned*)xo_ = pk2(bflo(xb_) + g_.x * lo_ * (1.0f / 256.0f), bfhi(xb_) + g_.y * hi_ * (1.0f / 256.0f)); } while (0)
        { v4u e0, e1, e2; V4_E(e0, 0); V4_E(e1, 1); V4_E(e2, 2); V4_E(eA, 3);
          V4_W(w0, 0); V4_ROWS(R0, e0); V4_W(w1, 1); V4_ROWS(R1, e1); V4_W(w2, 2); V4_ROWS(R2, e2); }
        for (int u = 0; u < ntok; u += 4) {
            V4_E(eB, u + 4); V4_W(w3, u + 3); V4_ROWS(R3, eA); V4_COMPUTE(R0, w0, V4_TOK(u));
            if (u + 1 >= ntok) break;
            V4_E(eA, u + 5); V4_W(w0, u + 4); V4_ROWS(R0, eB); V4_COMPUTE(R1, w1, V4_TOK(u + 1));
            if (u + 2 >= ntok) break;
            V4_E(eB, u + 6); V4_W(w1, u + 5); V4_ROWS(R1, eA); V4_COMPUTE(R2, w2, V4_TOK(u + 2));
            if (u + 3 >= ntok) break;
            V4_E(eA, u + 7); V4_W(w2, u + 6); V4_ROWS(R2, eB); V4_COMPUTE(R3, w3, V4_TOK(u + 3));
        }
#undef V4_ROWS
#undef V4_TOK
#undef V4_E
#undef V4_W
#undef V4_COMPUTE
    }
}
__device__ __forceinline__ void vpass_wide(const Args& a, LAS unsigned char* lds, int wave, int lane_in, size_t xdst_off = WS_X1B) {
    int lane = lane_in; asm volatile("" : "+v"(lane));
    const int G = gridDim.x, bx = blockIdx.x;
    const bool sliced = (G % 8) == 0;
    const int nj = sliced ? 1 : 4, j0 = sliced ? ((bx & 7) >> 1) : 0;
    const int tmul = sliced ? 2 : 1, tadd = sliced ? (bx & 1) : 0;
    const int first = sliced ? ((bx >> 3) * NWAVES + wave) : (bx * NWAVES + wave), stride = sliced ? (G >> 3) * NWAVES : G * NWAVES;
    const int ntok = ((sliced ? M / 2 : M) - first + stride - 1) / stride;
    const int r8 = lane >> 3, p8 = lane & 7, n16 = lane & 15, qp = lane >> 4;
    const unsigned short* E = (const unsigned short*)(a.ws + WS_E); const unsigned char* W8 = a.ws + WS_W; const float* MOD = (const float*)(a.ws + WS_MOD);
    LAS unsigned char* slot = lds + wave * 16384;
    const int eoff = 16 * r8;
    const int wbase = (16 * r8) * 128;
    const int rkey = (n16 >> 1) & 7, rbase = (32 * qp + n16) * 128;
    const int kbw = ((r8 >> 1) ^ r8) & 1, qb = qp & 1;
    const bool even = (n16 & 1) == 0;
    const bool b0q = (n16 & 1) != 0, b1q = (n16 & 2) != 0;
    const int ccol = 16 * (4 * qp + (n16 & 3)) + (n16 & ~3);
    for (int jj = 0; jj < nj; ++jj) { const int j = j0 + jj;
        const unsigned char* tb = a.ws + WS_VB + (size_t)j * (16384 * 128);
        const unsigned poff = 16u * p8;
        v4u RA[16], RB[16], wA, wB, en, en2, fn, fn2; f32x4 gg = {0.f, 0.f, 0.f, 0.f}; int gbatch = -1;
#define VW_TOK(u_) ((size_t)tmul * ((size_t)first + (size_t)((u_) < ntok ? (u_) : ntok - 1) * stride) + tadd)
#define VW_ROWS(R, ev, fv) do { const unsigned w_[8] = {ev.x, ev.y, ev.z, ev.w, fv.x, fv.y, fv.z, fv.w}; _Pragma("unroll") for (int c_ = 0; c_ < 8; ++c_) { \
            R[2 * c_] = *(const v4u*)(tb + ((w_[c_] & 0xffffu) * 128u + poff)); R[2 * c_ + 1] = *(const v4u*)(tb + ((w_[c_] >> 16) * 128u + poff)); } } while (0)
#define VW_W(wv, u_) do { wv = *(const v4u*)(W8 + VW_TOK(u_) * 128 + 16 * qp + 64 * (n16 & 1)); } while (0)
#define VW_COMPUTE(R, wv, t) do { \
        _Pragma("unroll") for (int i_ = 0; i_ < 16; ++i_) { LAS unsigned char* wp_ = slot + wbase + i_ * 128 + 16 * (p8 ^ ((i_ >> 1) & 7)); *(LAS v2u*)(wp_ + 8 * kbw) = (v2u){R[i_].x, R[i_].y}; *(LAS v2u*)(wp_ + 8 - 8 * kbw) = (v2u){R[i_].z, R[i_].w}; } \
        v8i_t aw_; { const int o0_ = __builtin_amdgcn_update_dpp(0, (int)wv.x, 0xB1, 0xF, 0xF, false), o1_ = __builtin_amdgcn_update_dpp(0, (int)wv.y, 0xB1, 0xF, 0xF, false), \
              o2_ = __builtin_amdgcn_update_dpp(0, (int)wv.z, 0xB1, 0xF, 0xF, false), o3_ = __builtin_amdgcn_update_dpp(0, (int)wv.w, 0xB1, 0xF, 0xF, false); \
          aw_[0] = even ? (int)wv.x : o0_; aw_[1] = even ? (int)wv.y : o1_; aw_[2] = even ? (int)wv.z : o2_; aw_[3] = even ? (int)wv.w : o3_; \
          aw_[4] = even ? o0_ : (int)wv.x; aw_[5] = even ? o1_ : (int)wv.y; aw_[6] = even ? o2_ : (int)wv.z; aw_[7] = even ? o3_ : (int)wv.w; } \
        float tv_[16]; \
        _Pragma("unroll") for (int nt_ = 0; nt_ < 16; ++nt_) { const LAS unsigned char* rp_ = slot + rbase + 16 * ((nt_ >> 1) ^ rkey); const int h0_ = 8 * ((nt_ & 1) ^ qb); \
            const v2i_t b0_ = ds_tr4(rp_ + h0_), b1_ = ds_tr4(rp_ + 16 * 128 + 8 - h0_); const v8i_t bv_ = {b0_.x, b0_.y, b1_.x, b1_.y, 0, 0, 0, 0}; \
            const f32x4 c_ = __builtin_amdgcn_mfma_scale_f32_16x16x128_f8f6f4(aw_, bv_, (f32x4){0.f, 0.f, 0.f, 0.f}, 0, 4, 0, 0, 0, 0); tv_[nt_] = c_[0]; } \
          \
        float t0_ = (qp & 1) ? tv_[4] : tv_[0], t1_ = (qp & 1) ? tv_[5] : tv_[1], t2_ = (qp & 1) ? tv_[6] : tv_[2], t3_ = (qp & 1) ? tv_[7] : tv_[3]; \
        { const float u0_ = (qp & 1) ? tv_[12] : tv_[8], u1_ = (qp & 1) ? tv_[13] : tv_[9], u2_ = (qp & 1) ? tv_[14] : tv_[10], u3_ = (qp & 1) ? tv_[15] : tv_[11]; \
          t0_ = (qp & 2) ? u0_ : t0_; t1_ = (qp & 2) ? u1_ : t1_; t2_ = (qp & 2) ? u2_ : t2_; t3_ = (qp & 2) ? u3_ : t3_; } \
          \
        { const float sa_ = b0q ? t0_ : t1_, sb_ = b0q ? t2_ : t3_; \
          const float ra_ = __builtin_bit_cast(float, __builtin_amdgcn_update_dpp(0, __builtin_bit_cast(int, sa_), 0xB1, 0xF, 0xF, false)), rb_ = __builtin_bit_cast(float, __builtin_amdgcn_update_dpp(0, __builtin_bit_cast(int, sb_), 0xB1, 0xF, 0xF, false)); \
          t0_ = b0q ? ra_ : t0_; t1_ = b0q ? t1_ : ra_; t2_ = b0q ? rb_ : t2_; t3_ = b0q ? t3_ : rb_; } \
        { const float sa_ = b1q ? t0_ : t2_, sb_ = b1q ? t1_ : t3_; \
          const float ra_ = __builtin_bit_cast(float, __builtin_amdgcn_update_dpp(0, __builtin_bit_cast(int, sa_), 0x4E, 0xF, 0xF, false)), rb_ = __builtin_bit_cast(float, __builtin_amdgcn_update_dpp(0, __builtin_bit_cast(int, sb_), 0x4E, 0xF, 0xF, false)); \
          t0_ = b1q ? ra_ : t0_; t2_ = b1q ? t2_ : ra_; t1_ = b1q ? rb_ : t1_; t3_ = b1q ? t3_ : rb_; } \
        { const int bt_ = (int)((size_t)(t) >> 13); if (bt_ != gbatch) { gbatch = bt_; gg = *(const f32x4*)(MOD + (size_t)bt_ * NMODC + 5120 + 256 * j + ccol) * (1.0f / 256.0f); } } \
        bf16* xo_ = (bf16*)(a.ws + xdst_off) + (size_t)(t) * 1024 + 256 * j + ccol; const bf16* xi_ = (const bf16*)(a.ws + WS_X1B) + (size_t)(t) * 1024 + 256 * j + ccol; \
        const v2u xv_ = *(const v2u*)xi_; \
        *(v2u*)xo_ = (v2u){pk2(bflo(xv_.x) + gg.x * t0_, bfhi(xv_.x) + gg.y * t1_), pk2(bflo(xv_.y) + gg.z * t2_, bfhi(xv_.y) + gg.w * t3_)}; } while (0)
        { const v4u e0 = *(const v4u*)(E + VW_TOK(0) * 128 + eoff), f0 = *(const v4u*)(E + VW_TOK(0) * 128 + eoff + 8); VW_W(wA, 0); VW_ROWS(RA, e0, f0); en = *(const v4u*)(E + VW_TOK(1) * 128 + eoff); fn = *(const v4u*)(E + VW_TOK(1) * 128 + eoff + 8); }
        for (int u = 0; u < ntok; u += 2) {
            { en2 = *(const v4u*)(E + VW_TOK(u + 2) * 128 + eoff); fn2 = *(const v4u*)(E + VW_TOK(u + 2) * 128 + eoff + 8); VW_W(wB, u + 1); VW_ROWS(RB, en, fn); VW_COMPUTE(RA, wA, VW_TOK(u)); }
            if (u + 1 >= ntok) break;
            { en = *(const v4u*)(E + VW_TOK(u + 3) * 128 + eoff); fn = *(const v4u*)(E + VW_TOK(u + 3) * 128 + eoff + 8); VW_W(wA, u + 2); VW_ROWS(RA, en2, fn2); VW_COMPUTE(RB, wB, VW_TOK(u + 1)); }
        }
#undef VW_TOK
#undef VW_ROWS
#undef VW_W
#undef VW_COMPUTE
    }
}
__device__ __forceinline__ void upass_wide(const Args& a, LAS unsigned char* lds, int wave, int lane_in) {
    int lane = lane_in; asm volatile("" : "+v"(lane));
    const int G = gridDim.x, bx = blockIdx.x;
    const bool sliced = (G % 8) == 0;
    const int nj = sliced ? 1 : 4, j0 = sliced ? ((bx & 7) >> 1) : 0;
    const int tmul = sliced ? 2 : 1, tadd = sliced ? (bx & 1) : 0;
    const int first = sliced ? ((bx >> 3) * NWAVES + wave) : (bx * NWAVES + wave), stride = sliced ? (G >> 3) * NWAVES : G * NWAVES;
    const int ntok = ((sliced ? M / 2 : M) - first + stride - 1) / stride;
    const int r8 = lane >> 3, p8 = lane & 7, n16 = lane & 15, qp = lane >> 4;
    const unsigned short* E = (const unsigned short*)(a.ws + WS_E); const unsigned char* H8 = a.ws + WS_H2Q; bf16* PA = (bf16*)(a.ws + WS_PA);
    LAS unsigned char* slot = lds + wave * 16384;
    const int eoff = 16 * r8, wbase = (16 * r8) * 128;
    const int akey = (n16 >> 1) & 7, abase = n16 * 128;
    const bool even = (n16 & 1) == 0;
    for (int jj = 0; jj < nj; ++jj) { const int j = j0 + jj;
        const unsigned char* tb = a.ws + WS_UB + (size_t)j * (16384 * 128);
        const unsigned poff = 16u * p8;
        v4u RA[16], RB[16], haA, hbA, haB, hbB, en, en2, fn, fn2;
#define UW_TOK(u_) ((size_t)tmul * ((size_t)first + (size_t)((u_) < ntok ? (u_) : ntok - 1) * stride) + tadd)
#define UW_ROWS(R, ev, fv) do { const unsigned w_[8] = {ev.x, ev.y, ev.z, ev.w, fv.x, fv.y, fv.z, fv.w}; _Pragma("unroll") for (int c_ = 0; c_ < 8; ++c_) { \
            R[2 * c_] = *(const v4u*)(tb + ((w_[c_] & 0xffffu) * 128u + poff)); R[2 * c_ + 1] = *(const v4u*)(tb + ((w_[c_] >> 16) * 128u + poff)); } } while (0)
#define UW_H(ha, hb, u_) do { const unsigned char* hp_ = H8 + UW_TOK(u_) * 1024 + 256 * j + 16 * qp + 128 * (n16 & 1); ha = *(const v4u*)hp_; hb = *(const v4u*)(hp_ + 64); } while (0)
#define UW_COMPUTE(R, ha, hb, t) do { \
        _Pragma("unroll") for (int i_ = 0; i_ < 16; ++i_) { *(LAS v4u*)(slot + wbase + i_ * 128 + 16 * (p8 ^ ((i_ >> 1) & 7))) = R[i_]; } \
        v8i_t bh0_, bh1_; { const int mine_[8] = {(int)ha.x, (int)ha.y, (int)ha.z, (int)ha.w, (int)hb.x, (int)hb.y, (int)hb.z, (int)hb.w}; \
          _Pragma("unroll") for (int d_ = 0; d_ < 8; ++d_) { const int o_ = __builtin_amdgcn_update_dpp(0, mine_[d_], 0xB1, 0xF, 0xF, false); bh0_[d_] = even ? mine_[d_] : o_; bh1_[d_] = even ? o_ : mine_[d_]; } } \
        f32x4 acc_[8]; \
        _Pragma("unroll") for (int mb_ = 0; mb_ < 8; ++mb_) { \
            const v4u a0_ = *(const LAS v4u*)(slot + mb_ * 2048 + abase + 16 * (qp ^ akey)), a1_ = *(const LAS v4u*)(slot + mb_ * 2048 + abase + 16 * ((4 + qp) ^ akey)); \
            const v8i_t av0_ = {(int)a0_.x, (int)a0_.y, (int)a0_.z, (int)a0_.w, 0, 0, 0, 0}, av1_ = {(int)a1_.x, (int)a1_.y, (int)a1_.z, (int)a1_.w, 0, 0, 0, 0}; \
            f32x4 c_ = __builtin_amdgcn_mfma_scale_f32_16x16x128_f8f6f4(av0_, bh0_, (f32x4){0.f, 0.f, 0.f, 0.f}, 4, 0, 0, 0, 0, 0); \
            acc_[mb_] = __builtin_amdgcn_mfma_scale_f32_16x16x128_f8f6f4(av1_, bh1_, c_, 4, 0, 0, 0, 0, 0); } \
        const f32x4 s01_ = (n16 & 1) ? acc_[1] : acc_[0], s23_ = (n16 & 1) ? acc_[3] : acc_[2], s45_ = (n16 & 1) ? acc_[5] : acc_[4], s67_ = (n16 & 1) ? acc_[7] : acc_[6]; \
        const f32x4 s03_ = (n16 & 2) ? s23_ : s01_, s47_ = (n16 & 2) ? s67_ : s45_; const f32x4 sel_ = (n16 & 4) ? s47_ : s03_; \
        if (n16 < 8) *(v2u*)(PA + ((size_t)j * M + (t)) * 128 + n16 * 16 + 4 * qp) = (v2u){pg8::cvt_pk_bf16(sel_[0], sel_[1]), pg8::cvt_pk_bf16(sel_[2], sel_[3])}; } while (0)
        { const v4u e0 = *(const v4u*)(E + UW_TOK(0) * 128 + eoff), f0 = *(const v4u*)(E + UW_TOK(0) * 128 + eoff + 8); UW_ROWS(RA, e0, f0); UW_H(haA, hbA, 0); en = *(const v4u*)(E + UW_TOK(1) * 128 + eoff); fn = *(const v4u*)(E + UW_TOK(1) * 128 + eoff + 8); }
        for (int u = 0; u < ntok; u += 2) {
            { en2 = *(const v4u*)(E + UW_TOK(u + 2) * 128 + eoff); fn2 = *(const v4u*)(E + UW_TOK(u + 2) * 128 + eoff + 8); UW_H(haB, hbB, u + 1); UW_ROWS(RB, en, fn); UW_COMPUTE(RA, haA, hbA, UW_TOK(u)); }
            if (u + 1 >= ntok) break;
            { en = *(const v4u*)(E + UW_TOK(u + 3) * 128 + eoff); fn = *(const v4u*)(E + UW_TOK(u + 3) * 128 + eoff + 8); UW_H(haA, hbA, u + 2); UW_ROWS(RA, en2, fn2); UW_COMPUTE(RB, haB, hbB, UW_TOK(u + 1)); }
        }
#undef UW_TOK
#undef UW_ROWS
#undef UW_H
#undef UW_COMPUTE
    }
}
__device__ __forceinline__ void peer_reduce(const Args& a, LAS unsigned char* lds, int tid) {
    const unsigned short* E = (const unsigned short*)(a.ws + WS_E); const float* Gt = (const float*)(a.ws + WS_G); unsigned char* W = a.ws + WS_W; const bf16* PA = (const bf16*)(a.ws + WS_PA);
    const float* SU = (const float*)(a.ws + WS_SU); const float* SV = (const float*)(a.ws + WS_SV); const float* SH = (const float*)(a.ws + WS_SH);
    __syncthreads();
    for (int i = tid; i < 16384 / 4; i += 512) { const f32x4 u4 = *(const f32x4*)(SU + 4 * i), v4 = *(const f32x4*)(SV + 4 * i);
        *(LAS f32x4*)(lds + 32 * i) = (f32x4){u4.x, v4.x, u4.y, v4.y}; *(LAS f32x4*)(lds + 32 * i + 16) = (f32x4){u4.z, v4.z, u4.w, v4.w}; }
    __syncthreads();
    const size_t n4 = (size_t)M * 128 / 4, gth = (size_t)gridDim.x * 512;
    for (size_t i = (size_t)blockIdx.x * 512 + tid; i < n4; i += gth) {
        f32x4 s = {0.f, 0.f, 0.f, 0.f};
#pragma unroll
        for (int j = 0; j < 4; ++j) { const v2u pq = __builtin_nontemporal_load((const v2u*)(PA + (size_t)j * M * 128 + i * 4)); s += (f32x4){bflo(pq.x), bfhi(pq.x), bflo(pq.y), bfhi(pq.y)}; }
        const float sh = SH[i >> 5];
        const v2u ep = *(const v2u*)(E + i * 4); const f32x4 g = *(const f32x4*)(Gt + i * 4); f32x4 w;
        const f2_t t0 = *(const LAS f2_t*)(lds + 8 * (ep.x & 0xffffu)), t1 = *(const LAS f2_t*)(lds + 8 * (ep.x >> 16)), t2 = *(const LAS f2_t*)(lds + 8 * (ep.y & 0xffffu)), t3 = *(const LAS f2_t*)(lds + 8 * (ep.y >> 16));
        w.x = g.x * gelu_t(s.x * sh * t0.x) * t0.y; w.y = g.y * gelu_t(s.y * sh * t1.x) * t1.y; w.z = g.z * gelu_t(s.z * sh * t2.x) * t2.y; w.w = g.w * gelu_t(s.w * sh * t3.x) * t3.y;
        { const f32x4 ws_ = w * 256.0f; int pk = 0;
          pk = __builtin_amdgcn_cvt_pk_fp8_f32(fminf(fmaxf(ws_.x, -440.f), 440.f), fminf(fmaxf(ws_.y, -440.f), 440.f), pk, false);
          pk = __builtin_amdgcn_cvt_pk_fp8_f32(fminf(fmaxf(ws_.z, -440.f), 440.f), fminf(fmaxf(ws_.w, -440.f), 440.f), pk, true);
          *(unsigned*)(W + i * 4) = (unsigned)pk; } }
}
__device__ __forceinline__ void final_norm(const Args& a, int wave, int lane) {
    const float* gf = a.in[I_GFIN]; const bf16* X2 = (const bf16*)(a.ws + WS_X1B);
    f32x4 g[4];
#pragma unroll
    for (int q = 0; q < 2; ++q) { g[2 * q] = *(const f32x4*)(gf + 512 * q + 8 * lane); g[2 * q + 1] = *(const f32x4*)(gf + 512 * q + 8 * lane + 4); }
    for (size_t row = (size_t)blockIdx.x * NWAVES + wave; row < (size_t)M; row += (size_t)gridDim.x * NWAVES) {
        f32x4 x[4]; float ss = 0.f;
#pragma unroll
        for (int q = 0; q < 2; ++q) { const v4u r = __builtin_nontemporal_load((const v4u*)(X2 + row * 1024 + 512 * q + 8 * lane)); x[2 * q] = (f32x4){bflo(r.x), bfhi(r.x), bflo(r.y), bfhi(r.y)}; x[2 * q + 1] = (f32x4){bflo(r.z), bfhi(r.z), bflo(r.w), bfhi(r.w)}; }
#pragma unroll
        for (int i = 0; i < 4; ++i) ss += (x[i].x * x[i].x + x[i].y * x[i].y) + (x[i].z * x[i].z + x[i].w * x[i].w);
        const float rstd = 1.0f / sqrtf(wave_sum(ss) * (1.0f / 1024.0f) + EPS);
#pragma unroll
        for (int q = 0; q < 2; ++q) { float* o = a.out + row * 1024 + 512 * q + 8 * lane; __builtin_nontemporal_store(x[2 * q] * rstd * g[2 * q], (f32x4*)(o)); __builtin_nontemporal_store(x[2 * q + 1] * rstd * g[2 * q + 1], (f32x4*)(o + 4)); } }
}
__device__ __forceinline__ void phase_topk(const Args& a, LAS unsigned char* lds, int wave, int lane) {
    const bf16* Q = (const bf16*)(a.ws + WS_ZG); const bf16* KEYS = (const bf16*)(a.ws + WS_KEYS);
    const int G = gridDim.x, gw = blockIdx.x * NWAVES + wave, NGW = G * NWAVES;
    for (int grp = gw; grp < M / 32; grp += NGW) peer_topk32(Q, KEYS, (unsigned short*)(a.ws + WS_E), (float*)(a.ws + WS_G), lds + wave * 4096, grp * 32, lane);
}
#define XB_TMO      128
#define XB_XCNT(j)  (256  + 64 * (j))
#define XB_XSUB(j)  (1280 + 64 * (j))
#define XB_XGEN(j)  (2304 + 64 * (j))
#define XB_TOP      3328
#define XB_TOPGEN   3392
#define XCD_BAR_WORDS 3456
#define XB_SPIN_CAP (1u << 18)

__device__ __forceinline__ unsigned xb_ld(unsigned* p)              { return __hip_atomic_load(p, __ATOMIC_RELAXED, __HIP_MEMORY_SCOPE_AGENT); }
__device__ __forceinline__ unsigned xb_add(unsigned* p, unsigned v) { return __hip_atomic_fetch_add(p, v, __ATOMIC_RELAXED, __HIP_MEMORY_SCOPE_AGENT); }
__device__ __forceinline__ unsigned xb_xcc_id() { return (unsigned)__builtin_amdgcn_s_getreg((3 << 11) | 20) & 0xFu; }
#define XB_SPIN(cond, bar) do { unsigned _sp = 0; while (cond) { __builtin_amdgcn_s_sleep(1); \
    if ((++_sp & 255u) == 0u) { if (xb_ld(&(bar)[XB_TMO])) break; if (_sp > XB_SPIN_CAP) { atomicAdd(&(bar)[XB_TMO], 1u); break; } } } } while (0)

struct XcdBarrier {
    unsigned* bar; unsigned x;
    volatile LAS unsigned* st;
};

__device__ __forceinline__ XcdBarrier xcd_barrier_post(unsigned* bar, volatile LAS unsigned* st) {
    XcdBarrier b; b.bar = bar; b.x = xb_xcc_id(); b.st = st;
    if (threadIdx.x == 0) (void)xb_add(&bar[XB_XCNT(b.x)], 1u);
    return b;
}
__device__ __forceinline__ void xcd_barrier_complete(unsigned* bar, unsigned x, unsigned& nloc, unsigned& nx) {
    const unsigned G = gridDim.x * gridDim.y * gridDim.z;
    unsigned sum, cnt, mine, sp = 0u;
    for (;;) {
        sum = 0u; cnt = 0u; mine = 0u;
#pragma unroll
        for (unsigned j = 0; j < 16; ++j) { const unsigned c = xb_ld(&bar[XB_XCNT(j)]); sum += c; cnt += (c > 0u) ? 1u : 0u; mine = (j == x) ? c : mine; }
        if (sum == G) break;
        __builtin_amdgcn_s_sleep(1);
        if ((++sp & 255u) == 0u) { if (xb_ld(&bar[XB_TMO])) break; if (sp > XB_SPIN_CAP) { atomicAdd(&bar[XB_TMO], 1u); break; } }
    }
    nloc = mine > 0u ? mine : 1u; nx = cnt > 0u ? cnt : 1u;
}

__device__ __forceinline__ void xcd_barrier(const XcdBarrier& b) {
    asm volatile("s_waitcnt vmcnt(0)" ::: "memory");
    __syncthreads();
    if (threadIdx.x == 0) {
        unsigned* bar = b.bar;
        __builtin_amdgcn_s_waitcnt(0);
        unsigned nloc = b.st[0], nx = b.st[1];
        if (nloc == 0u) { xcd_barrier_complete(bar, b.x, nloc, nx); b.st[0] = nloc; b.st[1] = nx; }
        const unsigned old = xb_add(&bar[XB_XSUB(b.x)], 1u);
        const unsigned gen = old / nloc;
        if (old + 1u == (gen + 1u) * nloc) {
            __builtin_amdgcn_fence(__ATOMIC_RELEASE, "agent");
            asm volatile("s_waitcnt vmcnt(0)" ::: "memory");
            const unsigned og = xb_add(&bar[XB_TOP], 1u);
            const unsigned tg = og / nx;
            if (og + 1u == (tg + 1u) * nx) xb_add(&bar[XB_TOPGEN], 1u);
            else XB_SPIN(xb_ld(&bar[XB_TOPGEN]) == tg, bar);
            __builtin_amdgcn_fence(__ATOMIC_ACQUIRE, "agent");
            xb_add(&bar[XB_XGEN(b.x)], 1u);
            asm volatile("s_waitcnt vmcnt(0)" ::: "memory");
        } else {
            XB_SPIN(xb_ld(&bar[XB_XGEN(b.x)]) == gen, bar);
            __builtin_amdgcn_fence(__ATOMIC_ACQUIRE, "agent");
            asm volatile("s_waitcnt vmcnt(0)" ::: "memory");
        }
    }
    __syncthreads();
}
constexpr int N_PHASES = 13;
__global__ void __launch_bounds__(NWAVES * 64, 2) hybrid_fwd(Args a) {
    extern __shared__ __attribute__((aligned(16))) unsigned char lds_raw[];
    LAS unsigned char* lds = (LAS unsigned char*)lds_raw;
    const int tid = threadIdx.x, lane = tid & 63, wave = __builtin_amdgcn_readfirstlane(tid >> 6);
    const int G = gridDim.x, bx = blockIdx.x;
    unsigned char* ws = a.ws;
    const float* MOD = (const float*)(ws + WS_MOD);
    const int lo = a.ph_lo, hi = a.ph_hi;
    if (tid < 16) ((LAS unsigned*)(lds + LDS_MISC_OFF))[tid] = 0u;
    __syncthreads();
    XcdBarrier xbar = xcd_barrier_post((unsigned*)(ws + WS_BAR), (volatile LAS unsigned*)(lds + LDS_MISC_OFF));
#ifndef REP_MASK
#define REP_MASK 0
#endif
#define IN(k) (lo <= (k) && (k) < hi)
#ifndef REPN
#define REPN 1
#endif
#define REPS(k) (1 + REPN * ((REP_MASK >> (k)) & 1))
#define SEAM(k) do { if (IN(k) && IN((k) + 1)) xcd_barrier(xbar); } while (0)
    if (hi > N_PHASES) cg::this_grid().sync();

    if (IN(0)) for (int rep_ = 0; rep_ < REPS(0); ++rep_) { phase_prologue(a, lds, tid, wave, lane); } SEAM(0);
    if (IN(1)) for (int rep_ = 0; rep_ < REPS(1); ++rep_) { phase_norm_mod(a.in[I_X], a.in[I_GMIX], MOD, 0, 1024, (bf16*)(ws + WS_H), wave, lane); } SEAM(1);
    if (IN(2)) for (int rep_ = 0; rep_ < REPS(2); ++rep_) { pg8::Gemm g{(const pg8::bf16_t*)(ws + WS_H), (const pg8::bf16_t*)(ws + WS_WIN), M, INW, DM}; pg8::StaticOrder S; S.init(M, INW, G, bx);
        pg8::EpiIn E{(pg8::bf16_t*)(ws + WS_ZG), (pg8::bf16_t*)(ws + WS_ZS)};
        pg8::gemm_phase<pg8::EpiIn, pg8::StaticOrder, true, true>(lds, g, S, E); } SEAM(2);
    if (IN(3)) for (int rep_ = 0; rep_ < REPS(3); ++rep_) { for (int it = bx; it < 256; it += G) s5_item(a, lds, it, wave, lane);
        for (int it = bx; it < 512; it += G) sgu_item(a, lds, it, wave, lane); } SEAM(3);
    if (IN(4)) for (int rep_ = 0; rep_ < REPS(4); ++rep_) { pg8::Gemm g{(const pg8::bf16_t*)(ws + WS_YS), (const pg8::bf16_t*)(ws + WS_WGLU), M, 512, 512}; pg8::StaticOrder S; S.init(M, 512, G, bx);
        pg8::EpiGlu E{(const pg8::bf16_t*)(ws + WS_YS), a.in[I_BGLU], (pg8::bf16_t*)(ws + WS_Y)};
        pg8::gemm_phase<pg8::EpiGlu, pg8::StaticOrder, true, true>(lds, g, S, E); } SEAM(4);
    if (IN(5)) for (int rep_ = 0; rep_ < REPS(5); ++rep_) { pg8::Gemm g{(const pg8::bf16_t*)(ws + WS_Y), (const pg8::bf16_t*)(ws + WS_WOUT), M, DM, DM}; pg8::StaticOrder S; S.init(M, DM, G, bx);
        pg8::EpiOut E{a.in[I_X], MOD, (pg8::bf16_t*)(ws + WS_X1B)};
        pg8::gemm_phase<pg8::EpiOut, pg8::StaticOrder, true, true>(lds, g, S, E); } SEAM(5);
    if (IN(6)) for (int rep_ = 0; rep_ < REPS(6); ++rep_) { phase_norm_mod_bf((const bf16*)(ws + WS_X1B), a.in[I_GFFN], MOD, 3072, 4096, (bf16*)(ws + WS_H), ws + WS_H2Q, (float*)(ws + WS_SH), wave, lane); } SEAM(6);
    if (IN(7)) for (int rep_ = 0; rep_ < REPS(7); ++rep_) { pg8::Gemm g{(const pg8::bf16_t*)(ws + WS_H), (const pg8::bf16_t*)(ws + WS_WQ), M, DM, DM}; pg8::StaticOrder S; S.init(M, DM, G, bx);
        pg8::EpiPlain E{(pg8::bf16_t*)(ws + WS_ZG), 1024};
        pg8::gemm_phase<pg8::EpiPlain, pg8::StaticOrder, true, true>(lds, g, S, E); } SEAM(7);
    if (IN(8)) for (int rep_ = 0; rep_ < REPS(8); ++rep_) { phase_topk(a, lds, wave, lane); } SEAM(8);
    if (IN(9)) for (int rep_ = 0; rep_ < REPS(9); ++rep_) { upass_wide(a, lds, wave, lane); } SEAM(9);
    if (IN(10)) for (int rep_ = 0; rep_ < REPS(10); ++rep_) { peer_reduce(a, lds, tid); } SEAM(10);
    if (IN(11)) for (int rep_ = 0; rep_ < REPS(11); ++rep_) { vpass_wide(a, lds, wave, lane); } SEAM(11);
    if (IN(12)) for (int rep_ = 0; rep_ < REPS(12); ++rep_) { final_norm(a, wave, lane); }
#undef IN
#undef SEAM
}

extern "C" void kernel_launch(void* const* d_in, const int* in_sizes, int n_in, void* d_out, int out_size, void* d_ws, size_t ws_size, hipStream_t stream) {
    static int grid = 0;
    if (grid == 0) {
        if (n_in != 27 || in_sizes[0] != M * DM || out_size != M * DM || ws_size < WS_END) { fprintf(stderr, "kernel_launch: unexpected problem (n_in %d, in0 %d, out %d, ws %zu); nothing launched\n", n_in, n_in > 0 ? in_sizes[0] : -1, out_size, ws_size); grid = -1; return; }
        int dev = 0, cus = 0, per_cu = 0;
        if (hipGetDevice(&dev) != hipSuccess || hipDeviceGetAttribute(&cus, hipDeviceAttributeMultiprocessorCount, dev) != hipSuccess) { grid = -1; return; }
        if (hipFuncSetAttribute((const void*)hybrid_fwd, hipFuncAttributeMaxDynamicSharedMemorySize, LDS_BYTES) != hipSuccess) { fprintf(stderr, "kernel_launch: hipFuncSetAttribute failed\n"); grid = -1; return; }
        if (hipOccupancyMaxActiveBlocksPerMultiprocessor(&per_cu, (const void*)hybrid_fwd, NWAVES * 64, LDS_BYTES) != hipSuccess || per_cu < 1) { fprintf(stderr, "kernel_launch: occupancy query failed (%d)\n", per_cu); (void)hipGetLastError(); per_cu = 1; }
        grid = cus * 1;
        if (per_cu < 1) grid = -1;
    }
    if (grid < 0) return;
    if (hipMemsetAsync((char*)d_ws + WS_BAR, 0, 16384, stream) != hipSuccess) { fprintf(stderr, "kernel_launch: hipMemsetAsync failed\n"); return; }
    Args a{};
    for (int i = 0; i < 27; ++i) a.in[i] = (const float*)d_in[i];
    a.out = (float*)d_out; a.ws = (unsigned char*)d_ws;
#if N_LAUNCHES == 1
    a.ph_lo = 0; a.ph_hi = N_PHASES;
    void* args[] = {&a};
    hipError_t e = hipLaunchCooperativeKernel((const void*)hybrid_fwd, dim3(grid), dim3(NWAVES * 64), args, LDS_BYTES, stream);
    if (e != hipSuccess) fprintf(stderr, "kernel_launch: cooperative launch failed: %s (grid %d)\n", hipGetErrorString(e), grid);
#else
    for (int p = 0; p < N_PHASES; ++p) { a.ph_lo = p; a.ph_hi = p + 1;
        hipLaunchKernelGGL(hybrid_fwd, dim3(grid), dim3(NWAVES * 64), LDS_BYTES, stream, a);
        const hipError_t le = hipPeekAtLastError(); if (le != hipSuccess) { fprintf(stderr, "kernel_launch: launch %d failed: %s\n", p, hipGetErrorName(le)); break; } }
#endif
}
```

```cpp
#include <hip/hip_runtime.h>
#include <hip/hip_cooperative_groups.h>
#include <cstdio>
#include <cstdint>
namespace cg = cooperative_groups;

#ifndef N_LAUNCHES
#define N_LAUNCHES 1
#endif

#define GAS __attribute__((address_space(1)))
#define LAS __attribute__((address_space(3)))
namespace pg8 {
#define PG8_LAS __attribute__((address_space(3)))
typedef unsigned short bf16_t;
typedef short bf16x8 __attribute__((ext_vector_type(8)));
typedef float f32x4 __attribute__((ext_vector_type(4)));
typedef unsigned u32x4 __attribute__((ext_vector_type(4)));
constexpr int BM = 256, BK = 64, HALF = 128, HTB = HALF * BK * 2  , STAGE_BYTES = 8 * HTB, NXCD = 8, WGM = 8;

__host__ __device__ __forceinline__ int lds_byte(int r, int c) { const int st = (r >> 4) * 2 + (c >> 5), rr = r & 15, cc = c & 31, ob = rr * 64 + cc * 2; return st * 1024 + (ob ^ (((ob >> 9) & 1) << 5)); }
__host__ __device__ __forceinline__ void stage_rc(int b, int& R, int& C) { const int st = b / 1024, sb = b % 1024, swz = sb ^ (((sb >> 9) & 1) << 5); R = (st >> 1) * 16 + swz / 64; C = (st & 1) * 32 + (swz % 64) / 2; }
__host__ __device__ __forceinline__ int perm32(int rho) { const int n = rho >> 4, i = rho & 15; return 8 * (i >> 2) + 4 * n + (i & 3); }

struct Unit { int pm, pn; };
struct Gemm { const bf16_t* A; const bf16_t* Bt; int M, N, K; };

struct StaticOrder {
    int nM, nN, nwg, G, c;
    __host__ __device__ void init(int M, int N, int G_, int c_) { nM = M / BM; nN = N / BM; nwg = nM * nN; G = G_; c = c_; }
    __host__ __device__ bool next(int i, Unit& u) const {
        const long L = (long)i * G + c; if (L >= nwg) return false;
        int wgid = (int)L; { const int q = nwg / NXCD, r = nwg % NXCD, xcd = wgid % NXCD, off = wgid / NXCD; wgid = (xcd < r ? xcd * (q + 1) : r * (q + 1) + (xcd - r) * q) + off; }
        const int nig = WGM * nN, gid = wgid / nig, fm = gid * WGM, gsz = (nM - fm) < WGM ? (nM - fm) : WGM;
        u.pm = fm + ((wgid % nig) % gsz); u.pn = (wgid % nig) / gsz; return true;
    }
    __device__ __forceinline__ void a_ready(const Unit&) const {}
    __device__ __forceinline__ void done(const Unit&) const {}
};

typedef float f32x2 __attribute__((ext_vector_type(2)));
__device__ __forceinline__ unsigned cvt_pk_bf16(float lo, float hi) { unsigned r; asm volatile("v_cvt_pk_bf16_f32 %0, %1, %2" : "=v"(r) : "v"(lo), "v"(hi)); return r; }
__device__ __forceinline__ float bf_lo(unsigned u) { return __builtin_bit_cast(float, u << 16); }
__device__ __forceinline__ float bf_hi(unsigned u) { return __builtin_bit_cast(float, u & 0xffff0000u); }
__device__ __forceinline__ float gelu_t(float x) { const float t = x * (1.0f + 0.044715f * x * x) * (-2.3022082f); return x * __builtin_amdgcn_rcpf(1.0f + __builtin_amdgcn_exp2f(t)); }
__device__ __forceinline__ float sigmoid_f(float x) { return __builtin_amdgcn_rcpf(1.0f + __builtin_amdgcn_exp2f(x * -1.4426950409f)); }

struct EpiIn { static constexpr bool PERM = true, AFTER_DRAIN = false; bf16_t* ZG; bf16_t* ZS;
    __device__ __forceinline__ void operator()(const f32x4 (&acc)[2][2][4][2], const Unit& u, int wr, int wc, int fr, int fq) const {
        const int row0 = u.pm * BM + wr * 64 + fr, colt = u.pn * BM;
#pragma unroll
        for (int ai = 0; ai < 2; ++ai)
#pragma unroll
            for (int m = 0; m < 4; ++m) { const int row = row0 + ai * HALF + m * 16;
#pragma unroll
                for (int bj = 0; bj < 2; ++bj) { const int col = colt + bj * HALF + wc * 32 + 8 * fq; f32x4 v0 = acc[ai][bj][m][0], v1 = acc[ai][bj][m][1]; u32x4 w;
                    if (colt < 1024) {
                        w.x = cvt_pk_bf16(gelu_t(v0[0]), gelu_t(v0[1])); w.y = cvt_pk_bf16(gelu_t(v0[2]), gelu_t(v0[3])); w.z = cvt_pk_bf16(gelu_t(v1[0]), gelu_t(v1[1])); w.w = cvt_pk_bf16(gelu_t(v1[2]), gelu_t(v1[3]));
                        *(u32x4*)(ZG + (size_t)row * 1024 + col) = w;
                    } else {
                        w.x = cvt_pk_bf16(v0[0], v0[1]); w.y = cvt_pk_bf16(v0[2], v0[3]); w.z = cvt_pk_bf16(v1[0], v1[1]); w.w = cvt_pk_bf16(v1[2], v1[3]);
                        const int cs = col - 1024, g = cs >> 4, ch = cs & 15, b = row >> 13, s = row & 8191;
                        *(u32x4*)(ZS + ((((size_t)(b * 32 + g)) * 8192 + s) << 4) + ch) = w;
                    } } }
    }
};
struct EpiGlu { static constexpr bool PERM = true, AFTER_DRAIN = false; const bf16_t* YS; const float* bglu; bf16_t* Y;
    __device__ __forceinline__ void operator()(const f32x4 (&acc)[2][2][4][2], const Unit& u, int wr, int wc, int fr, int fq) const {
        const int row0 = u.pm * BM + wr * 64 + fr, colt = u.pn * BM;
        u32x4 yA[4], yB[4];
#define EG_LOAD(YV, b_) do { const int bj_ = (b_) >> 1, ai_ = (b_) & 1; const int col_ = colt + bj_ * HALF + wc * 32 + 8 * fq; \
            _Pragma("unroll") for (int m = 0; m < 4; ++m) YV[m] = *(const u32x4*)(YS + (size_t)(row0 + ai_ * HALF + m * 16) * 512 + col_); } while (0)
#define EG_PROC(YV, b_) do { const int bj_ = (b_) >> 1, ai_ = (b_) & 1; const int col_ = colt + bj_ * HALF + wc * 32 + 8 * fq; const f32x4 b0 = *(const f32x4*)(bglu + col_), b1 = *(const f32x4*)(bglu + col_ + 4); \
            _Pragma("unroll") for (int m = 0; m < 4; ++m) { const int row = row0 + ai_ * HALF + m * 16; const f32x4 v0 = acc[ai_][bj_][m][0] + b0, v1 = acc[ai_][bj_][m][1] + b1; const u32x4 ys = YV[m]; u32x4 w; \
                w.x = cvt_pk_bf16(bf_lo(ys.x) * sigmoid_f(v0[0]), bf_hi(ys.x) * sigmoid_f(v0[1])); w.y = cvt_pk_bf16(bf_lo(ys.y) * sigmoid_f(v0[2]), bf_hi(ys.y) * sigmoid_f(v0[3])); \
                w.z = cvt_pk_bf16(bf_lo(ys.z) * sigmoid_f(v1[0]), bf_hi(ys.z) * sigmoid_f(v1[1])); w.w = cvt_pk_bf16(bf_lo(ys.w) * sigmoid_f(v1[2]), bf_hi(ys.w) * sigmoid_f(v1[3])); \
                *(u32x4*)(Y + (size_t)row * 1024 + 512 + col_) = w; } } while (0)
        EG_LOAD(yA, 0);
        EG_LOAD(yB, 1); __builtin_amdgcn_sched_barrier(0); EG_PROC(yA, 0); __builtin_amdgcn_sched_barrier(0);
        EG_LOAD(yA, 2); __builtin_amdgcn_sched_barrier(0); EG_PROC(yB, 1); __builtin_amdgcn_sched_barrier(0);
        EG_LOAD(yB, 3); __builtin_amdgcn_sched_barrier(0); EG_PROC(yA, 2); __builtin_amdgcn_sched_barrier(0);
        EG_PROC(yB, 3);
#undef EG_LOAD
#undef EG_PROC
    }
};
struct EpiOut { static constexpr bool PERM = true, AFTER_DRAIN = false; const float* x; const float* mod; bf16_t* X1; PG8_LAS unsigned char* ldsb;
    __device__ __forceinline__ void operator()(const f32x4 (&acc)[2][2][4][2], const Unit& u, int wr, int wc, int fr, int fq) const {
        const int row0 = u.pm * BM + wr * 64 + fr, colt = u.pn * BM; const float* gt = mod + (size_t)((u.pm * BM) >> 13) * 6144 + 2048;
        const int lane = fq * 16 + fr, lr = lane >> 3, lp = lane & 7;
        PG8_LAS unsigned char* sg = ldsb + 131072 + (wr * 4 + wc) * 2560;
        f32x4 xsA[4], xsB[4];
#define EO_LOAD(XS, b_) do { const int bj_ = (b_) >> 2, ai_ = ((b_) >> 1) & 1, mp_ = (b_) & 1; const int col0_ = colt + bj_ * HALF + wc * 32; \
            _Pragma("unroll") for (int mm = 0; mm < 2; ++mm) { const size_t rb = (size_t)(u.pm * BM + wr * 64 + ai_ * HALF + (2 * mp_ + mm) * 16 + lr) * 1024 + col0_ + 4 * lp; \
                XS[2 * mm] = __builtin_nontemporal_load((const f32x4*)(x + rb)); XS[2 * mm + 1] = __builtin_nontemporal_load((const f32x4*)(x + rb + 8 * 1024)); } } while (0)
#define EO_PROC(XS, b_) do { const int bj_ = (b_) >> 2, ai_ = ((b_) >> 1) & 1, mp_ = (b_) & 1; const int col_ = colt + bj_ * HALF + wc * 32 + 8 * fq; \
            const f32x4 g0 = *(const f32x4*)(gt + col_), g1 = *(const f32x4*)(gt + col_ + 4); \
            _Pragma("unroll") for (int mm = 0; mm < 2; ++mm) { const int m = 2 * mp_ + mm; \
                *(PG8_LAS f32x4*)(sg + lr * 144 + lp * 16) = XS[2 * mm]; *(PG8_LAS f32x4*)(sg + (8 + lr) * 144 + lp * 16) = XS[2 * mm + 1]; \
                const f32x4 x0 = *(const PG8_LAS f32x4*)(sg + fr * 144 + fq * 32), x1 = *(const PG8_LAS f32x4*)(sg + fr * 144 + fq * 32 + 16); \
                const size_t o = (size_t)(row0 + ai_ * HALF + m * 16) * 1024 + col_; \
                const f32x4 v0 = x0 + g0 * acc[ai_][bj_][m][0], v1 = x1 + g1 * acc[ai_][bj_][m][1]; u32x4 w; \
                w.x = cvt_pk_bf16(v0[0], v0[1]); w.y = cvt_pk_bf16(v0[2], v0[3]); w.z = cvt_pk_bf16(v1[0], v1[1]); w.w = cvt_pk_bf16(v1[2], v1[3]); \
                *(u32x4*)(X1 + o) = w; } } while (0)
        EO_LOAD(xsA, 0);
        EO_LOAD(xsB, 1); __builtin_amdgcn_sched_barrier(0); EO_PROC(xsA, 0); __builtin_amdgcn_sched_barrier(0);
        EO_LOAD(xsA, 2); __builtin_amdgcn_sched_barrier(0); EO_PROC(xsB, 1); __builtin_amdgcn_sched_barrier(0);
        EO_LOAD(xsB, 3); __builtin_amdgcn_sched_barrier(0); EO_PROC(xsA, 2); __builtin_amdgcn_sched_barrier(0);
        EO_LOAD(xsA, 4); __builtin_amdgcn_sched_barrier(0); EO_PROC(xsB, 3); __builtin_amdgcn_sched_barrier(0);
        EO_LOAD(xsB, 5); __builtin_amdgcn_sched_barrier(0); EO_PROC(xsA, 4); __builtin_amdgcn_sched_barrier(0);
        EO_LOAD(xsA, 6); __builtin_amdgcn_sched_barrier(0); EO_PROC(xsB, 5); __builtin_amdgcn_sched_barrier(0);
        EO_LOAD(xsB, 7); __builtin_amdgcn_sched_barrier(0); EO_PROC(xsA, 6); __builtin_amdgcn_sched_barrier(0);
        EO_PROC(xsB, 7);
#undef EO_LOAD
#undef EO_PROC
    }
};
struct EpiPlain { static constexpr bool PERM = true, AFTER_DRAIN = false; bf16_t* O; int ldc;
    __device__ __forceinline__ void operator()(const f32x4 (&acc)[2][2][4][2], const Unit& u, int wr, int wc, int fr, int fq) const {
        const int row0 = u.pm * BM + wr * 64 + fr, colt = u.pn * BM;
#pragma unroll
        for (int ai = 0; ai < 2; ++ai)
#pragma unroll
            for (int m = 0; m < 4; ++m) { const int row = row0 + ai * HALF + m * 16;
#pragma unroll
                for (int bj = 0; bj < 2; ++bj) { const int col = colt + bj * HALF + wc * 32 + 8 * fq; const f32x4 v0 = acc[ai][bj][m][0], v1 = acc[ai][bj][m][1]; u32x4 w;
                    w.x = cvt_pk_bf16(v0[0], v0[1]); w.y = cvt_pk_bf16(v0[2], v0[3]); w.z = cvt_pk_bf16(v1[0], v1[1]); w.w = cvt_pk_bf16(v1[2], v1[3]);
                    *(u32x4*)(O + (size_t)row * ldc + col) = w; } }
    }
};
template <class Epi, class Sched, bool ALIGN_EPI = false, bool SP2 = false>
__device__ __forceinline__ void gemm_phase(PG8_LAS unsigned char* lds, const Gemm g, const Sched& S, const Epi& E) {
    const int tid = threadIdx.x, wid = __builtin_amdgcn_readfirstlane(tid >> 6), lane = tid & 63, wr = wid >> 2, wc = wid & 3, fr = lane & 15, fq = lane >> 4;
    const int K = g.K, nt = K / BK;
    unsigned voffA[2], voffB[2];
#pragma unroll
    for (int i = 0; i < 2; ++i) { int R, C; stage_rc(tid * 16 + i * 8192, R, C); const int Rb = Epi::PERM ? ((R & ~31) + perm32(R & 31)) : R;
        voffA[i] = (unsigned)(R * K + C) * 2u; voffB[i] = (unsigned)(Rb * K + C) * 2u; }
    const size_t kstep = (size_t)(BK * 2);
    const size_t hstep = (size_t)HALF * K * 2;
    const size_t tstep = 2 * hstep;
    const unsigned ldsw = (unsigned)wid * 1024u;
    const int aoff = lds_byte(wr * 64 + fr, fq * 8), boff = lds_byte(wc * 32 + fr, fq * 8);
#define PG8_SA(b, h) (((b) * 2 + (h)) * HTB)
#define PG8_SB(b, h) ((4 + (b) * 2 + (h)) * HTB)
#define PG8_STAGE(bufoff, gbase, voff) do { _Pragma("unroll") for (int _i = 0; _i < 2; ++_i) \
        __builtin_amdgcn_global_load_lds((const unsigned*)((const char*)(gbase) + (voff)[_i]), (PG8_LAS unsigned*)(lds + (bufoff) + ldsw + _i * 8192), 16, 0, 0); } while (0)
#define PG8_LDA(dst, b, h) do { _Pragma("unroll") for (int m = 0; m < 4; ++m) _Pragma("unroll") for (int k = 0; k < 2; ++k) dst[m][k] = *(const PG8_LAS bf16x8*)(lds + PG8_SA(b, h) + aoff + m * 2048 + k * 1024); } while (0)
#define PG8_LDB(dst, b, h) do { _Pragma("unroll") for (int n = 0; n < 2; ++n) _Pragma("unroll") for (int k = 0; k < 2; ++k) dst[n][k] = *(const PG8_LAS bf16x8*)(lds + PG8_SB(b, h) + boff + n * 2048 + k * 1024); } while (0)
#define PG8_MMA(ai, bj, At, Bt) do { __builtin_amdgcn_s_setprio(1); _Pragma("unroll") for (int m = 0; m < 4; ++m) _Pragma("unroll") for (int n = 0; n < 2; ++n) _Pragma("unroll") for (int k = 0; k < 2; ++k) \
        acc[ai][bj][m][n] = __builtin_amdgcn_mfma_f32_16x16x32_bf16(Bt[n][k], At[m][k], acc[ai][bj][m][n], 0, 0, 0); __builtin_amdgcn_s_setprio(0); } while (0)
#define PG8_WAIT_V(n) asm volatile("s_waitcnt vmcnt(" #n ")" ::: "memory")
#define PG8_WAIT_L(n) asm volatile("s_waitcnt lgkmcnt(" #n ")" ::: "memory")
#define PG8_BAR __builtin_amdgcn_s_barrier()
#define PG8_SCHED __builtin_amdgcn_sched_barrier(0)
    Unit cur, nxt; int ui = 0;
    if (!S.next(0, cur)) return;
    f32x4 acc[2][2][4][2];
#pragma unroll
    for (int a = 0; a < 2; ++a)
#pragma unroll
        for (int b = 0; b < 2; ++b)
#pragma unroll
            for (int m = 0; m < 4; ++m)
#pragma unroll
                for (int n = 0; n < 2; ++n) acc[a][b][m][n] = (f32x4){0.f, 0.f, 0.f, 0.f};
    bf16x8 At[4][2], B0[2][2], B1[2][2];
    const char* cA = (const char*)g.A + (size_t)cur.pm * tstep; const char* cB = (const char*)g.Bt + (size_t)cur.pn * tstep;
    S.a_ready(cur);
    if constexpr (SP2) {
        PG8_STAGE(PG8_SB(0, 0), cB, voffB); PG8_STAGE(PG8_SB(0, 1), cB + hstep, voffB); PG8_STAGE(PG8_SA(0, 0), cA, voffA); PG8_STAGE(PG8_SA(0, 1), cA + hstep, voffA);
        if (wr == 1) PG8_BAR;
        PG8_WAIT_V(2); PG8_BAR;
        PG8_STAGE(PG8_SB(1, 0), cB + kstep, voffB); PG8_STAGE(PG8_SA(1, 0), cA + kstep, voffA); PG8_STAGE(PG8_SB(1, 1), cB + hstep + kstep, voffB);
        PG8_WAIT_V(6); PG8_BAR;
    } else {
        PG8_STAGE(PG8_SB(0, 0), cB, voffB); PG8_STAGE(PG8_SA(0, 0), cA, voffA); PG8_STAGE(PG8_SB(0, 1), cB + hstep, voffB); PG8_STAGE(PG8_SA(0, 1), cA + hstep, voffA);
        if (wr == 1) PG8_BAR;
        PG8_WAIT_V(4); PG8_BAR;
        PG8_STAGE(PG8_SB(1, 0), cB + kstep, voffB); PG8_STAGE(PG8_SA(1, 0), cA + kstep, voffA); PG8_STAGE(PG8_SB(1, 1), cB + hstep + kstep, voffB);
        PG8_WAIT_V(6); PG8_BAR;
    }
    for (;;) {
        const bool has_next = S.next(ui + 1, nxt);
        const char* nA = has_next ? (const char*)g.A + (size_t)nxt.pm * tstep : cA; const char* nB = has_next ? (const char*)g.Bt + (size_t)nxt.pn * tstep : cB;
        for (int t = 0; t < nt; t += 2) {
            const bool last = (t == nt - 2);
            const char* a1 = cA + (size_t)(t + 1) * kstep;
            const char* a2 = last ? nA : cA + (size_t)(t + 2) * kstep; const char* b2 = last ? nB : cB + (size_t)(t + 2) * kstep;
            const char* a3 = a2 + kstep; const char* b3 = b2 + kstep;
            if (last && has_next) S.a_ready(nxt);
            if constexpr (SP2) {
            PG8_LDB(B0, 0, 0); PG8_LDB(B1, 0, 1); PG8_SCHED; PG8_LDA(At, 0, 0); PG8_STAGE(PG8_SA(1, 1), a1 + hstep, voffA);
            PG8_WAIT_V(8); PG8_WAIT_L(0); PG8_BAR; PG8_MMA(0, 0, At, B0); PG8_MMA(0, 1, At, B1); PG8_BAR; PG8_SCHED;
            PG8_LDA(At, 0, 1); PG8_STAGE(PG8_SB(0, 0), b2, voffB); PG8_STAGE(PG8_SB(0, 1), b2 + hstep, voffB); PG8_STAGE(PG8_SA(0, 0), a2, voffA);
            PG8_WAIT_V(8); PG8_WAIT_L(0); PG8_BAR; PG8_MMA(1, 0, At, B0); PG8_MMA(1, 1, At, B1); PG8_BAR; PG8_SCHED;
            PG8_LDB(B0, 1, 0); PG8_LDB(B1, 1, 1); PG8_SCHED; PG8_LDA(At, 1, 0); PG8_STAGE(PG8_SA(0, 1), a2 + hstep, voffA);
            PG8_WAIT_V(8); PG8_WAIT_L(0); PG8_BAR; PG8_MMA(0, 0, At, B0); PG8_MMA(0, 1, At, B1); PG8_BAR; PG8_SCHED;
            PG8_LDA(At, 1, 1); PG8_STAGE(PG8_SB(1, 0), b3, voffB); PG8_STAGE(PG8_SB(1, 1), b3 + hstep, voffB); PG8_STAGE(PG8_SA(1, 0), a3, voffA);
            PG8_WAIT_V(8); PG8_WAIT_L(0); PG8_BAR; PG8_MMA(1, 0, At, B0); PG8_MMA(1, 1, At, B1); PG8_BAR; PG8_SCHED;
            } else {
            PG8_LDB(B0, 0, 0); PG8_SCHED; PG8_LDA(At, 0, 0); PG8_STAGE(PG8_SA(1, 1), a1 + hstep, voffA);
            PG8_WAIT_L(8); PG8_BAR; PG8_WAIT_L(0); PG8_MMA(0, 0, At, B0); PG8_BAR; PG8_SCHED;
            PG8_LDB(B1, 0, 1); PG8_STAGE(PG8_SB(0, 0), b2, voffB);
            PG8_BAR; PG8_WAIT_L(0); PG8_MMA(0, 1, At, B1); PG8_BAR;
            PG8_LDA(At, 0, 1); PG8_STAGE(PG8_SA(0, 0), a2, voffA);
            PG8_BAR; PG8_WAIT_L(0); PG8_MMA(1, 0, At, B0); PG8_BAR; PG8_SCHED;
            PG8_STAGE(PG8_SB(0, 1), b2 + hstep, voffB);
            PG8_WAIT_V(6); PG8_BAR; PG8_MMA(1, 1, At, B1); PG8_BAR;
            PG8_LDB(B0, 1, 0); PG8_SCHED; PG8_LDA(At, 1, 0); PG8_STAGE(PG8_SA(0, 1), a2 + hstep, voffA);
            PG8_WAIT_L(8); PG8_BAR; PG8_WAIT_L(0); PG8_MMA(0, 0, At, B0); PG8_BAR; PG8_SCHED;
            PG8_LDB(B1, 1, 1); PG8_STAGE(PG8_SB(1, 0), b3, voffB);
            PG8_BAR; PG8_WAIT_L(0); PG8_MMA(0, 1, At, B1); PG8_BAR;
            PG8_LDA(At, 1, 1); PG8_STAGE(PG8_SA(1, 0), a3, voffA);
            PG8_BAR; PG8_WAIT_L(0); PG8_MMA(1, 0, At, B0); PG8_BAR; PG8_SCHED;
            PG8_STAGE(PG8_SB(1, 1), b3 + hstep, voffB);
            PG8_WAIT_V(6); PG8_BAR; PG8_MMA(1, 1, At, B1); PG8_BAR;
            }
        }
        if constexpr (ALIGN_EPI) { if (wr == 0) PG8_BAR; }
        if constexpr (!Epi::AFTER_DRAIN) { E(acc, cur, wr, wc, fr, fq); S.done(cur); }
        if (!has_next) break;
#pragma unroll
        for (int a = 0; a < 2; ++a)
#pragma unroll
            for (int b = 0; b < 2; ++b)
#pragma unroll
                for (int m = 0; m < 4; ++m)
#pragma unroll
                    for (int n = 0; n < 2; ++n) acc[a][b][m][n] = (f32x4){0.f, 0.f, 0.f, 0.f};
        cur = nxt; cA = nA; cB = nB; ++ui;
        if constexpr (ALIGN_EPI) { if (wr == 1) PG8_BAR; }
    }
    PG8_WAIT_V(0);
    if constexpr (!ALIGN_EPI) { if (wr == 0) PG8_BAR; }
    PG8_BAR;
    if constexpr (Epi::AFTER_DRAIN) { E.fused(acc, cur, wr, wc, fr, fq, lds, wid, lane); S.done(cur); }
#undef PG8_SA
#undef PG8_SB
#undef PG8_STAGE
#undef PG8_LDA
#undef PG8_LDB
#undef PG8_MMA
#undef PG8_WAIT_V
#undef PG8_WAIT_L
#undef PG8_BAR
#undef PG8_SCHED
}
}
typedef unsigned short bf16;
typedef unsigned v4u __attribute__((ext_vector_type(4)));
typedef unsigned v2u __attribute__((ext_vector_type(2)));
typedef float f32x4 __attribute__((ext_vector_type(4)));
typedef float f2_t __attribute__((ext_vector_type(2)));
typedef float f32x16 __attribute__((ext_vector_type(16)));
typedef short bf16x8 __attribute__((ext_vector_type(8)));
typedef short s16x4 __attribute__((ext_vector_type(4)));
typedef __bf16 bf2_t __attribute__((ext_vector_type(2)));

constexpr int NWAVES = 8;
constexpr int DM = 1024, NB = 8, SEQ = 8192, M = NB * SEQ, INW = 1536, NMODC = 6144;
constexpr int LDS_BYTES = 160 * 1024, LDS_MISC_OFF = LDS_BYTES - 64;
constexpr size_t MiB = 1u << 20;
constexpr size_t WS_MOD = 0;
constexpr size_t WS_BAR = 208 * 1024;
constexpr size_t WS_SU = 256 * 1024;
constexpr size_t WS_SV = 384 * 1024;
constexpr size_t WS_WIN = 1 * MiB;
constexpr size_t WS_WGLU = 4 * MiB;
constexpr size_t WS_WOUT = 5 * MiB;
constexpr size_t WS_WQ = 7 * MiB;
constexpr size_t WS_KEYS = 9 * MiB;
constexpr size_t WS_WM = 9 * MiB + 512 * 1024;
constexpr size_t WS_UB = 16 * MiB;
constexpr size_t WS_VB = 48 * MiB;
constexpr size_t WS_H = 80 * MiB;
constexpr size_t WS_ZG = 208 * MiB;
constexpr size_t WS_ZS = 336 * MiB;
constexpr size_t WS_Y = 400 * MiB;
constexpr size_t WS_YS = 528 * MiB;
constexpr size_t WS_E = 592 * MiB;
constexpr size_t WS_G = 624 * MiB;
constexpr size_t WS_W = 656 * MiB;
constexpr size_t WS_SS = 688 * MiB;
constexpr size_t WS_PA = 336 * MiB;
constexpr size_t WS_X1B = 690 * MiB;
constexpr size_t WS_H2Q = 818 * MiB;
constexpr size_t WS_SH = 882 * MiB;
constexpr size_t WS_END = 883 * MiB;
constexpr float EPS = 1e-6f;

#define LDS_WAIT() asm volatile("s_waitcnt lgkmcnt(0)" ::: "memory")
__device__ __forceinline__ unsigned f2bf(float f) { unsigned u = __builtin_bit_cast(unsigned, f); return (u + 0x7fffu + ((u >> 16) & 1u)) >> 16; }
__device__ __forceinline__ unsigned pk2(float lo, float hi) { return f2bf(lo) | (f2bf(hi) << 16); }
__device__ __forceinline__ float bflo(unsigned u) { return __builtin_bit_cast(float, u << 16); }
__device__ __forceinline__ float bfhi(unsigned u) { return __builtin_bit_cast(float, u & 0xffff0000u); }
__device__ __forceinline__ float wave_sum(float v) {
#pragma unroll
    for (int o = 1; o < 64; o <<= 1) v += __shfl_xor(v, o);
    return v;
}
using pg8::gelu_t;
using pg8::sigmoid_f;

struct Args { const float* in[27]; float* out; unsigned char* ws; int ph_lo, ph_hi; };
enum { I_X = 0, I_C, I_WADA, I_BADA, I_GMIX, I_WIN, I_LNG, I_LNB, I_WS, I_BS, I_ARE, I_AIM, I_LOGDT, I_BRE, I_BIM, I_CRE, I_CIM, I_D, I_WGLU, I_BGLU, I_WOUT, I_GFFN, I_WQ, I_KEYS, I_PU, I_PV, I_GFIN };

__host__ __device__ __forceinline__ int sgu_pos(int ch) { const int c = ch & 127, nt = c >> 4, q = (c >> 2) & 3, r = c & 3; return (ch & ~127) | (32 * (nt >> 1) + 8 * q + 4 * (nt & 1) + r); }
template <int MODE = 0> __device__ __forceinline__ void p0_transpose_item(const float* W, int K, int N, bf16* WT, LAS float* scr, int item, int lane) {
    const int nblk = N / 32, kb = item / nblk, nb = item % nblk, k0 = 64 * kb, n0 = 32 * nb;
#pragma unroll 8
    for (int i = 0; i < 32; ++i) { const int kk = 2 * i + (lane >> 5); scr[kk * 33 + (lane & 31)] = W[(size_t)(k0 + kk) * N + n0 + (lane & 31)]; }
    LDS_WAIT(); asm volatile("" ::: "memory");
    const int c = lane & 7;
#pragma unroll
    for (int j = 0; j < 4; ++j) { const int n = (lane >> 3) + 8 * j; const LAS float* s = scr + (8 * c) * 33 + n;
        v4u o; o.x = pk2(s[0 * 33], s[1 * 33]); o.y = pk2(s[2 * 33], s[3 * 33]); o.z = pk2(s[4 * 33], s[5 * 33]); o.w = pk2(s[6 * 33], s[7 * 33]);
        int row = n0 + n; if (MODE == 1 && row < 512) row = sgu_pos(row);
        const int kq = k0 + 8 * c;
        if (MODE == 2 && kq < 512) { *(v2u*)(WT + (size_t)row * K + sgu_pos(kq)) = (v2u){o.x, o.y}; *(v2u*)(WT + (size_t)row * K + sgu_pos(kq + 4)) = (v2u){o.z, o.w}; }
        else *(v4u*)(WT + (size_t)row * K + kq) = o; }
    LDS_WAIT(); asm volatile("" ::: "memory");
}
__device__ __forceinline__ void cvt_stream(const float* src, bf16* dst, size_t n8, size_t gtid, size_t gthreads) {
    for (size_t i = gtid; i < n8; i += gthreads) { const f32x4 a = *(const f32x4*)(src + i * 8), b = *(const f32x4*)(src + i * 8 + 4);
        v4u o; o.x = pk2(a.x, a.y); o.y = pk2(a.z, a.w); o.z = pk2(b.x, b.y); o.w = pk2(b.z, b.w); *(v4u*)(dst + i * 8) = o; }
}
__device__ __forceinline__ float wave_max(float v) {
#pragma unroll
    for (int o = 1; o < 64; o <<= 1) v = fmaxf(v, __shfl_xor(v, o));
    return v;
}
__device__ __forceinline__ void cvt_rows_fp8(const float* src, unsigned char* dst, float* inv, int gw, int NGW, int lane) {
    for (int row = gw; row < 16384; row += NGW) { const f32x4* p = (const f32x4*)(src + (size_t)row * 1024) + lane;
        f32x4 v[4]; float m = 0.f;
#pragma unroll
        for (int j = 0; j < 4; ++j) { v[j] = __builtin_nontemporal_load(p + 64 * j); m = fmaxf(fmaxf(m, fmaxf(fabsf(v[j].x), fabsf(v[j].y))), fmaxf(fabsf(v[j].z), fabsf(v[j].w))); }
        m = wave_max(m); const float sc = m > 0.f ? 240.0f / m : 1.0f;
#pragma unroll
        for (int j = 0; j < 4; ++j) { int pk = 0; pk = __builtin_amdgcn_cvt_pk_fp8_f32(v[j].x * sc, v[j].y * sc, pk, false); pk = __builtin_amdgcn_cvt_pk_fp8_f32(v[j].z * sc, v[j].w * sc, pk, true);
            const int c = 4 * lane + 256 * j; *(unsigned*)(dst + ((size_t)(c >> 7) * 16384 + row) * 128 + (c & 127)) = (unsigned)pk; }
        if (lane == 0) inv[row] = m > 0.f ? m * (1.0f / 240.0f) : 1.0f; }
}
__device__ __forceinline__ unsigned pack_i8x4(float a, float b, float c, float d) {
    const int ia = (int)rintf(a), ib = (int)rintf(b), ic = (int)rintf(c), id = (int)rintf(d);
    return (unsigned)(ia & 0xff) | ((unsigned)(ib & 0xff) << 8) | ((unsigned)(ic & 0xff) << 16) | ((unsigned)(id & 0xff) << 24);
}
__device__ __forceinline__ void cvt_rows_i8(const float* src, unsigned char* dst, float* inv, int gw, int NGW, int lane) {
    for (int row = gw; row < 16384; row += NGW) { const f32x4* p = (const f32x4*)(src + (size_t)row * 1024) + lane;
        f32x4 v[4]; float m = 0.f;
#pragma unroll
        for (int j = 0; j < 4; ++j) { v[j] = __builtin_nontemporal_load(p + 64 * j); m = fmaxf(fmaxf(m, fmaxf(fabsf(v[j].x), fabsf(v[j].y))), fmaxf(fabsf(v[j].z), fabsf(v[j].w))); }
        m = wave_max(m); const float sc = m > 0.f ? 127.0f / m : 1.0f;
#pragma unroll
        for (int j = 0; j < 4; ++j) { const int c = 4 * lane + 256 * j; *(unsigned*)(dst + ((size_t)(c >> 7) * 16384 + row) * 128 + (c & 127)) = pack_i8x4(v[j].x * sc, v[j].y * sc, v[j].z * sc, v[j].w * sc); }
        if (lane == 0) inv[row] = m > 0.f ? m * (1.0f / 127.0f) : 1.0f; }
}
__device__ __forceinline__ unsigned pack_i4x8(const float (&v)[8], float inv) {
    unsigned d = 0;
#pragma unroll
    for (int i = 0; i < 8; ++i) { int q = (int)rintf(v[i] * inv); q = q < -8 ? -8 : (q > 7 ? 7 : q); d |= (unsigned)(q & 15) << (4 * i); }
    return d;
}
__device__ __forceinline__ void cvt_rows_i4(const float* src, unsigned char* dst, float* invs, int gw, int NGW, int lane) {
    for (int row = gw; row < 16384; row += NGW) { const float* p = src + (size_t)row * 1024;
        float v[2][8]; float ss = 0.f;
#pragma unroll
        for (int q = 0; q < 2; ++q) { const f32x4 x0 = __builtin_nontemporal_load((const f32x4*)(p + 512 * q + 8 * lane)), x1 = __builtin_nontemporal_load((const f32x4*)(p + 512 * q + 8 * lane + 4));
            v[q][0] = x0.x; v[q][1] = x0.y; v[q][2] = x0.z; v[q][3] = x0.w; v[q][4] = x1.x; v[q][5] = x1.y; v[q][6] = x1.z; v[q][7] = x1.w;
#pragma unroll
            for (int i = 0; i < 8; ++i) ss += v[q][i] * v[q][i]; }
        const float rms = sqrtf(wave_sum(ss) * (1.0f / 1024.0f)); const float step = rms > 0.f ? rms * (2.5f / 7.5f) : 1.0f, inv = 1.0f / step;
#pragma unroll
        for (int q = 0; q < 2; ++q) { const int c = 512 * q + 8 * lane; *(unsigned*)(dst + ((size_t)(c >> 7) * 16384 + row) * 64 + ((c & 127) >> 1)) = pack_i4x8(v[q], inv); }
        if (lane == 0) invs[row] = step; }
}
template <int LOG2W> __device__ __forceinline__ void cvt_rows_fp4(const float* src, unsigned char* dst, float* invs, int gw, int NGW, int lane) {
    static_assert(LOG2W == 8, "slices of 256 columns");
    for (int base = gw; base < 16384; base += 4 * NGW) {
        f32x4 v[4][4]; float ss[4];
#pragma unroll
        for (int rr = 0; rr < 4; ++rr) { const int row = min(base + rr * NGW, 16383); const float* p = src + (size_t)row * 1024 + 4 * lane;
#pragma unroll
            for (int j = 0; j < 4; ++j) v[rr][j] = __builtin_nontemporal_load((const f32x4*)(p + 256 * j)); }
#pragma unroll
        for (int rr = 0; rr < 4; ++rr) { float s = 0.f;
#pragma unroll
            for (int j = 0; j < 4; ++j) s += (v[rr][j].x * v[rr][j].x + v[rr][j].y * v[rr][j].y) + (v[rr][j].z * v[rr][j].z + v[rr][j].w * v[rr][j].w);
            ss[rr] = wave_sum(s); }
#pragma unroll
        for (int rr = 0; rr < 4; ++rr) { const int row = base + rr * NGW; if (row < 16384) {
            const float rms = sqrtf(ss[rr] * (1.0f / 1024.0f)); const float sc = rms > 0.f ? rms * 0.5f : 1.0f, inv = 1.0f / sc;
#pragma unroll
            for (int j = 0; j < 4; ++j) { const f32x4 t = {fminf(fmaxf(v[rr][j].x * inv, -6.0f), 6.0f), fminf(fmaxf(v[rr][j].y * inv, -6.0f), 6.0f), fminf(fmaxf(v[rr][j].z * inv, -6.0f), 6.0f), fminf(fmaxf(v[rr][j].w * inv, -6.0f), 6.0f)};
                unsigned d = 0;
                d = __builtin_amdgcn_cvt_scalef32_pk_fp4_f32(d, t.x, t.y, 1.0f, 0); d = __builtin_amdgcn_cvt_scalef32_pk_fp4_f32(d, t.z, t.w, 1.0f, 1);
                const unsigned o = (unsigned)__builtin_amdgcn_update_dpp(0, (int)d, 0xB1, 0xF, 0xF, false);
                if ((lane & 1) == 0) *(unsigned*)(dst + ((size_t)j * 16384 + row) * 128 + 2 * lane) = (d & 0xffffu) | (o << 16); }
            if (lane == 0) invs[row] = sc; } }
    }
}
__device__ __forceinline__ void p0_mod_item(const float* c, const float* w_ada, const float* b_ada, float* mod, LAS float* scr, int item, int tid) {
    LAS float* cond = scr;
    LAS float* red = scr + 8 * 1024;
    for (int i = tid; i < 8 * 1024; i += 512) { const float v = c[i]; cond[i] = v * sigmoid_f(v); }
    __syncthreads();
    const int kq = tid >> 3, cq = tid & 7, j0 = item * 24 + cq * 3;
    float acc[8][3];
#pragma unroll
    for (int b = 0; b < 8; ++b) { acc[b][0] = 0.f; acc[b][1] = 0.f; acc[b][2] = 0.f; }
    for (int i = 0; i < 16; ++i) { const int k = kq + 64 * i; const float* wp = w_ada + (size_t)k * NMODC + j0; const float w0 = wp[0], w1 = wp[1], w2 = wp[2];
#pragma unroll
        for (int b = 0; b < 8; ++b) { const float s = cond[b * 1024 + k]; acc[b][0] += s * w0; acc[b][1] += s * w1; acc[b][2] += s * w2; } }
#pragma unroll
    for (int b = 0; b < 8; ++b)
#pragma unroll
        for (int e = 0; e < 3; ++e) red[kq * 192 + b * 24 + cq * 3 + e] = acc[b][e];
    __syncthreads();
    if (tid < 192) { float s = 0.f; for (int q = 0; q < 64; ++q) s += red[q * 192 + tid]; const int b = tid / 24, j = item * 24 + tid % 24; mod[b * NMODC + j] = s + b_ada[j]; }
    __syncthreads();
}
__device__ __forceinline__ void phase_prologue(const Args& a, LAS unsigned char* lds, int tid, int wave, int lane) {
    unsigned char* ws = a.ws; const int G = gridDim.x, bx = blockIdx.x;
    for (int it = bx; it < 256; it += G) p0_mod_item(a.in[I_C], a.in[I_WADA], a.in[I_BADA], (float*)(ws + WS_MOD), (LAS float*)lds, it, tid);
    LAS float* scr = (LAS float*)(lds + wave * 16384);
    const int gw = bx * NWAVES + wave, NGW = G * NWAVES;
    constexpr int I_IN = 16 * 48, I_GLU = 8 * 16, I_OUT = 16 * 32, I_Q = 16 * 32, NITEMS = I_IN + I_GLU + I_OUT + I_Q;
    for (int it = gw; it < NITEMS; it += NGW) { int r = it;
        if (r < I_IN) { p0_transpose_item<1>(a.in[I_WIN], 1024, 1536, (bf16*)(ws + WS_WIN), scr, r, lane); continue; } r -= I_IN;
        if (r < I_GLU) { p0_transpose_item(a.in[I_WGLU], 512, 512, (bf16*)(ws + WS_WGLU), scr, r, lane); continue; } r -= I_GLU;
        if (r < I_OUT) { p0_transpose_item<2>(a.in[I_WOUT], 1024, 1024, (bf16*)(ws + WS_WOUT), scr, r, lane); continue; } r -= I_OUT;
        p0_transpose_item(a.in[I_WQ], 1024, 1024, (bf16*)(ws + WS_WQ), scr, r, lane); }
    const size_t gtid = (size_t)bx * 512 + tid, gth = (size_t)G * 512;
    cvt_stream(a.in[I_KEYS], (bf16*)(ws + WS_KEYS), 8 * 2 * 128 * 64 / 8, gtid, gth);
    { const float* w = a.in[I_WS]; bf16* wm = (bf16*)(ws + WS_WM);
      for (size_t i = gtid; i < 4 * 128 * 128 / 8; i += gth) { const int e0 = (int)i * 8, ii = (e0 >> 7) & 127, j0 = e0 & 127; const f32x4 p = *(const f32x4*)(w + e0), q = *(const f32x4*)(w + e0 + 4);
          float v[8] = {p.x, p.y, p.z, p.w, q.x, q.y, q.z, q.w};
#pragma unroll
          for (int e = 0; e < 8; ++e) v[e] = (j0 + e <= ii) ? v[e] : 0.f;
          v4u o; o.x = pk2(v[0], v[1]); o.y = pk2(v[2], v[3]); o.z = pk2(v[4], v[5]); o.w = pk2(v[6], v[7]); *(v4u*)(wm + e0) = o; } }
    cvt_rows_fp4<8>(a.in[I_PU], ws + WS_UB, (float*)(ws + WS_SU), gw, NGW, lane); cvt_rows_fp4<8>(a.in[I_PV], ws + WS_VB, (float*)(ws + WS_SV), gw, NGW, lane);
}

__device__ __forceinline__ void phase_norm_mod(const float* x, const float* gw, const float* mod, int sh_off, int sc_off, bf16* H, int wave, int lane) {
    const int G = gridDim.x;
    for (int it = blockIdx.x; it < 256; it += G) { const int b = it >> 5; const float* mb = mod + (size_t)b * NMODC;
        f32x4 A[4], S[4];
#pragma unroll
        for (int j = 0; j < 4; ++j) { const int c0 = 4 * lane + 256 * j; const f32x4 g = *(const f32x4*)(gw + c0), sc = *(const f32x4*)(mb + sc_off + c0); A[j] = g * (sc + 1.0f); S[j] = *(const f32x4*)(mb + sh_off + c0); }
        f32x4 vn[4];
        { const f32x4* xr = (const f32x4*)(x + ((size_t)it * 256 + wave * 32) * 1024) + lane;
#pragma unroll
          for (int j = 0; j < 4; ++j) vn[j] = __builtin_nontemporal_load(xr + 64 * j); }
        for (int r = 0; r < 32; ++r) { const size_t row = (size_t)it * 256 + wave * 32 + r;
            f32x4 v[4]; float s = 0.f;
#pragma unroll
            for (int j = 0; j < 4; ++j) { v[j] = vn[j]; s += (v[j].x * v[j].x + v[j].y * v[j].y) + (v[j].z * v[j].z + v[j].w * v[j].w); }
            { const f32x4* xr = (const f32x4*)(x + (row + (r < 31 ? 1 : 0)) * 1024) + lane;
#pragma unroll
              for (int j = 0; j < 4; ++j) vn[j] = __builtin_nontemporal_load(xr + 64 * j); }
            const float rstd = 1.0f / sqrtf(wave_sum(s) * (1.0f / 1024.0f) + EPS);
            unsigned long long* o8 = (unsigned long long*)(H + row * 1024) + lane;
#pragma unroll
            for (int j = 0; j < 4; ++j) { const f32x4 h = v[j] * rstd * A[j] + S[j]; o8[64 * j] = (unsigned long long)pk2(h.x, h.y) | ((unsigned long long)pk2(h.z, h.w) << 32); } } }
}
__device__ __forceinline__ void phase_norm_mod_bf(const bf16* x, const float* gw, const float* mod, int sh_off, int sc_off, bf16* H, unsigned char* HQ, float* SH, int wave, int lane) {
    const int G = gridDim.x;
    for (int it = blockIdx.x; it < 256; it += G) { const int b = it >> 5; const float* mb = mod + (size_t)b * NMODC;
        float A[16], S[16];
#pragma unroll
        for (int q = 0; q < 2; ++q)
#pragma unroll
            for (int j = 0; j < 8; ++j) { const int c = 512 * q + 8 * lane + j; A[8 * q + j] = gw[c] * (mb[sc_off + c] + 1.0f); S[8 * q + j] = mb[sh_off + c]; }
        v4u n0 = *(const v4u*)(x + ((size_t)it * 256 + wave * 32) * 1024 + 8 * lane), n1 = *(const v4u*)(x + ((size_t)it * 256 + wave * 32) * 1024 + 512 + 8 * lane);
        for (int r = 0; r < 32; ++r) { const size_t row = (size_t)it * 256 + wave * 32 + r;
            const v4u r0 = n0, r1 = n1;
            { const size_t nr = row + (r < 31 ? 1 : 0); n0 = *(const v4u*)(x + nr * 1024 + 8 * lane); n1 = *(const v4u*)(x + nr * 1024 + 512 + 8 * lane); }
            float v[16] = {bflo(r0.x), bfhi(r0.x), bflo(r0.y), bfhi(r0.y), bflo(r0.z), bfhi(r0.z), bflo(r0.w), bfhi(r0.w), bflo(r1.x), bfhi(r1.x), bflo(r1.y), bfhi(r1.y), bflo(r1.z), bfhi(r1.z), bflo(r1.w), bfhi(r1.w)};
            float s = 0.f;
#pragma unroll
            for (int j = 0; j < 16; ++j) s += v[j] * v[j];
            const float rstd = 1.0f / sqrtf(wave_sum(s) * (1.0f / 1024.0f) + EPS);
#pragma unroll
            for (int j = 0; j < 16; ++j) v[j] = v[j] * rstd * A[j] + S[j];
            v4u o0, o1; o0.x = pk2(v[0], v[1]); o0.y = pk2(v[2], v[3]); o0.z = pk2(v[4], v[5]); o0.w = pk2(v[6], v[7]); o1.x = pk2(v[8], v[9]); o1.y = pk2(v[10], v[11]); o1.z = pk2(v[12], v[13]); o1.w = pk2(v[14], v[15]);
            *(v4u*)(H + row * 1024 + 8 * lane) = o0; *(v4u*)(H + row * 1024 + 512 + 8 * lane) = o1;
            float mx = 0.f;
#pragma unroll
            for (int j = 0; j < 16; ++j) mx = fmaxf(mx, fabsf(v[j]));
            mx = wave_max(mx); const float qs = mx > 0.f ? 200.0f / mx : 1.0f;
#pragma unroll
            for (int q = 0; q < 2; ++q) { int p0 = 0, p1 = 0;
                p0 = __builtin_amdgcn_cvt_pk_fp8_f32(v[8 * q] * qs, v[8 * q + 1] * qs, p0, false); p0 = __builtin_amdgcn_cvt_pk_fp8_f32(v[8 * q + 2] * qs, v[8 * q + 3] * qs, p0, true);
                p1 = __builtin_amdgcn_cvt_pk_fp8_f32(v[8 * q + 4] * qs, v[8 * q + 5] * qs, p1, false); p1 = __builtin_amdgcn_cvt_pk_fp8_f32(v[8 * q + 6] * qs, v[8 * q + 7] * qs, p1, true);
                *(v2u*)(HQ + row * 1024 + 512 * q + 8 * lane) = (v2u){(unsigned)p0, (unsigned)p1}; }
            if (lane == 0) SH[row] = mx > 0.f ? mx * (1.0f / 200.0f) : 1.0f; } }
}
__device__ __forceinline__ void sincos_f(float th, float& s, float& c) {
    const float q = rintf(th * 0.63661977236758f);
    float y = fmaf(q, -1.5707962513f, th); y = fmaf(q, -7.5497894159e-8f, y); y = fmaf(q, -5.3903029534e-15f, y);
    const float y2 = y * y;
    const float sp = y + y * y2 * (-1.6666667163e-1f + y2 * (8.3333337680e-3f + y2 * (-1.9841270114e-4f + y2 * 2.7557314297e-6f)));
    const float cp = 1.0f + y2 * (-0.5f + y2 * (4.1666667908e-2f + y2 * (-1.3888889225e-3f + y2 * (2.4801587642e-5f + y2 * -2.7557314297e-7f))));
    const int qi = (int)q & 3;
    s = (qi == 0) ? sp : (qi == 1) ? cp : (qi == 2) ? -sp : -cp;
    c = (qi == 0) ? cp : (qi == 1) ? -sp : (qi == 2) ? -cp : sp;
}
__device__ __forceinline__ void s5_disc(const float* are, const float* aim, float dt, int gp, float& abr, float& abi, float& cr, float& ci) {
    const float ar = fminf(are[gp], -1e-4f), ai = aim[gp];
    const float mag = expf(ar * dt); float sn, cs; sincos_f(ai * dt, sn, cs);
    abr = mag * cs; abi = mag * sn;
    const float nr = abr - 1.0f, ni = abi, den = 1.0f / (ar * ar + ai * ai);
    cr = (nr * ar + ni * ai) * den; ci = (ni * ar - nr * ai) * den;
}
constexpr int S5_X_LD = 136;
constexpr int S5_X_OFF = 0, S5_E_OFF = 128 * S5_X_LD * 2;
#define LDS_BARRIER() do { asm volatile("s_waitcnt lgkmcnt(0)" ::: "memory"); __builtin_amdgcn_s_barrier(); asm volatile("" ::: "memory"); } while (0)
#define CMAC_R(ar, ai, br, bi, cr) fmaf((ar), (br), fmaf(-(ai), (bi), (cr)))
#define CMAC_I(ar, ai, br, bi, ci) fmaf((ar), (bi), fmaf((ai), (br), (ci)))
#define CMUL_R(ar, ai, br, bi) ((ar) * (br) - (ai) * (bi))
#define CMUL_I(ar, ai, br, bi) ((ar) * (bi) + (ai) * (br))
__device__ __forceinline__ void s5_item(const Args& a, LAS unsigned char* lds, int item, int wave, int lane) {
    const int b = item >> 5, g = item & 31;
    const float dt = expf(a.in[I_LOGDT][g]);
    LAS bf16* X = (LAS bf16*)(lds + S5_X_OFF); LAS float* E = (LAS float*)(lds + S5_E_OFF);
    const int mt = wave >> 1, sh = wave & 1, l32 = lane & 31, hf = lane >> 5, p = 32 * sh + l32;
    float a1r, a1i, cr, ci; s5_disc(a.in[I_ARE], a.in[I_AIM], dt, g * 64 + p, a1r, a1i, cr, ci);
    const float a2r = CMUL_R(a1r, a1i, a1r, a1i), a2i = CMUL_I(a1r, a1i, a1r, a1i), a3r = CMUL_R(a2r, a2i, a1r, a1i), a3i = CMUL_I(a2r, a2i, a1r, a1i);
    const float a4r = CMUL_R(a2r, a2i, a2r, a2i), a4i = CMUL_I(a2r, a2i, a2r, a2i), a8r = CMUL_R(a4r, a4i, a4r, a4i), a8i = CMUL_I(a4r, a4i, a4r, a4i);
    const float a12r = CMUL_R(a8r, a8i, a4r, a4i), a12i = CMUL_I(a8r, a8i, a4r, a4i), a16r = CMUL_R(a8r, a8i, a8r, a8i), a16i = CMUL_I(a8r, a8i, a8r, a8i);
    const float a20r = CMUL_R(a16r, a16i, a4r, a4i), a20i = CMUL_I(a16r, a16i, a4r, a4i), a24r = CMUL_R(a16r, a16i, a8r, a8i), a24i = CMUL_I(a16r, a16i, a8r, a8i);
    const float a28r = CMUL_R(a24r, a24i, a4r, a4i), a28i = CMUL_I(a24r, a24i, a4r, a4i), a32r = CMUL_R(a16r, a16i, a16r, a16i), a32i = CMUL_I(a16r, a16i, a16r, a16i);
    const float pwr[4] = {a1r, a2r, a3r, a4r}, pwi[4] = {a1i, a2i, a3i, a4i};
    const float qkr[4] = {hf ? a4r : 1.0f, hf ? a12r : a8r, hf ? a20r : a16r, hf ? a28r : a24r}, qki[4] = {hf ? a4i : 0.0f, hf ? a12i : a8i, hf ? a20i : a16i, hf ? a28i : a24i};
    bf16x8 bfr_re, bfr_im;
    { const float* br = a.in[I_BRE] + (size_t)(g * 64 + p) * 16 + 8 * hf; const float* bi = a.in[I_BIM] + (size_t)(g * 64 + p) * 16 + 8 * hf;
      float vr[8], vi[8];
#pragma unroll
      for (int j = 0; j < 8; ++j) { vr[j] = cr * br[j] - ci * bi[j]; vi[j] = cr * bi[j] + ci * br[j]; }
      v4u o; o.x = pk2(vr[0], vr[1]); o.y = pk2(vr[2], vr[3]); o.z = pk2(vr[4], vr[5]); o.w = pk2(vr[6], vr[7]); bfr_re = __builtin_bit_cast(bf16x8, o);
      o.x = pk2(vi[0], vi[1]); o.y = pk2(vi[2], vi[3]); o.z = pk2(vi[4], vi[5]); o.w = pk2(vi[6], vi[7]); bfr_im = __builtin_bit_cast(bf16x8, o); }
    const int l16 = lane & 15, q4 = lane >> 4;
    bf16x8 cm[4];
#pragma unroll
    for (int ks = 0; ks < 4; ++ks) { const int s0 = 16 * ks + 4 * q4; const float* cre = a.in[I_CRE] + (size_t)(g * 16 + l16) * 64 + s0; const float* cim = a.in[I_CIM] + (size_t)(g * 16 + l16) * 64 + s0;
        v4u o; o.x = pk2(cre[0], -cim[0]); o.y = pk2(cre[1], -cim[1]); o.z = pk2(cre[2], -cim[2]); o.w = pk2(cre[3], -cim[3]); cm[ks] = __builtin_bit_cast(bf16x8, o); }
    float dsk[4];
#pragma unroll
    for (int r = 0; r < 4; ++r) dsk[r] = a.in[I_D][g * 16 + 4 * q4 + r];
    const bf16* ZS = (const bf16*)(a.ws + WS_ZS) + ((size_t)(b * 32 + g) * 8192) * 16;
    bf16* YS = (bf16*)(a.ws + WS_YS) + (size_t)b * 8192 * 512 + g * 16;
    float xinr = 0.f, xini = 0.f;
    bf16x8 ua_n = *(const bf16x8*)(ZS + (mt * 32 + l32) * 16 + hf * 8);
    v2u uu_n = *(const v2u*)(ZS + (16 * wave + l16) * 16 + 4 * q4);
    for (int ch = 0; ch < 64; ++ch) {
        const bf16x8 ua = ua_n; const v2u uu = uu_n;
        { const int cn = ch < 63 ? ch + 1 : 63; const bf16* zn = ZS + (size_t)cn * 128 * 16;
          ua_n = *(const bf16x8*)(zn + (mt * 32 + l32) * 16 + hf * 8); uu_n = *(const v2u*)(zn + (16 * wave + l16) * 16 + 4 * q4); }
        const f32x16 z16 = {0.f, 0.f, 0.f, 0.f, 0.f, 0.f, 0.f, 0.f, 0.f, 0.f, 0.f, 0.f, 0.f, 0.f, 0.f, 0.f};
        const f32x16 bre = __builtin_amdgcn_mfma_f32_32x32x16_bf16(ua, bfr_re, z16, 0, 0, 0), bim = __builtin_amdgcn_mfma_f32_32x32x16_bf16(ua, bfr_im, z16, 0, 0, 0);
        float xr[16], xi[16];
#pragma unroll
        for (int j = 0; j < 4; ++j) { xr[4 * j] = bre[4 * j]; xi[4 * j] = bim[4 * j];
#pragma unroll
            for (int i = 1; i < 4; ++i) { xr[4 * j + i] = CMAC_R(a1r, a1i, xr[4 * j + i - 1], xi[4 * j + i - 1], bre[4 * j + i]); xi[4 * j + i] = CMAC_I(a1r, a1i, xr[4 * j + i - 1], xi[4 * j + i - 1], bim[4 * j + i]); } }
        float clr[4], cli[4], ber, bei;
        { float pgr[4], pgi[4];
#pragma unroll
          for (int j = 0; j < 4; ++j) { pgr[j] = __shfl_xor(xr[4 * j + 3], 32); pgi[j] = __shfl_xor(xi[4 * j + 3], 32); }
          float cr_ = 0.f, ci_ = 0.f;
#pragma unroll
          for (int k = 0; k < 8; ++k) { const int j = k >> 1; const bool mine = (hf == (k & 1));
              if ((k & 1) == 0) { clr[j] = cr_; cli[j] = ci_; } else { clr[j] = mine ? cr_ : clr[j]; cli[j] = mine ? ci_ : cli[j]; }
              const float gr = mine ? xr[4 * j + 3] : pgr[j], gi = mine ? xi[4 * j + 3] : pgi[j];
              const float nr = CMAC_R(a4r, a4i, cr_, ci_, gr), ni = CMAC_I(a4r, a4i, cr_, ci_, gi); cr_ = nr; ci_ = ni; }
          ber = cr_; bei = ci_; }
        if (hf == 0) { E[(mt * 64 + p) * 2] = ber; E[(mt * 64 + p) * 2 + 1] = bei; }
        LDS_BARRIER();
        float mbr = 0.f, mbi = 0.f;
        { float cr_ = xinr, ci_ = xini;
#pragma unroll
          for (int m = 0; m < 4; ++m) { if (m == mt) { mbr = cr_; mbi = ci_; } const float er = E[(m * 64 + p) * 2], ei = E[(m * 64 + p) * 2 + 1];
              const float nr = CMAC_R(a32r, a32i, cr_, ci_, er), ni = CMAC_I(a32r, a32i, cr_, ci_, ei); cr_ = nr; ci_ = ni; }
          xinr = cr_; xini = ci_; }
#pragma unroll
        for (int j = 0; j < 4; ++j) { const float ckr = CMAC_R(qkr[j], qki[j], mbr, mbi, clr[j]), cki = CMAC_I(qkr[j], qki[j], mbr, mbi, cli[j]);
#pragma unroll
            for (int i = 0; i < 4; ++i) { const float fr = CMAC_R(pwr[i], pwi[i], ckr, cki, xr[4 * j + i]), fi = CMAC_I(pwr[i], pwi[i], ckr, cki, xi[4 * j + i]);
                *(LAS unsigned*)(X + (32 * mt + 8 * j + 4 * hf + i) * S5_X_LD + 2 * p) = pg8::cvt_pk_bf16(fr, fi); } }
        LDS_BARRIER();
        { f32x4 o = {0.f, 0.f, 0.f, 0.f};
#pragma unroll
          for (int ks = 0; ks < 4; ++ks) { const bf16x8 xa = *(const LAS bf16x8*)(X + (16 * wave + l16) * S5_X_LD + 32 * ks + 8 * q4); o = __builtin_amdgcn_mfma_f32_16x16x32_bf16(cm[ks], xa, o, 0, 0, 0); }
          const int t = 16 * wave + l16;
          const float y0 = gelu_t(o[0] + dsk[0] * bflo(uu.x)), y1 = gelu_t(o[1] + dsk[1] * bfhi(uu.x)), y2 = gelu_t(o[2] + dsk[2] * bflo(uu.y)), y3 = gelu_t(o[3] + dsk[3] * bfhi(uu.y));
          v2u w; w.x = pg8::cvt_pk_bf16(y0, y1); w.y = pg8::cvt_pk_bf16(y2, y3); *(v2u*)(YS + (size_t)(ch * 128 + t) * 512 + 4 * q4) = w; }
    }
    __syncthreads();
}

constexpr int SGU_RS = 1056;
typedef short v4i16_t __attribute__((ext_vector_type(4)));
__device__ __forceinline__ s16x4 ds_tr16(const LAS unsigned char* p) { return __builtin_bit_cast(s16x4, __builtin_amdgcn_ds_read_tr16_b64_v4i16((LAS v4i16_t*)p)); }
__device__ __forceinline__ void sgu_item(const Args& a, LAS unsigned char* lds, int item, int wave, int lane) {
    const bf16* ZG = (const bf16*)(a.ws + WS_ZG); bf16* Y = (bf16*)(a.ws + WS_Y); const bf16* WM = (const bf16*)(a.ws + WS_WM);
    const int r0 = item * 128;
    { float lg[8], lb[8];
#pragma unroll
      for (int j = 0; j < 8; ++j) { lg[j] = a.in[I_LNG][8 * lane + j]; lb[j] = a.in[I_LNB][8 * lane + j]; }
      v4u raw[16];
#pragma unroll
      for (int tt = 0; tt < 16; ++tt) raw[tt] = __builtin_nontemporal_load((const v4u*)(ZG + (size_t)(r0 + 16 * wave + tt) * 1024 + 512 + 8 * lane));
      float s1[16], s2[16];
#pragma unroll
      for (int tt = 0; tt < 16; ++tt) { const float f[8] = {bflo(raw[tt].x), bfhi(raw[tt].x), bflo(raw[tt].y), bfhi(raw[tt].y), bflo(raw[tt].z), bfhi(raw[tt].z), bflo(raw[tt].w), bfhi(raw[tt].w)};
          float a1 = 0.f, a2 = 0.f;
#pragma unroll
          for (int j = 0; j < 8; ++j) { a1 += f[j]; a2 += f[j] * f[j]; }
          s1[tt] = a1; s2[tt] = a2; }
#pragma unroll
      for (int o = 1; o < 64; o <<= 1) {
#pragma unroll
          for (int tt = 0; tt < 16; ++tt) { s1[tt] += __shfl_xor(s1[tt], o); s2[tt] += __shfl_xor(s2[tt], o); } }
#pragma unroll
      for (int tt = 0; tt < 16; ++tt) { const int t = 16 * wave + tt;
          float f[8] = {bflo(raw[tt].x), bfhi(raw[tt].x), bflo(raw[tt].y), bfhi(raw[tt].y), bflo(raw[tt].z), bfhi(raw[tt].z), bflo(raw[tt].w), bfhi(raw[tt].w)};
          const float mu = s1[tt] * (1.0f / 512.0f), var = fmaxf(s2[tt] * (1.0f / 512.0f) - mu * mu, 0.f), rstd = 1.0f / sqrtf(var + EPS);
#pragma unroll
          for (int j = 0; j < 8; ++j) f[j] = (f[j] - mu) * rstd * lg[j] + lb[j];
          v4u o; o.x = pk2(f[0], f[1]); o.y = pk2(f[2], f[3]); o.z = pk2(f[4], f[5]); o.w = pk2(f[6], f[7]);
          *(LAS v4u*)(lds + t * SGU_RS + 16 * lane) = o; } }
    __syncthreads();
    const int l16 = lane & 15, q4 = lane >> 4, qq = l16 >> 2, pp = l16 & 3, nks = (wave >> 1) + 1, irow = 16 * wave + l16;
    { bf16x8 wf[4]; v4u uq[4]; float bs; const float* bsp = a.in[I_BS] + irow;
      const unsigned char* zgb = (const unsigned char*)ZG + (size_t)r0 * 2048; unsigned char* yb = (unsigned char*)Y + (size_t)r0 * 2048; const unsigned char* wmb = (const unsigned char*)WM;
      const unsigned voz = (unsigned)irow * 2048u + (unsigned)q4 * 16u, vow = (unsigned)irow * 256u + (unsigned)q4 * 16u;
#define SGU_LOADH(h_) do { \
        _Pragma("unroll") for (int ks = 0; ks < 4; ++ks) { const int kc = ks < nks ? ks : nks - 1; wf[ks] = *(const bf16x8*)(wmb + (vow + (unsigned)((h_) * 32768 + 64 * kc))); } \
        _Pragma("unroll") for (int k = 0; k < 4; ++k) uq[k] = __builtin_nontemporal_load((const v4u*)(zgb + (voz + (unsigned)((h_) * 256 + 64 * k)))); \
        bs = bsp[(h_) * 128]; } while (0)
      SGU_LOADH(0);
#pragma unroll 1
      for (int h = 0; h < 4; ++h) {
        f32x4 acc[8];
#pragma unroll
        for (int nt = 0; nt < 8; ++nt) acc[nt] = (f32x4){0.f, 0.f, 0.f, 0.f};
#pragma unroll
        for (int ks = 0; ks < 4; ++ks) { if (ks < nks) {
            const LAS unsigned char* vb = lds + (32 * ks + 8 * q4 + qq) * SGU_RS + (h * 128 + 4 * pp) * 2;
#pragma unroll
            for (int nt = 0; nt < 8; ++nt) { const s16x4 lo = ds_tr16(vb + nt * 32), hi = ds_tr16(vb + nt * 32 + 4 * SGU_RS);
                const bf16x8 vf = {lo[0], lo[1], lo[2], lo[3], hi[0], hi[1], hi[2], hi[3]};
                acc[nt] = __builtin_amdgcn_mfma_f32_16x16x32_bf16(vf, wf[ks], acc[nt], 0, 0, 0); } } }
        v4u ov[4];
#pragma unroll
        for (int k = 0; k < 4; ++k) {
            ov[k].x = pk2(bflo(uq[k].x) * (acc[2 * k][0] + bs), bfhi(uq[k].x) * (acc[2 * k][1] + bs)); ov[k].y = pk2(bflo(uq[k].y) * (acc[2 * k][2] + bs), bfhi(uq[k].y) * (acc[2 * k][3] + bs));
            ov[k].z = pk2(bflo(uq[k].z) * (acc[2 * k + 1][0] + bs), bfhi(uq[k].z) * (acc[2 * k + 1][1] + bs)); ov[k].w = pk2(bflo(uq[k].w) * (acc[2 * k + 1][2] + bs), bfhi(uq[k].w) * (acc[2 * k + 1][3] + bs)); }
        if (h < 3) SGU_LOADH(h + 1);
#pragma unroll
        for (int k = 0; k < 4; ++k) *(v4u*)(yb + (voz + (unsigned)(h * 256 + 64 * k))) = ov[k];
      }
#undef SGU_LOADH
    }
    __syncthreads();
}
__device__ __forceinline__ int f2i(float f) { return __builtin_bit_cast(int, f); }
__device__ __forceinline__ float i2f(int i) { return __builtin_bit_cast(float, i); }
__device__ __forceinline__ float kmax(float a, float b) { float r; asm("v_max_f32 %0, %1, %2" : "=v"(r) : "v"(a), "v"(b)); return r; }
__device__ __forceinline__ float kmin(float a, float b) { float r; asm("v_min_f32 %0, %1, %2" : "=v"(r) : "v"(a), "v"(b)); return r; }
__device__ __forceinline__ float mkkey(float s, int keep, int payload) { return i2f((f2i(s) & keep) | payload); }
__device__ __forceinline__ void sort16(float (&v)[16]) {
#define CE16(i, j) { const float x_ = v[i], y_ = v[j]; v[i] = kmax(x_, y_); v[j] = kmin(x_, y_); }
    CE16(0,1) CE16(2,3) CE16(0,2) CE16(1,3) CE16(1,2) CE16(4,5) CE16(6,7) CE16(4,6) CE16(5,7) CE16(5,6) CE16(0,4) CE16(2,6) CE16(2,4) CE16(1,5) CE16(3,7) CE16(3,5) CE16(1,2) CE16(3,4) CE16(5,6) CE16(8,9) CE16(10,11) CE16(8,10) CE16(9,11) CE16(9,10) CE16(12,13) CE16(14,15) CE16(12,14) CE16(13,15) CE16(13,14) CE16(8,12) CE16(10,14) CE16(10,12) CE16(9,13) CE16(11,15) CE16(11,13) CE16(9,10) CE16(11,12) CE16(13,14) CE16(0,8) CE16(4,12) CE16(4,8) CE16(2,10) CE16(6,14) CE16(6,10) CE16(2,4) CE16(6,8) CE16(10,12) CE16(1,9) CE16(5,13) CE16(5,9) CE16(3,11) CE16(7,15) CE16(7,11) CE16(3,5) CE16(7,9) CE16(11,13) CE16(1,2) CE16(3,4) CE16(5,6) CE16(7,8) CE16(9,10) CE16(11,12) CE16(13,14)
#undef CE16
}
__device__ __forceinline__ void merge16(float (&a)[16], const float (&b)[16]) {
#pragma unroll
    for (int i = 0; i < 16; ++i) a[i] = kmax(a[i], b[15 - i]);
#pragma unroll
    for (int j = 8; j > 0; j >>= 1)
#pragma unroll
        for (int i = 0; i < 16; ++i) { const int l = i ^ j; if (l > i) { const float x = a[i], y = a[l]; a[i] = kmax(x, y); a[l] = kmin(x, y); } }
}
constexpr int NCAND = 50;
constexpr int cand_a(int n) { int c = 0; for (int a = 0; a < 16; ++a) for (int b = 0; b < 16; ++b) if ((a + 1) * (b + 1) <= 16) { if (c == n) return a; ++c; } return 0; }
constexpr int cand_b(int n) { int c = 0; for (int a = 0; a < 16; ++a) for (int b = 0; b < 16; ++b) if ((a + 1) * (b + 1) <= 16) { if (c == n) return b; ++c; } return 0; }
template <int N> struct CandAB { static constexpr int a = cand_a(N), b = cand_b(N); };
template <int S> __device__ __forceinline__ float cand_key2(const float (&f1)[16], const float (&f2)[16], bool hf) {
    if constexpr (S < 25) { constexpr int a0 = CandAB<S>::a, b0 = CandAB<S>::b, a1 = CandAB<25 + S>::a, b1 = CandAB<25 + S>::b;
        const float s = (hf ? f1[a1] : f1[a0]) + (hf ? f2[b1] : f2[b0]); return mkkey(s, ~0xff, hf ? ((a1 << 4) | b1) : ((a0 << 4) | b0)); }
    else return i2f((int)0xff800000);
}
template <int G> __device__ __forceinline__ void cand_fill2(float (&v)[16], const float (&f1)[16], const float (&f2)[16], bool hf) {
    v[0] = cand_key2<G * 16 + 0>(f1, f2, hf); v[1] = cand_key2<G * 16 + 1>(f1, f2, hf); v[2] = cand_key2<G * 16 + 2>(f1, f2, hf); v[3] = cand_key2<G * 16 + 3>(f1, f2, hf);
    v[4] = cand_key2<G * 16 + 4>(f1, f2, hf); v[5] = cand_key2<G * 16 + 5>(f1, f2, hf); v[6] = cand_key2<G * 16 + 6>(f1, f2, hf); v[7] = cand_key2<G * 16 + 7>(f1, f2, hf);
    v[8] = cand_key2<G * 16 + 8>(f1, f2, hf); v[9] = cand_key2<G * 16 + 9>(f1, f2, hf); v[10] = cand_key2<G * 16 + 10>(f1, f2, hf); v[11] = cand_key2<G * 16 + 11>(f1, f2, hf);
    v[12] = cand_key2<G * 16 + 12>(f1, f2, hf); v[13] = cand_key2<G * 16 + 13>(f1, f2, hf); v[14] = cand_key2<G * 16 + 14>(f1, f2, hf); v[15] = cand_key2<G * 16 + 15>(f1, f2, hf);
}

__device__ __forceinline__ void peer_topk32(const bf16* Q, const bf16* KEYS, unsigned short* EO, bf16* GO, LAS unsigned char* wl  , LAS unsigned char* stg  , int tok0, int lane) {
    const int l32 = lane & 31, hf = lane >> 5; const size_t tok = (size_t)tok0 + l32;
    const bf16* qrow = Q + tok * 1024 + hf * 8; const bf16* krow = KEYS + (size_t)l32 * 64 + hf * 8;
    bf16x8 bq[4], bqn[4], akn[4];
#pragma unroll
    for (int ks = 0; ks < 4; ++ks) { bq[ks] = __builtin_nontemporal_load((const bf16x8*)(qrow + ks * 16)); akn[ks] = *(const bf16x8*)(krow + ks * 16); }
    for (int h = 0; h < 8; ++h) {
        float L0[16], L1[16];
#pragma unroll
        for (int c = 0; c < 2; ++c) {
            const int hc = 2 * h + c, hn = hc < 15 ? hc + 1 : 15;
#pragma unroll
            for (int ks = 0; ks < 4; ++ks) bqn[ks] = __builtin_nontemporal_load((const bf16x8*)(qrow + hn * 64 + ks * 16));
            float T[16], S[16];
            { f32x16 acc = (f32x16){0.f, 0.f, 0.f, 0.f, 0.f, 0.f, 0.f, 0.f, 0.f, 0.f, 0.f, 0.f, 0.f, 0.f, 0.f, 0.f};
              const bf16x8 ak0 = akn[0], ak1 = akn[1], ak2 = akn[2], ak3 = akn[3];
              { const bf16* kn = krow + (size_t)(hc * 4 + 1) * (32 * 64);
#pragma unroll
                for (int ks = 0; ks < 4; ++ks) akn[ks] = *(const bf16x8*)(kn + ks * 16); }
              acc = __builtin_amdgcn_mfma_f32_32x32x16_bf16(ak0, bq[0], acc, 0, 0, 0); acc = __builtin_amdgcn_mfma_f32_32x32x16_bf16(ak1, bq[1], acc, 0, 0, 0);
              acc = __builtin_amdgcn_mfma_f32_32x32x16_bf16(ak2, bq[2], acc, 0, 0, 0); acc = __builtin_amdgcn_mfma_f32_32x32x16_bf16(ak3, bq[3], acc, 0, 0, 0);
#pragma unroll
              for (int r = 0; r < 16; ++r) T[r] = mkkey(acc[r], ~0x7f, 8 * (r >> 2) + 4 * hf + (r & 3));
              sort16(T); }
            for (int mt = 1; mt < 4; ++mt) {
                f32x16 acc = (f32x16){0.f, 0.f, 0.f, 0.f, 0.f, 0.f, 0.f, 0.f, 0.f, 0.f, 0.f, 0.f, 0.f, 0.f, 0.f, 0.f};
                const bf16x8 ak0 = akn[0], ak1 = akn[1], ak2 = akn[2], ak3 = akn[3];
                { const int tn = hc * 4 + mt + 1; const bf16* kn = krow + (size_t)(tn < 64 ? tn : 63) * (32 * 64);
#pragma unroll
                  for (int ks = 0; ks < 4; ++ks) akn[ks] = *(const bf16x8*)(kn + ks * 16); }
                acc = __builtin_amdgcn_mfma_f32_32x32x16_bf16(ak0, bq[0], acc, 0, 0, 0); acc = __builtin_amdgcn_mfma_f32_32x32x16_bf16(ak1, bq[1], acc, 0, 0, 0);
                acc = __builtin_amdgcn_mfma_f32_32x32x16_bf16(ak2, bq[2], acc, 0, 0, 0); acc = __builtin_amdgcn_mfma_f32_32x32x16_bf16(ak3, bq[3], acc, 0, 0, 0);
#pragma unroll
                for (int r = 0; r < 16; ++r) S[r] = mkkey(acc[r], ~0x7f, mt * 32 + 8 * (r >> 2) + 4 * hf + (r & 3));
                sort16(S); merge16(T, S); }
#pragma unroll
            for (int ks = 0; ks < 4; ++ks) bq[ks] = bqn[ks];
#pragma unroll
            for (int r = 0; r < 16; ++r) S[r] = __shfl_xor(T[r], 32);
            merge16(T, S);
            if (c == 0) {
#pragma unroll
                for (int r = 0; r < 16; ++r) L0[r] = T[r];
            } else {
#pragma unroll
                for (int r = 0; r < 16; ++r) L1[r] = T[r];
            }
        }
        float f1[16], f2[16];
#pragma unroll
        for (int r = 0; r < 16; ++r) { const int k0 = f2i(L0[r]), k1 = f2i(L1[r]); f1[r] = i2f(k0 & ~0x7f); f2[r] = i2f(k1 & ~0x7f); wl[lane * 36 + r] = (unsigned char)(k0 & 0x7f); wl[lane * 36 + 16 + r] = (unsigned char)(k1 & 0x7f); }
        float K[16], S2[16];
        cand_fill2<0>(K, f1, f2, hf != 0); sort16(K);
        cand_fill2<1>(S2, f1, f2, hf != 0); sort16(S2); merge16(K, S2);
#pragma unroll
        for (int r = 0; r < 16; ++r) S2[r] = __shfl_xor(K[r], 32);
        merge16(K, S2);
        float pe[16], ssum = 0.f; const float mx = i2f(f2i(K[0]) & ~0xff);
#pragma unroll
        for (int r = 0; r < 16; ++r) { pe[r] = __expf(i2f(f2i(K[r]) & ~0xff) - mx); ssum += pe[r]; }
        const float inv = 1.0f / ssum;
        int ev[16]; float gv[16];
#pragma unroll
        for (int j = 0; j < 16; ++j) { const int ab = f2i(K[j]) & 0xff; const int i1 = wl[lane * 36 + (ab >> 4)], i2 = wl[lane * 36 + 16 + (ab & 15)]; ev[j] = i1 * 128 + i2; gv[j] = pe[j] * inv; }
        { const v4u e0 = {(unsigned)ev[0] | ((unsigned)ev[1] << 16), (unsigned)ev[2] | ((unsigned)ev[3] << 16), (unsigned)ev[4] | ((unsigned)ev[5] << 16), (unsigned)ev[6] | ((unsigned)ev[7] << 16)};
          const v4u e1 = {(unsigned)ev[8] | ((unsigned)ev[9] << 16), (unsigned)ev[10] | ((unsigned)ev[11] << 16), (unsigned)ev[12] | ((unsigned)ev[13] << 16), (unsigned)ev[14] | ((unsigned)ev[15] << 16)};
          const v4u g0 = {pk2(gv[0], gv[1]), pk2(gv[2], gv[3]), pk2(gv[4], gv[5]), pk2(gv[6], gv[7])}, g1 = {pk2(gv[8], gv[9]), pk2(gv[10], gv[11]), pk2(gv[12], gv[13]), pk2(gv[14], gv[15])};
          LAS unsigned char* sp = stg + hf * (32 * 272) + l32 * 272 + h * 32;
          *(LAS v4u*)sp = hf ? g0 : e0; *(LAS v4u*)(sp + 16) = hf ? g1 : e1; }
    }
#pragma unroll
    for (int q = 0; q < 8; ++q) { const int t = 4 * q + (lane >> 4), pc = (lane & 15) * 16;
        const v4u ve = *(const LAS v4u*)(stg + t * 272 + pc), vg = *(const LAS v4u*)(stg + 32 * 272 + t * 272 + pc);
        *(v4u*)((unsigned char*)(EO + ((size_t)tok0 + t) * 128) + pc) = ve; *(v4u*)((unsigned char*)(GO + ((size_t)tok0 + t) * 128) + pc) = vg; }
}

typedef float f32x2_t __attribute__((ext_vector_type(2)));
typedef _Float16 h2_t __attribute__((ext_vector_type(2)));
__device__ __forceinline__ h2_t as_h2(unsigned u) { return __builtin_bit_cast(h2_t, u); }
template <bool HI> __device__ __forceinline__ h2_t cvt_h2_fp8(unsigned d) { const auto t = __builtin_amdgcn_cvt_scalef32_pk_f16_fp8((int)d, 1.0f, HI); return __builtin_bit_cast(h2_t, t); }
typedef int v4i __attribute__((ext_vector_type(4)));
__device__ __forceinline__ void cvt8x2(v4u r, f32x2_t (&f)[8]) {
    const unsigned w0 = r.x, w1 = r.y, w2 = r.z, w3 = r.w;
    f[0] = __builtin_amdgcn_cvt_pk_f32_fp8((int)w0, false); f[1] = __builtin_amdgcn_cvt_pk_f32_fp8((int)w0, true);
    f[2] = __builtin_amdgcn_cvt_pk_f32_fp8((int)w1, false); f[3] = __builtin_amdgcn_cvt_pk_f32_fp8((int)w1, true);
    f[4] = __builtin_amdgcn_cvt_pk_f32_fp8((int)w2, false); f[5] = __builtin_amdgcn_cvt_pk_f32_fp8((int)w2, true);
    f[6] = __builtin_amdgcn_cvt_pk_f32_fp8((int)w3, false); f[7] = __builtin_amdgcn_cvt_pk_f32_fp8((int)w3, true);
}
__device__ __forceinline__ void load_elist(const unsigned short* E, size_t tok, int h, int (&e)[16]) {
    const v4u* ep = (const v4u*)(E + tok * 128 + h * 16);
#pragma unroll
    for (int i = 0; i < 2; ++i) { const v4u v = ep[i]; const unsigned w[4] = {v.x, v.y, v.z, v.w};
#pragma unroll
        for (int c = 0; c < 4; ++c) { e[8 * i + 2 * c] = (int)(w[c] & 0xffffu); e[8 * i + 2 * c + 1] = (int)(w[c] >> 16); } }
}
__device__ __forceinline__ void issue_rows(v4u (&r)[16], const unsigned char* tb, unsigned poff, const int (&e)[16]) {
#pragma unroll
    for (int k = 0; k < 16; ++k) r[k] = *(const v4u*)(tb + ((unsigned)e[k] * 128u + poff));
}
template <int B2, int B1, int B0> __device__ __forceinline__ void treduce16(const float (&v)[16], int lane, float& o0, float& o1) {
    float q8[8], q4[4];
    { const bool hi = (lane & B2) != 0;
#pragma unroll
      for (int i = 0; i < 8; ++i) { const float keep = hi ? v[i + 8] : v[i], send = hi ? v[i] : v[i + 8]; q8[i] = keep + __shfl_xor(send, B2); } }
    { const bool hi = (lane & B1) != 0;
#pragma unroll
      for (int i = 0; i < 4; ++i) { const float keep = hi ? q8[i + 4] : q8[i], send = hi ? q8[i] : q8[i + 4]; q4[i] = keep + __shfl_xor(send, B1); } }
    { const bool hi = (lane & B0) != 0;
      { const float keep = hi ? q4[2] : q4[0], send = hi ? q4[0] : q4[2]; o0 = keep + __shfl_xor(send, B0); }
      { const float keep = hi ? q4[3] : q4[1], send = hi ? q4[1] : q4[3]; o1 = keep + __shfl_xor(send, B0); } }
}
__device__ __forceinline__ void treduce16i_p(const int (&v)[16], int lane, int& o0, int& o1) {
    int q8[8], q4[4];
    { const bool hi = (lane & 4) != 0;
#pragma unroll
      for (int i = 0; i < 8; ++i) { const int keep = hi ? v[i + 8] : v[i], send = hi ? v[i] : v[i + 8]; q8[i] = keep + __builtin_amdgcn_update_dpp(0, send, 0x141, 0xF, 0xF, false); } }
    { const bool hi = (lane & 2) != 0;
#pragma unroll
      for (int i = 0; i < 4; ++i) { const int keep = hi ? q8[i + 4] : q8[i], send = hi ? q8[i] : q8[i + 4]; q4[i] = keep + __builtin_amdgcn_update_dpp(0, send, 0x4E, 0xF, 0xF, false); } }
    { const bool hi = (lane & 1) != 0;
      { const int keep = hi ? q4[2] : q4[0], send = hi ? q4[0] : q4[2]; o0 = keep + __builtin_amdgcn_update_dpp(0, send, 0xB1, 0xF, 0xF, false); }
      { const int keep = hi ? q4[3] : q4[1], send = hi ? q4[1] : q4[3]; o1 = keep + __builtin_amdgcn_update_dpp(0, send, 0xB1, 0xF, 0xF, false); } }
}
__device__ __forceinline__ void treduce16f_h(const float (&v)[16], int lane, float& o0, float& o1) {
    float q8[8], q4[4];
    { const bool hi = (lane & 8) != 0;
#pragma unroll
      for (int i = 0; i < 8; ++i) { const float keep = hi ? v[i + 8] : v[i], send = hi ? v[i] : v[i + 8];
          q8[i] = keep + __builtin_bit_cast(float, __builtin_amdgcn_update_dpp(0, __builtin_bit_cast(int, send), 0x128, 0xF, 0xF, false)); } }
    { const bool hi = (lane & 16) != 0;
#pragma unroll
      for (int i = 0; i < 4; ++i) { const float keep = hi ? q8[i + 4] : q8[i], send = hi ? q8[i] : q8[i + 4];
          q4[i] = keep + __builtin_bit_cast(float, __builtin_amdgcn_ds_swizzle(__builtin_bit_cast(int, send), 0x401F)); } }
    { const bool hi = (lane & 32) != 0;
      { const float keep = hi ? q4[2] : q4[0], send = hi ? q4[0] : q4[2]; o0 = keep + __shfl_xor(send, 32); }
      { const float keep = hi ? q4[3] : q4[1], send = hi ? q4[1] : q4[3]; o1 = keep + __shfl_xor(send, 32); } }
}
__device__ __forceinline__ void upass_compute(const v4u (&r)[16], v4u hq, short* pa, int lane, v4u (&rn)[16], const unsigned char* tb, unsigned poff, const int (&en)[16]) {
    int part[16];
#pragma unroll
    for (int k = 0; k < 16; ++k) { rn[k] = *(const v4u*)(tb + ((unsigned)en[k] * 128u + poff));
        int s = __builtin_amdgcn_sdot4((int)r[k].x, (int)hq.x, 0, false); s = __builtin_amdgcn_sdot4((int)r[k].y, (int)hq.y, s, false); s = __builtin_amdgcn_sdot4((int)r[k].z, (int)hq.z, s, false); part[k] = __builtin_amdgcn_sdot4((int)r[k].w, (int)hq.w, s, false);
        __builtin_amdgcn_sched_barrier(0); }
    int o0, o1; treduce16i_p(part, lane, o0, o1);
    *(unsigned*)(pa + (lane >> 3) * 16 + 2 * (lane & 7)) = (unsigned)(((o0 + 32) >> 6) & 0xffff) | ((unsigned)((o1 + 32) >> 6) << 16);
}
__device__ __forceinline__ void vpass_compute(const v4u (&r)[16], const v4u (&wp)[2], bf16* xo  , const float* gt  , int lane, v4u (&rn)[16], const unsigned char* tb, unsigned poff, const int (&en)[16]) {
    h2_t o2[8];
#pragma unroll
    for (int i = 0; i < 8; ++i) o2[i] = (h2_t){(_Float16)0.f, (_Float16)0.f};
    const unsigned wq[8] = {wp[0].x, wp[0].y, wp[0].z, wp[0].w, wp[1].x, wp[1].y, wp[1].z, wp[1].w};
#pragma unroll
    for (int k = 0; k < 16; ++k) { rn[k] = *(const v4u*)(tb + ((unsigned)en[k] * 128u + poff));
        const unsigned d0 = r[k].x, d1 = r[k].y, d2 = r[k].z, d3 = r[k].w; const h2_t wpair = as_h2(wq[k >> 1]); const _Float16 wh = (k & 1) ? wpair.y : wpair.x; const h2_t ww = {wh, wh};
        o2[0] = __builtin_elementwise_fma(cvt_h2_fp8<false>(d0), ww, o2[0]); o2[1] = __builtin_elementwise_fma(cvt_h2_fp8<true>(d0), ww, o2[1]);
        o2[2] = __builtin_elementwise_fma(cvt_h2_fp8<false>(d1), ww, o2[2]); o2[3] = __builtin_elementwise_fma(cvt_h2_fp8<true>(d1), ww, o2[3]);
        o2[4] = __builtin_elementwise_fma(cvt_h2_fp8<false>(d2), ww, o2[4]); o2[5] = __builtin_elementwise_fma(cvt_h2_fp8<true>(d2), ww, o2[5]);
        o2[6] = __builtin_elementwise_fma(cvt_h2_fp8<false>(d3), ww, o2[6]); o2[7] = __builtin_elementwise_fma(cvt_h2_fp8<true>(d3), ww, o2[7]);
        __builtin_amdgcn_sched_barrier(0); }
    float v[16];
#pragma unroll
    for (int i = 0; i < 8; ++i) { v[2 * i] = (float)o2[i].x * (1.0f / 64.0f); v[2 * i + 1] = (float)o2[i].y * (1.0f / 64.0f); }
    float o0, o1; treduce16f_h(v, lane, o0, o1);
    const int c = 16 * (lane & 7) + 2 * (((lane >> 1) & 4) | ((lane >> 3) & 2) | ((lane >> 5) & 1));
    const unsigned xb = *(const unsigned*)(xo + c); const f32x2_t g = *(const f32x2_t*)(gt + c);
    const float a0 = bflo(xb) + g.x * o0, a1 = bfhi(xb) + g.y * o1;
    const unsigned ob = pk2(a0, a1);
    *(unsigned*)(xo + c) = ob;
}
template <bool UP> __device__ __forceinline__ void peer_pass(const Args& a, int wave, int lane_in) {
    int lane = lane_in; asm volatile("" : "+v"(lane));
    const int G = gridDim.x, bx = blockIdx.x;
    const bool sliced = (G % 8) == 0;
    const int nj = sliced ? 1 : 8, j0 = sliced ? (bx & 7) : 0;
    const int first = sliced ? ((bx >> 3) * NWAVES + wave) : (bx * NWAVES + wave), stride = sliced ? (G >> 3) * NWAVES : G * NWAVES;
    const int h = lane >> 3, p = lane & 7;
    const unsigned short* E = (const unsigned short*)(a.ws + WS_E); const unsigned char* HQ = a.ws + WS_H2Q; const _Float16* W = (const _Float16*)(a.ws + WS_W);
    short* PA = (short*)(a.ws + WS_PA); const float* MOD = (const float*)(a.ws + WS_MOD);
    const unsigned char* T8 = a.ws + (UP ? WS_UB : WS_VB);
    const int ntok = (M - first + stride - 1) / stride;
    for (int jj = 0; jj < nj; ++jj) { const int j = j0 + jj;
        const unsigned char* tb = T8 + (size_t)j * (16384 * 128);
        v4u RA[16], RB[16]; int en[16], en2[16];
        v4u hA0, hB0; v4u wA[2], wB[2];
        { const size_t t0 = (size_t)first; int e0[16]; load_elist(E, t0, h, e0); issue_rows(RA, tb, 16u * p, e0);
          if (UP) { hA0 = *(const v4u*)(HQ + t0 * 1024 + 128 * j + 16 * p); }
          else { wA[0] = *(const v4u*)(W + t0 * 128 + h * 16); wA[1] = *(const v4u*)(W + t0 * 128 + h * 16 + 8); }
          const size_t t1 = (size_t)first + (size_t)(ntok > 1 ? 1 : 0) * stride; load_elist(E, t1, h, en); }
        for (int u = 0; u < ntok; u += 2) {
            { const int u1 = (u + 1 < ntok) ? u + 1 : ntok - 1, u2 = (u + 2 < ntok) ? u + 2 : ntok - 1; const size_t t1 = (size_t)first + (size_t)u1 * stride, t2 = (size_t)first + (size_t)u2 * stride;
              load_elist(E, t2, h, en2);
              if (UP) { hB0 = *(const v4u*)(HQ + t1 * 1024 + 128 * j + 16 * p); }
              else { wB[0] = *(const v4u*)(W + t1 * 128 + h * 16); wB[1] = *(const v4u*)(W + t1 * 128 + h * 16 + 8); }
              const size_t t = (size_t)first + (size_t)u * stride;
              if (UP) upass_compute(RA, hA0, PA + ((size_t)j * M + t) * 128, lane, RB, tb, 16u * p, en);
              else vpass_compute(RA, wA, (bf16*)(a.ws + WS_X1B) + t * 1024 + 128 * j, MOD + (t >> 13) * NMODC + 5120 + 128 * j, lane, RB, tb, 16u * p, en); }
            if (u + 1 >= ntok) break;
            { const int u1 = (u + 2 < ntok) ? u + 2 : ntok - 1, u2 = (u + 3 < ntok) ? u + 3 : ntok - 1; const size_t t1 = (size_t)first + (size_t)u1 * stride, t2 = (size_t)first + (size_t)u2 * stride;
              load_elist(E, t2, h, en);
              if (UP) { hA0 = *(const v4u*)(HQ + t1 * 1024 + 128 * j + 16 * p); }
              else { wA[0] = *(const v4u*)(W + t1 * 128 + h * 16); wA[1] = *(const v4u*)(W + t1 * 128 + h * 16 + 8); }
              const size_t t = (size_t)first + (size_t)(u + 1) * stride;
              if (UP) upass_compute(RB, hB0, PA + ((size_t)j * M + t) * 128, lane, RA, tb, 16u * p, en2);
              else vpass_compute(RB, wB, (bf16*)(a.ws + WS_X1B) + t * 1024 + 128 * j, MOD + (t >> 13) * NMODC + 5120 + 128 * j, lane, RA, tb, 16u * p, en2); }
        }
    }
}
__device__ __forceinline__ void upass4(const Args& a, int wave, int lane_in) {
    int lane = lane_in; asm volatile("" : "+v"(lane));
    const int G = gridDim.x, bx = blockIdx.x;
    const bool sliced = (G % 8) == 0;
    const int nj = sliced ? 1 : 8, j0 = sliced ? (bx & 7) : 0;
    const int first = sliced ? ((bx >> 3) * NWAVES + wave) : (bx * NWAVES + wave), stride = sliced ? (G >> 3) * NWAVES : G * NWAVES;
    const int r = lane >> 2, p = lane & 3;
    const unsigned short* E = (const unsigned short*)(a.ws + WS_E); const unsigned char* HQh = a.ws + WS_H2Q; const unsigned char* HQl = a.ws + WS_H2Q + (size_t)32 * MiB; short* PA = (short*)(a.ws + WS_PA);
    const int ntok = (M - first + stride - 1) / stride;
    const int eoff = (r >> 1) * 16 + 8 * (r & 1);
    for (int jj = 0; jj < nj; ++jj) { const int j = j0 + jj;
        const unsigned char* tb = a.ws + WS_UB + (size_t)j * (16384 * 64);
        const unsigned poff = 16u * p;
        v4u R0[8], R1[8], R2[8], R3[8], hh0, hl0, hh1, hl1, hh2, hl2, hh3, hl3, eA, eB;
#define U4_ROWS(R, ev) do { const unsigned w_[4] = {ev.x, ev.y, ev.z, ev.w}; _Pragma("unroll") for (int c_ = 0; c_ < 4; ++c_) { R[2 * c_] = *(const v4u*)(tb + ((w_[c_] & 0xffffu) * 64u + poff)); R[2 * c_ + 1] = *(const v4u*)(tb + ((w_[c_] >> 16) * 64u + poff)); } } while (0)
#define U4_COMPUTE(R, hh, hl, t) do { int part[8]; _Pragma("unroll") for (int i_ = 0; i_ < 8; ++i_) { \
            int sh_ = __builtin_amdgcn_sdot8((int)R[i_].x, (int)hh.x, 0, false); sh_ = __builtin_amdgcn_sdot8((int)R[i_].y, (int)hh.y, sh_, false); sh_ = __builtin_amdgcn_sdot8((int)R[i_].z, (int)hh.z, sh_, false); sh_ = __builtin_amdgcn_sdot8((int)R[i_].w, (int)hh.w, sh_, false); \
            int sl_ = __builtin_amdgcn_sdot8((int)R[i_].x, (int)hl.x, 0, false); sl_ = __builtin_amdgcn_sdot8((int)R[i_].y, (int)hl.y, sl_, false); sl_ = __builtin_amdgcn_sdot8((int)R[i_].z, (int)hl.z, sl_, false); sl_ = __builtin_amdgcn_sdot8((int)R[i_].w, (int)hl.w, sl_, false); \
            part[i_] = 16 * sh_ + sl_; } \
        int q4_[4]; { const bool hi_ = (lane & 2) != 0; _Pragma("unroll") for (int i_ = 0; i_ < 4; ++i_) { const int keep_ = hi_ ? part[i_ + 4] : part[i_], send_ = hi_ ? part[i_] : part[i_ + 4]; q4_[i_] = keep_ + __builtin_amdgcn_update_dpp(0, send_, 0x4E, 0xF, 0xF, false); } } \
        int o0_, o1_; { const bool hi_ = (lane & 1) != 0; { const int keep_ = hi_ ? q4_[2] : q4_[0], send_ = hi_ ? q4_[0] : q4_[2]; o0_ = keep_ + __builtin_amdgcn_update_dpp(0, send_, 0xB1, 0xF, 0xF, false); } \
            { const int keep_ = hi_ ? q4_[3] : q4_[1], send_ = hi_ ? q4_[1] : q4_[3]; o1_ = keep_ + __builtin_amdgcn_update_dpp(0, send_, 0xB1, 0xF, 0xF, false); } } \
        *(unsigned*)(PA + ((size_t)j * M + (t)) * 128 + eoff + 2 * p) = (unsigned)(((o0_ + 2) >> 2) & 0xffff) | ((unsigned)((o1_ + 2) >> 2) << 16); } while (0)
#define U4_TOK(u_) ((size_t)first + (size_t)((u_) < ntok ? (u_) : ntok - 1) * stride)
#define U4_E(ev, u_) do { ev = *(const v4u*)(E + U4_TOK(u_) * 128 + eoff); } while (0)
#define U4_H(hh, hl, u_) do { const size_t t_ = U4_TOK(u_); hh = *(const v4u*)(HQh + t_ * 512 + 64 * j + poff); hl = *(const v4u*)(HQl + t_ * 512 + 64 * j + poff); } while (0)
        { v4u e0, e1, e2; U4_E(e0, 0); U4_E(e1, 1); U4_E(e2, 2); U4_E(eA, 3);
          U4_H(hh0, hl0, 0); U4_ROWS(R0, e0); U4_H(hh1, hl1, 1); U4_ROWS(R1, e1); U4_H(hh2, hl2, 2); U4_ROWS(R2, e2); }
        for (int u = 0; u < ntok; u += 4) {
            U4_E(eB, u + 4); U4_H(hh3, hl3, u + 3); U4_ROWS(R3, eA); U4_COMPUTE(R0, hh0, hl0, U4_TOK(u));
            if (u + 1 >= ntok) break;
            U4_E(eA, u + 5); U4_H(hh0, hl0, u + 4); U4_ROWS(R0, eB); U4_COMPUTE(R1, hh1, hl1, U4_TOK(u + 1));
            if (u + 2 >= ntok) break;
            U4_E(eB, u + 6); U4_H(hh1, hl1, u + 5); U4_ROWS(R1, eA); U4_COMPUTE(R2, hh2, hl2, U4_TOK(u + 2));
            if (u + 3 >= ntok) break;
            U4_E(eA, u + 7); U4_H(hh2, hl2, u + 6); U4_ROWS(R2, eB); U4_COMPUTE(R3, hh3, hl3, U4_TOK(u + 3));
        }
#undef U4_TOK
#undef U4_E
#undef U4_H
#undef U4_ROWS
#undef U4_COMPUTE
    }
}
typedef long i64_t;
typedef int v2i_t __attribute__((ext_vector_type(2)));
__device__ __forceinline__ i64_t ds_tr8(const LAS unsigned char* p) { const v2i_t r = __builtin_amdgcn_ds_read_tr8_b64_v2i32((LAS v2i_t*)p); return (i64_t)(unsigned)r.x | ((i64_t)(unsigned)r.y << 32); }
__device__ __forceinline__ void vpass_mfma(const Args& a, LAS unsigned char* lds, int wave, int lane_in) {
    int lane = lane_in; asm volatile("" : "+v"(lane));
    const int G = gridDim.x, bx = blockIdx.x;
    const bool sliced = (G % 8) == 0;
    const int nj = sliced ? 1 : 8, j0 = sliced ? (bx & 7) : 0;
    const int first = sliced ? ((bx >> 3) * NWAVES + wave) : (bx * NWAVES + wave), stride = sliced ? (G >> 3) * NWAVES : G * NWAVES;
    const int r = lane >> 2, p4 = lane & 3, n16 = lane & 15, qp = lane >> 4;
    const unsigned short* E = (const unsigned short*)(a.ws + WS_E); const unsigned char* W8 = a.ws + WS_W; const float* MOD = (const float*)(a.ws + WS_MOD);
    LAS unsigned char* slot = lds + wave * 16384;
    const int ntok = (M - first + stride - 1) / stride;
    const int eoff = (r >> 1) * 16 + 8 * (r & 1);
    const int wbase = (8 * r) * 128, hk = (r >> 2) & 1;
    const int rkey = (n16 >> 1) ^ (qp & 1), rbase = (32 * qp + (n16 >> 1)) * 128 + 8 * (n16 & 1);
    const bool even = (n16 & 1) == 0; const int ccol = 32 * qp + (even ? n16 : 15 + n16);
    for (int jj = 0; jj < nj; ++jj) { const int j = j0 + jj;
        const unsigned char* tb = a.ws + WS_VB + (size_t)j * (16384 * 128);
        const unsigned poff = 32u * p4;
        v4u RA[16], RB[16], wA, wB, en, en2;
#define VM_ROWS(R, ev) do { const unsigned w_[4] = {ev.x, ev.y, ev.z, ev.w}; _Pragma("unroll") for (int c_ = 0; c_ < 4; ++c_) { \
            const unsigned char* r0_ = tb + ((w_[c_] & 0xffffu) * 128u + poff); const unsigned char* r1_ = tb + ((w_[c_] >> 16) * 128u + poff); \
            R[4 * c_] = *(const v4u*)r0_; R[4 * c_ + 1] = *(const v4u*)(r0_ + 16); R[4 * c_ + 2] = *(const v4u*)r1_; R[4 * c_ + 3] = *(const v4u*)(r1_ + 16); } } while (0)
#define VM_W(wv, t) do { wv = *(const v4u*)(W8 + (size_t)(t) * 128 + 32 * qp + 16 * (n16 & 1)); } while (0)
#define VM_COMPUTE(R, wv, t) do { \
        _Pragma("unroll") for (int i_ = 0; i_ < 8; ++i_) { const int k_ = (i_ & 7) ^ hk; *(LAS v4u*)(slot + wbase + i_ * 128 + 16 * ((2 * p4) ^ k_)) = R[2 * i_]; *(LAS v4u*)(slot + wbase + i_ * 128 + 16 * ((2 * p4 + 1) ^ k_)) = R[2 * i_ + 1]; } \
        unsigned wq_[8]; { const unsigned o0_ = (unsigned)__builtin_amdgcn_update_dpp(0, (int)wv.x, 0xB1, 0xF, 0xF, false), o1_ = (unsigned)__builtin_amdgcn_update_dpp(0, (int)wv.y, 0xB1, 0xF, 0xF, false), \
              o2_ = (unsigned)__builtin_amdgcn_update_dpp(0, (int)wv.z, 0xB1, 0xF, 0xF, false), o3_ = (unsigned)__builtin_amdgcn_update_dpp(0, (int)wv.w, 0xB1, 0xF, 0xF, false); \
          wq_[0] = even ? wv.x : o0_; wq_[1] = even ? wv.y : o1_; wq_[2] = even ? wv.z : o2_; wq_[3] = even ? wv.w : o3_; wq_[4] = even ? o0_ : wv.x; wq_[5] = even ? o1_ : wv.y; wq_[6] = even ? o2_ : wv.z; wq_[7] = even ? o3_ : wv.w; } \
        f32x4 acc_[8]; _Pragma("unroll") for (int nt_ = 0; nt_ < 8; ++nt_) acc_[nt_] = (f32x4){0.f, 0.f, 0.f, 0.f}; \
        _Pragma("unroll") for (int ks_ = 0; ks_ < 4; ++ks_) { const i64_t aw_ = (i64_t)wq_[2 * ks_] | ((i64_t)wq_[2 * ks_ + 1] << 32); \
            _Pragma("unroll") for (int nt_ = 0; nt_ < 8; ++nt_) { const i64_t bv_ = ds_tr8(slot + rbase + ks_ * 1024 + 16 * (nt_ ^ rkey)); acc_[nt_] = __builtin_amdgcn_mfma_f32_16x16x32_fp8_fp8(aw_, bv_, acc_[nt_], 0, 0, 0); } } \
        const float e01_ = (qp & 1) ? acc_[2][0] : acc_[0][0], e23_ = (qp & 1) ? acc_[6][0] : acc_[4][0], o01_ = (qp & 1) ? acc_[3][0] : acc_[1][0], o23_ = (qp & 1) ? acc_[7][0] : acc_[5][0]; \
        const float se_ = (qp & 2) ? e23_ : e01_, so_ = (qp & 2) ? o23_ : o01_; \
        const float mine_ = even ? se_ : so_, send_ = even ? so_ : se_; \
        const float recv_ = __builtin_bit_cast(float, __builtin_amdgcn_update_dpp(0, __builtin_bit_cast(int, send_), 0xB1, 0xF, 0xF, false)); \
        const float lo_ = even ? mine_ : recv_, hi_ = even ? recv_ : mine_; \
        bf16* xo_ = (bf16*)(a.ws + WS_X1B) + (size_t)(t) * 1024 + 128 * j + ccol; const float* gt_ = MOD + ((size_t)(t) >> 13) * NMODC + 5120 + 128 * j + ccol; \
        const unsigned xb_ = *(const unsigned*)xo_; const f32x2_t g_ = *(const f32x2_t*)gt_; \
        *(unsigned*)xo_ = pk2(bflo(xb_) + g_.x * lo_ * (1.0f / 4096.0f), bfhi(xb_) + g_.y * hi_ * (1.0f / 4096.0f)); } while (0)
#define VM_TOK(u_) ((size_t)first + (size_t)((u_) < ntok ? (u_) : ntok - 1) * stride)
        { v4u e0 = *(const v4u*)(E + VM_TOK(0) * 128 + eoff); VM_ROWS(RA, e0); VM_W(wA, VM_TOK(0)); en = *(const v4u*)(E + VM_TOK(1) * 128 + eoff); }
        for (int u = 0; u < ntok; u += 2) {
            { en2 = *(const v4u*)(E + VM_TOK(u + 2) * 128 + eoff); VM_W(wB, VM_TOK(u + 1)); VM_ROWS(RB, en); VM_COMPUTE(RA, wA, VM_TOK(u)); }
            if (u + 1 >= ntok) break;
            { en = *(const v4u*)(E + VM_TOK(u + 3) * 128 + eoff); VM_W(wA, VM_TOK(u + 2)); VM_ROWS(RA, en2); VM_COMPUTE(RB, wB, VM_TOK(u + 1)); }
        }
#undef VM_ROWS
#undef VM_COMPUTE
#undef VM_W
#undef VM_TOK
    }
}
typedef int v8i_t __attribute__((ext_vector_type(8)));
__device__ __forceinline__ v2i_t ds_tr4(const LAS unsigned char* p) { return __builtin_amdgcn_ds_read_tr4_b64_v2i32((LAS v2i_t*)p); }
__device__ __forceinline__ void vpass_mfma4(const Args& a, LAS unsigned char* lds, int wave, int lane_in) {
    int lane = lane_in; asm volatile("" : "+v"(lane));
    const int G = gridDim.x, bx = blockIdx.x;
    const bool sliced = (G % 8) == 0;
    const int nj = sliced ? 1 : 8, j0 = sliced ? (bx & 7) : 0;
    const int first = sliced ? ((bx >> 3) * NWAVES + wave) : (bx * NWAVES + wave), stride = sliced ? (G >> 3) * NWAVES : G * NWAVES;
    const int r = lane >> 2, p4 = lane & 3, n16 = lane & 15, qp = lane >> 4;
    const unsigned short* E = (const unsigned short*)(a.ws + WS_E); const unsigned char* W8 = a.ws + WS_W; const float* MOD = (const float*)(a.ws + WS_MOD);
    LAS unsigned char* slot = lds + wave * 8192;
    const int ntok = (M - first + stride - 1) / stride;
    const int eoff = 8 * r;
    const int wbase = (8 * r) * 64;
    const int rkey = (n16 >> 2) & 3, rbase = (32 * qp + n16) * 64;
    const bool even = (n16 & 1) == 0; const int ccol = 32 * qp + (even ? n16 : 15 + n16);
    for (int jj = 0; jj < nj; ++jj) { const int j = j0 + jj;
        const unsigned char* tb = a.ws + WS_VB + (size_t)j * (16384 * 64);
        const unsigned poff = 16u * p4;
        v4u R0[8], R1[8], R2[8], R3[8], w0, w1, w2, w3, eA, eB;
#define V4_ROWS(R, ev) do { const unsigned w_[4] = {ev.x, ev.y, ev.z, ev.w}; _Pragma("unroll") for (int c_ = 0; c_ < 4; ++c_) { R[2 * c_] = *(const v4u*)(tb + ((w_[c_] & 0xffffu) * 64u + poff)); R[2 * c_ + 1] = *(const v4u*)(tb + ((w_[c_] >> 16) * 64u + poff)); } } while (0)
#define V4_TOK(u_) ((size_t)first + (size_t)((u_) < ntok ? (u_) : ntok - 1) * stride)
#define V4_E(ev, u_) do { ev = *(const v4u*)(E + V4_TOK(u_) * 128 + eoff); } while (0)
#define V4_W(wv, u_) do { wv = *(const v4u*)(W8 + V4_TOK(u_) * 128 + 16 * qp + 64 * (n16 & 1)); } while (0)
#define V4_COMPUTE(R, wv, t) do { \
        _Pragma("unroll") for (int i_ = 0; i_ < 8; ++i_) *(LAS v4u*)(slot + wbase + i_ * 64 + 16 * (p4 ^ ((2 * r + (i_ >> 2)) & 3))) = R[i_]; \
        v8i_t aw_; { const int o0_ = __builtin_amdgcn_update_dpp(0, (int)wv.x, 0xB1, 0xF, 0xF, false), o1_ = __builtin_amdgcn_update_dpp(0, (int)wv.y, 0xB1, 0xF, 0xF, false), \
              o2_ = __builtin_amdgcn_update_dpp(0, (int)wv.z, 0xB1, 0xF, 0xF, false), o3_ = __builtin_amdgcn_update_dpp(0, (int)wv.w, 0xB1, 0xF, 0xF, false); \
          aw_[0] = even ? (int)wv.x : o0_; aw_[1] = even ? (int)wv.y : o1_; aw_[2] = even ? (int)wv.z : o2_; aw_[3] = even ? (int)wv.w : o3_; \
          aw_[4] = even ? o0_ : (int)wv.x; aw_[5] = even ? o1_ : (int)wv.y; aw_[6] = even ? o2_ : (int)wv.z; aw_[7] = even ? o3_ : (int)wv.w; } \
        f32x4 acc_[8]; \
        _Pragma("unroll") for (int nt_ = 0; nt_ < 8; ++nt_) { const LAS unsigned char* rp_ = slot + rbase + 16 * ((nt_ >> 1) ^ rkey) + 8 * (nt_ & 1); \
            const v2i_t b0_ = ds_tr4(rp_), b1_ = ds_tr4(rp_ + 16 * 64); const v8i_t bv_ = {b0_.x, b0_.y, b1_.x, b1_.y, 0, 0, 0, 0}; \
            acc_[nt_] = __builtin_amdgcn_mfma_scale_f32_16x16x128_f8f6f4(aw_, bv_, (f32x4){0.f, 0.f, 0.f, 0.f}, 0, 4, 0, 0, 0, 0); } \
        const float e01_ = (qp & 1) ? acc_[2][0] : acc_[0][0], e23_ = (qp & 1) ? acc_[6][0] : acc_[4][0], o01_ = (qp & 1) ? acc_[3][0] : acc_[1][0], o23_ = (qp & 1) ? acc_[7][0] : acc_[5][0]; \
        const float se_ = (qp & 2) ? e23_ : e01_, so_ = (qp & 2) ? o23_ : o01_; \
        const float mine_ = even ? se_ : so_, send_ = even ? so_ : se_; \
        const float recv_ = __builtin_bit_cast(float, __builtin_amdgcn_update_dpp(0, __builtin_bit_cast(int, send_), 0xB1, 0xF, 0xF, false)); \
        const float lo_ = even ? mine_ : recv_, hi_ = even ? recv_ : mine_; \
        bf16* xo_ = (bf16*)(a.ws + WS_X1B) + (size_t)(t) * 1024 + 128 * j + ccol; const float* gt_ = MOD + ((size_t)(t) >> 13) * NMODC + 5120 + 128 * j + ccol; \
        const unsigned xb_ = *(const unsigned*)xo_; const f32x2_t g_ = *(const f32x2_t*)gt_; \
        *(unsigned*)xo_ = pk2(bflo(xb_) + g_.x * lo_ * (1.0f / 256.0f), bfhi(xb_) + g_.y * hi_ * (1.0f / 256.0f)); } while (0)
        { v4u e0, e1, e2; V4_E(e0, 0); V4_E(e1, 1); V4_E(e2, 2); V4_E(eA, 3);
          V4_W(w0, 0); V4_ROWS(R0, e0); V4_W(w1, 1); V4_ROWS(R1, e1); V4_W(w2, 2); V4_ROWS(R2, e2); }
        for (int u = 0; u < ntok; u += 4) {
            V4_E(eB, u + 4); V4_W(w3, u + 3); V4_ROWS(R3, eA); V4_COMPUTE(R0, w0, V4_TOK(u));
            if (u + 1 >= ntok) break;
            V4_E(eA, u + 5); V4_W(w0, u + 4); V4_ROWS(R0, eB); V4_COMPUTE(R1, w1, V4_TOK(u + 1));
            if (u + 2 >= ntok) break;
            V4_E(eB, u + 6); V4_W(w1, u + 5); V4_ROWS(R1, eA); V4_COMPUTE(R2, w2, V4_TOK(u + 2));
            if (u + 3 >= ntok) break;
            V4_E(eA, u + 7); V4_W(w2, u + 6); V4_ROWS(R2, eB); V4_COMPUTE(R3, w3, V4_TOK(u + 3));
        }
#undef V4_ROWS
#undef V4_TOK
#undef V4_E
#undef V4_W
#undef V4_COMPUTE
    }
}
__device__ __forceinline__ void vpass_wide(const Args& a, LAS unsigned char* lds, int wave, int lane_in, size_t xdst_off = WS_X1B) {
    int lane = lane_in; asm volatile("" : "+v"(lane));
    const int G = gridDim.x, bx = blockIdx.x;
    const bool sliced = (G % 8) == 0;
    const int nj = sliced ? 1 : 4, j0 = sliced ? ((bx & 7) >> 1) : 0;
    const int tmul = sliced ? 2 : 1, tadd = sliced ? (bx & 1) : 0;
    const int first = sliced ? ((bx >> 3) * NWAVES + wave) : (bx * NWAVES + wave), stride = sliced ? (G >> 3) * NWAVES : G * NWAVES;
    const int ntok = ((sliced ? M / 2 : M) - first + stride - 1) / stride;
    const int r8 = lane >> 3, p8 = lane & 7, n16 = lane & 15, qp = lane >> 4;
    const unsigned short* E = (const unsigned short*)(a.ws + WS_E); const unsigned char* W8 = a.ws + WS_W; const float* MOD = (const float*)(a.ws + WS_MOD);
    LAS unsigned char* slot = lds + wave * 16384;
    const int eoff = 16 * r8 + 8 * (p8 >> 2); const bool ehi = (p8 & 4) != 0;
    const int wbase = (16 * r8) * 128;
    const int rkey = (n16 >> 1) & 7, rbase = (32 * qp + n16) * 128;
    const int kbw = ((r8 >> 1) ^ r8) & 1, qb = qp & 1;
    const bool even = (n16 & 1) == 0;
    const bool b0q = (n16 & 1) != 0, b1q = (n16 & 2) != 0;
    const int ccol = 16 * (4 * qp + (n16 & 3)) + (n16 & ~3);
    for (int jj = 0; jj < nj; ++jj) { const int j = j0 + jj;
        const unsigned char* tb = a.ws + WS_VB + (size_t)j * (16384 * 128);
        const unsigned poff = 16u * p8;
        v4u RA[16], RB[16], wA, wB, en, en2; f32x4 gg = {0.f, 0.f, 0.f, 0.f}; int gbatch = -1;
#define VW_TOK(u_) ((size_t)tmul * ((size_t)first + (size_t)((u_) < ntok ? (u_) : ntok - 1) * stride) + tadd)
#define VW_ROWS(R, eq) do { unsigned w_[8]; { const unsigned m_[4] = {eq.x, eq.y, eq.z, eq.w}; _Pragma("unroll") for (int d_ = 0; d_ < 4; ++d_) { \
            const unsigned up_ = (unsigned)__builtin_amdgcn_update_dpp(0, (int)m_[d_], 0x104, 0xF, 0xF, false), dn_ = (unsigned)__builtin_amdgcn_update_dpp(0, (int)m_[d_], 0x114, 0xF, 0xF, false); \
            const unsigned ot_ = ehi ? dn_ : up_; w_[d_] = ehi ? ot_ : m_[d_]; w_[4 + d_] = ehi ? m_[d_] : ot_; } } _Pragma("unroll") for (int c_ = 0; c_ < 8; ++c_) { \
            R[2 * c_] = *(const v4u*)(tb + ((w_[c_] & 0xffffu) * 128u + poff)); R[2 * c_ + 1] = *(const v4u*)(tb + ((w_[c_] >> 16) * 128u + poff)); } } while (0)
#define VW_W(wv, u_) do { wv = *(const v4u*)(W8 + VW_TOK(u_) * 128 + 16 * qp + 64 * (n16 & 1)); } while (0)
#define VW_X(u_) (*(const v2u*)((const bf16*)(a.ws + WS_X1B) + VW_TOK(u_) * 1024 + 256 * j + ccol))
#define VW_COMPUTE(R, wv, xv_, t) do { \
        _Pragma("unroll") for (int i_ = 0; i_ < 16; ++i_) { LAS unsigned char* wp_ = slot + wbase + i_ * 128 + 16 * (p8 ^ ((i_ >> 1) & 7)); *(LAS v2u*)(wp_ + 8 * kbw) = (v2u){R[i_].x, R[i_].y}; *(LAS v2u*)(wp_ + 8 - 8 * kbw) = (v2u){R[i_].z, R[i_].w}; } \
        v8i_t aw_; { const int o0_ = __builtin_amdgcn_update_dpp(0, (int)wv.x, 0xB1, 0xF, 0xF, false), o1_ = __builtin_amdgcn_update_dpp(0, (int)wv.y, 0xB1, 0xF, 0xF, false), \
              o2_ = __builtin_amdgcn_update_dpp(0, (int)wv.z, 0xB1, 0xF, 0xF, false), o3_ = __builtin_amdgcn_update_dpp(0, (int)wv.w, 0xB1, 0xF, 0xF, false); \
          aw_[0] = even ? (int)wv.x : o0_; aw_[1] = even ? (int)wv.y : o1_; aw_[2] = even ? (int)wv.z : o2_; aw_[3] = even ? (int)wv.w : o3_; \
          aw_[4] = even ? o0_ : (int)wv.x; aw_[5] = even ? o1_ : (int)wv.y; aw_[6] = even ? o2_ : (int)wv.z; aw_[7] = even ? o3_ : (int)wv.w; } \
        float tv_[16]; \
        _Pragma("unroll") for (int nt_ = 0; nt_ < 16; ++nt_) { const LAS unsigned char* rp_ = slot + rbase + 16 * ((nt_ >> 1) ^ rkey); const int h0_ = 8 * ((nt_ & 1) ^ qb); \
            const v2i_t b0_ = ds_tr4(rp_ + h0_), b1_ = ds_tr4(rp_ + 16 * 128 + 8 - h0_); const v8i_t bv_ = {b0_.x, b0_.y, b1_.x, b1_.y, 0, 0, 0, 0}; \
            const f32x4 c_ = __builtin_amdgcn_mfma_scale_f32_16x16x128_f8f6f4(aw_, bv_, (f32x4){0.f, 0.f, 0.f, 0.f}, 0, 4, 0, 0, 0, 0); tv_[nt_] = c_[0]; } \
          \
        float t0_ = (qp & 1) ? tv_[4] : tv_[0], t1_ = (qp & 1) ? tv_[5] : tv_[1], t2_ = (qp & 1) ? tv_[6] : tv_[2], t3_ = (qp & 1) ? tv_[7] : tv_[3]; \
        { const float u0_ = (qp & 1) ? tv_[12] : tv_[8], u1_ = (qp & 1) ? tv_[13] : tv_[9], u2_ = (qp & 1) ? tv_[14] : tv_[10], u3_ = (qp & 1) ? tv_[15] : tv_[11]; \
          t0_ = (qp & 2) ? u0_ : t0_; t1_ = (qp & 2) ? u1_ : t1_; t2_ = (qp & 2) ? u2_ : t2_; t3_ = (qp & 2) ? u3_ : t3_; } \
          \
        { const float sa_ = b0q ? t0_ : t1_, sb_ = b0q ? t2_ : t3_; \
          const float ra_ = __builtin_bit_cast(float, __builtin_amdgcn_update_dpp(0, __builtin_bit_cast(int, sa_), 0xB1, 0xF, 0xF, false)), rb_ = __builtin_bit_cast(float, __builtin_amdgcn_update_dpp(0, __builtin_bit_cast(int, sb_), 0xB1, 0xF, 0xF, false)); \
          t0_ = b0q ? ra_ : t0_; t1_ = b0q ? t1_ : ra_; t2_ = b0q ? rb_ : t2_; t3_ = b0q ? t3_ : rb_; } \
        { const float sa_ = b1q ? t0_ : t2_, sb_ = b1q ? t1_ : t3_; \
          const float ra_ = __builtin_bit_cast(float, __builtin_amdgcn_update_dpp(0, __builtin_bit_cast(int, sa_), 0x4E, 0xF, 0xF, false)), rb_ = __builtin_bit_cast(float, __builtin_amdgcn_update_dpp(0, __builtin_bit_cast(int, sb_), 0x4E, 0xF, 0xF, false)); \
          t0_ = b1q ? ra_ : t0_; t2_ = b1q ? t2_ : ra_; t1_ = b1q ? rb_ : t1_; t3_ = b1q ? t3_ : rb_; } \
        { const int bt_ = (int)((size_t)(t) >> 13); if (bt_ != gbatch) { gbatch = bt_; gg = *(const f32x4*)(MOD + (size_t)bt_ * NMODC + 5120 + 256 * j + ccol) * (1.0f / 256.0f); } } \
        bf16* xo_ = (bf16*)(a.ws + xdst_off) + (size_t)(t) * 1024 + 256 * j + ccol; \
        *(v2u*)xo_ = (v2u){pk2(bflo(xv_.x) + gg.x * t0_, bfhi(xv_.x) + gg.y * t1_), pk2(bflo(xv_.y) + gg.z * t2_, bfhi(xv_.y) + gg.w * t3_)}; } while (0)
        v2u xa = VW_X(0), xb = xa;
        { const v4u e0 = *(const v4u*)(E + VW_TOK(0) * 128 + eoff); VW_W(wA, 0); VW_ROWS(RA, e0); en = *(const v4u*)(E + VW_TOK(1) * 128 + eoff); }
        for (int u = 0; u < ntok; u += 2) {
            { xb = VW_X(u + 1); en2 = *(const v4u*)(E + VW_TOK(u + 2) * 128 + eoff); VW_W(wB, u + 1); VW_ROWS(RB, en); VW_COMPUTE(RA, wA, xa, VW_TOK(u)); }
            if (u + 1 >= ntok) break;
            { xa = VW_X(u + 2); en = *(const v4u*)(E + VW_TOK(u + 3) * 128 + eoff); VW_W(wA, u + 2); VW_ROWS(RA, en2); VW_COMPUTE(RB, wB, xb, VW_TOK(u + 1)); }
        }
#undef VW_TOK
#undef VW_ROWS
#undef VW_W
#undef VW_X
#undef VW_COMPUTE
    }
}
__device__ __forceinline__ void upass_wide(const Args& a, LAS unsigned char* lds, int wave, int lane_in) {
    int lane = lane_in; asm volatile("" : "+v"(lane));
    const int G = gridDim.x, bx = blockIdx.x;
    const bool sliced = (G % 8) == 0;
    const int nj = sliced ? 1 : 4, j0 = sliced ? ((bx & 7) >> 1) : 0;
    const int tmul = sliced ? 2 : 1, tadd = sliced ? (bx & 1) : 0;
    const int first = sliced ? ((bx >> 3) * NWAVES + wave) : (bx * NWAVES + wave), stride = sliced ? (G >> 3) * NWAVES : G * NWAVES;
    const int ntok = ((sliced ? M / 2 : M) - first + stride - 1) / stride;
    const int r8 = lane >> 3, p8 = lane & 7, n16 = lane & 15, qp = lane >> 4;
    const unsigned short* E = (const unsigned short*)(a.ws + WS_E); const unsigned char* H8 = a.ws + WS_H2Q; bf16* PA = (bf16*)(a.ws + WS_PA);
    LAS unsigned char* slot = lds + wave * 16384;
    const int eoff = 16 * r8 + 8 * (p8 >> 2), wbase = (16 * r8) * 128; const bool ehi = (p8 & 4) != 0;
    const int akey = (n16 >> 1) & 7, abase = n16 * 128;
    const bool even = (n16 & 1) == 0;
    for (int jj = 0; jj < nj; ++jj) { const int j = j0 + jj;
        const unsigned char* tb = a.ws + WS_UB + (size_t)j * (16384 * 128);
        const unsigned poff = 16u * p8;
        v4u RA[16], RB[16], haA, hbA, haB, hbB, en, en2;
#define UW_TOK(u_) ((size_t)tmul * ((size_t)first + (size_t)((u_) < ntok ? (u_) : ntok - 1) * stride) + tadd)
#define UW_ROWS(R, eq) do { unsigned w_[8]; { const unsigned m_[4] = {eq.x, eq.y, eq.z, eq.w}; _Pragma("unroll") for (int d_ = 0; d_ < 4; ++d_) { \
            const unsigned up_ = (unsigned)__builtin_amdgcn_update_dpp(0, (int)m_[d_], 0x104, 0xF, 0xF, false), dn_ = (unsigned)__builtin_amdgcn_update_dpp(0, (int)m_[d_], 0x114, 0xF, 0xF, false); \
            const unsigned ot_ = ehi ? dn_ : up_; w_[d_] = ehi ? ot_ : m_[d_]; w_[4 + d_] = ehi ? m_[d_] : ot_; } } _Pragma("unroll") for (int c_ = 0; c_ < 8; ++c_) { \
            R[2 * c_] = *(const v4u*)(tb + ((w_[c_] & 0xffffu) * 128u + poff)); R[2 * c_ + 1] = *(const v4u*)(tb + ((w_[c_] >> 16) * 128u + poff)); } } while (0)
#define UW_H(ha, hb, u_) do { const unsigned char* hp_ = H8 + UW_TOK(u_) * 1024 + 256 * j + 16 * qp + 128 * (n16 & 1); ha = *(const v4u*)hp_; hb = *(const v4u*)(hp_ + 64); } while (0)
#define UW_COMPUTE(R, ha, hb, t) do { \
        _Pragma("unroll") for (int i_ = 0; i_ < 16; ++i_) { *(LAS v4u*)(slot + wbase + i_ * 128 + 16 * (p8 ^ ((i_ >> 1) & 7))) = R[i_]; } \
        v8i_t bh0_, bh1_; { const int mine_[8] = {(int)ha.x, (int)ha.y, (int)ha.z, (int)ha.w, (int)hb.x, (int)hb.y, (int)hb.z, (int)hb.w}; \
          _Pragma("unroll") for (int d_ = 0; d_ < 8; ++d_) { const int o_ = __builtin_amdgcn_update_dpp(0, mine_[d_], 0xB1, 0xF, 0xF, false); bh0_[d_] = even ? mine_[d_] : o_; bh1_[d_] = even ? o_ : mine_[d_]; } } \
        f32x4 acc_[8]; \
        _Pragma("unroll") for (int mb_ = 0; mb_ < 8; ++mb_) { \
            const v4u a0_ = *(const LAS v4u*)(slot + mb_ * 2048 + abase + 16 * (qp ^ akey)), a1_ = *(const LAS v4u*)(slot + mb_ * 2048 + abase + 16 * ((4 + qp) ^ akey)); \
            const v8i_t av0_ = {(int)a0_.x, (int)a0_.y, (int)a0_.z, (int)a0_.w, 0, 0, 0, 0}, av1_ = {(int)a1_.x, (int)a1_.y, (int)a1_.z, (int)a1_.w, 0, 0, 0, 0}; \
            f32x4 c_ = __builtin_amdgcn_mfma_scale_f32_16x16x128_f8f6f4(av0_, bh0_, (f32x4){0.f, 0.f, 0.f, 0.f}, 4, 0, 0, 0, 0, 0); \
            acc_[mb_] = __builtin_amdgcn_mfma_scale_f32_16x16x128_f8f6f4(av1_, bh1_, c_, 4, 0, 0, 0, 0, 0); } \
        const f32x4 s01_ = (n16 & 1) ? acc_[1] : acc_[0], s23_ = (n16 & 1) ? acc_[3] : acc_[2], s45_ = (n16 & 1) ? acc_[5] : acc_[4], s67_ = (n16 & 1) ? acc_[7] : acc_[6]; \
        const f32x4 s03_ = (n16 & 2) ? s23_ : s01_, s47_ = (n16 & 2) ? s67_ : s45_; const f32x4 sel_ = (n16 & 4) ? s47_ : s03_; \
        if (n16 < 8) *(v2u*)(PA + ((size_t)j * M + (t)) * 128 + n16 * 16 + 4 * qp) = (v2u){pg8::cvt_pk_bf16(sel_[0], sel_[1]), pg8::cvt_pk_bf16(sel_[2], sel_[3])}; } while (0)
        { const v4u e0 = *(const v4u*)(E + UW_TOK(0) * 128 + eoff); UW_ROWS(RA, e0); UW_H(haA, hbA, 0); en = *(const v4u*)(E + UW_TOK(1) * 128 + eoff); }
        for (int u = 0; u < ntok; u += 2) {
            { en2 = *(const v4u*)(E + UW_TOK(u + 2) * 128 + eoff); UW_H(haB, hbB, u + 1); UW_ROWS(RB, en); UW_COMPUTE(RA, haA, hbA, UW_TOK(u)); }
            if (u + 1 >= ntok) break;
            { en = *(const v4u*)(E + UW_TOK(u + 3) * 128 + eoff); UW_H(haA, hbA, u + 2); UW_ROWS(RA, en2); UW_COMPUTE(RB, haB, hbB, UW_TOK(u + 1)); }
        }
#undef UW_TOK
#undef UW_ROWS
#undef UW_H
#undef UW_COMPUTE
    }
}
__device__ __forceinline__ void peer_reduce(const Args& a, LAS unsigned char* lds, int tid) {
    const unsigned short* E = (const unsigned short*)(a.ws + WS_E); const bf16* Gt = (const bf16*)(a.ws + WS_G); unsigned char* W = a.ws + WS_W; const bf16* PA = (const bf16*)(a.ws + WS_PA);
    const float* SU = (const float*)(a.ws + WS_SU); const float* SV = (const float*)(a.ws + WS_SV); const float* SH = (const float*)(a.ws + WS_SH);
    __syncthreads();
    for (int i = tid; i < 16384 / 4; i += 512) { const f32x4 u4 = *(const f32x4*)(SU + 4 * i), v4 = *(const f32x4*)(SV + 4 * i);
        *(LAS f32x4*)(lds + 32 * i) = (f32x4){u4.x, v4.x, u4.y, v4.y}; *(LAS f32x4*)(lds + 32 * i + 16) = (f32x4){u4.z, v4.z, u4.w, v4.w}; }
    __syncthreads();
    const size_t n4 = (size_t)M * 128 / 4, gth = (size_t)gridDim.x * 512;
    size_t i = (size_t)blockIdx.x * 512 + tid; if (i >= n4) return;
    v2u pn[4], epn, gqn; float shn;
#define PR_LOAD(ii) do { _Pragma("unroll") for (int j = 0; j < 4; ++j) pn[j] = __builtin_nontemporal_load((const v2u*)(PA + (size_t)j * M * 128 + (ii) * 4)); \
        shn = SH[(ii) >> 5]; epn = *(const v2u*)(E + (ii) * 4); gqn = *(const v2u*)(Gt + (ii) * 4); } while (0)
    PR_LOAD(i);
    for (; i < n4; i += gth) {
        f32x4 s = {0.f, 0.f, 0.f, 0.f};
#pragma unroll
        for (int j = 0; j < 4; ++j) s += (f32x4){bflo(pn[j].x), bfhi(pn[j].x), bflo(pn[j].y), bfhi(pn[j].y)};
        const float sh = shn;
        const v2u ep = epn, gq = gqn; const f32x4 g = {bflo(gq.x), bfhi(gq.x), bflo(gq.y), bfhi(gq.y)}; f32x4 w;
        { const size_t in = i + gth < n4 ? i + gth : i; PR_LOAD(in); }
        const f2_t t0 = *(const LAS f2_t*)(lds + 8 * (ep.x & 0xffffu)), t1 = *(const LAS f2_t*)(lds + 8 * (ep.x >> 16)), t2 = *(const LAS f2_t*)(lds + 8 * (ep.y & 0xffffu)), t3 = *(const LAS f2_t*)(lds + 8 * (ep.y >> 16));
        w.x = g.x * gelu_t(s.x * sh * t0.x) * t0.y; w.y = g.y * gelu_t(s.y * sh * t1.x) * t1.y; w.z = g.z * gelu_t(s.z * sh * t2.x) * t2.y; w.w = g.w * gelu_t(s.w * sh * t3.x) * t3.y;
        { const f32x4 ws_ = w * 256.0f; int pk = 0;
          pk = __builtin_amdgcn_cvt_pk_fp8_f32(fminf(fmaxf(ws_.x, -440.f), 440.f), fminf(fmaxf(ws_.y, -440.f), 440.f), pk, false);
          pk = __builtin_amdgcn_cvt_pk_fp8_f32(fminf(fmaxf(ws_.z, -440.f), 440.f), fminf(fmaxf(ws_.w, -440.f), 440.f), pk, true);
          *(unsigned*)(W + i * 4) = (unsigned)pk; } }
#undef PR_LOAD
}
__device__ __forceinline__ void final_norm(const Args& a, int wave, int lane) {
    const float* gf = a.in[I_GFIN]; const bf16* X2 = (const bf16*)(a.ws + WS_X1B);
    f32x4 g[4];
#pragma unroll
    for (int j = 0; j < 4; ++j) g[j] = *(const f32x4*)(gf + 256 * j + 4 * lane);
    const size_t stride = (size_t)gridDim.x * NWAVES; size_t row = (size_t)blockIdx.x * NWAVES + wave;
    if (row >= (size_t)M) return;
    v2u raw[4];
#pragma unroll
    for (int j = 0; j < 4; ++j) raw[j] = __builtin_nontemporal_load((const v2u*)(X2 + row * 1024 + 256 * j + 4 * lane));
    for (; row < (size_t)M; row += stride) {
        const size_t nrow = row + stride < (size_t)M ? row + stride : row; v2u rawn[4];
#pragma unroll
        for (int j = 0; j < 4; ++j) rawn[j] = __builtin_nontemporal_load((const v2u*)(X2 + nrow * 1024 + 256 * j + 4 * lane));
        f32x4 x[4]; float ss = 0.f;
#pragma unroll
        for (int j = 0; j < 4; ++j) x[j] = (f32x4){bflo(raw[j].x), bfhi(raw[j].x), bflo(raw[j].y), bfhi(raw[j].y)};
#pragma unroll
        for (int i = 0; i < 4; ++i) ss += (x[i].x * x[i].x + x[i].y * x[i].y) + (x[i].z * x[i].z + x[i].w * x[i].w);
        const float rstd = 1.0f / sqrtf(wave_sum(ss) * (1.0f / 1024.0f) + EPS);
#pragma unroll
        for (int j = 0; j < 4; ++j) __builtin_nontemporal_store(x[j] * rstd * g[j], (f32x4*)(a.out + row * 1024 + 256 * j + 4 * lane));
#pragma unroll
        for (int j = 0; j < 4; ++j) raw[j] = rawn[j]; }
}
__device__ __forceinline__ void phase_topk(const Args& a, LAS unsigned char* lds, int wave, int lane) {
    const bf16* Q = (const bf16*)(a.ws + WS_ZG); const bf16* KEYS = (const bf16*)(a.ws + WS_KEYS);
    const int G = gridDim.x, gw = blockIdx.x * NWAVES + wave, NGW = G * NWAVES;
    for (int grp = gw; grp < M / 32; grp += NGW) peer_topk32(Q, KEYS, (unsigned short*)(a.ws + WS_E), (bf16*)(a.ws + WS_G), lds + wave * 2560, lds + 20480 + wave * 17408, grp * 32, lane);
}
#define XB_TMO      128
#define XB_XCNT(j)  (256  + 64 * (j))
#define XB_XSUB(j)  (1280 + 64 * (j))
#define XB_XGEN(j)  (2304 + 64 * (j))
#define XB_TOP      3328
#define XB_TOPGEN   3392
#define XCD_BAR_WORDS 3456
#define XB_SPIN_CAP (1u << 18)

__device__ __forceinline__ unsigned xb_ld(unsigned* p)              { return __hip_atomic_load(p, __ATOMIC_RELAXED, __HIP_MEMORY_SCOPE_AGENT); }
__device__ __forceinline__ unsigned xb_add(unsigned* p, unsigned v) { return __hip_atomic_fetch_add(p, v, __ATOMIC_RELAXED, __HIP_MEMORY_SCOPE_AGENT); }
__device__ __forceinline__ unsigned xb_xcc_id() { return (unsigned)__builtin_amdgcn_s_getreg((3 << 11) | 20) & 0xFu; }
#define XB_SPIN(cond, bar) do { unsigned _sp = 0; while (cond) { __builtin_amdgcn_s_sleep(1); \
    if ((++_sp & 255u) == 0u) { if (xb_ld(&(bar)[XB_TMO])) break; if (_sp > XB_SPIN_CAP) { atomicAdd(&(bar)[XB_TMO], 1u); break; } } } } while (0)

struct XcdBarrier {
    unsigned* bar; unsigned x;
    volatile LAS unsigned* st;
};

__device__ __forceinline__ XcdBarrier xcd_barrier_post(unsigned* bar, volatile LAS unsigned* st) {
    XcdBarrier b; b.bar = bar; b.x = xb_xcc_id(); b.st = st;
    if (threadIdx.x == 0) (void)xb_add(&bar[XB_XCNT(b.x)], 1u);
    return b;
}
__device__ __forceinline__ void xcd_barrier_complete(unsigned* bar, unsigned x, unsigned& nloc, unsigned& nx) {
    const unsigned G = gridDim.x * gridDim.y * gridDim.z;
    unsigned sum, cnt, mine, sp = 0u;
    for (;;) {
        sum = 0u; cnt = 0u; mine = 0u;
#pragma unroll
        for (unsigned j = 0; j < 16; ++j) { const unsigned c = xb_ld(&bar[XB_XCNT(j)]); sum += c; cnt += (c > 0u) ? 1u : 0u; mine = (j == x) ? c : mine; }
        if (sum == G) break;
        __builtin_amdgcn_s_sleep(1);
        if ((++sp & 255u) == 0u) { if (xb_ld(&bar[XB_TMO])) break; if (sp > XB_SPIN_CAP) { atomicAdd(&bar[XB_TMO], 1u); break; } }
    }
    nloc = mine > 0u ? mine : 1u; nx = cnt > 0u ? cnt : 1u;
}

__device__ __forceinline__ void xcd_barrier(const XcdBarrier& b) {
    asm volatile("s_waitcnt vmcnt(0)" ::: "memory");
    __syncthreads();
    if (threadIdx.x == 0) {
        unsigned* bar = b.bar;
        __builtin_amdgcn_s_waitcnt(0);
        unsigned nloc = b.st[0], nx = b.st[1];
        if (nloc == 0u) { xcd_barrier_complete(bar, b.x, nloc, nx); b.st[0] = nloc; b.st[1] = nx; }
        const unsigned old = xb_add(&bar[XB_XSUB(b.x)], 1u);
        const unsigned gen = old / nloc;
        if (old + 1u == (gen + 1u) * nloc) {
            __builtin_amdgcn_fence(__ATOMIC_RELEASE, "agent");
            asm volatile("s_waitcnt vmcnt(0)" ::: "memory");
            const unsigned og = xb_add(&bar[XB_TOP], 1u);
            const unsigned tg = og / nx;
            if (og + 1u == (tg + 1u) * nx) xb_add(&bar[XB_TOPGEN], 1u);
            else XB_SPIN(xb_ld(&bar[XB_TOPGEN]) == tg, bar);
            __builtin_amdgcn_fence(__ATOMIC_ACQUIRE, "agent");
            xb_add(&bar[XB_XGEN(b.x)], 1u);
            asm volatile("s_waitcnt vmcnt(0)" ::: "memory");
        } else {
            XB_SPIN(xb_ld(&bar[XB_XGEN(b.x)]) == gen, bar);
            __builtin_amdgcn_fence(__ATOMIC_ACQUIRE, "agent");
            asm volatile("s_waitcnt vmcnt(0)" ::: "memory");
        }
    }
    __syncthreads();
}
constexpr int N_PHASES = 13;
__global__ void __launch_bounds__(NWAVES * 64, 2) hybrid_fwd(Args a) {
    extern __shared__ __attribute__((aligned(16))) unsigned char lds_raw[];
    LAS unsigned char* lds = (LAS unsigned char*)lds_raw;
    const int tid = threadIdx.x, lane = tid & 63, wave = __builtin_amdgcn_readfirstlane(tid >> 6);
    const int G = gridDim.x, bx = blockIdx.x;
    unsigned char* ws = a.ws;
    const float* MOD = (const float*)(ws + WS_MOD);
    const int lo = a.ph_lo, hi = a.ph_hi;
    if (tid < 16) ((LAS unsigned*)(lds + LDS_MISC_OFF))[tid] = 0u;
    __syncthreads();
    XcdBarrier xbar = xcd_barrier_post((unsigned*)(ws + WS_BAR), (volatile LAS unsigned*)(lds + LDS_MISC_OFF));
#ifndef REP_MASK
#define REP_MASK 0
#endif
#define IN(k) (lo <= (k) && (k) < hi)
#ifndef REPN
#define REPN 1
#endif
#define REPS(k) (1 + REPN * ((REP_MASK >> (k)) & 1))
#define SEAM(k) do { if (IN(k) && IN((k) + 1)) xcd_barrier(xbar); } while (0)
    if (hi > N_PHASES) cg::this_grid().sync();

    if (IN(0)) for (int rep_ = 0; rep_ < REPS(0); ++rep_) { phase_prologue(a, lds, tid, wave, lane); } SEAM(0);
    if (IN(1)) for (int rep_ = 0; rep_ < REPS(1); ++rep_) { phase_norm_mod(a.in[I_X], a.in[I_GMIX], MOD, 0, 1024, (bf16*)(ws + WS_H), wave, lane); } SEAM(1);
    if (IN(2)) for (int rep_ = 0; rep_ < REPS(2); ++rep_) { pg8::Gemm g{(const pg8::bf16_t*)(ws + WS_H), (const pg8::bf16_t*)(ws + WS_WIN), M, INW, DM}; pg8::StaticOrder S; S.init(M, INW, G, bx);
        pg8::EpiIn E{(pg8::bf16_t*)(ws + WS_ZG), (pg8::bf16_t*)(ws + WS_ZS)};
        pg8::gemm_phase<pg8::EpiIn, pg8::StaticOrder, true, true>(lds, g, S, E); } SEAM(2);
    if (IN(3)) for (int rep_ = 0; rep_ < REPS(3); ++rep_) { for (int it = bx; it < 256; it += G) s5_item(a, lds, it, wave, lane);
        for (int it = bx; it < 512; it += G) sgu_item(a, lds, it, wave, lane); } SEAM(3);
    if (IN(4)) for (int rep_ = 0; rep_ < REPS(4); ++rep_) { pg8::Gemm g{(const pg8::bf16_t*)(ws + WS_YS), (const pg8::bf16_t*)(ws + WS_WGLU), M, 512, 512}; pg8::StaticOrder S; S.init(M, 512, G, bx);
        pg8::EpiGlu E{(const pg8::bf16_t*)(ws + WS_YS), a.in[I_BGLU], (pg8::bf16_t*)(ws + WS_Y)};
        pg8::gemm_phase<pg8::EpiGlu, pg8::StaticOrder, true, true>(lds, g, S, E); } SEAM(4);
    if (IN(5)) for (int rep_ = 0; rep_ < REPS(5); ++rep_) { pg8::Gemm g{(const pg8::bf16_t*)(ws + WS_Y), (const pg8::bf16_t*)(ws + WS_WOUT), M, DM, DM}; pg8::StaticOrder S; S.init(M, DM, G, bx);
        pg8::EpiOut E{a.in[I_X], MOD, (pg8::bf16_t*)(ws + WS_X1B), lds};
        pg8::gemm_phase<pg8::EpiOut, pg8::StaticOrder, true, true>(lds, g, S, E); } SEAM(5);
    if (IN(6)) for (int rep_ = 0; rep_ < REPS(6); ++rep_) { phase_norm_mod_bf((const bf16*)(ws + WS_X1B), a.in[I_GFFN], MOD, 3072, 4096, (bf16*)(ws + WS_H), ws + WS_H2Q, (float*)(ws + WS_SH), wave, lane); } SEAM(6);
    if (IN(7)) for (int rep_ = 0; rep_ < REPS(7); ++rep_) { pg8::Gemm g{(const pg8::bf16_t*)(ws + WS_H), (const pg8::bf16_t*)(ws + WS_WQ), M, DM, DM}; pg8::StaticOrder S; S.init(M, DM, G, bx);
        pg8::EpiPlain E{(pg8::bf16_t*)(ws + WS_ZG), 1024};
        pg8::gemm_phase<pg8::EpiPlain, pg8::StaticOrder, true, true>(lds, g, S, E); } SEAM(7);
    if (IN(8)) for (int rep_ = 0; rep_ < REPS(8); ++rep_) { phase_topk(a, lds, wave, lane); } SEAM(8);
    if (IN(9)) for (int rep_ = 0; rep_ < REPS(9); ++rep_) { upass_wide(a, lds, wave, lane); } SEAM(9);
    if (IN(10)) for (int rep_ = 0; rep_ < REPS(10); ++rep_) { peer_reduce(a, lds, tid); } SEAM(10);
    if (IN(11)) for (int rep_ = 0; rep_ < REPS(11); ++rep_) { vpass_wide(a, lds, wave, lane); } SEAM(11);
    if (IN(12)) for (int rep_ = 0; rep_ < REPS(12); ++rep_) { final_norm(a, wave, lane); }
#undef IN
#undef SEAM
}

extern "C" void kernel_launch(void* const* d_in, const int* in_sizes, int n_in, void* d_out, int out_size, void* d_ws, size_t ws_size, hipStream_t stream) {
    static int grid = 0;
    if (grid == 0) {
        if (n_in != 27 || in_sizes[0] != M * DM || out_size != M * DM || ws_size < WS_END) { fprintf(stderr, "kernel_launch: unexpected problem (n_in %d, in0 %d, out %d, ws %zu); nothing launched\n", n_in, n_in > 0 ? in_sizes[0] : -1, out_size, ws_size); grid = -1; return; }
        int dev = 0, cus = 0, per_cu = 0;
        if (hipGetDevice(&dev) != hipSuccess || hipDeviceGetAttribute(&cus, hipDeviceAttributeMultiprocessorCount, dev) != hipSuccess) { grid = -1; return; }
        if (hipFuncSetAttribute((const void*)hybrid_fwd, hipFuncAttributeMaxDynamicSharedMemorySize, LDS_BYTES) != hipSuccess) { fprintf(stderr, "kernel_launch: hipFuncSetAttribute failed\n"); grid = -1; return; }
        if (hipOccupancyMaxActiveBlocksPerMultiprocessor(&per_cu, (const void*)hybrid_fwd, NWAVES * 64, LDS_BYTES) != hipSuccess || per_cu < 1) { fprintf(stderr, "kernel_launch: occupancy query failed (%d)\n", per_cu); (void)hipGetLastError(); per_cu = 1; }
        grid = cus * 1;
        if (per_cu < 1) grid = -1;
    }
    if (grid < 0) return;
    if (hipMemsetAsync((char*)d_ws + WS_BAR, 0, 16384, stream) != hipSuccess) { fprintf(stderr, "kernel_launch: hipMemsetAsync failed\n"); return; }
    Args a{};
    for (int i = 0; i < 27; ++i) a.in[i] = (const float*)d_in[i];
    a.out = (float*)d_out; a.ws = (unsigned char*)d_ws;
#if N_LAUNCHES == 1
    a.ph_lo = 0; a.ph_hi = N_PHASES;
    void* args[] = {&a};
    hipError_t e = hipLaunchCooperativeKernel((const void*)hybrid_fwd, dim3(grid), dim3(NWAVES * 64), args, LDS_BYTES, stream);
    if (e != hipSuccess) fprintf(stderr, "kernel_launch: cooperative launch failed: %s (grid %d)\n", hipGetErrorString(e), grid);
#else
    for (int p = 0; p < N_PHASES; ++p) { a.ph_lo = p; a.ph_hi = p + 1;
        hipLaunchKernelGGL(hybrid_fwd, dim3(grid), dim3(NWAVES * 64), LDS_BYTES, stream, a);
        const hipError_t le = hipPeekAtLastError(); if (le != hipSuccess) { fprintf(stderr, "kernel_launch: launch %d failed: %s\n", p, hipGetErrorName(le)); break; } }
#endif
}
```
